# Optimizing an MI355X kernel written in HIP

```python
import jax, jax.numpy as jnp
from jax import lax
import numpy as np

D_MODEL = 1024
BATCH = 2
SEQ = 8192
DEPTH = 2

GRID_W = 64
CTX_LEN = 256
D_MIX = D_MODEL
W_F = D_MIX // 4
W_ATT = D_MIX // 4
W_CONV = D_MIX // 4
W_POOL = D_MIX // 4
HEAD_DIM = 64
N_HEADS = W_ATT // HEAD_DIM
N_KV_HEADS = N_HEADS // 2
GQA = N_HEADS // N_KV_HEADS
KV_DIM = N_KV_HEADS * HEAD_DIM
ATT_SCALE = HEAD_DIM ** -0.5
ROPE_FREQS = HEAD_DIM // 4
ROPE_THETA = 10000.0
Q_BLOCK = 128
F_HEADS = 4
F_DIM = W_F // F_HEADS
CONV_W = 3
POOL_WINDOWS = (2, 4, 8, 16)
POOL_DIM = W_POOL // len(POOL_WINDOWS)
EPS = 1e-6
SPLIT_WIDTHS = (W_ATT, KV_DIM, KV_DIM, W_ATT, W_F, W_F, W_CONV, W_CONV, W_CONV, W_CONV, W_POOL, W_POOL)
D_IN = sum(SPLIT_WIDTHS)

kernel_name = "hymba_style_parallel_hybrid_dit"


def _split_cols(p):
    return jnp.split(p, np.cumsum(SPLIT_WIDTHS)[:-1].tolist(), axis=-1)


def _rmsnorm(x, g):
    xf = x.astype(jnp.float32)
    y = xf * lax.rsqrt(jnp.mean(xf * xf, axis=-1, keepdims=True) + EPS)
    return (y * g.astype(jnp.float32)).astype(x.dtype)


def _axial_angles(n):
    n_rows = n // GRID_W
    row = jnp.repeat(jnp.arange(n_rows), GRID_W).astype(jnp.float32)
    col = jnp.tile(jnp.arange(GRID_W), n_rows).astype(jnp.float32)
    inv = ROPE_THETA ** (-jnp.arange(ROPE_FREQS, dtype=jnp.float32) / ROPE_FREQS)
    return row[:, None] * inv, col[:, None] * inv


def _rotate(x, ang):
    f = ang.shape[-1]
    cos = jnp.cos(ang)[None, :, None, :].astype(x.dtype)
    sin = jnp.sin(ang)[None, :, None, :].astype(x.dtype)
    x1, x2 = x[..., :f], x[..., f:]
    return jnp.concatenate([x1 * cos - x2 * sin, x2 * cos + x1 * sin], axis=-1)


def _axial_rope(x, ang_row, ang_col):
    half = HEAD_DIM // 2
    return jnp.concatenate([_rotate(x[..., :half], ang_row), _rotate(x[..., half:], ang_col)], axis=-1)


def _latent_attention(q, k, v, kc, vc):
    b, s = q.shape[0], q.shape[1]
    nblk = s // Q_BLOCK
    k_all = jnp.concatenate([kc, k], axis=1)
    v_all = jnp.concatenate([vc, v], axis=1)
    qb = q.reshape(b, nblk, Q_BLOCK, N_KV_HEADS, GQA, HEAD_DIM).transpose(1, 0, 2, 3, 4, 5)

    def one_block(qi):
        sc = jnp.einsum('bqkgd,bskd->bkgqs', qi, k_all, preferred_element_type=jnp.float32)
        p = jax.nn.softmax(sc, axis=-1).astype(v_all.dtype)
        return jnp.einsum('bkgqs,bskd->bqkgd', p, v_all)

    o = lax.map(one_block, qb)
    return o.transpose(1, 0, 2, 3, 4, 5).reshape(b, s, W_ATT)


def _context_attention(qc, kc, vc):
    b, n = qc.shape[0], qc.shape[1]
    qg = qc.reshape(b, n, N_KV_HEADS, GQA, HEAD_DIM)
    sc = jnp.einsum('bqkgd,bskd->bkgqs', qg, kc, preferred_element_type=jnp.float32)
    p = jax.nn.softmax(sc, axis=-1).astype(vc.dtype)
    return jnp.einsum('bkgqs,bskd->bqkgd', p, vc).reshape(b, n, W_ATT)


def _fourier_branch(u, z, w_fourier):
    b, n, _ = u.shape
    uf = u.astype(jnp.float32).reshape(b, n, F_HEADS, F_DIM)
    y = jnp.fft.fftn(uf, axes=(1, 3), norm='ortho').real.reshape(b, n, W_F).astype(u.dtype)
    return jax.nn.silu(z) * (y @ w_fourier)


def _conv_branch(bg, cg, hv, z, conv_w, conv_b):
    t = cg * hv
    tp = jnp.pad(t, ((0, 0), (1, 1), (0, 0)))
    y = tp[:, :-2] * conv_w[0] + tp[:, 1:-1] * conv_w[1] + tp[:, 2:] * conv_w[2] + conv_b
    return jax.nn.silu(z) * (bg * y)


def _pool_branch(u, z, pool_w, pool_scale):
    b, n, _ = u.shape
    cs = jnp.cumsum(u.astype(jnp.float32), axis=1)
    cs = jnp.concatenate([jnp.zeros((b, 1, W_POOL), jnp.float32), cs], axis=1)
    pos = jnp.arange(n)
    outs = []
    for i, w in enumerate(POOL_WINDOWS):
        left = w // 2
        right = w - 1 - left
        lo = jnp.clip(pos - left, 0, n)
        hi = jnp.clip(pos + right + 1, 0, n)
        sl = slice(i * POOL_DIM, (i + 1) * POOL_DIM)
        mean = (cs[:, hi, sl] - cs[:, lo, sl]) / (hi - lo).astype(jnp.float32)[None, :, None]
        d = (mean - u[..., sl].astype(jnp.float32)).astype(u.dtype)
        outs.append(d @ pool_w[i])
    y = jnp.concatenate(outs, axis=-1) * pool_scale
    return jax.nn.silu(z) * y


def _local_branches(parts, w_fourier, conv_w, conv_b, pool_w, pool_scale):
    _, _, _, _, u_f, z_f, b_c, c_c, h_c, z_c, u_p, z_p = parts
    o_f = _fourier_branch(u_f, z_f, w_fourier)
    o_c = _conv_branch(b_c, c_c, h_c, z_c, conv_w, conv_b)
    o_p = _pool_branch(u_p, z_p, pool_w, pool_scale)
    return o_f, o_c, o_p


def _layer(x, xc, c, c_ctx, ang_row, ang_col, w_mod, b_mod, norm_g, w_in, q_gain, k_gain,
           w_fourier, conv_w, conv_b, pool_w, pool_scale, w_out, ctx_out):
    b, s, _ = x.shape
    n_ctx = xc.shape[1]
    shift, scale, gate = jnp.split(jax.nn.silu(c) @ w_mod + b_mod, 3, axis=-1)
    shift_c, scale_c, gate_c = jnp.split(jax.nn.silu(c_ctx) @ w_mod + b_mod, 3, axis=-1)
    h = _rmsnorm(x, norm_g) * (1.0 + scale[:, None]) + shift[:, None]
    hc = _rmsnorm(xc, norm_g) * (1.0 + scale_c) + shift_c

    parts = _split_cols(h @ w_in)
    if ctx_out:
        parts_c = _split_cols(hc @ w_in)
        kc_raw, vc_raw = parts_c[1], parts_c[2]
    else:
        kc_raw, vc_raw = jnp.split(hc @ w_in[:, W_ATT:W_ATT + 2 * KV_DIM], 2, axis=-1)
    kc = _rmsnorm(kc_raw.reshape(b, n_ctx, N_KV_HEADS, HEAD_DIM), k_gain)
    vc = vc_raw.reshape(b, n_ctx, N_KV_HEADS, HEAD_DIM)

    q = _rmsnorm(parts[0].reshape(b, s, N_HEADS, HEAD_DIM), q_gain)
    k = _rmsnorm(parts[1].reshape(b, s, N_KV_HEADS, HEAD_DIM), k_gain)
    v = parts[2].reshape(b, s, N_KV_HEADS, HEAD_DIM)
    q = _axial_rope(q, ang_row, ang_col) * ATT_SCALE
    k = _axial_rope(k, ang_row, ang_col)
    o_att = jax.nn.silu(parts[3]) * _latent_attention(q, k, v, kc, vc)
    o_f, o_c, o_p = _local_branches(parts, w_fourier, conv_w, conv_b, pool_w, pool_scale)
    out = jnp.concatenate([o_f, o_att, o_c, o_p], axis=-1) @ w_out
    x_new = x + gate[:, None] * out

    if ctx_out:
        qc = _rmsnorm(parts_c[0].reshape(b, n_ctx, N_HEADS, HEAD_DIM), q_gain) * ATT_SCALE
        oc_att = jax.nn.silu(parts_c[3]) * _context_attention(qc, kc, vc)
        oc_f, oc_c, oc_p = _local_branches(parts_c, w_fourier, conv_w, conv_b, pool_w, pool_scale)
        out_c = jnp.concatenate([oc_f, oc_att, oc_c, oc_p], axis=-1) @ w_out
        xc = xc + gate_c * out_c
    return x_new, xc


def setup_inputs(seed: int = 0) -> dict:
    key = jax.random.key(seed)
    ks = jax.random.split(key, 20)
    f32 = jnp.float32
    nrm = lambda k, shape: jax.random.normal(k, shape, f32)
    return {
        "x": nrm(ks[0], (BATCH, SEQ, D_MODEL)),
        "c": nrm(ks[1], (BATCH, D_MODEL)),
        "ctx": nrm(ks[2], (BATCH, CTX_LEN, D_MODEL)),
        "c_ctx": nrm(ks[3], (D_MODEL,)),
        "w_mod": nrm(ks[4], (DEPTH, D_MODEL, 3 * D_MODEL)) * (0.5 * D_MODEL ** -0.5),
        "b_mod": nrm(ks[5], (DEPTH, 3 * D_MODEL)) * 0.02,
        "norm_g": 1.0 + 0.05 * nrm(ks[6], (DEPTH, D_MODEL)),
        "w_in": nrm(ks[7], (DEPTH, D_MODEL, D_IN)) * D_MODEL ** -0.5,
        "q_gain": 1.0 + 0.05 * nrm(ks[8], (DEPTH, HEAD_DIM)),
        "k_gain": 1.0 + 0.05 * nrm(ks[9], (DEPTH, HEAD_DIM)),
        "w_fourier": nrm(ks[10], (DEPTH, W_F, W_F)) * W_F ** -0.5,
        "conv_w": nrm(ks[11], (DEPTH, CONV_W, W_CONV)) * CONV_W ** -0.5,
        "conv_b": nrm(ks[12], (DEPTH, W_CONV)) * 0.02,
        "pool_w": nrm(ks[13], (DEPTH, len(POOL_WINDOWS), POOL_DIM, POOL_DIM)) * POOL_DIM ** -0.5,
        "pool_scale": 1.0 + 0.1 * nrm(ks[14], (DEPTH, W_POOL)),
        "w_out": nrm(ks[15], (DEPTH, D_MIX, D_MODEL)) * D_MIX ** -0.5,
    }


def reference(x, c, ctx, c_ctx, w_mod, b_mod, norm_g, w_in, q_gain, k_gain,
              w_fourier, conv_w, conv_b, pool_w, pool_scale, w_out):
    ang_row, ang_col = _axial_angles(x.shape[1])
    xc = ctx
    for l in range(DEPTH):
        x, xc = _layer(x, xc, c, c_ctx, ang_row, ang_col, w_mod[l], b_mod[l], norm_g[l], w_in[l],
                       q_gain[l], k_gain[l], w_fourier[l], conv_w[l], conv_b[l], pool_w[l],
                       pool_scale[l], w_out[l], ctx_out=(l < DEPTH - 1))
    return x
```

```cpp
#include <hip/hip_runtime.h>
#include <hip/hip_cooperative_groups.h>
#include <stdint.h>
#include <cstdio>
namespace cg = cooperative_groups;

typedef unsigned short bf16_t;
typedef __attribute__((ext_vector_type(8))) short bf16x8;
typedef __attribute__((ext_vector_type(4))) short bf16x4;
typedef __attribute__((ext_vector_type(4))) float f32x4;
typedef __attribute__((ext_vector_type(16))) float f32x16;
#define DI __device__ __forceinline__

#define SEQ 8192
#define CTX 256
#define DM 1024
#define DIN 2816
#define ROWS_L 16384
#define ROWS_C 512
#define ROWS 16896
#define NKEY 8448
#define PW 2304
#define PC_ZATT 0
#define PC_UF 256
#define PC_ZF 512
#define PC_BC 768
#define PC_CC 1024
#define PC_HC 1280
#define PC_ZC 1536
#define PC_UP 1792
#define PC_ZP 2048

constexpr size_t OFF_BAR = 0;
constexpr size_t OFF_MODV = 16384;
constexpr size_t OFF_ROPE = OFF_MODV + 2 * 3 * 3072 * 4;
constexpr size_t OFF_TW = OFF_ROPE + 6144 * 4;
constexpr size_t OFF_F1 = OFF_TW + 8192 * 2 * 4;
constexpr size_t OFF_F2 = OFF_F1 + 256 * 128 * 2;
constexpr size_t OFF_FC = OFF_F2 + 128 * 128 * 2;
constexpr size_t OFF_WCOMB = OFF_FC + 512 * 256 * 2;
constexpr size_t OFF_WPOOL = OFF_WCOMB + 2 * 256 * 512 * 2;
constexpr size_t OFF_WTIN = 2097152;
constexpr size_t OFF_WTOUT = OFF_WTIN + (size_t)2 * DIN * DM * 2;
constexpr size_t OFF_H = OFF_WTOUT + (size_t)2 * DM * DM * 2;
constexpr size_t OFF_PARTS = OFF_H + (size_t)ROWS * DM * 2;
constexpr size_t OFF_Q = OFF_PARTS + (size_t)ROWS * PW * 2;
constexpr size_t OFF_QC = OFF_Q + (size_t)2 * 4 * SEQ * 64 * 2;
constexpr size_t OFF_K = OFF_QC + (size_t)2 * 4 * CTX * 64 * 2;
constexpr size_t OFF_VT = OFF_K + (size_t)2 * 2 * NKEY * 64 * 2;
constexpr size_t OFF_DBUF = OFF_VT + (size_t)2 * 2 * NKEY * 64 * 2;
constexpr size_t OFF_G1 = OFF_DBUF + (size_t)ROWS * 256 * 2;
constexpr size_t OFF_PCAT = OFF_G1 + (size_t)2 * 128 * 2 * 64 * 256 * 2;
constexpr size_t OFF_XC1 = OFF_PCAT + (size_t)ROWS * 512 * 2;
constexpr size_t WS_END = OFF_XC1 + (size_t)ROWS_C * DM * 4;
static_assert(OFF_WPOOL + 2 * 256 * 256 * 2 <= OFF_WTIN, "ws map");

struct Params {
    const float *x, *c, *ctx, *c_ctx, *w_mod, *b_mod, *norm_g, *w_in, *q_gain, *k_gain, *w_fourier, *conv_w, *conv_b, *pool_w, *pool_scale, *w_out;
    float* out;
    unsigned char* ws;
    int never;
    int pad;
};

DI bf16_t f2bf(float x) { unsigned u = __float_as_uint(x); u += 0x7fffu + ((u >> 16) & 1u); return (bf16_t)(u >> 16); }
DI float bf2f(bf16_t h) { return __uint_as_float(((unsigned)h) << 16); }
typedef __attribute__((ext_vector_type(2))) float f32x2;
typedef __attribute__((ext_vector_type(2))) __bf16 bf16x2v;
DI unsigned pack2(float a, float b) { const f32x2 v = {a, b}; return __builtin_bit_cast(unsigned, __builtin_convertvector(v, bf16x2v)); }
struct XIter { int u, end, step; };
DI XIter xiter(int ntiles) {
    const int x = blockIdx.x & 7, j = blockIdx.x >> 3, nb = gridDim.x >> 3, per = (ntiles + 7) >> 3;
    XIter r; r.u = x * per + j; r.end = min((x + 1) * per, ntiles); r.step = nb; return r;
}
DI float silu_f(float z) { return z / (1.f + __expf(-z)); }
DI float bflo(unsigned w) { return __uint_as_float(w << 16); }
DI float bfhi(unsigned w) { return __uint_as_float(w & 0xffff0000u); }
DI int otid() { int t = threadIdx.x; asm volatile("" : "+v"(t)); return t; }

#define XB_TMO      128
#define XB_XCNT(j)  (256  + 64 * (j))
#define XB_XSUB(j)  (1280 + 64 * (j))
#define XB_XGEN(j)  (2304 + 64 * (j))
#define XB_TOP      3328
#define XB_TOPGEN   3392
#define XCD_BAR_WORDS 3456
#define XB_SPIN_CAP (1u << 20)
#define LAS __attribute__((address_space(3)))
DI unsigned xb_ld(unsigned* p) { return __hip_atomic_load(p, __ATOMIC_RELAXED, __HIP_MEMORY_SCOPE_AGENT); }
DI unsigned xb_add(unsigned* p, unsigned v) { return __hip_atomic_fetch_add(p, v, __ATOMIC_RELAXED, __HIP_MEMORY_SCOPE_AGENT); }
DI unsigned xb_xcc_id() { return (unsigned)__builtin_amdgcn_s_getreg((3 << 11) | 20) & 0xFu; }
#define XB_SPIN(cond, bar) do { unsigned _sp = 0; while (cond) { __builtin_amdgcn_s_sleep(1); \
    if ((++_sp & 255u) == 0u) { if (xb_ld(&(bar)[XB_TMO])) break; if (_sp > XB_SPIN_CAP) { atomicAdd(&(bar)[XB_TMO], 1u); break; } } } } while (0)
struct XcdBarrier { unsigned* bar; unsigned x; volatile LAS unsigned* st; };
DI XcdBarrier xcd_barrier_post(unsigned* bar, volatile LAS unsigned* st) {
    XcdBarrier b; b.bar = bar; b.x = xb_xcc_id(); b.st = st;
    if (threadIdx.x == 0) (void)xb_add(&bar[XB_XCNT(b.x)], 1u);
    return b;
}
DI void xcd_barrier_complete(unsigned* bar, unsigned x, unsigned& nloc, unsigned& nx) {
    const unsigned G = gridDim.x * gridDim.y * gridDim.z;
    unsigned sum, cnt, mine, sp = 0u;
    for (;;) {
        sum = 0u; cnt = 0u; mine = 0u;
#pragma unroll
        for (unsigned j = 0; j < 16; ++j) { const unsigned c = xb_ld(&bar[XB_XCNT(j)]); sum += c; cnt += (c > 0u) ? 1u : 0u; mine = (j == x) ? c : mine; }
        if (sum == G) break;
        __builtin_amdgcn_s_sleep(1);
        if ((++sp & 255u) == 0u) { if (xb_ld(&bar[XB_TMO])) break; if (sp > XB_SPIN_CAP) { atomicAdd(&bar[XB_TMO], 1u); break; } }
    }
    nloc = mine > 0u ? mine : 1u; nx = cnt > 0u ? cnt : 1u;
}
DI void xcd_barrier(const XcdBarrier& b) {
    asm volatile("s_waitcnt vmcnt(0)" ::: "memory");
    __syncthreads();
    if (threadIdx.x == 0) {
        unsigned* bar = b.bar;
        __builtin_amdgcn_s_waitcnt(0);
        unsigned nloc = b.st[0], nx = b.st[1];
        if (nloc == 0u) { xcd_barrier_complete(bar, b.x, nloc, nx); b.st[0] = nloc; b.st[1] = nx; }
        const unsigned old = xb_add(&bar[XB_XSUB(b.x)], 1u);
        const unsigned gen = old / nloc;
        if (old + 1u == (gen + 1u) * nloc) {
            __builtin_amdgcn_fence(__ATOMIC_RELEASE, "agent");
            asm volatile("s_waitcnt vmcnt(0)" ::: "memory");
            const unsigned og = xb_add(&bar[XB_TOP], 1u);
            const unsigned tg = og / nx;
            if (og + 1u == (tg + 1u) * nx) xb_add(&bar[XB_TOPGEN], 1u);
            else XB_SPIN(xb_ld(&bar[XB_TOPGEN]) == tg, bar);
            __builtin_amdgcn_fence(__ATOMIC_ACQUIRE, "agent");
            xb_add(&bar[XB_XGEN(b.x)], 1u);
            asm volatile("s_waitcnt vmcnt(0)" ::: "memory");
        } else {
            XB_SPIN(xb_ld(&bar[XB_XGEN(b.x)]) == gen, bar);
            __builtin_amdgcn_fence(__ATOMIC_ACQUIRE, "agent");
            asm volatile("s_waitcnt vmcnt(0)" ::: "memory");
        }
    }
    __syncthreads();
}

#define LROW 72
#define TILE_E (128 * LROW)
#define SMEM_MAIN (4 * TILE_E * 2)
#define SMEM_BYTES (SMEM_MAIN + 16)

typedef __attribute__((ext_vector_type(4))) unsigned u32x4;
struct Stg { u32x4 a0, a1, a2, a3, b0, b1, b2, b3; };
template <bool BN>
DI u32x4 g_ld_b(const bf16_t* __restrict__ B, int ldb, int kt, int q) {
    if (!BN) return *(const u32x4*)(B + (size_t)(q >> 3) * ldb + kt * 64 + (q & 7) * 8);
    else     return *(const u32x4*)(B + (size_t)(kt * 64 + (q >> 4)) * ldb + (q & 15) * 8);
}
template <bool BN>
DI void g_load(Stg& r, const bf16_t* __restrict__ A, int lda, const bf16_t* __restrict__ B, int ldb, int kt, int tid) {
    const bf16_t* ap = A + (size_t)(tid >> 3) * lda + kt * 64 + (tid & 7) * 8;
    r.a0 = *(const u32x4*)(ap);
    r.a1 = *(const u32x4*)(ap + (size_t)32 * lda);
    r.a2 = *(const u32x4*)(ap + (size_t)64 * lda);
    r.a3 = *(const u32x4*)(ap + (size_t)96 * lda);
    r.b0 = g_ld_b<BN>(B, ldb, kt, tid);
    r.b1 = g_ld_b<BN>(B, ldb, kt, tid + 256);
    r.b2 = g_ld_b<BN>(B, ldb, kt, tid + 512);
    r.b3 = g_ld_b<BN>(B, ldb, kt, tid + 768);
}
template <bool BN>
DI void s_st_b(bf16_t* b, const u32x4 v, int q) {
    if (!BN) *(u32x4*)(b + (q >> 3) * LROW + (q & 7) * 8) = v;
    else {
        const int kr = q >> 4, n0 = (q & 15) * 8;
        b[(n0 + 0) * LROW + kr] = (bf16_t)(v.x & 0xffffu); b[(n0 + 1) * LROW + kr] = (bf16_t)(v.x >> 16);
        b[(n0 + 2) * LROW + kr] = (bf16_t)(v.y & 0xffffu); b[(n0 + 3) * LROW + kr] = (bf16_t)(v.y >> 16);
        b[(n0 + 4) * LROW + kr] = (bf16_t)(v.z & 0xffffu); b[(n0 + 5) * LROW + kr] = (bf16_t)(v.z >> 16);
        b[(n0 + 6) * LROW + kr] = (bf16_t)(v.w & 0xffffu); b[(n0 + 7) * LROW + kr] = (bf16_t)(v.w >> 16);
    }
}
template <bool BN>
DI void s_store(const Stg& r, bf16_t* smem, int buf, int tid) {
    bf16_t* a = smem + buf * 2 * TILE_E;
    bf16_t* b = a + TILE_E;
    bf16_t* ap = a + (tid >> 3) * LROW + (tid & 7) * 8;
    *(u32x4*)(ap) = r.a0;
    *(u32x4*)(ap + 32 * LROW) = r.a1;
    *(u32x4*)(ap + 64 * LROW) = r.a2;
    *(u32x4*)(ap + 96 * LROW) = r.a3;
    s_st_b<BN>(b, r.b0, tid);
    s_st_b<BN>(b, r.b1, tid + 256);
    s_st_b<BN>(b, r.b2, tid + 512);
    s_st_b<BN>(b, r.b3, tid + 768);
}
DI void mma_tile(const bf16_t* smem, int buf, f32x4 (&acc)[4][4], int wm, int wn, int lane) {
    const bf16_t* a = smem + buf * 2 * TILE_E;
    const bf16_t* b = a + TILE_E;
#pragma unroll
    for (int kk = 0; kk < 2; ++kk) {
        bf16x8 af[4], bfr[4];
#pragma unroll
        for (int mi = 0; mi < 4; ++mi) af[mi] = *(const bf16x8*)(a + (wm * 64 + mi * 16 + (lane & 15)) * LROW + kk * 32 + (lane >> 4) * 8);
#pragma unroll
        for (int ni = 0; ni < 4; ++ni) bfr[ni] = *(const bf16x8*)(b + (wn * 64 + ni * 16 + (lane & 15)) * LROW + kk * 32 + (lane >> 4) * 8);
#pragma unroll
        for (int mi = 0; mi < 4; ++mi)
#pragma unroll
            for (int ni = 0; ni < 4; ++ni) acc[mi][ni] = __builtin_amdgcn_mfma_f32_16x16x32_bf16(af[mi], bfr[ni], acc[mi][ni], 0, 0, 0);
    }
}
template <bool BN>
DI void gemm_core(const bf16_t* __restrict__ A, int lda, const bf16_t* __restrict__ B, int ldb, int K, f32x4 (&acc)[4][4], bf16_t* smem) {
    const int tid = otid(), lane = tid & 63, wave = tid >> 6;
    const int wm = wave >> 1, wn = wave & 1;
#pragma unroll
    for (int mi = 0; mi < 4; ++mi)
#pragma unroll
        for (int ni = 0; ni < 4; ++ni) acc[mi][ni] = (f32x4){0.f, 0.f, 0.f, 0.f};
    const int nk = K >> 6;
    Stg r0, r1;
    __syncthreads();
    g_load<BN>(r0, A, lda, B, ldb, 0, tid);
    g_load<BN>(r1, A, lda, B, ldb, 1, tid);
    s_store<BN>(r0, smem, 0, tid);
    __syncthreads();
    for (int kt = 0; kt < nk; kt += 2) {
        if (kt + 2 < nk) g_load<BN>(r0, A, lda, B, ldb, kt + 2, tid);
        mma_tile(smem, 0, acc, wm, wn, lane);
        s_store<BN>(r1, smem, 1, tid);
        __syncthreads();
        if (kt + 3 < nk) g_load<BN>(r1, A, lda, B, ldb, kt + 3, tid);
        mma_tile(smem, 1, acc, wm, wn, lane);
        if (kt + 2 < nk) s_store<BN>(r0, smem, 0, tid);
        __syncthreads();
    }
}
#define GT_E (128 * 64)
DI void glds_tile(const bf16_t* __restrict__ G, int ld, int kt, bf16_t* lt, int tid) {
    const int c = (tid & 7) ^ ((tid >> 4) & 7);
    const bf16_t* g = G + (size_t)(tid >> 3) * ld + kt * 64 + c * 8;
    char* l = (char*)lt + tid * 16;
#pragma unroll
    for (int p = 0; p < 4; ++p)
        __builtin_amdgcn_global_load_lds((const unsigned*)(g + (size_t)(p * 32) * ld), (LAS unsigned*)(l + p * 4096), 16, 0, 0);
}
DI void mma_tile_sw(const bf16_t* smem, int buf, f32x4 (&acc)[4][4], int wm, int wn, int lane) {
    const char* a = (const char*)(smem + buf * 2 * GT_E);
    const char* b = a + GT_E * 2;
    const int sw = (lane & 15) >> 1;
#pragma unroll
    for (int kk = 0; kk < 2; ++kk) {
        bf16x8 af[4], bfr[4];
        const int co = ((kk * 4 + (lane >> 4)) ^ sw) << 4;
#pragma unroll
        for (int mi = 0; mi < 4; ++mi) af[mi] = *(const bf16x8*)(a + (wm * 64 + mi * 16 + (lane & 15)) * 128 + co);
#pragma unroll
        for (int ni = 0; ni < 4; ++ni) bfr[ni] = *(const bf16x8*)(b + (wn * 64 + ni * 16 + (lane & 15)) * 128 + co);
#pragma unroll
        for (int mi = 0; mi < 4; ++mi)
#pragma unroll
            for (int ni = 0; ni < 4; ++ni) acc[mi][ni] = __builtin_amdgcn_mfma_f32_16x16x32_bf16(af[mi], bfr[ni], acc[mi][ni], 0, 0, 0);
    }
}
DI void gemm_core_dma(const bf16_t* __restrict__ A, int lda, const bf16_t* __restrict__ B, int ldb, int K, f32x4 (&acc)[4][4], bf16_t* smem) {
    const int tid = otid(), lane = tid & 63, wave = tid >> 6;
    const int wm = wave >> 1, wn = wave & 1;
#pragma unroll
    for (int mi = 0; mi < 4; ++mi)
#pragma unroll
        for (int ni = 0; ni < 4; ++ni) acc[mi][ni] = (f32x4){0.f, 0.f, 0.f, 0.f};
    const int nk = K >> 6;
    __syncthreads();
    glds_tile(A, lda, 0, smem, tid);
    glds_tile(B, ldb, 0, smem + GT_E, tid);
    for (int kt = 0; kt < nk; ++kt) {
        asm volatile("s_waitcnt vmcnt(0)" ::: "memory");
        __syncthreads();
        if (kt + 1 < nk) {
            bf16_t* nb = smem + ((kt + 1) & 1) * 2 * GT_E;
            glds_tile(A, lda, kt + 1, nb, tid);
            glds_tile(B, ldb, kt + 1, nb + GT_E, tid);
        }
        mma_tile_sw(smem, kt & 1, acc, wm, wn, lane);
    }
    __syncthreads();
}
#define ST_LD 132
DI void stage_acc(f32x4 (&acc)[4][4], float* st) {
    const int lane = otid() & 63, wave = otid() >> 6, wm = wave >> 1, wn = wave & 1, fl = lane & 15, g4 = lane >> 4;
#pragma unroll
    for (int mi = 0; mi < 4; ++mi)
#pragma unroll
        for (int ni = 0; ni < 4; ++ni)
#pragma unroll
            for (int j = 0; j < 4; ++j) st[(wm * 64 + mi * 16 + g4 * 4 + j) * ST_LD + wn * 64 + ni * 16 + fl] = acc[mi][ni][j];
    __syncthreads();
}
DI void ld8(const float* q, float (&v)[8]) {
    const float4 a = *(const float4*)q, b = *(const float4*)(q + 4);
    v[0] = a.x; v[1] = a.y; v[2] = a.z; v[3] = a.w; v[4] = b.x; v[5] = b.y; v[6] = b.z; v[7] = b.w;
}
DI uint4 pack8(const float (&v)[8]) { return make_uint4(pack2(v[0], v[1]), pack2(v[2], v[3]), pack2(v[4], v[5]), pack2(v[6], v[7])); }
DI void unpack8(const uint4 u, float (&v)[8]) {
    v[0] = bflo(u.x); v[1] = bfhi(u.x); v[2] = bflo(u.y); v[3] = bfhi(u.y); v[4] = bflo(u.z); v[5] = bfhi(u.z); v[6] = bflo(u.w); v[7] = bfhi(u.w);
}

DI void phase0_mod(const Params& p, float* smf) {
    const int tid = otid();
    float* modv = (float*)(p.ws + OFF_MODV);
    for (int it = blockIdx.x; it < 384; it += gridDim.x) {
        const int l = it / 192, n0 = (it % 192) * 16;
        __syncthreads();
        for (int i = tid; i < 3072; i += 256) {
            const int v = i >> 10, k = i & 1023;
            const float cv = (v == 0) ? p.c[k] : (v == 1) ? p.c[1024 + k] : p.c_ctx[k];
            smf[i] = silu_f(cv);
        }
        __syncthreads();
        const int col = tid & 15, kg = tid >> 4;
        float a0 = 0.f, a1 = 0.f, a2 = 0.f;
        const float* w = p.w_mod + (size_t)l * 1024 * 3072 + (size_t)(kg * 64) * 3072 + n0 + col;
        float wv[64];
#pragma unroll
        for (int kk = 0; kk < 64; ++kk) wv[kk] = w[(size_t)kk * 3072];
#pragma unroll
        for (int kk = 0; kk < 64; ++kk) { const int k = kg * 64 + kk; a0 += smf[k] * wv[kk]; a1 += smf[1024 + k] * wv[kk]; a2 += smf[2048 + k] * wv[kk]; }
        __syncthreads();
        smf[3072 + (kg * 3 + 0) * 16 + col] = a0; smf[3072 + (kg * 3 + 1) * 16 + col] = a1; smf[3072 + (kg * 3 + 2) * 16 + col] = a2;
        __syncthreads();
        if (tid < 48) {
            const int v = tid >> 4, cc = tid & 15;
            float s2 = 0.f;
#pragma unroll
            for (int g = 0; g < 16; ++g) s2 += smf[3072 + (g * 3 + v) * 16 + cc];
            modv[(l * 3 + v) * 3072 + n0 + cc] = s2 + p.b_mod[l * 3072 + n0 + cc];
        }
    }
}
DI void phase0(const Params& p, float* smf) {
    const int tid = otid();
    unsigned char* ws = p.ws;
    {
        const int n_in = 2 * 16 * 44, n_out = 2 * 16 * 16;
        for (int it = blockIdx.x; it < n_in + n_out; it += gridDim.x) {
            const float* src; bf16_t* dst; int N, kt, nt;
            if (it < n_in) { const int l = it / 704, r = it % 704; kt = r / 44; nt = r % 44; N = DIN; src = p.w_in + (size_t)l * DM * DIN; dst = (bf16_t*)(ws + OFF_WTIN) + (size_t)l * DIN * DM; }
            else { const int j = it - n_in; const int l = j / 256, r = j % 256; kt = r / 16; nt = r % 16; N = DM; src = p.w_out + (size_t)l * DM * DM; dst = (bf16_t*)(ws + OFF_WTOUT) + (size_t)l * DM * DM; }
            __syncthreads();
#pragma unroll
            for (int ps = 0; ps < 4; ++ps) {
                const int kr = ps * 16 + (tid >> 4), c4 = (tid & 15) * 4;
                const float4 v = *(const float4*)(src + (size_t)(kt * 64 + kr) * N + nt * 64 + c4);
                smf[kr * 65 + c4 + 0] = v.x; smf[kr * 65 + c4 + 1] = v.y; smf[kr * 65 + c4 + 2] = v.z; smf[kr * 65 + c4 + 3] = v.w;
            }
            __syncthreads();
            const int n = tid >> 2, ks = (tid & 3) * 16;
            unsigned w[8];
#pragma unroll
            for (int e = 0; e < 8; ++e) w[e] = pack2(smf[(ks + 2 * e) * 65 + n], smf[(ks + 2 * e + 1) * 65 + n]);
            bf16_t* d = dst + (size_t)(nt * 64 + n) * DM + kt * 64 + ks;
            *(uint4*)d = make_uint4(w[0], w[1], w[2], w[3]);
            *(uint4*)(d + 8) = make_uint4(w[4], w[5], w[6], w[7]);
        }
    }
    const int gtid = blockIdx.x * 256 + tid, gsz = gridDim.x * 256;
    {
        bf16_t* wc = (bf16_t*)(ws + OFF_WCOMB);
        __syncthreads();
        if (tid < 64) { smf[tid] = cospif((float)tid * (1.f / 32.f)); smf[64 + tid] = sinpif((float)tid * (1.f / 32.f)); }
        __syncthreads();
        for (int i = gtid; i < 2 * 512 * 256; i += gsz) {
            const int n = i & 255, kk = (i >> 8) & 511, l = i >> 17;
            const int c = kk >> 8, head = (kk >> 6) & 3, ch = kk & 63;
            const float* wf = p.w_fourier + (size_t)l * 65536 + (size_t)(head * 64) * 256 + n;
            float s = 0.f;
#pragma unroll 16
            for (int j = 0; j < 64; ++j) s += smf[c * 64 + ((j * ch) & 63)] * wf[j * 256];
            wc[(size_t)l * 131072 + n * 512 + kk] = f2bf(s);
        }
    }
    {
        bf16_t* wp = (bf16_t*)(ws + OFF_WPOOL);
        for (int i = gtid; i < 2 * 256 * 256; i += gsz) {
            const int k = i & 255, n = (i >> 8) & 255, l = i >> 16;
            float v = 0.f;
            if ((k >> 6) == (n >> 6)) v = p.pool_w[(size_t)l * 16384 + (n >> 6) * 4096 + (k & 63) * 64 + (n & 63)];
            wp[i] = f2bf(v);
        }
    }
    {
        float* tw = (float*)(ws + OFF_TW);
        for (int i = gtid; i < 8192; i += gsz) { const float a = (float)i * (1.f / 4096.f); tw[2 * i] = cospif(a); tw[2 * i + 1] = sinpif(a); }
        bf16_t* f1 = (bf16_t*)(ws + OFF_F1);
        for (int i = gtid; i < 256 * 128; i += gsz) {
            const int t1 = i & 127, m = i >> 7;
            const int k1 = (m >> 5) * 16 + (m & 15), c = (m >> 4) & 1;
            const float a = (float)((k1 * t1) & 127) * (1.f / 64.f);
            f1[i] = f2bf(c ? -sinpif(a) : cospif(a));
        }
        bf16_t* f2 = (bf16_t*)(ws + OFF_F2);
        for (int i = gtid; i < 128 * 128; i += gsz) {
            const int kx = i & 127, m = i >> 7;
            const int c = m >> 6, k2 = m & 63, cp = kx >> 6, t2 = kx & 63;
            const float a = (float)((k2 * t2) & 63) * (1.f / 32.f);
            float v;
            if (c == cp) v = cospif(a); else if (c == 0) v = sinpif(a); else v = -sinpif(a);
            f2[i] = f2bf(v);
        }
        bf16_t* fc = (bf16_t*)(ws + OFF_FC);
        for (int i = gtid; i < 512 * 256; i += gsz) {
            const int t = i & 255, m = i >> 8;
            const int c = m >> 8, k = m & 255;
            const float a = (float)((k * t) & 255) * (1.f / 128.f);
            fc[i] = f2bf(c ? -sinpif(a) : cospif(a));
        }
        float* rp = (float*)(ws + OFF_ROPE);
        for (int i = gtid; i < 3072; i += gsz) {
            const int f = i & 15;
            const int pos = (i < 2048) ? (i >> 4) : ((i - 2048) >> 4);
            const float inv = powf(10000.f, -(float)f * (1.f / 16.f));
            const float ang = (float)pos * inv;
            const double ad = (double)ang;
            const float cs = (float)cos(ad), sn = (float)sin(ad);
            if (i < 2048) { rp[i] = cs; rp[2048 + i] = sn; }
            else { rp[4096 + (i - 2048)] = cs; rp[5120 + (i - 2048)] = sn; }
        }
    }
}

DI void phase_norm(const Params& p, int l, const float* xl, const float* xc) {
    const int lane = otid() & 63, wave = otid() >> 6;
    const float* modv = (const float*)(p.ws + OFF_MODV) + (size_t)l * 3 * 3072;
    const float* g = p.norm_g + l * 1024;
    bf16_t* H = (bf16_t*)(p.ws + OFF_H);
    for (int row = blockIdx.x * 4 + wave; row < ROWS; row += gridDim.x * 4) {
        const float* src = (row < ROWS_L) ? xl + (size_t)row * DM : xc + (size_t)(row - ROWS_L) * DM;
        const int v = (row < ROWS_L) ? (row >> 13) : 2;
        const float* mv = modv + v * 3072;
        float4 a[4];
        float ss = 0.f;
#pragma unroll
        for (int i = 0; i < 4; ++i) { a[i] = *(const float4*)(src + i * 256 + lane * 4); ss += a[i].x * a[i].x + a[i].y * a[i].y + a[i].z * a[i].z + a[i].w * a[i].w; }
#pragma unroll
        for (int o = 32; o >= 1; o >>= 1) ss += __shfl_xor(ss, o);
        const float rs = rsqrtf(ss * (1.f / 1024.f) + 1e-6f);
#pragma unroll
        for (int i = 0; i < 4; ++i) {
            const int c0 = i * 256 + lane * 4;
            const float4 gg = *(const float4*)(g + c0), sh = *(const float4*)(mv + c0), sc = *(const float4*)(mv + 1024 + c0);
            const float o0 = a[i].x * rs * gg.x * (1.f + sc.x) + sh.x, o1 = a[i].y * rs * gg.y * (1.f + sc.y) + sh.y;
            const float o2 = a[i].z * rs * gg.z * (1.f + sc.z) + sh.z, o3 = a[i].w * rs * gg.w * (1.f + sc.w) + sh.w;
            *(uint2*)(H + (size_t)row * DM + c0) = make_uint2(pack2(o0, o1), pack2(o2, o3));
        }
    }
}

DI void epi_inproj(const Params& p, int l, int tm, int tn, f32x4 (&acc)[4][4], float* st) {
    const int tid = otid();
    unsigned char* ws = p.ws;
    stage_acc(acc, st);
    const int rbase = tm * 128;
    const bool isctx = rbase >= ROWS_L;
    if (tn < 3) {
        const bool isq = tn < 2;
        const float* gain = (isq ? p.q_gain : p.k_gain) + l * 64;
        const float* rp = (const float*)(ws + OFF_ROPE);
#pragma unroll 1
        for (int i = 0; i < 8; ++i) {
            const int q = tid + 256 * i, rl = q >> 4, c8 = (q & 15) * 8;
            const int row = rbase + rl, hd = c8 >> 6, d0 = c8 & 63;
            float v[8], pv[8], g[8], pg[8];
            ld8(st + rl * ST_LD + c8, v);
            ld8(st + rl * ST_LD + (c8 ^ 16), pv);
            ld8(gain + d0, g);
            ld8(gain + (d0 ^ 16), pg);
            float ss = 0.f;
#pragma unroll
            for (int e = 0; e < 8; ++e) ss += v[e] * v[e];
            ss += __shfl_xor(ss, 1); ss += __shfl_xor(ss, 2); ss += __shfl_xor(ss, 4);
            const float rs = rsqrtf(ss * (1.f / 64.f) + 1e-6f);
#pragma unroll
            for (int e = 0; e < 8; ++e) { v[e] *= rs * g[e]; pv[e] *= rs * pg[e]; }
            bf16_t* dst;
            if (!isctx) {
                const int b = row >> 13, t = row & 8191;
                const int pos = (d0 >= 32) ? (t & 63) : (t >> 6);
                const float* ct = rp + ((d0 >= 32) ? 4096 : 0) + pos * 16 + (d0 & 8);
                float cs[8], sn[8];
                ld8(ct, cs);
                ld8(ct + ((d0 >= 32) ? 1024 : 2048), sn);
                const float sg = (d0 & 16) ? 1.f : -1.f;
#pragma unroll
                for (int e = 0; e < 8; ++e) v[e] = v[e] * cs[e] + sg * pv[e] * sn[e];
                if (isq) dst = (bf16_t*)(ws + OFF_Q) + ((size_t)(b * 4 + tn * 2 + hd) * SEQ + t) * 64 + d0;
                else     dst = (bf16_t*)(ws + OFF_K) + ((size_t)(b * 2 + hd) * NKEY + CTX + t) * 64 + d0;
            } else {
                const int rc = row - ROWS_L, b = rc >> 8, t = rc & 255;
                if (isq) dst = (bf16_t*)(ws + OFF_QC) + ((size_t)(b * 4 + tn * 2 + hd) * CTX + t) * 64 + d0;
                else     dst = (bf16_t*)(ws + OFF_K) + ((size_t)(b * 2 + hd) * NKEY + t) * 64 + d0;
            }
            if (isq) {
#pragma unroll
                for (int e = 0; e < 8; ++e) v[e] *= 0.18033688011112042f;
            }
            *(uint4*)dst = pack8(v);
        }
    } else if (tn == 3) {
        int b, key0;
        if (!isctx) { b = rbase >> 13; key0 = CTX + (rbase & 8191); } else { const int rc = rbase - ROWS_L; b = rc >> 8; key0 = rc & 255; }
#pragma unroll 1
        for (int i = 0; i < 8; ++i) {
            const int q = tid + 256 * i, col = q & 127, r8 = (q >> 7) * 8;
            float v[8];
#pragma unroll
            for (int e = 0; e < 8; ++e) v[e] = st[(r8 + e) * ST_LD + col];
            bf16_t* vt = (bf16_t*)(ws + OFF_VT) + ((size_t)(b * 2 + (col >> 6)) * 64 + (col & 63)) * NKEY + key0 + (r8 & ~15);
            const uint4 pk = pack8(v);
            *(uint2*)(vt + ((r8 & 8) ? 4 : 0)) = make_uint2(pk.x, pk.y);
            *(uint2*)(vt + ((r8 & 8) ? 12 : 8)) = make_uint2(pk.z, pk.w);
        }
    } else {
        bf16_t* parts = (bf16_t*)(ws + OFF_PARTS);
#pragma unroll 1
        for (int i = 0; i < 8; ++i) {
            const int q = tid + 256 * i, rl = q >> 4, c8 = (q & 15) * 8;
            float v[8];
            ld8(st + rl * ST_LD + c8, v);
            *(uint4*)(parts + (size_t)(rbase + rl) * PW + tn * 128 - 512 + c8) = pack8(v);
        }
    }
}

DI void phase_inproj(const Params& p, int l, bf16_t* smem) {
    const bf16_t* H = (const bf16_t*)(p.ws + OFF_H);
    const bf16_t* W = (const bf16_t*)(p.ws + OFF_WTIN) + (size_t)l * DIN * DM;
    const int nlat = 128 * 22;
    const int ntiles = nlat + (l == 0 ? 4 * 22 : 4 * 2);
    for (XIter t = xiter(ntiles); t.u < t.end; t.u += t.step) {
        const int u = t.u;
        int tm, tn;
        if (u < nlat) { const int ch = u / 176, r = u % 176; tn = r >> 3; tm = ch * 8 + (r & 7); }
        else { const int j = u - nlat; tm = 128 + (j & 3); tn = (l == 0 ? 0 : 2) + (j >> 2); }
        f32x4 acc[4][4];
        gemm_core_dma(H + (size_t)tm * 128 * DM, DM, W + (size_t)tn * 128 * DM, DM, DM, acc, smem);
        epi_inproj(p, l, tm, tn, acc, (float*)smem);
    }
}

#define KT_E (64 * LROW)
DI void attn_dma_tile(const bf16_t* __restrict__ kg, const bf16_t* __restrict__ vg, int kt, bf16_t* stage, int tid) {
    char* l = (char*)stage + tid * 16;
    const bf16_t* k0 = kg + (size_t)kt * 4096;
    const bf16_t* v0 = vg + kt * 64;
    __builtin_amdgcn_global_load_lds((const unsigned*)(k0), (LAS unsigned*)(l), 16, 0, 0);
    __builtin_amdgcn_global_load_lds((const unsigned*)(k0 + 2048), (LAS unsigned*)(l + 4096), 16, 0, 0);
    __builtin_amdgcn_global_load_lds((const unsigned*)(v0), (LAS unsigned*)(l + 8192), 16, 0, 0);
    __builtin_amdgcn_global_load_lds((const unsigned*)(v0 + (size_t)32 * NKEY), (LAS unsigned*)(l + 12288), 16, 0, 0);
}
DI void attn_item(const Params& p, const bf16_t* __restrict__ Qb, const bf16_t* __restrict__ Kb, const bf16_t* __restrict__ VTb, int ntiles, int rowbase, int hq, bf16_t* smem) {
    const int tid = otid(), lane = tid & 63, wave = tid >> 6;
    const int r = lane & 31, h = lane >> 5;
    bf16x8 qf[4];
    {
        const bf16_t* qrow = Qb + (size_t)(wave * 32 + r) * 64;
#pragma unroll
        for (int s = 0; s < 4; ++s) qf[s] = *(const bf16x8*)(qrow + s * 16 + h * 8);
    }
    f32x16 ot[2], minit;
#pragma unroll
    for (int i = 0; i < 16; ++i) { ot[0][i] = 0.f; ot[1][i] = 0.f; minit[i] = 0.f; }
    float m = 0.f, lsum = 0.f;
    const int csw = (tid & 7) ^ ((tid >> 4) & 7);
    const bf16_t* kg = Kb + (size_t)(tid >> 3) * 64 + csw * 8;
    const bf16_t* vg = VTb + (size_t)(tid >> 3) * NKEY + csw * 8;
    const int rsw = (r >> 1) & 7;
    const unsigned lds0 = (unsigned)(size_t)smem;
    const unsigned ka0 = r * 128 + (((0 + h) ^ rsw) << 4), ka1 = r * 128 + (((2 + h) ^ rsw) << 4), ka2 = r * 128 + (((4 + h) ^ rsw) << 4), ka3 = r * 128 + (((6 + h) ^ rsw) << 4);
    const unsigned va0 = ka0, va1 = ka1, va2 = ka2, va3 = ka3;
    __syncthreads();
    attn_dma_tile(kg, vg, 0, smem, tid);
    if (ntiles > 1) attn_dma_tile(kg, vg, 1, smem + 8192, tid);
    if (ntiles > 2) attn_dma_tile(kg, vg, 2, smem + 16384, tid);
    for (int kt = 0; kt < ntiles; ++kt) {
        if (kt + 2 < ntiles) asm volatile("s_waitcnt vmcnt(8)" ::: "memory");
        else if (kt + 1 < ntiles) asm volatile("s_waitcnt vmcnt(4)" ::: "memory");
        else asm volatile("s_waitcnt vmcnt(0)" ::: "memory");
        __builtin_amdgcn_s_barrier();
        if (kt + 3 < ntiles) attn_dma_tile(kg, vg, kt + 3, smem + ((kt + 3) & 3) * 8192, tid);
        const unsigned sb = lds0 + (unsigned)(kt & 3) * 16384u;
        const unsigned a0 = sb + ka0, a1 = sb + ka1, a2 = sb + ka2, a3 = sb + ka3;
        bf16x8 kf0, kf1, kf2, kf3, kf4, kf5, kf6, kf7;
        asm volatile("ds_read_b128 %0, %8\n\tds_read_b128 %1, %9\n\tds_read_b128 %2, %10\n\tds_read_b128 %3, %11\n\t"
                     "ds_read_b128 %4, %8 offset:4096\n\tds_read_b128 %5, %9 offset:4096\n\tds_read_b128 %6, %10 offset:4096\n\tds_read_b128 %7, %11 offset:4096\n\t"
                     "s_waitcnt lgkmcnt(0)"
                     : "=&v"(kf0), "=&v"(kf1), "=&v"(kf2), "=&v"(kf3), "=&v"(kf4), "=&v"(kf5), "=&v"(kf6), "=&v"(kf7)
                     : "v"(a0), "v"(a1), "v"(a2), "v"(a3) : "memory");
        f32x16 st[2], pe[2];
        st[0] = __builtin_amdgcn_mfma_f32_32x32x16_bf16(kf0, qf[0], minit, 0, 0, 0);
        st[1] = __builtin_amdgcn_mfma_f32_32x32x16_bf16(kf4, qf[0], minit, 0, 0, 0);
        st[0] = __builtin_amdgcn_mfma_f32_32x32x16_bf16(kf1, qf[1], st[0], 0, 0, 0);
        st[1] = __builtin_amdgcn_mfma_f32_32x32x16_bf16(kf5, qf[1], st[1], 0, 0, 0);
        st[0] = __builtin_amdgcn_mfma_f32_32x32x16_bf16(kf2, qf[2], st[0], 0, 0, 0);
        st[1] = __builtin_amdgcn_mfma_f32_32x32x16_bf16(kf6, qf[2], st[1], 0, 0, 0);
        st[0] = __builtin_amdgcn_mfma_f32_32x32x16_bf16(kf3, qf[3], st[0], 0, 0, 0);
        st[1] = __builtin_amdgcn_mfma_f32_32x32x16_bf16(kf7, qf[3], st[1], 0, 0, 0);
        bf16x8 vf0, vf1, vf2, vf3, vf4, vf5, vf6, vf7;
        asm volatile("ds_read_b128 %0, %8 offset:8192\n\tds_read_b128 %1, %9 offset:8192\n\tds_read_b128 %2, %10 offset:8192\n\tds_read_b128 %3, %11 offset:8192\n\t"
                     "ds_read_b128 %4, %8 offset:12288\n\tds_read_b128 %5, %9 offset:12288\n\tds_read_b128 %6, %10 offset:12288\n\tds_read_b128 %7, %11 offset:12288\n\t"
                     "s_waitcnt lgkmcnt(0)"
                     : "=&v"(vf0), "=&v"(vf1), "=&v"(vf2), "=&v"(vf3), "=&v"(vf4), "=&v"(vf5), "=&v"(vf6), "=&v"(vf7)
                     : "v"(sb + va0), "v"(sb + va1), "v"(sb + va2), "v"(sb + va3) : "memory");
        float ls = 0.f;
#pragma unroll
        for (int i = 0; i < 16; ++i) {
            pe[0][i] = __builtin_amdgcn_exp2f(st[0][i]); ls += pe[0][i];
            pe[1][i] = __builtin_amdgcn_exp2f(st[1][i]); ls += pe[1][i];
        }
        if (kt == 0 || __any(!(ls <= 256.f))) {
            float tmx = st[0][0];
#pragma unroll
            for (int i = 0; i < 16; ++i) { tmx = fmaxf(tmx, st[0][i]); tmx = fmaxf(tmx, st[1][i]); }
            tmx = fmaxf(tmx, __shfl_xor(tmx, 32));
            const float delta = (kt == 0) ? tmx : fmaxf(tmx, 0.f);
            const float alpha = (kt == 0) ? 1.f : __builtin_amdgcn_exp2f(-delta);
            m += delta;
            lsum *= alpha;
            ls = 0.f;
#pragma unroll
            for (int i = 0; i < 16; ++i) {
                ot[0][i] *= alpha; ot[1][i] *= alpha; minit[i] = -m;
                pe[0][i] = __builtin_amdgcn_exp2f(st[0][i] - delta); ls += pe[0][i];
                pe[1][i] = __builtin_amdgcn_exp2f(st[1][i] - delta); ls += pe[1][i];
            }
        }
        lsum += ls;
        bf16x8 pk[2][2];
#pragma unroll
        for (int blk = 0; blk < 2; ++blk)
#pragma unroll
            for (int s = 0; s < 2; ++s) {
                u32x4 u;
                u.x = pack2(pe[blk][8 * s + 0], pe[blk][8 * s + 1]); u.y = pack2(pe[blk][8 * s + 2], pe[blk][8 * s + 3]);
                u.z = pack2(pe[blk][8 * s + 4], pe[blk][8 * s + 5]); u.w = pack2(pe[blk][8 * s + 6], pe[blk][8 * s + 7]);
                pk[blk][s] = __builtin_bit_cast(bf16x8, u);
            }
        ot[0] = __builtin_amdgcn_mfma_f32_32x32x16_bf16(vf0, pk[0][0], ot[0], 0, 0, 0);
        ot[1] = __builtin_amdgcn_mfma_f32_32x32x16_bf16(vf4, pk[0][0], ot[1], 0, 0, 0);
        ot[0] = __builtin_amdgcn_mfma_f32_32x32x16_bf16(vf1, pk[0][1], ot[0], 0, 0, 0);
        ot[1] = __builtin_amdgcn_mfma_f32_32x32x16_bf16(vf5, pk[0][1], ot[1], 0, 0, 0);
        ot[0] = __builtin_amdgcn_mfma_f32_32x32x16_bf16(vf2, pk[1][0], ot[0], 0, 0, 0);
        ot[1] = __builtin_amdgcn_mfma_f32_32x32x16_bf16(vf6, pk[1][0], ot[1], 0, 0, 0);
        ot[0] = __builtin_amdgcn_mfma_f32_32x32x16_bf16(vf3, pk[1][1], ot[0], 0, 0, 0);
        ot[1] = __builtin_amdgcn_mfma_f32_32x32x16_bf16(vf7, pk[1][1], ot[1], 0, 0, 0);
    }
    lsum += __shfl_xor(lsum, 32);
    const float inv = 1.f / lsum;
    const int row = rowbase + wave * 32 + r;
    const bf16_t* zrow = (const bf16_t*)(p.ws + OFF_PARTS) + (size_t)row * PW + PC_ZATT + hq * 64;
    bf16_t* orow = (bf16_t*)(p.ws + OFF_H) + (size_t)row * DM + 256 + hq * 64;
#pragma unroll
    for (int db = 0; db < 2; ++db)
#pragma unroll
        for (int g = 0; g < 4; ++g) {
            const int d = db * 32 + g * 8 + h * 4;
            const uint2 z = *(const uint2*)(zrow + d);
            const float o0 = silu_f(bflo(z.x)) * ot[db][4 * g + 0] * inv, o1 = silu_f(bfhi(z.x)) * ot[db][4 * g + 1] * inv;
            const float o2 = silu_f(bflo(z.y)) * ot[db][4 * g + 2] * inv, o3 = silu_f(bfhi(z.y)) * ot[db][4 * g + 3] * inv;
            *(uint2*)(orow + d) = make_uint2(pack2(o0, o1), pack2(o2, o3));
        }
}

DI void phase_attn(const Params& p, int l, bf16_t* smem) {
    const bf16_t* Q = (const bf16_t*)(p.ws + OFF_Q);
    const bf16_t* QC = (const bf16_t*)(p.ws + OFF_QC);
    const bf16_t* Kk = (const bf16_t*)(p.ws + OFF_K);
    const bf16_t* VT = (const bf16_t*)(p.ws + OFF_VT);
    for (XIter t = xiter(512); t.u < t.end; t.u += t.step) {
        const int it = t.u;
        const int b = it >> 8, hq = (it >> 6) & 3, qt = it & 63;
        const size_t kv = (size_t)(b * 2 + (hq >> 1));
        attn_item(p, Q + ((size_t)(b * 4 + hq) * SEQ + qt * 128) * 64, Kk + kv * NKEY * 64, VT + kv * 64 * NKEY, NKEY / 64, b * SEQ + qt * 128, hq, smem);
    }
    if (l == 0) {
        for (int j = blockIdx.x; j < 16; j += gridDim.x) {
            const int b = j >> 3, hq = (j >> 1) & 3, qt = j & 1;
            const size_t kv = (size_t)(b * 2 + (hq >> 1));
            attn_item(p, QC + ((size_t)(b * 4 + hq) * CTX + qt * 128) * 64, Kk + kv * NKEY * 64, VT + kv * 64 * NKEY, CTX / 64, ROWS_L + b * CTX + qt * 128, hq, smem);
        }
    }
}

DI void phase_convpool(const Params& p, int l) {
    const bf16_t* __restrict__ parts = (const bf16_t*)(p.ws + OFF_PARTS);
    bf16_t* __restrict__ cat = (bf16_t*)(p.ws + OFF_H);
    bf16_t* __restrict__ dbuf = (bf16_t*)(p.ws + OFF_DBUF);
    const int nrows = (l == 0 ? ROWS : ROWS_L);
    const int gsz = gridDim.x * 256;
    for (int i = blockIdx.x * 256 + otid(); i < nrows * 32; i += gsz) {
        const int row = i >> 5, c8 = (i & 31) * 8;
        int seq0, n;
        if (row < ROWS_L) { seq0 = (row >> 13) << 13; n = SEQ; } else { seq0 = ROWS_L + (((row - ROWS_L) >> 8) << 8); n = CTX; }
        const int pos = row - seq0;
        const bf16_t* pr = parts + (size_t)row * PW + c8;
        {
            float cc[8], hc[8], tp[8], tc[8], tn[8], w0[8], w1[8], w2[8], bs[8], bc[8], zc[8], o[8];
            unpack8(*(const uint4*)(pr + PC_CC), cc); unpack8(*(const uint4*)(pr + PC_HC), hc);
#pragma unroll
            for (int e = 0; e < 8; ++e) tc[e] = cc[e] * hc[e];
            if (pos > 0) {
                unpack8(*(const uint4*)(pr - PW + PC_CC), cc); unpack8(*(const uint4*)(pr - PW + PC_HC), hc);
#pragma unroll
                for (int e = 0; e < 8; ++e) tp[e] = cc[e] * hc[e];
            } else {
#pragma unroll
                for (int e = 0; e < 8; ++e) tp[e] = 0.f;
            }
            if (pos + 1 < n) {
                unpack8(*(const uint4*)(pr + PW + PC_CC), cc); unpack8(*(const uint4*)(pr + PW + PC_HC), hc);
#pragma unroll
                for (int e = 0; e < 8; ++e) tn[e] = cc[e] * hc[e];
            } else {
#pragma unroll
                for (int e = 0; e < 8; ++e) tn[e] = 0.f;
            }
            ld8(p.conv_w + l * 768 + c8, w0); ld8(p.conv_w + l * 768 + 256 + c8, w1); ld8(p.conv_w + l * 768 + 512 + c8, w2); ld8(p.conv_b + l * 256 + c8, bs);
            unpack8(*(const uint4*)(pr + PC_BC), bc); unpack8(*(const uint4*)(pr + PC_ZC), zc);
#pragma unroll
            for (int e = 0; e < 8; ++e) o[e] = silu_f(zc[e]) * (bc[e] * (tp[e] * w0[e] + tc[e] * w1[e] + tn[e] * w2[e] + bs[e]));
            *(uint4*)(cat + (size_t)row * DM + 512 + c8) = pack8(o);
        }
        {
            const int g = c8 >> 6, w = 2 << g, left = w >> 1, right = w - 1 - left;
            const int lo = max(pos - left, 0), hi = min(pos + right + 1, n);
            float sum[8], u[8];
#pragma unroll
            for (int e = 0; e < 8; ++e) sum[e] = 0.f;
            const bf16_t* pu = parts + (size_t)seq0 * PW + PC_UP + c8;
#pragma unroll 4
            for (int q = lo; q < hi; ++q) {
                unpack8(*(const uint4*)(pu + (size_t)q * PW), u);
#pragma unroll
                for (int e = 0; e < 8; ++e) sum[e] += u[e];
            }
            unpack8(*(const uint4*)(pr + PC_UP), u);
            const float ic = 1.f / (float)(hi - lo);
#pragma unroll
            for (int e = 0; e < 8; ++e) sum[e] = sum[e] * ic - u[e];
            *(uint4*)(dbuf + (size_t)row * 256 + c8) = pack8(sum);
        }
    }
}

DI void phase_dft1(const Params& p, int l, bf16_t* smem) {
    const int tid = otid();
    float* st = (float*)smem;
    const bf16_t* parts = (const bf16_t*)(p.ws + OFF_PARTS);
    const bf16_t* F1 = (const bf16_t*)(p.ws + OFF_F1);
    const bf16_t* FC = (const bf16_t*)(p.ws + OFF_FC);
    const float* tw = (const float*)(p.ws + OFF_TW);
    bf16_t* G1 = (bf16_t*)(p.ws + OFF_G1);
    bf16_t* pcat = (bf16_t*)(p.ws + OFF_PCAT);
    const int nt1 = 2 * 64 * 4;
    const int ntot = nt1 + (l == 0 ? 16 : 0);
    for (int it = blockIdx.x; it < ntot; it += gridDim.x) {
        f32x4 acc[4][4];
        if (it < nt1) {
            const int b = it >> 8, t2 = (it >> 2) & 63, mt = (it >> 1) & 1, nt = it & 1;
            gemm_core<true>(F1 + (size_t)mt * 128 * 128, 128, parts + (size_t)(b * SEQ + t2) * PW + PC_UF + nt * 128, 64 * PW, 128, acc, smem);
            stage_acc(acc, st);
#pragma unroll 1
            for (int i = 0; i < 4; ++i) {
                const int q = tid + 256 * i, kk = q >> 4, c8 = (q & 15) * 8;
                const int rr = 32 * (kk >> 4) + (kk & 15);
                const int k1 = mt * 64 + kk;
                const float cs = tw[2 * (k1 * t2)], sn = tw[2 * (k1 * t2) + 1];
                float gr[8], gi[8], o[8];
                ld8(st + rr * ST_LD + c8, gr);
                ld8(st + (rr + 16) * ST_LD + c8, gi);
                bf16_t* dr = G1 + ((size_t)((b * 128 + k1) * 2 + 0) * 64 + t2) * 256 + nt * 128 + c8;
#pragma unroll
                for (int e = 0; e < 8; ++e) o[e] = gr[e] * cs + gi[e] * sn;
                *(uint4*)dr = pack8(o);
#pragma unroll
                for (int e = 0; e < 8; ++e) o[e] = gi[e] * cs - gr[e] * sn;
                *(uint4*)(dr + (size_t)64 * 256) = pack8(o);
            }
        } else {
            const int j0 = it - nt1, b = j0 >> 3, mt = (j0 >> 1) & 3, nt = j0 & 1;
            gemm_core<true>(FC + (size_t)mt * 128 * 256, 256, parts + (size_t)(ROWS_L + b * CTX) * PW + PC_UF + nt * 128, PW, 256, acc, smem);
            stage_acc(acc, st);
#pragma unroll 1
            for (int i = 0; i < 8; ++i) {
                const int q = tid + 256 * i, rl = q >> 4, c8 = (q & 15) * 8;
                const int m = mt * 128 + rl, c = m >> 8, k = m & 255;
                float v[8];
                ld8(st + rl * ST_LD + c8, v);
                *(uint4*)(pcat + (size_t)(ROWS_L + b * CTX + k) * 512 + c * 256 + nt * 128 + c8) = pack8(v);
            }
        }
    }
}

DI void phase_dft2_mixp(const Params& p, int l, bf16_t* smem) {
    const int tid = otid();
    float* st = (float*)smem;
    const bf16_t* F2 = (const bf16_t*)(p.ws + OFF_F2);
    const bf16_t* G1 = (const bf16_t*)(p.ws + OFF_G1);
    bf16_t* pcat = (bf16_t*)(p.ws + OFF_PCAT);
    const bf16_t* dbuf = (const bf16_t*)(p.ws + OFF_DBUF);
    const bf16_t* wp = (const bf16_t*)(p.ws + OFF_WPOOL) + (size_t)l * 65536;
    const bf16_t* parts = (const bf16_t*)(p.ws + OFF_PARTS);
    bf16_t* cat = (bf16_t*)(p.ws + OFF_H);
    const int nt2 = 2 * 128 * 2;
    const int nmt = (l == 0 ? ROWS : ROWS_L) / 128;
    const int ntot = nt2 + nmt * 2;
    for (int it = blockIdx.x; it < ntot; it += gridDim.x) {
        f32x4 acc[4][4];
        if (it < nt2) {
            const int b = it >> 8, k1 = (it >> 1) & 127, nt = it & 1;
            gemm_core<true>(F2, 128, G1 + (size_t)(b * 128 + k1) * 128 * 256 + nt * 128, 256, 128, acc, smem);
            stage_acc(acc, st);
#pragma unroll 1
            for (int i = 0; i < 8; ++i) {
                const int q = tid + 256 * i, m = q >> 4, c8 = (q & 15) * 8;
                const int c = m >> 6, k2 = m & 63;
                float v[8];
                ld8(st + m * ST_LD + c8, v);
                *(uint4*)(pcat + (size_t)(b * SEQ + k1 + 128 * k2) * 512 + c * 256 + nt * 128 + c8) = pack8(v);
            }
        } else {
            const int j0 = it - nt2, tm = j0 >> 1, nt = j0 & 1;
            gemm_core_dma(dbuf + (size_t)tm * 128 * 256 + nt * 128, 256, wp + (size_t)(nt * 128) * 256 + nt * 128, 256, 128, acc, smem);
            stage_acc(acc, st);
#pragma unroll 1
            for (int i = 0; i < 8; ++i) {
                const int q = tid + 256 * i, rl = q >> 4, c8 = (q & 15) * 8;
                const int row = tm * 128 + rl, n = nt * 128 + c8;
                float v[8], z[8], ps[8];
                ld8(st + rl * ST_LD + c8, v);
                ld8(p.pool_scale + l * 256 + n, ps);
                unpack8(*(const uint4*)(parts + (size_t)row * PW + PC_ZP + n), z);
#pragma unroll
                for (int e = 0; e < 8; ++e) v[e] = silu_f(z[e]) * ps[e] * v[e];
                *(uint4*)(cat + (size_t)row * DM + 768 + n) = pack8(v);
            }
        }
    }
}

DI void phase_mixf(const Params& p, int l, bf16_t* smem) {
    const int tid = otid();
    float* st = (float*)smem;
    const bf16_t* pcat = (const bf16_t*)(p.ws + OFF_PCAT);
    const bf16_t* wc = (const bf16_t*)(p.ws + OFF_WCOMB) + (size_t)l * 131072;
    const bf16_t* parts = (const bf16_t*)(p.ws + OFF_PARTS);
    bf16_t* cat = (bf16_t*)(p.ws + OFF_H);
    const int nmt = (l == 0 ? ROWS : ROWS_L) / 128;
    for (int it = blockIdx.x; it < nmt * 2; it += gridDim.x) {
        const int tm = it >> 1, nt = it & 1;
        f32x4 acc[4][4];
        gemm_core_dma(pcat + (size_t)tm * 128 * 512, 512, wc + (size_t)(nt * 128) * 512, 512, 512, acc, smem);
        stage_acc(acc, st);
        const float sc = (tm < 128) ? 0.001381067932004976f : 0.0078125f;
#pragma unroll 1
        for (int i = 0; i < 8; ++i) {
            const int q = tid + 256 * i, rl = q >> 4, c8 = (q & 15) * 8;
            const int row = tm * 128 + rl, n = nt * 128 + c8;
            float v[8], z[8];
            ld8(st + rl * ST_LD + c8, v);
            unpack8(*(const uint4*)(parts + (size_t)row * PW + PC_ZF + n), z);
#pragma unroll
            for (int e = 0; e < 8; ++e) v[e] = silu_f(z[e]) * sc * v[e];
            *(uint4*)(cat + (size_t)row * DM + n) = pack8(v);
        }
    }
}

DI void phase_out(const Params& p, int l, const float* xl_in, const float* xc_in, float* xl_out, float* xc_out, bf16_t* smem) {
    const int tid = otid();
    float* st = (float*)smem;
    const bf16_t* cat = (const bf16_t*)(p.ws + OFF_H);
    const bf16_t* W = (const bf16_t*)(p.ws + OFF_WTOUT) + (size_t)l * DM * DM;
    const float* modv = (const float*)(p.ws + OFF_MODV) + (size_t)l * 3 * 3072;
    const int nmt = (l == 0 ? ROWS : ROWS_L) / 128;
    for (XIter t = xiter(nmt * 8); t.u < t.end; t.u += t.step) {
        int tm, tn;
        if (t.u < 1024) { const int ch = t.u >> 6, r = t.u & 63; tn = r >> 3; tm = ch * 8 + (r & 7); }
        else { const int j = t.u - 1024; tn = j >> 2; tm = 128 + (j & 3); }
        f32x4 acc[4][4];
        gemm_core_dma(cat + (size_t)tm * 128 * DM, DM, W + (size_t)tn * 128 * DM, DM, DM, acc, smem);
        stage_acc(acc, st);
        const int rb = tm * 128;
        const int v = (rb < ROWS_L) ? (rb >> 13) : 2;
        const float* gate = modv + v * 3072 + 2048;
        const float* xin = (rb < ROWS_L) ? xl_in : xc_in - (size_t)ROWS_L * DM;
        float* xout = (rb < ROWS_L) ? xl_out : xc_out - (size_t)ROWS_L * DM;
#pragma unroll 1
        for (int i = 0; i < 8; ++i) {
            const int q = tid + 256 * i, rl = q >> 4, c8 = (q & 15) * 8;
            const size_t o = (size_t)(rb + rl) * DM + tn * 128 + c8;
            float a[8], xi[8], gt[8];
            ld8(st + rl * ST_LD + c8, a);
            ld8(xin + o, xi);
            ld8(gate + tn * 128 + c8, gt);
            *(float4*)(xout + o) = make_float4(xi[0] + gt[0] * a[0], xi[1] + gt[1] * a[1], xi[2] + gt[2] * a[2], xi[3] + gt[3] * a[3]);
            *(float4*)(xout + o + 4) = make_float4(xi[4] + gt[4] * a[4], xi[5] + gt[5] * a[5], xi[6] + gt[6] * a[6], xi[7] + gt[7] * a[7]);
        }
    }
}

#ifndef PH_MASK
#define PH_MASK 0xFFFF
#endif
#ifndef PH_DUP
#define PH_DUP 0
#endif
__global__ void __launch_bounds__(256, 2) fwd_megakernel(Params p) {
    __shared__ __attribute__((aligned(16))) unsigned char smem_raw[SMEM_BYTES];
    bf16_t* smem = (bf16_t*)smem_raw;
    float* smf = (float*)smem_raw;
    volatile LAS unsigned* stw = (volatile LAS unsigned*)(smem_raw + SMEM_MAIN);
    if (threadIdx.x == 0) { stw[0] = 0u; stw[1] = 0u; stw[2] = 0u; stw[3] = 0u; }
    __syncthreads();
    if (p.never) cg::this_grid().sync();
    XcdBarrier bar = xcd_barrier_post((unsigned*)(p.ws + OFF_BAR), stw);

    if (PH_MASK & 1) phase0_mod(p, smf);
    xcd_barrier(bar);
    if (PH_MASK & 1) phase0(p, smf);
    if (PH_DUP & 1) phase0(p, smf);
    float* xc1 = (float*)(p.ws + OFF_XC1);
    for (int l = 0; l < 2; ++l) {
        const float* xl_in = (l == 0) ? p.x : p.out;
        const float* xc_in = (l == 0) ? p.ctx : xc1;
        if (PH_MASK & 2) phase_norm(p, l, xl_in, xc_in);
        if (PH_DUP & 2) phase_norm(p, l, xl_in, xc_in);
        xcd_barrier(bar);
        if (PH_MASK & 4) phase_inproj(p, l, smem);
        if (PH_DUP & 4) phase_inproj(p, l, smem);
        xcd_barrier(bar);
        if (PH_MASK & 8) phase_attn(p, l, smem);
        if (PH_DUP & 8) phase_attn(p, l, smem);
        if (PH_MASK & 16) phase_convpool(p, l);
        if (PH_DUP & 16) phase_convpool(p, l);
        if (PH_MASK & 32) phase_dft1(p, l, smem);
        if (PH_DUP & 32) phase_dft1(p, l, smem);
        xcd_barrier(bar);
        if (PH_MASK & 64) phase_dft2_mixp(p, l, smem);
        if (PH_DUP & 64) phase_dft2_mixp(p, l, smem);
        xcd_barrier(bar);
        if (PH_MASK & 128) phase_mixf(p, l, smem);
        if (PH_DUP & 128) phase_mixf(p, l, smem);
        xcd_barrier(bar);
        if (PH_MASK & 256) phase_out(p, l, xl_in, xc_in, p.out, xc1, smem);
        if (PH_DUP & 256) phase_out(p, l, xl_in, xc_in, (float*)(p.ws + OFF_G1), (float*)(p.ws + OFF_G1), smem);
        if (l == 0) xcd_barrier(bar);
    }
}

extern "C" void kernel_launch(void* const* d_in, const int* in_sizes, int n_in, void* d_out, int out_size, void* d_ws, size_t ws_size, hipStream_t stream) {
    static int grid_blocks = 0;
    if (!grid_blocks) {
        int dev = 0, cus = 0, per_cu = 0;
        hipGetDevice(&dev);
        hipDeviceGetAttribute(&cus, hipDeviceAttributeMultiprocessorCount, dev);
        hipOccupancyMaxActiveBlocksPerMultiprocessor(&per_cu, fwd_megakernel, 256, 0);
        if (per_cu > 2) per_cu = 2;
        if (per_cu < 1) per_cu = 1;
        grid_blocks = cus * per_cu;
        if (ws_size < WS_END) fprintf(stderr, "kernel_launch: workspace too small: %zu < %zu\n", ws_size, (size_t)WS_END);
    }
    hipMemsetAsync((char*)d_ws + OFF_BAR, 0, 16384, stream);
    Params p{};
    p.x = (const float*)d_in[0]; p.c = (const float*)d_in[1]; p.ctx = (const float*)d_in[2]; p.c_ctx = (const float*)d_in[3];
    p.w_mod = (const float*)d_in[4]; p.b_mod = (const float*)d_in[5]; p.norm_g = (const float*)d_in[6]; p.w_in = (const float*)d_in[7];
    p.q_gain = (const float*)d_in[8]; p.k_gain = (const float*)d_in[9]; p.w_fourier = (const float*)d_in[10]; p.conv_w = (const float*)d_in[11];
    p.conv_b = (const float*)d_in[12]; p.pool_w = (const float*)d_in[13]; p.pool_scale = (const float*)d_in[14]; p.w_out = (const float*)d_in[15];
    p.out = (float*)d_out; p.ws = (unsigned char*)d_ws; p.never = 0; p.pad = 0;
    void* args[] = {&p};
    hipError_t e = hipLaunchCooperativeKernel((void*)fwd_megakernel, dim3(grid_blocks), dim3(256), args, 0, stream);
    if (e != hipSuccess) fprintf(stderr, "cooperative launch failed: %s (grid %d)\n", hipGetErrorString(e), grid_blocks);
}
```

```cpp
#include <hip/hip_runtime.h>
#include <hip/hip_cooperative_groups.h>
#include <stdint.h>
#include <cstdio>
namespace cg = cooperative_groups;

typedef unsigned short bf16_t;
typedef __attribute__((ext_vector_type(8))) short bf16x8;
typedef __attribute__((ext_vector_type(4))) short bf16x4;
typedef __attribute__((ext_vector_type(4))) float f32x4;
typedef __attribute__((ext_vector_type(16))) float f32x16;
#define DI __device__ __forceinline__

#define SEQ 8192
#define CTX 256
#define DM 1024
#define DIN 2816
#define ROWS_L 16384
#define ROWS_C 512
#define ROWS 16896
#define NKEY 8448
#define PW 2304
#define PC_ZATT 0
#define PC_UF 256
#define PC_ZF 512
#define PC_BC 768
#define PC_CC 1024
#define PC_HC 1280
#define PC_ZC 1536
#define PC_UP 1792
#define PC_ZP 2048

constexpr size_t OFF_BAR = 0;
constexpr size_t OFF_MODV = 16384;
constexpr size_t OFF_ROPE = OFF_MODV + 2 * 3 * 3072 * 4;
constexpr size_t OFF_TW = OFF_ROPE + 6144 * 4;
constexpr size_t OFF_F1 = OFF_TW + 8192 * 2 * 4;
constexpr size_t OFF_F2 = OFF_F1 + 256 * 128 * 2;
constexpr size_t OFF_FC = OFF_F2 + 128 * 128 * 2;
constexpr size_t OFF_WCOMB = OFF_FC + 512 * 256 * 2;
constexpr size_t OFF_WPOOL = OFF_WCOMB + 2 * 256 * 512 * 2;
constexpr size_t OFF_WTIN = 2097152;
constexpr size_t OFF_WTOUT = OFF_WTIN + (size_t)2 * DIN * DM * 2;
constexpr size_t OFF_H = OFF_WTOUT + (size_t)2 * DM * DM * 2;
constexpr size_t OFF_PARTS = OFF_H + (size_t)ROWS * DM * 2;
constexpr size_t OFF_Q = OFF_PARTS + (size_t)ROWS * PW * 2;
constexpr size_t OFF_QC = OFF_Q + (size_t)2 * 4 * SEQ * 64 * 2;
constexpr size_t OFF_K = OFF_QC + (size_t)2 * 4 * CTX * 64 * 2;
constexpr size_t OFF_VT = OFF_K + (size_t)2 * 2 * NKEY * 64 * 2;
constexpr size_t OFF_DBUF = OFF_VT + (size_t)2 * 2 * NKEY * 64 * 2;
constexpr size_t OFF_G1 = OFF_DBUF + (size_t)ROWS * 256 * 2;
constexpr size_t OFF_PCAT = OFF_G1 + (size_t)2 * 128 * 2 * 64 * 256 * 2;
constexpr size_t OFF_XC1 = OFF_PCAT + (size_t)ROWS * 512 * 2;
constexpr size_t WS_END = OFF_XC1 + (size_t)ROWS_C * DM * 4;
static_assert(OFF_WPOOL + 2 * 256 * 256 * 2 <= OFF_WTIN, "ws map");

struct Params {
    const float *x, *c, *ctx, *c_ctx, *w_mod, *b_mod, *norm_g, *w_in, *q_gain, *k_gain, *w_fourier, *conv_w, *conv_b, *pool_w, *pool_scale, *w_out;
    float* out;
    unsigned char* ws;
    int never;
    int pad;
};

DI bf16_t f2bf(float x) { unsigned u = __float_as_uint(x); u += 0x7fffu + ((u >> 16) & 1u); return (bf16_t)(u >> 16); }
DI float bf2f(bf16_t h) { return __uint_as_float(((unsigned)h) << 16); }
typedef __attribute__((ext_vector_type(2))) float f32x2;
typedef __attribute__((ext_vector_type(2))) __bf16 bf16x2v;
DI unsigned pack2(float a, float b) { const f32x2 v = {a, b}; return __builtin_bit_cast(unsigned, __builtin_convertvector(v, bf16x2v)); }
struct XIter { int u, end, step; };
DI XIter xiter(int ntiles) {
    const int x = blockIdx.x & 7, j = blockIdx.x >> 3, nb = gridDim.x >> 3, per = (ntiles + 7) >> 3;
    XIter r; r.u = x * per + j; r.end = min((x + 1) * per, ntiles); r.step = nb; return r;
}
DI float silu_f(float z) { return z / (1.f + __expf(-z)); }
DI float bflo(unsigned w) { return __uint_as_float(w << 16); }
DI float bfhi(unsigned w) { return __uint_as_float(w & 0xffff0000u); }
DI int otid() { int t = threadIdx.x; asm volatile("" : "+v"(t)); return t; }

#define XB_TMO      128
#define XB_XCNT(j)  (256  + 64 * (j))
#define XB_XSUB(j)  (1280 + 64 * (j))
#define XB_XGEN(j)  (2304 + 64 * (j))
#define XB_TOP      3328
#define XB_TOPGEN   3392
#define XCD_BAR_WORDS 3456
#define XB_SPIN_CAP (1u << 20)
#define LAS __attribute__((address_space(3)))
DI unsigned xb_ld(unsigned* p) { return __hip_atomic_load(p, __ATOMIC_RELAXED, __HIP_MEMORY_SCOPE_AGENT); }
DI unsigned xb_add(unsigned* p, unsigned v) { return __hip_atomic_fetch_add(p, v, __ATOMIC_RELAXED, __HIP_MEMORY_SCOPE_AGENT); }
DI unsigned xb_xcc_id() { return (unsigned)__builtin_amdgcn_s_getreg((3 << 11) | 20) & 0xFu; }
#define XB_SPIN(cond, bar) do { unsigned _sp = 0; while (cond) { __builtin_amdgcn_s_sleep(1); \
    if ((++_sp & 255u) == 0u) { if (xb_ld(&(bar)[XB_TMO])) break; if (_sp > XB_SPIN_CAP) { atomicAdd(&(bar)[XB_TMO], 1u); break; } } } } while (0)
struct XcdBarrier { unsigned* bar; unsigned x; volatile LAS unsigned* st; };
DI XcdBarrier xcd_barrier_post(unsigned* bar, volatile LAS unsigned* st) {
    XcdBarrier b; b.bar = bar; b.x = xb_xcc_id(); b.st = st;
    if (threadIdx.x == 0) (void)xb_add(&bar[XB_XCNT(b.x)], 1u);
    return b;
}
DI void xcd_barrier_complete(unsigned* bar, unsigned x, unsigned& nloc, unsigned& nx) {
    const unsigned G = gridDim.x * gridDim.y * gridDim.z;
    unsigned sum, cnt, mine, sp = 0u;
    for (;;) {
        sum = 0u; cnt = 0u; mine = 0u;
#pragma unroll
        for (unsigned j = 0; j < 16; ++j) { const unsigned c = xb_ld(&bar[XB_XCNT(j)]); sum += c; cnt += (c > 0u) ? 1u : 0u; mine = (j == x) ? c : mine; }
        if (sum == G) break;
        __builtin_amdgcn_s_sleep(1);
        if ((++sp & 255u) == 0u) { if (xb_ld(&bar[XB_TMO])) break; if (sp > XB_SPIN_CAP) { atomicAdd(&bar[XB_TMO], 1u); break; } }
    }
    nloc = mine > 0u ? mine : 1u; nx = cnt > 0u ? cnt : 1u;
}
DI void xcd_barrier(const XcdBarrier& b) {
    asm volatile("s_waitcnt vmcnt(0)" ::: "memory");
    __syncthreads();
    if (threadIdx.x == 0) {
        unsigned* bar = b.bar;
        __builtin_amdgcn_s_waitcnt(0);
        unsigned nloc = b.st[0], nx = b.st[1];
        if (nloc == 0u) { xcd_barrier_complete(bar, b.x, nloc, nx); b.st[0] = nloc; b.st[1] = nx; }
        const unsigned old = xb_add(&bar[XB_XSUB(b.x)], 1u);
        const unsigned gen = old / nloc;
        if (old + 1u == (gen + 1u) * nloc) {
            __builtin_amdgcn_fence(__ATOMIC_RELEASE, "agent");
            asm volatile("s_waitcnt vmcnt(0)" ::: "memory");
            const unsigned og = xb_add(&bar[XB_TOP], 1u);
            const unsigned tg = og / nx;
            if (og + 1u == (tg + 1u) * nx) xb_add(&bar[XB_TOPGEN], 1u);
            else XB_SPIN(xb_ld(&bar[XB_TOPGEN]) == tg, bar);
            __builtin_amdgcn_fence(__ATOMIC_ACQUIRE, "agent");
            xb_add(&bar[XB_XGEN(b.x)], 1u);
            asm volatile("s_waitcnt vmcnt(0)" ::: "memory");
        } else {
            XB_SPIN(xb_ld(&bar[XB_XGEN(b.x)]) == gen, bar);
            __builtin_amdgcn_fence(__ATOMIC_ACQUIRE, "agent");
            asm volatile("s_waitcnt vmcnt(0)" ::: "memory");
        }
    }
    __syncthreads();
}

#define LROW 72
#define TILE_E (128 * LROW)
#define SMEM_MAIN (4 * TILE_E * 2)
#define SMEM_BYTES (SMEM_MAIN + 16)

typedef __attribute__((ext_vector_type(4))) unsigned u32x4;
struct Stg { u32x4 a0, a1, a2, a3, b0, b1, b2, b3; };
template <bool BN>
DI u32x4 g_ld_b(const bf16_t* __restrict__ B, int ldb, int kt, int q) {
    if (!BN) return *(const u32x4*)(B + (size_t)(q >> 3) * ldb + kt * 64 + (q & 7) * 8);
    else     return *(const u32x4*)(B + (size_t)(kt * 64 + (q >> 4)) * ldb + (q & 15) * 8);
}
template <bool BN>
DI void g_load(Stg& r, const bf16_t* __restrict__ A, int lda, const bf16_t* __restrict__ B, int ldb, int kt, int tid) {
    const bf16_t* ap = A + (size_t)(tid >> 3) * lda + kt * 64 + (tid & 7) * 8;
    r.a0 = *(const u32x4*)(ap);
    r.a1 = *(const u32x4*)(ap + (size_t)32 * lda);
    r.a2 = *(const u32x4*)(ap + (size_t)64 * lda);
    r.a3 = *(const u32x4*)(ap + (size_t)96 * lda);
    r.b0 = g_ld_b<BN>(B, ldb, kt, tid);
    r.b1 = g_ld_b<BN>(B, ldb, kt, tid + 256);
    r.b2 = g_ld_b<BN>(B, ldb, kt, tid + 512);
    r.b3 = g_ld_b<BN>(B, ldb, kt, tid + 768);
}
template <bool BN>
DI void s_st_b(bf16_t* b, const u32x4 v, int q) {
    if (!BN) *(u32x4*)(b + (q >> 3) * LROW + (q & 7) * 8) = v;
    else {
        const int kr = q >> 4, n0 = (q & 15) * 8;
        b[(n0 + 0) * LROW + kr] = (bf16_t)(v.x & 0xffffu); b[(n0 + 1) * LROW + kr] = (bf16_t)(v.x >> 16);
        b[(n0 + 2) * LROW + kr] = (bf16_t)(v.y & 0xffffu); b[(n0 + 3) * LROW + kr] = (bf16_t)(v.y >> 16);
        b[(n0 + 4) * LROW + kr] = (bf16_t)(v.z & 0xffffu); b[(n0 + 5) * LROW + kr] = (bf16_t)(v.z >> 16);
        b[(n0 + 6) * LROW + kr] = (bf16_t)(v.w & 0xffffu); b[(n0 + 7) * LROW + kr] = (bf16_t)(v.w >> 16);
    }
}
template <bool BN>
DI void s_store(const Stg& r, bf16_t* smem, int buf, int tid) {
    bf16_t* a = smem + buf * 2 * TILE_E;
    bf16_t* b = a + TILE_E;
    bf16_t* ap = a + (tid >> 3) * LROW + (tid & 7) * 8;
    *(u32x4*)(ap) = r.a0;
    *(u32x4*)(ap + 32 * LROW) = r.a1;
    *(u32x4*)(ap + 64 * LROW) = r.a2;
    *(u32x4*)(ap + 96 * LROW) = r.a3;
    s_st_b<BN>(b, r.b0, tid);
    s_st_b<BN>(b, r.b1, tid + 256);
    s_st_b<BN>(b, r.b2, tid + 512);
    s_st_b<BN>(b, r.b3, tid + 768);
}
DI void mma_tile(const bf16_t* smem, int buf, f32x4 (&acc)[4][4], int wm, int wn, int lane) {
    const bf16_t* a = smem + buf * 2 * TILE_E;
    const bf16_t* b = a + TILE_E;
#pragma unroll
    for (int kk = 0; kk < 2; ++kk) {
        bf16x8 af[4], bfr[4];
#pragma unroll
        for (int mi = 0; mi < 4; ++mi) af[mi] = *(const bf16x8*)(a + (wm * 64 + mi * 16 + (lane & 15)) * LROW + kk * 32 + (lane >> 4) * 8);
#pragma unroll
        for (int ni = 0; ni < 4; ++ni) bfr[ni] = *(const bf16x8*)(b + (wn * 64 + ni * 16 + (lane & 15)) * LROW + kk * 32 + (lane >> 4) * 8);
#pragma unroll
        for (int mi = 0; mi < 4; ++mi)
#pragma unroll
            for (int ni = 0; ni < 4; ++ni) acc[mi][ni] = __builtin_amdgcn_mfma_f32_16x16x32_bf16(af[mi], bfr[ni], acc[mi][ni], 0, 0, 0);
    }
}
template <bool BN>
DI void gemm_core(const bf16_t* __restrict__ A, int lda, const bf16_t* __restrict__ B, int ldb, int K, f32x4 (&acc)[4][4], bf16_t* smem) {
    const int tid = otid(), lane = tid & 63, wave = tid >> 6;
    const int wm = wave >> 1, wn = wave & 1;
#pragma unroll
    for (int mi = 0; mi < 4; ++mi)
#pragma unroll
        for (int ni = 0; ni < 4; ++ni) acc[mi][ni] = (f32x4){0.f, 0.f, 0.f, 0.f};
    const int nk = K >> 6;
    Stg r0, r1;
    __syncthreads();
    g_load<BN>(r0, A, lda, B, ldb, 0, tid);
    g_load<BN>(r1, A, lda, B, ldb, 1, tid);
    s_store<BN>(r0, smem, 0, tid);
    __syncthreads();
    for (int kt = 0; kt < nk; kt += 2) {
        if (kt + 2 < nk) g_load<BN>(r0, A, lda, B, ldb, kt + 2, tid);
        mma_tile(smem, 0, acc, wm, wn, lane);
        s_store<BN>(r1, smem, 1, tid);
        __syncthreads();
        if (kt + 3 < nk) g_load<BN>(r1, A, lda, B, ldb, kt + 3, tid);
        mma_tile(smem, 1, acc, wm, wn, lane);
        if (kt + 2 < nk) s_store<BN>(r0, smem, 0, tid);
        __syncthreads();
    }
}
#define GT_E (128 * 64)
DI void glds_tile(const bf16_t* __restrict__ G, int ld, int kt, bf16_t* lt, int tid) {
    const int c = (tid & 7) ^ ((tid >> 4) & 7);
    const bf16_t* g = G + (size_t)(tid >> 3) * ld + kt * 64 + c * 8;
    char* l = (char*)lt + tid * 16;
#pragma unroll
    for (int p = 0; p < 4; ++p)
        __builtin_amdgcn_global_load_lds((const unsigned*)(g + (size_t)(p * 32) * ld), (LAS unsigned*)(l + p * 4096), 16, 0, 0);
}
DI void mma_tile_sw(const bf16_t* smem, int buf, f32x4 (&acc)[4][4], int wm, int wn, int lane) {
    const char* a = (const char*)(smem + buf * 2 * GT_E);
    const char* b = a + GT_E * 2;
    const int sw = (lane & 15) >> 1;
#pragma unroll
    for (int kk = 0; kk < 2; ++kk) {
        bf16x8 af[4], bfr[4];
        const int co = ((kk * 4 + (lane >> 4)) ^ sw) << 4;
#pragma unroll
        for (int mi = 0; mi < 4; ++mi) af[mi] = *(const bf16x8*)(a + (wm * 64 + mi * 16 + (lane & 15)) * 128 + co);
#pragma unroll
        for (int ni = 0; ni < 4; ++ni) bfr[ni] = *(const bf16x8*)(b + (wn * 64 + ni * 16 + (lane & 15)) * 128 + co);
#pragma unroll
        for (int mi = 0; mi < 4; ++mi)
#pragma unroll
            for (int ni = 0; ni < 4; ++ni) acc[mi][ni] = __builtin_amdgcn_mfma_f32_16x16x32_bf16(af[mi], bfr[ni], acc[mi][ni], 0, 0, 0);
    }
}
DI void gemm_core_dma(const bf16_t* __restrict__ A, int lda, const bf16_t* __restrict__ B, int ldb, int K, f32x4 (&acc)[4][4], bf16_t* smem) {
    const int tid = otid(), lane = tid & 63, wave = tid >> 6;
    const int wm = wave >> 1, wn = wave & 1;
#pragma unroll
    for (int mi = 0; mi < 4; ++mi)
#pragma unroll
        for (int ni = 0; ni < 4; ++ni) acc[mi][ni] = (f32x4){0.f, 0.f, 0.f, 0.f};
    const int nk = K >> 6;
    __syncthreads();
    glds_tile(A, lda, 0, smem, tid);
    glds_tile(B, ldb, 0, smem + GT_E, tid);
    for (int kt = 0; kt < nk; ++kt) {
        asm volatile("s_waitcnt vmcnt(0)" ::: "memory");
        __syncthreads();
        if (kt + 1 < nk) {
            bf16_t* nb = smem + ((kt + 1) & 1) * 2 * GT_E;
            glds_tile(A, lda, kt + 1, nb, tid);
            glds_tile(B, ldb, kt + 1, nb + GT_E, tid);
        }
        mma_tile_sw(smem, kt & 1, acc, wm, wn, lane);
    }
    __syncthreads();
}
#define ST_LD 132
DI void stage_acc(f32x4 (&acc)[4][4], float* st) {
    const int lane = otid() & 63, wave = otid() >> 6, wm = wave >> 1, wn = wave & 1, fl = lane & 15, g4 = lane >> 4;
#pragma unroll
    for (int mi = 0; mi < 4; ++mi)
#pragma unroll
        for (int ni = 0; ni < 4; ++ni)
#pragma unroll
            for (int j = 0; j < 4; ++j) st[(wm * 64 + mi * 16 + g4 * 4 + j) * ST_LD + wn * 64 + ni * 16 + fl] = acc[mi][ni][j];
    __syncthreads();
}
DI void ld8(const float* q, float (&v)[8]) {
    const float4 a = *(const float4*)q, b = *(const float4*)(q + 4);
    v[0] = a.x; v[1] = a.y; v[2] = a.z; v[3] = a.w; v[4] = b.x; v[5] = b.y; v[6] = b.z; v[7] = b.w;
}
DI uint4 pack8(const float (&v)[8]) { return make_uint4(pack2(v[0], v[1]), pack2(v[2], v[3]), pack2(v[4], v[5]), pack2(v[6], v[7])); }
DI void unpack8(const uint4 u, float (&v)[8]) {
    v[0] = bflo(u.x); v[1] = bfhi(u.x); v[2] = bflo(u.y); v[3] = bfhi(u.y); v[4] = bflo(u.z); v[5] = bfhi(u.z); v[6] = bflo(u.w); v[7] = bfhi(u.w);
}

DI void phase0(const Params& p, float* smf) {
    const int tid = otid();
    unsigned char* ws = p.ws;
    float* modv = (float*)(ws + OFF_MODV);
    for (int it = blockIdx.x; it < 192; it += gridDim.x) {
        const int l = it / 96, n0 = (it % 96) * 32;
        __syncthreads();
        for (int i = tid; i < 3072; i += 256) {
            const int v = i >> 10, k = i & 1023;
            const float cv = (v == 0) ? p.c[k] : (v == 1) ? p.c[1024 + k] : p.c_ctx[k];
            smf[i] = silu_f(cv);
        }
        __syncthreads();
        const int col = tid & 31, kg = tid >> 5;
        float a0 = 0.f, a1 = 0.f, a2 = 0.f;
        const float* w = p.w_mod + (size_t)l * 1024 * 3072 + n0 + col;
#pragma unroll 16
        for (int kk = 0; kk < 128; ++kk) {
            const int k = kg * 128 + kk;
            const float wv = w[(size_t)k * 3072];
            a0 += smf[k] * wv; a1 += smf[1024 + k] * wv; a2 += smf[2048 + k] * wv;
        }
        __syncthreads();
        smf[3072 + (kg * 3 + 0) * 32 + col] = a0; smf[3072 + (kg * 3 + 1) * 32 + col] = a1; smf[3072 + (kg * 3 + 2) * 32 + col] = a2;
        __syncthreads();
        if (tid < 96) {
            const int v = tid >> 5, cc = tid & 31;
            float s = 0.f;
            for (int g = 0; g < 8; ++g) s += smf[3072 + (g * 3 + v) * 32 + cc];
            modv[(l * 3 + v) * 3072 + n0 + cc] = s + p.b_mod[l * 3072 + n0 + cc];
        }
    }
    {
        const int n_in = 2 * 16 * 44, n_out = 2 * 16 * 16;
        for (int it = blockIdx.x; it < n_in + n_out; it += gridDim.x) {
            const float* src; bf16_t* dst; int N, kt, nt;
            if (it < n_in) { const int l = it / 704, r = it % 704; kt = r / 44; nt = r % 44; N = DIN; src = p.w_in + (size_t)l * DM * DIN; dst = (bf16_t*)(ws + OFF_WTIN) + (size_t)l * DIN * DM; }
            else { const int j = it - n_in; const int l = j / 256, r = j % 256; kt = r / 16; nt = r % 16; N = DM; src = p.w_out + (size_t)l * DM * DM; dst = (bf16_t*)(ws + OFF_WTOUT) + (size_t)l * DM * DM; }
            __syncthreads();
#pragma unroll
            for (int ps = 0; ps < 4; ++ps) {
                const int kr = ps * 16 + (tid >> 4), c4 = (tid & 15) * 4;
                const float4 v = *(const float4*)(src + (size_t)(kt * 64 + kr) * N + nt * 64 + c4);
                smf[kr * 65 + c4 + 0] = v.x; smf[kr * 65 + c4 + 1] = v.y; smf[kr * 65 + c4 + 2] = v.z; smf[kr * 65 + c4 + 3] = v.w;
            }
            __syncthreads();
            const int n = tid >> 2, ks = (tid & 3) * 16;
            unsigned w[8];
#pragma unroll
            for (int e = 0; e < 8; ++e) w[e] = pack2(smf[(ks + 2 * e) * 65 + n], smf[(ks + 2 * e + 1) * 65 + n]);
            bf16_t* d = dst + (size_t)(nt * 64 + n) * DM + kt * 64 + ks;
            *(uint4*)d = make_uint4(w[0], w[1], w[2], w[3]);
            *(uint4*)(d + 8) = make_uint4(w[4], w[5], w[6], w[7]);
        }
    }
    const int gtid = blockIdx.x * 256 + tid, gsz = gridDim.x * 256;
    {
        bf16_t* wc = (bf16_t*)(ws + OFF_WCOMB);
        __syncthreads();
        if (tid < 64) { smf[tid] = cospif((float)tid * (1.f / 32.f)); smf[64 + tid] = sinpif((float)tid * (1.f / 32.f)); }
        __syncthreads();
        for (int i = gtid; i < 2 * 512 * 256; i += gsz) {
            const int n = i & 255, kk = (i >> 8) & 511, l = i >> 17;
            const int c = kk >> 8, head = (kk >> 6) & 3, ch = kk & 63;
            const float* wf = p.w_fourier + (size_t)l * 65536 + (size_t)(head * 64) * 256 + n;
            float s = 0.f;
#pragma unroll 16
            for (int j = 0; j < 64; ++j) s += smf[c * 64 + ((j * ch) & 63)] * wf[j * 256];
            wc[(size_t)l * 131072 + n * 512 + kk] = f2bf(s);
        }
    }
    {
        bf16_t* wp = (bf16_t*)(ws + OFF_WPOOL);
        for (int i = gtid; i < 2 * 256 * 256; i += gsz) {
            const int k = i & 255, n = (i >> 8) & 255, l = i >> 16;
            float v = 0.f;
            if ((k >> 6) == (n >> 6)) v = p.pool_w[(size_t)l * 16384 + (n >> 6) * 4096 + (k & 63) * 64 + (n & 63)];
            wp[i] = f2bf(v);
        }
    }
    {
        float* tw = (float*)(ws + OFF_TW);
        for (int i = gtid; i < 8192; i += gsz) { const float a = (float)i * (1.f / 4096.f); tw[2 * i] = cospif(a); tw[2 * i + 1] = sinpif(a); }
        bf16_t* f1 = (bf16_t*)(ws + OFF_F1);
        for (int i = gtid; i < 256 * 128; i += gsz) {
            const int t1 = i & 127, m = i >> 7;
            const int k1 = (m >> 5) * 16 + (m & 15), c = (m >> 4) & 1;
            const float a = (float)((k1 * t1) & 127) * (1.f / 64.f);
            f1[i] = f2bf(c ? -sinpif(a) : cospif(a));
        }
        bf16_t* f2 = (bf16_t*)(ws + OFF_F2);
        for (int i = gtid; i < 128 * 128; i += gsz) {
            const int kx = i & 127, m = i >> 7;
            const int c = m >> 6, k2 = m & 63, cp = kx >> 6, t2 = kx & 63;
            const float a = (float)((k2 * t2) & 63) * (1.f / 32.f);
            float v;
            if (c == cp) v = cospif(a); else if (c == 0) v = sinpif(a); else v = -sinpif(a);
            f2[i] = f2bf(v);
        }
        bf16_t* fc = (bf16_t*)(ws + OFF_FC);
        for (int i = gtid; i < 512 * 256; i += gsz) {
            const int t = i & 255, m = i >> 8;
            const int c = m >> 8, k = m & 255;
            const float a = (float)((k * t) & 255) * (1.f / 128.f);
            fc[i] = f2bf(c ? -sinpif(a) : cospif(a));
        }
        float* rp = (float*)(ws + OFF_ROPE);
        for (int i = gtid; i < 3072; i += gsz) {
            const int f = i & 15;
            const int pos = (i < 2048) ? (i >> 4) : ((i - 2048) >> 4);
            const float inv = powf(10000.f, -(float)f * (1.f / 16.f));
            const float ang = (float)pos * inv;
            const double ad = (double)ang;
            const float cs = (float)cos(ad), sn = (float)sin(ad);
            if (i < 2048) { rp[i] = cs; rp[2048 + i] = sn; }
            else { rp[4096 + (i - 2048)] = cs; rp[5120 + (i - 2048)] = sn; }
        }
    }
}

DI void phase_norm(const Params& p, int l, const float* xl, const float* xc) {
    const int lane = otid() & 63, wave = otid() >> 6;
    const float* modv = (const float*)(p.ws + OFF_MODV) + (size_t)l * 3 * 3072;
    const float* g = p.norm_g + l * 1024;
    bf16_t* H = (bf16_t*)(p.ws + OFF_H);
    for (int row = blockIdx.x * 4 + wave; row < ROWS; row += gridDim.x * 4) {
        const float* src = (row < ROWS_L) ? xl + (size_t)row * DM : xc + (size_t)(row - ROWS_L) * DM;
        const int v = (row < ROWS_L) ? (row >> 13) : 2;
        const float* mv = modv + v * 3072;
        float4 a[4];
        float ss = 0.f;
#pragma unroll
        for (int i = 0; i < 4; ++i) { a[i] = *(const float4*)(src + i * 256 + lane * 4); ss += a[i].x * a[i].x + a[i].y * a[i].y + a[i].z * a[i].z + a[i].w * a[i].w; }
#pragma unroll
        for (int o = 32; o >= 1; o >>= 1) ss += __shfl_xor(ss, o);
        const float rs = rsqrtf(ss * (1.f / 1024.f) + 1e-6f);
#pragma unroll
        for (int i = 0; i < 4; ++i) {
            const int c0 = i * 256 + lane * 4;
            const float4 gg = *(const float4*)(g + c0), sh = *(const float4*)(mv + c0), sc = *(const float4*)(mv + 1024 + c0);
            const float o0 = a[i].x * rs * gg.x * (1.f + sc.x) + sh.x, o1 = a[i].y * rs * gg.y * (1.f + sc.y) + sh.y;
            const float o2 = a[i].z * rs * gg.z * (1.f + sc.z) + sh.z, o3 = a[i].w * rs * gg.w * (1.f + sc.w) + sh.w;
            *(uint2*)(H + (size_t)row * DM + c0) = make_uint2(pack2(o0, o1), pack2(o2, o3));
        }
    }
}

DI void epi_inproj(const Params& p, int l, int tm, int tn, f32x4 (&acc)[4][4], float* st) {
    const int tid = otid();
    unsigned char* ws = p.ws;
    stage_acc(acc, st);
    const int rbase = tm * 128;
    const bool isctx = rbase >= ROWS_L;
    if (tn < 3) {
        const bool isq = tn < 2;
        const float* gain = (isq ? p.q_gain : p.k_gain) + l * 64;
        const float* rp = (const float*)(ws + OFF_ROPE);
#pragma unroll 1
        for (int i = 0; i < 8; ++i) {
            const int q = tid + 256 * i, rl = q >> 4, c8 = (q & 15) * 8;
            const int row = rbase + rl, hd = c8 >> 6, d0 = c8 & 63;
            float v[8], pv[8], g[8], pg[8];
            ld8(st + rl * ST_LD + c8, v);
            ld8(st + rl * ST_LD + (c8 ^ 16), pv);
            ld8(gain + d0, g);
            ld8(gain + (d0 ^ 16), pg);
            float ss = 0.f;
#pragma unroll
            for (int e = 0; e < 8; ++e) ss += v[e] * v[e];
            ss += __shfl_xor(ss, 1); ss += __shfl_xor(ss, 2); ss += __shfl_xor(ss, 4);
            const float rs = rsqrtf(ss * (1.f / 64.f) + 1e-6f);
#pragma unroll
            for (int e = 0; e < 8; ++e) { v[e] *= rs * g[e]; pv[e] *= rs * pg[e]; }
            bf16_t* dst;
            if (!isctx) {
                const int b = row >> 13, t = row & 8191;
                const int pos = (d0 >= 32) ? (t & 63) : (t >> 6);
                const float* ct = rp + ((d0 >= 32) ? 4096 : 0) + pos * 16 + (d0 & 8);
                float cs[8], sn[8];
                ld8(ct, cs);
                ld8(ct + ((d0 >= 32) ? 1024 : 2048), sn);
                const float sg = (d0 & 16) ? 1.f : -1.f;
#pragma unroll
                for (int e = 0; e < 8; ++e) v[e] = v[e] * cs[e] + sg * pv[e] * sn[e];
                if (isq) dst = (bf16_t*)(ws + OFF_Q) + ((size_t)(b * 4 + tn * 2 + hd) * SEQ + t) * 64 + d0;
                else     dst = (bf16_t*)(ws + OFF_K) + ((size_t)(b * 2 + hd) * NKEY + CTX + t) * 64 + d0;
            } else {
                const int rc = row - ROWS_L, b = rc >> 8, t = rc & 255;
                if (isq) dst = (bf16_t*)(ws + OFF_QC) + ((size_t)(b * 4 + tn * 2 + hd) * CTX + t) * 64 + d0;
                else     dst = (bf16_t*)(ws + OFF_K) + ((size_t)(b * 2 + hd) * NKEY + t) * 64 + d0;
            }
            if (isq) {
#pragma unroll
                for (int e = 0; e < 8; ++e) v[e] *= 0.18033688011112042f;
            }
            *(uint4*)dst = pack8(v);
        }
    } else if (tn == 3) {
        int b, key0;
        if (!isctx) { b = rbase >> 13; key0 = CTX + (rbase & 8191); } else { const int rc = rbase - ROWS_L; b = rc >> 8; key0 = rc & 255; }
#pragma unroll 1
        for (int i = 0; i < 8; ++i) {
            const int q = tid + 256 * i, col = q & 127, r8 = (q >> 7) * 8;
            float v[8];
#pragma unroll
            for (int e = 0; e < 8; ++e) v[e] = st[(r8 + e) * ST_LD + col];
            bf16_t* vt = (bf16_t*)(ws + OFF_VT) + ((size_t)(b * 2 + (col >> 6)) * 64 + (col & 63)) * NKEY + key0 + r8;
            *(uint4*)vt = pack8(v);
        }
    } else {
        bf16_t* parts = (bf16_t*)(ws + OFF_PARTS);
#pragma unroll 1
        for (int i = 0; i < 8; ++i) {
            const int q = tid + 256 * i, rl = q >> 4, c8 = (q & 15) * 8;
            float v[8];
            ld8(st + rl * ST_LD + c8, v);
            *(uint4*)(parts + (size_t)(rbase + rl) * PW + tn * 128 - 512 + c8) = pack8(v);
        }
    }
}

DI void phase_inproj(const Params& p, int l, bf16_t* smem) {
    const bf16_t* H = (const bf16_t*)(p.ws + OFF_H);
    const bf16_t* W = (const bf16_t*)(p.ws + OFF_WTIN) + (size_t)l * DIN * DM;
    const int nlat = 128 * 22;
    const int ntiles = nlat + (l == 0 ? 4 * 22 : 4 * 2);
    for (XIter t = xiter(ntiles); t.u < t.end; t.u += t.step) {
        const int u = t.u;
        int tm, tn;
        if (u < nlat) { const int ch = u / 176, r = u % 176; tn = r >> 3; tm = ch * 8 + (r & 7); }
        else { const int j = u - nlat; tm = 128 + (j & 3); tn = (l == 0 ? 0 : 2) + (j >> 2); }
        f32x4 acc[4][4];
        gemm_core_dma(H + (size_t)tm * 128 * DM, DM, W + (size_t)tn * 128 * DM, DM, DM, acc, smem);
        epi_inproj(p, l, tm, tn, acc, (float*)smem);
    }
}

#define KT_E (64 * LROW)
DI void attn_item(const Params& p, const bf16_t* Qb, const bf16_t* Kb, const bf16_t* VTb, int ntiles, int rowbase, int hq, bf16_t* smem) {
    const int tid = otid(), lane = tid & 63, wave = tid >> 6;
    const int r = lane & 31, h = lane >> 5;
    const float LOG2E = 1.4426950408889634f;
    bf16x8 qf[4];
    {
        const bf16_t* qrow = Qb + (size_t)(wave * 32 + r) * 64;
#pragma unroll
        for (int s = 0; s < 4; ++s) qf[s] = *(const bf16x8*)(qrow + s * 16 + h * 8);
    }
    f32x16 ot[2], minit;
#pragma unroll
    for (int i = 0; i < 16; ++i) { ot[0][i] = 0.f; ot[1][i] = 0.f; minit[i] = 0.f; }
    float m = 0.f, lsum = 0.f;
    uint4 rk[2], rv[2];
    auto gload = [&](int kt) {
#pragma unroll
        for (int i = 0; i < 2; ++i) {
            const int q = tid + 256 * i;
            rk[i] = *(const uint4*)(Kb + (size_t)(kt * 64 + (q >> 3)) * 64 + (q & 7) * 8);
            rv[i] = *(const uint4*)(VTb + (size_t)(q >> 3) * NKEY + kt * 64 + (q & 7) * 8);
        }
    };
    auto sstore = [&](int buf) {
        bf16_t* sk = smem + buf * 2 * KT_E;
        bf16_t* sv = sk + KT_E;
#pragma unroll
        for (int i = 0; i < 2; ++i) {
            const int q = tid + 256 * i;
            *(uint4*)(sk + (q >> 3) * LROW + (q & 7) * 8) = rk[i];
            *(uint4*)(sv + (q >> 3) * LROW + (q & 7) * 8) = rv[i];
        }
    };
    __syncthreads();
    gload(0);
    sstore(0);
    __syncthreads();
    for (int kt = 0; kt < ntiles; ++kt) {
        if (kt + 1 < ntiles) gload(kt + 1);
        const bf16_t* sk = smem + (kt & 1) * 2 * KT_E;
        const bf16_t* sv = sk + KT_E;
        f32x16 st[2], pe[2];
#pragma unroll
        for (int blk = 0; blk < 2; ++blk) {
            st[blk] = __builtin_amdgcn_mfma_f32_32x32x16_bf16(*(const bf16x8*)(sk + (blk * 32 + r) * LROW + h * 8), qf[0], minit, 0, 0, 0);
#pragma unroll
            for (int s = 1; s < 4; ++s)
                st[blk] = __builtin_amdgcn_mfma_f32_32x32x16_bf16(*(const bf16x8*)(sk + (blk * 32 + r) * LROW + s * 16 + h * 8), qf[s], st[blk], 0, 0, 0);
        }
        float ls = 0.f;
#pragma unroll
        for (int i = 0; i < 16; ++i) {
            pe[0][i] = __builtin_amdgcn_exp2f(st[0][i]); ls += pe[0][i];
            pe[1][i] = __builtin_amdgcn_exp2f(st[1][i]); ls += pe[1][i];
        }
        if (kt == 0 || __any(!(ls <= 256.f))) {
            float tmx = st[0][0];
#pragma unroll
            for (int i = 0; i < 16; ++i) { tmx = fmaxf(tmx, st[0][i]); tmx = fmaxf(tmx, st[1][i]); }
            tmx = fmaxf(tmx, __shfl_xor(tmx, 32));
            const float delta = (kt == 0) ? tmx : fmaxf(tmx, 0.f);
            const float alpha = (kt == 0) ? 1.f : __builtin_amdgcn_exp2f(-delta);
            m += delta;
            lsum *= alpha;
            ls = 0.f;
#pragma unroll
            for (int i = 0; i < 16; ++i) {
                ot[0][i] *= alpha; ot[1][i] *= alpha; minit[i] = -m;
                pe[0][i] = __builtin_amdgcn_exp2f(st[0][i] - delta); ls += pe[0][i];
                pe[1][i] = __builtin_amdgcn_exp2f(st[1][i] - delta); ls += pe[1][i];
            }
        }
        lsum += ls;
        bf16x8 pk[2][2];
#pragma unroll
        for (int blk = 0; blk < 2; ++blk)
#pragma unroll
            for (int s = 0; s < 2; ++s) {
                uint4 u;
                u.x = pack2(pe[blk][8 * s + 0], pe[blk][8 * s + 1]); u.y = pack2(pe[blk][8 * s + 2], pe[blk][8 * s + 3]);
                u.z = pack2(pe[blk][8 * s + 4], pe[blk][8 * s + 5]); u.w = pack2(pe[blk][8 * s + 6], pe[blk][8 * s + 7]);
                pk[blk][s] = __builtin_bit_cast(bf16x8, u);
            }
#pragma unroll
        for (int db = 0; db < 2; ++db)
#pragma unroll
            for (int blk = 0; blk < 2; ++blk)
#pragma unroll
                for (int s = 0; s < 2; ++s) {
                    const bf16_t* vp = sv + (db * 32 + r) * LROW + blk * 32 + s * 16 + h * 4;
                    const bf16x4 lo = *(const bf16x4*)vp;
                    const bf16x4 hi = *(const bf16x4*)(vp + 8);
                    const bf16x8 vf = __builtin_shufflevector(lo, hi, 0, 1, 2, 3, 4, 5, 6, 7);
                    ot[db] = __builtin_amdgcn_mfma_f32_32x32x16_bf16(vf, pk[blk][s], ot[db], 0, 0, 0);
                }
        if (kt + 1 < ntiles) sstore((kt + 1) & 1);
        __syncthreads();
    }
    lsum += __shfl_xor(lsum, 32);
    const float inv = 1.f / lsum;
    const int row = rowbase + wave * 32 + r;
    const bf16_t* zrow = (const bf16_t*)(p.ws + OFF_PARTS) + (size_t)row * PW + PC_ZATT + hq * 64;
    bf16_t* orow = (bf16_t*)(p.ws + OFF_H) + (size_t)row * DM + 256 + hq * 64;
#pragma unroll
    for (int db = 0; db < 2; ++db)
#pragma unroll
        for (int g = 0; g < 4; ++g) {
            const int d = db * 32 + g * 8 + h * 4;
            const uint2 z = *(const uint2*)(zrow + d);
            const float o0 = silu_f(bflo(z.x)) * ot[db][4 * g + 0] * inv, o1 = silu_f(bfhi(z.x)) * ot[db][4 * g + 1] * inv;
            const float o2 = silu_f(bflo(z.y)) * ot[db][4 * g + 2] * inv, o3 = silu_f(bfhi(z.y)) * ot[db][4 * g + 3] * inv;
            *(uint2*)(orow + d) = make_uint2(pack2(o0, o1), pack2(o2, o3));
        }
}

DI void phase_attn(const Params& p, int l, bf16_t* smem) {
    const bf16_t* Q = (const bf16_t*)(p.ws + OFF_Q);
    const bf16_t* QC = (const bf16_t*)(p.ws + OFF_QC);
    const bf16_t* Kk = (const bf16_t*)(p.ws + OFF_K);
    const bf16_t* VT = (const bf16_t*)(p.ws + OFF_VT);
    for (XIter t = xiter(512); t.u < t.end; t.u += t.step) {
        const int it = t.u;
        const int b = it >> 8, hq = (it >> 6) & 3, qt = it & 63;
        const size_t kv = (size_t)(b * 2 + (hq >> 1));
        attn_item(p, Q + ((size_t)(b * 4 + hq) * SEQ + qt * 128) * 64, Kk + kv * NKEY * 64, VT + kv * 64 * NKEY, NKEY / 64, b * SEQ + qt * 128, hq, smem);
    }
    if (l == 0) {
        for (int j = blockIdx.x; j < 16; j += gridDim.x) {
            const int b = j >> 3, hq = (j >> 1) & 3, qt = j & 1;
            const size_t kv = (size_t)(b * 2 + (hq >> 1));
            attn_item(p, QC + ((size_t)(b * 4 + hq) * CTX + qt * 128) * 64, Kk + kv * NKEY * 64, VT + kv * 64 * NKEY, CTX / 64, ROWS_L + b * CTX + qt * 128, hq, smem);
        }
    }
}

DI void phase_convpool(const Params& p, int l) {
    const bf16_t* __restrict__ parts = (const bf16_t*)(p.ws + OFF_PARTS);
    bf16_t* __restrict__ cat = (bf16_t*)(p.ws + OFF_H);
    bf16_t* __restrict__ dbuf = (bf16_t*)(p.ws + OFF_DBUF);
    const int nrows = (l == 0 ? ROWS : ROWS_L);
    const int gsz = gridDim.x * 256;
    for (int i = blockIdx.x * 256 + otid(); i < nrows * 32; i += gsz) {
        const int row = i >> 5, c8 = (i & 31) * 8;
        int seq0, n;
        if (row < ROWS_L) { seq0 = (row >> 13) << 13; n = SEQ; } else { seq0 = ROWS_L + (((row - ROWS_L) >> 8) << 8); n = CTX; }
        const int pos = row - seq0;
        const bf16_t* pr = parts + (size_t)row * PW + c8;
        {
            float cc[8], hc[8], tp[8], tc[8], tn[8], w0[8], w1[8], w2[8], bs[8], bc[8], zc[8], o[8];
            unpack8(*(const uint4*)(pr + PC_CC), cc); unpack8(*(const uint4*)(pr + PC_HC), hc);
#pragma unroll
            for (int e = 0; e < 8; ++e) tc[e] = cc[e] * hc[e];
            if (pos > 0) {
                unpack8(*(const uint4*)(pr - PW + PC_CC), cc); unpack8(*(const uint4*)(pr - PW + PC_HC), hc);
#pragma unroll
                for (int e = 0; e < 8; ++e) tp[e] = cc[e] * hc[e];
            } else {
#pragma unroll
                for (int e = 0; e < 8; ++e) tp[e] = 0.f;
            }
            if (pos + 1 < n) {
                unpack8(*(const uint4*)(pr + PW + PC_CC), cc); unpack8(*(const uint4*)(pr + PW + PC_HC), hc);
#pragma unroll
                for (int e = 0; e < 8; ++e) tn[e] = cc[e] * hc[e];
            } else {
#pragma unroll
                for (int e = 0; e < 8; ++e) tn[e] = 0.f;
            }
            ld8(p.conv_w + l * 768 + c8, w0); ld8(p.conv_w + l * 768 + 256 + c8, w1); ld8(p.conv_w + l * 768 + 512 + c8, w2); ld8(p.conv_b + l * 256 + c8, bs);
            unpack8(*(const uint4*)(pr + PC_BC), bc); unpack8(*(const uint4*)(pr + PC_ZC), zc);
#pragma unroll
            for (int e = 0; e < 8; ++e) o[e] = silu_f(zc[e]) * (bc[e] * (tp[e] * w0[e] + tc[e] * w1[e] + tn[e] * w2[e] + bs[e]));
            *(uint4*)(cat + (size_t)row * DM + 512 + c8) = pack8(o);
        }
        {
            const int g = c8 >> 6, w = 2 << g, left = w >> 1, right = w - 1 - left;
            const int lo = max(pos - left, 0), hi = min(pos + right + 1, n);
            float sum[8], u[8];
#pragma unroll
            for (int e = 0; e < 8; ++e) sum[e] = 0.f;
            const bf16_t* pu = parts + (size_t)seq0 * PW + PC_UP + c8;
#pragma unroll 4
            for (int q = lo; q < hi; ++q) {
                unpack8(*(const uint4*)(pu + (size_t)q * PW), u);
#pragma unroll
                for (int e = 0; e < 8; ++e) sum[e] += u[e];
            }
            unpack8(*(const uint4*)(pr + PC_UP), u);
            const float ic = 1.f / (float)(hi - lo);
#pragma unroll
            for (int e = 0; e < 8; ++e) sum[e] = sum[e] * ic - u[e];
            *(uint4*)(dbuf + (size_t)row * 256 + c8) = pack8(sum);
        }
    }
}

DI void phase_dft1(const Params& p, int l, bf16_t* smem) {
    const int tid = otid();
    float* st = (float*)smem;
    const bf16_t* parts = (const bf16_t*)(p.ws + OFF_PARTS);
    const bf16_t* F1 = (const bf16_t*)(p.ws + OFF_F1);
    const bf16_t* FC = (const bf16_t*)(p.ws + OFF_FC);
    const float* tw = (const float*)(p.ws + OFF_TW);
    bf16_t* G1 = (bf16_t*)(p.ws + OFF_G1);
    bf16_t* pcat = (bf16_t*)(p.ws + OFF_PCAT);
    const int nt1 = 2 * 64 * 4;
    const int ntot = nt1 + (l == 0 ? 16 : 0);
    for (int it = blockIdx.x; it < ntot; it += gridDim.x) {
        f32x4 acc[4][4];
        if (it < nt1) {
            const int b = it >> 8, t2 = (it >> 2) & 63, mt = (it >> 1) & 1, nt = it & 1;
            gemm_core<true>(F1 + (size_t)mt * 128 * 128, 128, parts + (size_t)(b * SEQ + t2) * PW + PC_UF + nt * 128, 64 * PW, 128, acc, smem);
            stage_acc(acc, st);
#pragma unroll 1
            for (int i = 0; i < 4; ++i) {
                const int q = tid + 256 * i, kk = q >> 4, c8 = (q & 15) * 8;
                const int rr = 32 * (kk >> 4) + (kk & 15);
                const int k1 = mt * 64 + kk;
                const float cs = tw[2 * (k1 * t2)], sn = tw[2 * (k1 * t2) + 1];
                float gr[8], gi[8], o[8];
                ld8(st + rr * ST_LD + c8, gr);
                ld8(st + (rr + 16) * ST_LD + c8, gi);
                bf16_t* dr = G1 + ((size_t)((b * 128 + k1) * 2 + 0) * 64 + t2) * 256 + nt * 128 + c8;
#pragma unroll
                for (int e = 0; e < 8; ++e) o[e] = gr[e] * cs + gi[e] * sn;
                *(uint4*)dr = pack8(o);
#pragma unroll
                for (int e = 0; e < 8; ++e) o[e] = gi[e] * cs - gr[e] * sn;
                *(uint4*)(dr + (size_t)64 * 256) = pack8(o);
            }
        } else {
            const int j0 = it - nt1, b = j0 >> 3, mt = (j0 >> 1) & 3, nt = j0 & 1;
            gemm_core<true>(FC + (size_t)mt * 128 * 256, 256, parts + (size_t)(ROWS_L + b * CTX) * PW + PC_UF + nt * 128, PW, 256, acc, smem);
            stage_acc(acc, st);
#pragma unroll 1
            for (int i = 0; i < 8; ++i) {
                const int q = tid + 256 * i, rl = q >> 4, c8 = (q & 15) * 8;
                const int m = mt * 128 + rl, c = m >> 8, k = m & 255;
                float v[8];
                ld8(st + rl * ST_LD + c8, v);
                *(uint4*)(pcat + (size_t)(ROWS_L + b * CTX + k) * 512 + c * 256 + nt * 128 + c8) = pack8(v);
            }
        }
    }
}

DI void phase_dft2_mixp(const Params& p, int l, bf16_t* smem) {
    const int tid = otid();
    float* st = (float*)smem;
    const bf16_t* F2 = (const bf16_t*)(p.ws + OFF_F2);
    const bf16_t* G1 = (const bf16_t*)(p.ws + OFF_G1);
    bf16_t* pcat = (bf16_t*)(p.ws + OFF_PCAT);
    const bf16_t* dbuf = (const bf16_t*)(p.ws + OFF_DBUF);
    const bf16_t* wp = (const bf16_t*)(p.ws + OFF_WPOOL) + (size_t)l * 65536;
    const bf16_t* parts = (const bf16_t*)(p.ws + OFF_PARTS);
    bf16_t* cat = (bf16_t*)(p.ws + OFF_H);
    const int nt2 = 2 * 128 * 2;
    const int nmt = (l == 0 ? ROWS : ROWS_L) / 128;
    const int ntot = nt2 + nmt * 2;
    for (int it = blockIdx.x; it < ntot; it += gridDim.x) {
        f32x4 acc[4][4];
        if (it < nt2) {
            const int b = it >> 8, k1 = (it >> 1) & 127, nt = it & 1;
            gemm_core<true>(F2, 128, G1 + (size_t)(b * 128 + k1) * 128 * 256 + nt * 128, 256, 128, acc, smem);
            stage_acc(acc, st);
#pragma unroll 1
            for (int i = 0; i < 8; ++i) {
                const int q = tid + 256 * i, m = q >> 4, c8 = (q & 15) * 8;
                const int c = m >> 6, k2 = m & 63;
                float v[8];
                ld8(st + m * ST_LD + c8, v);
                *(uint4*)(pcat + (size_t)(b * SEQ + k1 + 128 * k2) * 512 + c * 256 + nt * 128 + c8) = pack8(v);
            }
        } else {
            const int j0 = it - nt2, tm = j0 >> 1, nt = j0 & 1;
            gemm_core_dma(dbuf + (size_t)tm * 128 * 256 + nt * 128, 256, wp + (size_t)(nt * 128) * 256 + nt * 128, 256, 128, acc, smem);
            stage_acc(acc, st);
            {
                const int c8 = (tid & 15) * 8, r0 = tid >> 4, n = nt * 128 + c8;
                float ps[8];
                ld8(p.pool_scale + l * 256 + n, ps);
                uint4 zr[8];
#pragma unroll
                for (int i = 0; i < 8; ++i) zr[i] = *(const uint4*)(parts + (size_t)(tm * 128 + r0 + 16 * i) * PW + PC_ZP + n);
#pragma unroll
                for (int i = 0; i < 8; ++i) {
                    float v[8], z[8];
                    ld8(st + (r0 + 16 * i) * ST_LD + c8, v);
                    unpack8(zr[i], z);
#pragma unroll
                    for (int e = 0; e < 8; ++e) v[e] = silu_f(z[e]) * ps[e] * v[e];
                    *(uint4*)(cat + (size_t)(tm * 128 + r0 + 16 * i) * DM + 768 + n) = pack8(v);
                }
            }
        }
    }
}

DI void phase_mixf(const Params& p, int l, bf16_t* smem) {
    const int tid = otid();
    float* st = (float*)smem;
    const bf16_t* pcat = (const bf16_t*)(p.ws + OFF_PCAT);
    const bf16_t* wc = (const bf16_t*)(p.ws + OFF_WCOMB) + (size_t)l * 131072;
    const bf16_t* parts = (const bf16_t*)(p.ws + OFF_PARTS);
    bf16_t* cat = (bf16_t*)(p.ws + OFF_H);
    const int nmt = (l == 0 ? ROWS : ROWS_L) / 128;
    for (int it = blockIdx.x; it < nmt * 2; it += gridDim.x) {
        const int tm = it >> 1, nt = it & 1;
        f32x4 acc[4][4];
        gemm_core_dma(pcat + (size_t)tm * 128 * 512, 512, wc + (size_t)(nt * 128) * 512, 512, 512, acc, smem);
        stage_acc(acc, st);
        const float sc = (tm < 128) ? 0.001381067932004976f : 0.0078125f;
        {
            const int c8 = (tid & 15) * 8, r0 = tid >> 4, n = nt * 128 + c8;
            uint4 zr[8];
#pragma unroll
            for (int i = 0; i < 8; ++i) zr[i] = *(const uint4*)(parts + (size_t)(tm * 128 + r0 + 16 * i) * PW + PC_ZF + n);
#pragma unroll
            for (int i = 0; i < 8; ++i) {
                float v[8], z[8];
                ld8(st + (r0 + 16 * i) * ST_LD + c8, v);
                unpack8(zr[i], z);
#pragma unroll
                for (int e = 0; e < 8; ++e) v[e] = silu_f(z[e]) * sc * v[e];
                *(uint4*)(cat + (size_t)(tm * 128 + r0 + 16 * i) * DM + n) = pack8(v);
            }
        }
    }
}

DI void phase_out(const Params& p, int l, const float* xl_in, const float* xc_in, float* xl_out, float* xc_out, bf16_t* smem) {
    const int tid = otid();
    float* st = (float*)smem;
    const bf16_t* cat = (const bf16_t*)(p.ws + OFF_H);
    const bf16_t* W = (const bf16_t*)(p.ws + OFF_WTOUT) + (size_t)l * DM * DM;
    const float* modv = (const float*)(p.ws + OFF_MODV) + (size_t)l * 3 * 3072;
    const int nmt = (l == 0 ? ROWS : ROWS_L) / 128;
    for (XIter t = xiter(nmt * 8); t.u < t.end; t.u += t.step) {
        int tm, tn;
        if (t.u < 1024) { const int ch = t.u >> 6, r = t.u & 63; tn = r >> 3; tm = ch * 8 + (r & 7); }
        else { const int j = t.u - 1024; tn = j >> 2; tm = 128 + (j & 3); }
        f32x4 acc[4][4];
        gemm_core_dma(cat + (size_t)tm * 128 * DM, DM, W + (size_t)tn * 128 * DM, DM, DM, acc, smem);
        stage_acc(acc, st);
        const int rb = tm * 128;
        const int v = (rb < ROWS_L) ? (rb >> 13) : 2;
        const float* gate = modv + v * 3072 + 2048;
        const float* xin = (rb < ROWS_L) ? xl_in : xc_in - (size_t)ROWS_L * DM;
        float* xout = (rb < ROWS_L) ? xl_out : xc_out - (size_t)ROWS_L * DM;
        {
            const int c8 = (tid & 15) * 8, r0 = tid >> 4;
            const size_t o0 = (size_t)(rb + r0) * DM + tn * 128 + c8;
            float gt[8];
            ld8(gate + tn * 128 + c8, gt);
            float4 x0[8], x1[8];
#pragma unroll
            for (int i = 0; i < 8; ++i) { x0[i] = *(const float4*)(xin + o0 + (size_t)i * 16 * DM); x1[i] = *(const float4*)(xin + o0 + (size_t)i * 16 * DM + 4); }
#pragma unroll
            for (int i = 0; i < 8; ++i) {
                float a[8];
                ld8(st + (r0 + 16 * i) * ST_LD + c8, a);
                float* d = xout + o0 + (size_t)i * 16 * DM;
                *(float4*)(d) = make_float4(x0[i].x + gt[0] * a[0], x0[i].y + gt[1] * a[1], x0[i].z + gt[2] * a[2], x0[i].w + gt[3] * a[3]);
                *(float4*)(d + 4) = make_float4(x1[i].x + gt[4] * a[4], x1[i].y + gt[5] * a[5], x1[i].z + gt[6] * a[6], x1[i].w + gt[7] * a[7]);
            }
        }
    }
}

#ifndef PH_MASK
#define PH_MASK 0xFFFF
#endif
#ifndef PH_DUP
#define PH_DUP 0
#endif
__global__ void __launch_bounds__(256, 2) fwd_megakernel(Params p) {
    __shared__ __attribute__((aligned(16))) unsigned char smem_raw[SMEM_BYTES];
    bf16_t* smem = (bf16_t*)smem_raw;
    float* smf = (float*)smem_raw;
    volatile LAS unsigned* stw = (volatile LAS unsigned*)(smem_raw + SMEM_MAIN);
    if (threadIdx.x == 0) { stw[0] = 0u; stw[1] = 0u; stw[2] = 0u; stw[3] = 0u; }
    __syncthreads();
    if (p.never) cg::this_grid().sync();
    XcdBarrier bar = xcd_barrier_post((unsigned*)(p.ws + OFF_BAR), stw);

    if (PH_MASK & 1) phase0(p, smf);
    if (PH_DUP & 1) phase0(p, smf);
    xcd_barrier(bar);
    float* xc1 = (float*)(p.ws + OFF_XC1);
    for (int l = 0; l < 2; ++l) {
        const float* xl_in = (l == 0) ? p.x : p.out;
        const float* xc_in = (l == 0) ? p.ctx : xc1;
        if (PH_MASK & 2) phase_norm(p, l, xl_in, xc_in);
        if (PH_DUP & 2) phase_norm(p, l, xl_in, xc_in);
        xcd_barrier(bar);
        if (PH_MASK & 4) phase_inproj(p, l, smem);
        if (PH_DUP & 4) phase_inproj(p, l, smem);
        xcd_barrier(bar);
        if (PH_MASK & 8) phase_attn(p, l, smem);
        if (PH_DUP & 8) phase_attn(p, l, smem);
        if (PH_MASK & 16) phase_convpool(p, l);
        if (PH_DUP & 16) phase_convpool(p, l);
        if (PH_MASK & 32) phase_dft1(p, l, smem);
        if (PH_DUP & 32) phase_dft1(p, l, smem);
        xcd_barrier(bar);
        if (PH_MASK & 64) phase_dft2_mixp(p, l, smem);
        if (PH_DUP & 64) phase_dft2_mixp(p, l, smem);
        xcd_barrier(bar);
        if (PH_MASK & 128) phase_mixf(p, l, smem);
        if (PH_DUP & 128) phase_mixf(p, l, smem);
        xcd_barrier(bar);
        if (PH_MASK & 256) phase_out(p, l, xl_in, xc_in, p.out, xc1, smem);
        if (PH_DUP & 256) phase_out(p, l, xl_in, xc_in, (float*)(p.ws + OFF_G1), (float*)(p.ws + OFF_G1), smem);
        if (l == 0) xcd_barrier(bar);
    }
}

extern "C" void kernel_launch(void* const* d_in, const int* in_sizes, int n_in, void* d_out, int out_size, void* d_ws, size_t ws_size, hipStream_t stream) {
    static int grid_blocks = 0;
    if (!grid_blocks) {
        int dev = 0, cus = 0, per_cu = 0;
        hipGetDevice(&dev);
        hipDeviceGetAttribute(&cus, hipDeviceAttributeMultiprocessorCount, dev);
        hipOccupancyMaxActiveBlocksPerMultiprocessor(&per_cu, fwd_megakernel, 256, 0);
        if (per_cu > 2) per_cu = 2;
        if (per_cu < 1) per_cu = 1;
        grid_blocks = cus * per_cu;
        if (ws_size < WS_END) fprintf(stderr, "kernel_launch: workspace too small: %zu < %zu\n", ws_size, (size_t)WS_END);
    }
    hipMemsetAsync((char*)d_ws + OFF_BAR, 0, 16384, stream);
    Params p{};
    p.x = (const float*)d_in[0]; p.c = (const float*)d_in[1]; p.ctx = (const float*)d_in[2]; p.c_ctx = (const float*)d_in[3];
    p.w_mod = (const float*)d_in[4]; p.b_mod = (const float*)d_in[5]; p.norm_g = (const float*)d_in[6]; p.w_in = (const float*)d_in[7];
    p.q_gain = (const float*)d_in[8]; p.k_gain = (const float*)d_in[9]; p.w_fourier = (const float*)d_in[10]; p.conv_w = (const float*)d_in[11];
    p.conv_b = (const float*)d_in[12]; p.pool_w = (const float*)d_in[13]; p.pool_scale = (const float*)d_in[14]; p.w_out = (const float*)d_in[15];
    p.out = (float*)d_out; p.ws = (unsigned char*)d_ws; p.never = 0; p.pad = 0;
    void* args[] = {&p};
    hipError_t e = hipLaunchCooperativeKernel((void*)fwd_megakernel, dim3(grid_blocks), dim3(256), args, 0, stream);
    if (e != hipSuccess) fprintf(stderr, "cooperative launch failed: %s (grid %d)\n", hipGetErrorString(e), grid_blocks);
}
```

```cpp
#include <hip/hip_runtime.h>
#include <hip/hip_cooperative_groups.h>
#include <stdint.h>
#include <cstdio>
namespace cg = cooperative_groups;

typedef unsigned short bf16_t;
typedef __attribute__((ext_vector_type(8))) short bf16x8;
typedef __attribute__((ext_vector_type(4))) short bf16x4;
typedef __attribute__((ext_vector_type(4))) float f32x4;
typedef __attribute__((ext_vector_type(16))) float f32x16;
#define DI __device__ __forceinline__

#define SEQ 8192
#define CTX 256
#define DM 1024
#define DIN 2816
#define ROWS_L 16384
#define ROWS_C 512
#define ROWS 16896
#define NKEY 8448
#define PW 2304
#define PC_ZATT 0
#define PC_UF 256
#define PC_ZF 512
#define PC_BC 768
#define PC_CC 1024
#define PC_HC 1280
#define PC_ZC 1536
#define PC_UP 1792
#define PC_ZP 2048

constexpr size_t OFF_BAR = 0;
constexpr size_t OFF_MODV = 16384;
constexpr size_t OFF_ROPE = OFF_MODV + 2 * 3 * 3072 * 4;
constexpr size_t OFF_TW = OFF_ROPE + 6144 * 4;
constexpr size_t OFF_F1 = OFF_TW + 8192 * 2 * 4;
constexpr size_t OFF_F2 = OFF_F1 + 256 * 128 * 2;
constexpr size_t OFF_FC = OFF_F2 + 128 * 128 * 2;
constexpr size_t OFF_WCOMB = OFF_FC + 512 * 256 * 2;
constexpr size_t OFF_WPOOL = OFF_WCOMB + 2 * 256 * 512 * 2;
constexpr size_t OFF_WTIN = 2097152;
constexpr size_t OFF_WTOUT = OFF_WTIN + (size_t)2 * DIN * DM * 2;
constexpr size_t OFF_H = OFF_WTOUT + (size_t)2 * DM * DM * 2;
constexpr size_t OFF_PARTS = OFF_H + (size_t)ROWS * DM * 2;
constexpr size_t OFF_Q = OFF_PARTS + (size_t)ROWS * PW * 2;
constexpr size_t OFF_QC = OFF_Q + (size_t)2 * 4 * SEQ * 64 * 2;
constexpr size_t OFF_K = OFF_QC + (size_t)2 * 4 * CTX * 64 * 2;
constexpr size_t OFF_VT = OFF_K + (size_t)2 * 2 * NKEY * 64 * 2;
constexpr size_t OFF_DBUF = OFF_VT + (size_t)2 * 2 * NKEY * 64 * 2;
constexpr size_t OFF_G1 = OFF_DBUF + (size_t)ROWS * 256 * 2;
constexpr size_t OFF_PCAT = OFF_G1 + (size_t)2 * 128 * 2 * 64 * 256 * 2;
constexpr size_t OFF_XC1 = OFF_PCAT + (size_t)ROWS * 512 * 2;
constexpr size_t WS_END = OFF_XC1 + (size_t)ROWS_C * DM * 4;
static_assert(OFF_WPOOL + 2 * 256 * 256 * 2 <= OFF_WTIN, "ws map");

struct Params {
    const float *x, *c, *ctx, *c_ctx, *w_mod, *b_mod, *norm_g, *w_in, *q_gain, *k_gain, *w_fourier, *conv_w, *conv_b, *pool_w, *pool_scale, *w_out;
    float* out;
    unsigned char* ws;
    int never;
    int pad;
};

DI bf16_t f2bf(float x) { unsigned u = __float_as_uint(x); u += 0x7fffu + ((u >> 16) & 1u); return (bf16_t)(u >> 16); }
DI float bf2f(bf16_t h) { return __uint_as_float(((unsigned)h) << 16); }
typedef __attribute__((ext_vector_type(2))) float f32x2;
typedef __attribute__((ext_vector_type(2))) __bf16 bf16x2v;
DI unsigned pack2(float a, float b) { const f32x2 v = {a, b}; return __builtin_bit_cast(unsigned, __builtin_convertvector(v, bf16x2v)); }
struct XIter { int u, end, step; };
DI XIter xiter(int ntiles) {
    const int x = blockIdx.x & 7, j = blockIdx.x >> 3, nb = gridDim.x >> 3, per = (ntiles + 7) >> 3;
    XIter r; r.u = x * per + j; r.end = min((x + 1) * per, ntiles); r.step = nb; return r;
}
DI float silu_f(float z) { return z / (1.f + __expf(-z)); }
DI float bflo(unsigned w) { return __uint_as_float(w << 16); }
DI float bfhi(unsigned w) { return __uint_as_float(w & 0xffff0000u); }
DI int otid() { int t = threadIdx.x; asm volatile("" : "+v"(t)); return t; }

#define XB_TMO      128
#define XB_XCNT(j)  (256  + 64 * (j))
#define XB_XSUB(j)  (1280 + 64 * (j))
#define XB_XGEN(j)  (2304 + 64 * (j))
#define XB_TOP      3328
#define XB_TOPGEN   3392
#define XCD_BAR_WORDS 3456
#define XB_SPIN_CAP (1u << 20)
#define LAS __attribute__((address_space(3)))
DI unsigned xb_ld(unsigned* p) { return __hip_atomic_load(p, __ATOMIC_RELAXED, __HIP_MEMORY_SCOPE_AGENT); }
DI unsigned xb_add(unsigned* p, unsigned v) { return __hip_atomic_fetch_add(p, v, __ATOMIC_RELAXED, __HIP_MEMORY_SCOPE_AGENT); }
DI unsigned xb_xcc_id() { return (unsigned)__builtin_amdgcn_s_getreg((3 << 11) | 20) & 0xFu; }
#define XB_SPIN(cond, bar) do { unsigned _sp = 0; while (cond) { __builtin_amdgcn_s_sleep(1); \
    if ((++_sp & 255u) == 0u) { if (xb_ld(&(bar)[XB_TMO])) break; if (_sp > XB_SPIN_CAP) { atomicAdd(&(bar)[XB_TMO], 1u); break; } } } } while (0)
struct XcdBarrier { unsigned* bar; unsigned x; volatile LAS unsigned* st; };
DI XcdBarrier xcd_barrier_post(unsigned* bar, volatile LAS unsigned* st) {
    XcdBarrier b; b.bar = bar; b.x = xb_xcc_id(); b.st = st;
    if (threadIdx.x == 0) (void)xb_add(&bar[XB_XCNT(b.x)], 1u);
    return b;
}
DI void xcd_barrier_complete(unsigned* bar, unsigned x, unsigned& nloc, unsigned& nx) {
    const unsigned G = gridDim.x * gridDim.y * gridDim.z;
    unsigned sum, cnt, mine, sp = 0u;
    for (;;) {
        sum = 0u; cnt = 0u; mine = 0u;
#pragma unroll
        for (unsigned j = 0; j < 16; ++j) { const unsigned c = xb_ld(&bar[XB_XCNT(j)]); sum += c; cnt += (c > 0u) ? 1u : 0u; mine = (j == x) ? c : mine; }
        if (sum == G) break;
        __builtin_amdgcn_s_sleep(1);
        if ((++sp & 255u) == 0u) { if (xb_ld(&bar[XB_TMO])) break; if (sp > XB_SPIN_CAP) { atomicAdd(&bar[XB_TMO], 1u); break; } }
    }
    nloc = mine > 0u ? mine : 1u; nx = cnt > 0u ? cnt : 1u;
}
DI void xcd_barrier(const XcdBarrier& b) {
    asm volatile("s_waitcnt vmcnt(0)" ::: "memory");
    __syncthreads();
    if (threadIdx.x == 0) {
        unsigned* bar = b.bar;
        __builtin_amdgcn_s_waitcnt(0);
        unsigned nloc = b.st[0], nx = b.st[1];
        if (nloc == 0u) { xcd_barrier_complete(bar, b.x, nloc, nx); b.st[0] = nloc; b.st[1] = nx; }
        const unsigned old = xb_add(&bar[XB_XSUB(b.x)], 1u);
        const unsigned gen = old / nloc;
        if (old + 1u == (gen + 1u) * nloc) {
            __builtin_amdgcn_fence(__ATOMIC_RELEASE, "agent");
            asm volatile("s_waitcnt vmcnt(0)" ::: "memory");
            const unsigned og = xb_add(&bar[XB_TOP], 1u);
            const unsigned tg = og / nx;
            if (og + 1u == (tg + 1u) * nx) xb_add(&bar[XB_TOPGEN], 1u);
            else XB_SPIN(xb_ld(&bar[XB_TOPGEN]) == tg, bar);
            __builtin_amdgcn_fence(__ATOMIC_ACQUIRE, "agent");
            xb_add(&bar[XB_XGEN(b.x)], 1u);
            asm volatile("s_waitcnt vmcnt(0)" ::: "memory");
        } else {
            XB_SPIN(xb_ld(&bar[XB_XGEN(b.x)]) == gen, bar);
            __builtin_amdgcn_fence(__ATOMIC_ACQUIRE, "agent");
            asm volatile("s_waitcnt vmcnt(0)" ::: "memory");
        }
    }
    __syncthreads();
}

#define LROW 72
#define TILE_E (128 * LROW)
#define SMEM_MAIN (4 * TILE_E * 2)
#define SMEM_BYTES (SMEM_MAIN + 16)

typedef __attribute__((ext_vector_type(4))) unsigned u32x4;
struct Stg { u32x4 a0, a1, a2, a3, b0, b1, b2, b3; };
template <bool BN>
DI u32x4 g_ld_b(const bf16_t* __restrict__ B, int ldb, int kt, int q) {
    if (!BN) return *(const u32x4*)(B + (size_t)(q >> 3) * ldb + kt * 64 + (q & 7) * 8);
    else     return *(const u32x4*)(B + (size_t)(kt * 64 + (q >> 4)) * ldb + (q & 15) * 8);
}
template <bool BN>
DI void g_load(Stg& r, const bf16_t* __restrict__ A, int lda, const bf16_t* __restrict__ B, int ldb, int kt, int tid) {
    const bf16_t* ap = A + (size_t)(tid >> 3) * lda + kt * 64 + (tid & 7) * 8;
    r.a0 = *(const u32x4*)(ap);
    r.a1 = *(const u32x4*)(ap + (size_t)32 * lda);
    r.a2 = *(const u32x4*)(ap + (size_t)64 * lda);
    r.a3 = *(const u32x4*)(ap + (size_t)96 * lda);
    r.b0 = g_ld_b<BN>(B, ldb, kt, tid);
    r.b1 = g_ld_b<BN>(B, ldb, kt, tid + 256);
    r.b2 = g_ld_b<BN>(B, ldb, kt, tid + 512);
    r.b3 = g_ld_b<BN>(B, ldb, kt, tid + 768);
}
template <bool BN>
DI void s_st_b(bf16_t* b, const u32x4 v, int q) {
    if (!BN) *(u32x4*)(b + (q >> 3) * LROW + (q & 7) * 8) = v;
    else {
        const int kr = q >> 4, n0 = (q & 15) * 8;
        b[(n0 + 0) * LROW + kr] = (bf16_t)(v.x & 0xffffu); b[(n0 + 1) * LROW + kr] = (bf16_t)(v.x >> 16);
        b[(n0 + 2) * LROW + kr] = (bf16_t)(v.y & 0xffffu); b[(n0 + 3) * LROW + kr] = (bf16_t)(v.y >> 16);
        b[(n0 + 4) * LROW + kr] = (bf16_t)(v.z & 0xffffu); b[(n0 + 5) * LROW + kr] = (bf16_t)(v.z >> 16);
        b[(n0 + 6) * LROW + kr] = (bf16_t)(v.w & 0xffffu); b[(n0 + 7) * LROW + kr] = (bf16_t)(v.w >> 16);
    }
}
template <bool BN>
DI void s_store(const Stg& r, bf16_t* smem, int buf, int tid) {
    bf16_t* a = smem + buf * 2 * TILE_E;
    bf16_t* b = a + TILE_E;
    bf16_t* ap = a + (tid >> 3) * LROW + (tid & 7) * 8;
    *(u32x4*)(ap) = r.a0;
    *(u32x4*)(ap + 32 * LROW) = r.a1;
    *(u32x4*)(ap + 64 * LROW) = r.a2;
    *(u32x4*)(ap + 96 * LROW) = r.a3;
    s_st_b<BN>(b, r.b0, tid);
    s_st_b<BN>(b, r.b1, tid + 256);
    s_st_b<BN>(b, r.b2, tid + 512);
    s_st_b<BN>(b, r.b3, tid + 768);
}
DI void mma_tile(const bf16_t* smem, int buf, f32x4 (&acc)[4][4], int wm, int wn, int lane) {
    const bf16_t* a = smem + buf * 2 * TILE_E;
    const bf16_t* b = a + TILE_E;
#pragma unroll
    for (int kk = 0; kk < 2; ++kk) {
        bf16x8 af[4], bfr[4];
#pragma unroll
        for (int mi = 0; mi < 4; ++mi) af[mi] = *(const bf16x8*)(a + (wm * 64 + mi * 16 + (lane & 15)) * LROW + kk * 32 + (lane >> 4) * 8);
#pragma unroll
        for (int ni = 0; ni < 4; ++ni) bfr[ni] = *(const bf16x8*)(b + (wn * 64 + ni * 16 + (lane & 15)) * LROW + kk * 32 + (lane >> 4) * 8);
#pragma unroll
        for (int mi = 0; mi < 4; ++mi)
#pragma unroll
            for (int ni = 0; ni < 4; ++ni) acc[mi][ni] = __builtin_amdgcn_mfma_f32_16x16x32_bf16(af[mi], bfr[ni], acc[mi][ni], 0, 0, 0);
    }
}
template <bool BN>
DI void gemm_core(const bf16_t* __restrict__ A, int lda, const bf16_t* __restrict__ B, int ldb, int K, f32x4 (&acc)[4][4], bf16_t* smem) {
    const int tid = otid(), lane = tid & 63, wave = tid >> 6;
    const int wm = wave >> 1, wn = wave & 1;
#pragma unroll
    for (int mi = 0; mi < 4; ++mi)
#pragma unroll
        for (int ni = 0; ni < 4; ++ni) acc[mi][ni] = (f32x4){0.f, 0.f, 0.f, 0.f};
    const int nk = K >> 6;
    Stg r0, r1;
    __syncthreads();
    g_load<BN>(r0, A, lda, B, ldb, 0, tid);
    g_load<BN>(r1, A, lda, B, ldb, 1, tid);
    s_store<BN>(r0, smem, 0, tid);
    __syncthreads();
    for (int kt = 0; kt < nk; kt += 2) {
        if (kt + 2 < nk) g_load<BN>(r0, A, lda, B, ldb, kt + 2, tid);
        mma_tile(smem, 0, acc, wm, wn, lane);
        s_store<BN>(r1, smem, 1, tid);
        __syncthreads();
        if (kt + 3 < nk) g_load<BN>(r1, A, lda, B, ldb, kt + 3, tid);
        mma_tile(smem, 1, acc, wm, wn, lane);
        if (kt + 2 < nk) s_store<BN>(r0, smem, 0, tid);
        __syncthreads();
    }
}
#define GT_E (128 * 64)
DI void glds_tile(const bf16_t* __restrict__ G, int ld, int kt, bf16_t* lt, int tid) {
    const int c = (tid & 7) ^ ((tid >> 4) & 7);
    const bf16_t* g = G + (size_t)(tid >> 3) * ld + kt * 64 + c * 8;
    char* l = (char*)lt + tid * 16;
#pragma unroll
    for (int p = 0; p < 4; ++p)
        __builtin_amdgcn_global_load_lds((const unsigned*)(g + (size_t)(p * 32) * ld), (LAS unsigned*)(l + p * 4096), 16, 0, 0);
}
DI void mma_tile_sw(const bf16_t* smem, int buf, f32x4 (&acc)[4][4], int wm, int wn, int lane) {
    const char* a = (const char*)(smem + buf * 2 * GT_E);
    const char* b = a + GT_E * 2;
    const int sw = (lane & 15) >> 1;
#pragma unroll
    for (int kk = 0; kk < 2; ++kk) {
        bf16x8 af[4], bfr[4];
        const int co = ((kk * 4 + (lane >> 4)) ^ sw) << 4;
#pragma unroll
        for (int mi = 0; mi < 4; ++mi) af[mi] = *(const bf16x8*)(a + (wm * 64 + mi * 16 + (lane & 15)) * 128 + co);
#pragma unroll
        for (int ni = 0; ni < 4; ++ni) bfr[ni] = *(const bf16x8*)(b + (wn * 64 + ni * 16 + (lane & 15)) * 128 + co);
#pragma unroll
        for (int mi = 0; mi < 4; ++mi)
#pragma unroll
            for (int ni = 0; ni < 4; ++ni) acc[mi][ni] = __builtin_amdgcn_mfma_f32_16x16x32_bf16(af[mi], bfr[ni], acc[mi][ni], 0, 0, 0);
    }
}
DI void gemm_core_dma(const bf16_t* __restrict__ A, int lda, const bf16_t* __restrict__ B, int ldb, int K, f32x4 (&acc)[4][4], bf16_t* smem) {
    const int tid = otid(), lane = tid & 63, wave = tid >> 6;
    const int wm = wave >> 1, wn = wave & 1;
#pragma unroll
    for (int mi = 0; mi < 4; ++mi)
#pragma unroll
        for (int ni = 0; ni < 4; ++ni) acc[mi][ni] = (f32x4){0.f, 0.f, 0.f, 0.f};
    const int nk = K >> 6;
    __syncthreads();
    glds_tile(A, lda, 0, smem, tid);
    glds_tile(B, ldb, 0, smem + GT_E, tid);
    for (int kt = 0; kt < nk; ++kt) {
        asm volatile("s_waitcnt vmcnt(0)" ::: "memory");
        __syncthreads();
        if (kt + 1 < nk) {
            bf16_t* nb = smem + ((kt + 1) & 1) * 2 * GT_E;
            glds_tile(A, lda, kt + 1, nb, tid);
            glds_tile(B, ldb, kt + 1, nb + GT_E, tid);
        }
        mma_tile_sw(smem, kt & 1, acc, wm, wn, lane);
    }
    __syncthreads();
}
#define ST_LD 132
DI void stage_acc(f32x4 (&acc)[4][4], float* st) {
    const int lane = otid() & 63, wave = otid() >> 6, wm = wave >> 1, wn = wave & 1, fl = lane & 15, g4 = lane >> 4;
#pragma unroll
    for (int mi = 0; mi < 4; ++mi)
#pragma unroll
        for (int ni = 0; ni < 4; ++ni)
#pragma unroll
            for (int j = 0; j < 4; ++j) st[(wm * 64 + mi * 16 + g4 * 4 + j) * ST_LD + wn * 64 + ni * 16 + fl] = acc[mi][ni][j];
    __syncthreads();
}
DI void ld8(const float* q, float (&v)[8]) {
    const float4 a = *(const float4*)q, b = *(const float4*)(q + 4);
    v[0] = a.x; v[1] = a.y; v[2] = a.z; v[3] = a.w; v[4] = b.x; v[5] = b.y; v[6] = b.z; v[7] = b.w;
}
DI uint4 pack8(const float (&v)[8]) { return make_uint4(pack2(v[0], v[1]), pack2(v[2], v[3]), pack2(v[4], v[5]), pack2(v[6], v[7])); }
DI void unpack8(const uint4 u, float (&v)[8]) {
    v[0] = bflo(u.x); v[1] = bfhi(u.x); v[2] = bflo(u.y); v[3] = bfhi(u.y); v[4] = bflo(u.z); v[5] = bfhi(u.z); v[6] = bflo(u.w); v[7] = bfhi(u.w);
}

DI void phase0(const Params& p, float* smf) {
    const int tid = otid();
    unsigned char* ws = p.ws;
    float* modv = (float*)(ws + OFF_MODV);
    for (int it = blockIdx.x; it < 192; it += gridDim.x) {
        const int l = it / 96, n0 = (it % 96) * 32;
        __syncthreads();
        for (int i = tid; i < 3072; i += 256) {
            const int v = i >> 10, k = i & 1023;
            const float cv = (v == 0) ? p.c[k] : (v == 1) ? p.c[1024 + k] : p.c_ctx[k];
            smf[i] = silu_f(cv);
        }
        __syncthreads();
        const int col = tid & 31, kg = tid >> 5;
        float a0 = 0.f, a1 = 0.f, a2 = 0.f;
        const float* w = p.w_mod + (size_t)l * 1024 * 3072 + n0 + col;
#pragma unroll 16
        for (int kk = 0; kk < 128; ++kk) {
            const int k = kg * 128 + kk;
            const float wv = w[(size_t)k * 3072];
            a0 += smf[k] * wv; a1 += smf[1024 + k] * wv; a2 += smf[2048 + k] * wv;
        }
        __syncthreads();
        smf[3072 + (kg * 3 + 0) * 32 + col] = a0; smf[3072 + (kg * 3 + 1) * 32 + col] = a1; smf[3072 + (kg * 3 + 2) * 32 + col] = a2;
        __syncthreads();
        if (tid < 96) {
            const int v = tid >> 5, cc = tid & 31;
            float s = 0.f;
            for (int g = 0; g < 8; ++g) s += smf[3072 + (g * 3 + v) * 32 + cc];
            modv[(l * 3 + v) * 3072 + n0 + cc] = s + p.b_mod[l * 3072 + n0 + cc];
        }
    }
    {
        const int n_in = 2 * 16 * 44, n_out = 2 * 16 * 16;
        for (int it = blockIdx.x; it < n_in + n_out; it += gridDim.x) {
            const float* src; bf16_t* dst; int N, kt, nt;
            if (it < n_in) { const int l = it / 704, r = it % 704; kt = r / 44; nt = r % 44; N = DIN; src = p.w_in + (size_t)l * DM * DIN; dst = (bf16_t*)(ws + OFF_WTIN) + (size_t)l * DIN * DM; }
            else { const int j = it - n_in; const int l = j / 256, r = j % 256; kt = r / 16; nt = r % 16; N = DM; src = p.w_out + (size_t)l * DM * DM; dst = (bf16_t*)(ws + OFF_WTOUT) + (size_t)l * DM * DM; }
            __syncthreads();
#pragma unroll
            for (int ps = 0; ps < 4; ++ps) {
                const int kr = ps * 16 + (tid >> 4), c4 = (tid & 15) * 4;
                const float4 v = *(const float4*)(src + (size_t)(kt * 64 + kr) * N + nt * 64 + c4);
                smf[kr * 65 + c4 + 0] = v.x; smf[kr * 65 + c4 + 1] = v.y; smf[kr * 65 + c4 + 2] = v.z; smf[kr * 65 + c4 + 3] = v.w;
            }
            __syncthreads();
            const int n = tid >> 2, ks = (tid & 3) * 16;
            unsigned w[8];
#pragma unroll
            for (int e = 0; e < 8; ++e) w[e] = pack2(smf[(ks + 2 * e) * 65 + n], smf[(ks + 2 * e + 1) * 65 + n]);
            bf16_t* d = dst + (size_t)(nt * 64 + n) * DM + kt * 64 + ks;
            *(uint4*)d = make_uint4(w[0], w[1], w[2], w[3]);
            *(uint4*)(d + 8) = make_uint4(w[4], w[5], w[6], w[7]);
        }
    }
    const int gtid = blockIdx.x * 256 + tid, gsz = gridDim.x * 256;
    {
        bf16_t* wc = (bf16_t*)(ws + OFF_WCOMB);
        __syncthreads();
        if (tid < 64) { smf[tid] = cospif((float)tid * (1.f / 32.f)); smf[64 + tid] = sinpif((float)tid * (1.f / 32.f)); }
        __syncthreads();
        for (int i = gtid; i < 2 * 512 * 256; i += gsz) {
            const int n = i & 255, kk = (i >> 8) & 511, l = i >> 17;
            const int c = kk >> 8, head = (kk >> 6) & 3, ch = kk & 63;
            const float* wf = p.w_fourier + (size_t)l * 65536 + (size_t)(head * 64) * 256 + n;
            float s = 0.f;
#pragma unroll 16
            for (int j = 0; j < 64; ++j) s += smf[c * 64 + ((j * ch) & 63)] * wf[j * 256];
            wc[(size_t)l * 131072 + n * 512 + kk] = f2bf(s);
        }
    }
    {
        bf16_t* wp = (bf16_t*)(ws + OFF_WPOOL);
        for (int i = gtid; i < 2 * 256 * 256; i += gsz) {
            const int k = i & 255, n = (i >> 8) & 255, l = i >> 16;
            float v = 0.f;
            if ((k >> 6) == (n >> 6)) v = p.pool_w[(size_t)l * 16384 + (n >> 6) * 4096 + (k & 63) * 64 + (n & 63)];
            wp[i] = f2bf(v);
        }
    }
    {
        float* tw = (float*)(ws + OFF_TW);
        for (int i = gtid; i < 8192; i += gsz) { const float a = (float)i * (1.f / 4096.f); tw[2 * i] = cospif(a); tw[2 * i + 1] = sinpif(a); }
        bf16_t* f1 = (bf16_t*)(ws + OFF_F1);
        for (int i = gtid; i < 256 * 128; i += gsz) {
            const int t1 = i & 127, m = i >> 7;
            const int k1 = (m >> 5) * 16 + (m & 15), c = (m >> 4) & 1;
            const float a = (float)((k1 * t1) & 127) * (1.f / 64.f);
            f1[i] = f2bf(c ? -sinpif(a) : cospif(a));
        }
        bf16_t* f2 = (bf16_t*)(ws + OFF_F2);
        for (int i = gtid; i < 128 * 128; i += gsz) {
            const int kx = i & 127, m = i >> 7;
            const int c = m >> 6, k2 = m & 63, cp = kx >> 6, t2 = kx & 63;
            const float a = (float)((k2 * t2) & 63) * (1.f / 32.f);
            float v;
            if (c == cp) v = cospif(a); else if (c == 0) v = sinpif(a); else v = -sinpif(a);
            f2[i] = f2bf(v);
        }
        bf16_t* fc = (bf16_t*)(ws + OFF_FC);
        for (int i = gtid; i < 512 * 256; i += gsz) {
            const int t = i & 255, m = i >> 8;
            const int c = m >> 8, k = m & 255;
            const float a = (float)((k * t) & 255) * (1.f / 128.f);
            fc[i] = f2bf(c ? -sinpif(a) : cospif(a));
        }
        float* rp = (float*)(ws + OFF_ROPE);
        for (int i = gtid; i < 3072; i += gsz) {
            const int f = i & 15;
            const int pos = (i < 2048) ? (i >> 4) : ((i - 2048) >> 4);
            const float inv = powf(10000.f, -(float)f * (1.f / 16.f));
            const float ang = (float)pos * inv;
            const double ad = (double)ang;
            const float cs = (float)cos(ad), sn = (float)sin(ad);
            if (i < 2048) { rp[i] = cs; rp[2048 + i] = sn; }
            else { rp[4096 + (i - 2048)] = cs; rp[5120 + (i - 2048)] = sn; }
        }
    }
}

DI void phase_norm(const Params& p, int l, const float* xl, const float* xc) {
    const int lane = otid() & 63, wave = otid() >> 6;
    const float* modv = (const float*)(p.ws + OFF_MODV) + (size_t)l * 3 * 3072;
    const float* g = p.norm_g + l * 1024;
    bf16_t* H = (bf16_t*)(p.ws + OFF_H);
    for (int row = blockIdx.x * 4 + wave; row < ROWS; row += gridDim.x * 4) {
        const float* src = (row < ROWS_L) ? xl + (size_t)row * DM : xc + (size_t)(row - ROWS_L) * DM;
        const int v = (row < ROWS_L) ? (row >> 13) : 2;
        const float* mv = modv + v * 3072;
        float4 a[4];
        float ss = 0.f;
#pragma unroll
        for (int i = 0; i < 4; ++i) { a[i] = *(const float4*)(src + i * 256 + lane * 4); ss += a[i].x * a[i].x + a[i].y * a[i].y + a[i].z * a[i].z + a[i].w * a[i].w; }
#pragma unroll
        for (int o = 32; o >= 1; o >>= 1) ss += __shfl_xor(ss, o);
        const float rs = rsqrtf(ss * (1.f / 1024.f) + 1e-6f);
#pragma unroll
        for (int i = 0; i < 4; ++i) {
            const int c0 = i * 256 + lane * 4;
            const float4 gg = *(const float4*)(g + c0), sh = *(const float4*)(mv + c0), sc = *(const float4*)(mv + 1024 + c0);
            const float o0 = a[i].x * rs * gg.x * (1.f + sc.x) + sh.x, o1 = a[i].y * rs * gg.y * (1.f + sc.y) + sh.y;
            const float o2 = a[i].z * rs * gg.z * (1.f + sc.z) + sh.z, o3 = a[i].w * rs * gg.w * (1.f + sc.w) + sh.w;
            *(uint2*)(H + (size_t)row * DM + c0) = make_uint2(pack2(o0, o1), pack2(o2, o3));
        }
    }
}

DI void epi_inproj(const Params& p, int l, int tm, int tn, f32x4 (&acc)[4][4], float* st) {
    const int tid = otid();
    unsigned char* ws = p.ws;
    stage_acc(acc, st);
    const int rbase = tm * 128;
    const bool isctx = rbase >= ROWS_L;
    if (tn < 3) {
        const bool isq = tn < 2;
        const float* gain = (isq ? p.q_gain : p.k_gain) + l * 64;
        const float* rp = (const float*)(ws + OFF_ROPE);
#pragma unroll 1
        for (int i = 0; i < 8; ++i) {
            const int q = tid + 256 * i, rl = q >> 4, c8 = (q & 15) * 8;
            const int row = rbase + rl, hd = c8 >> 6, d0 = c8 & 63;
            float v[8], pv[8], g[8], pg[8];
            ld8(st + rl * ST_LD + c8, v);
            ld8(st + rl * ST_LD + (c8 ^ 16), pv);
            ld8(gain + d0, g);
            ld8(gain + (d0 ^ 16), pg);
            float ss = 0.f;
#pragma unroll
            for (int e = 0; e < 8; ++e) ss += v[e] * v[e];
            ss += __shfl_xor(ss, 1); ss += __shfl_xor(ss, 2); ss += __shfl_xor(ss, 4);
            const float rs = rsqrtf(ss * (1.f / 64.f) + 1e-6f);
#pragma unroll
            for (int e = 0; e < 8; ++e) { v[e] *= rs * g[e]; pv[e] *= rs * pg[e]; }
            bf16_t* dst;
            if (!isctx) {
                const int b = row >> 13, t = row & 8191;
                const int pos = (d0 >= 32) ? (t & 63) : (t >> 6);
                const float* ct = rp + ((d0 >= 32) ? 4096 : 0) + pos * 16 + (d0 & 8);
                float cs[8], sn[8];
                ld8(ct, cs);
                ld8(ct + ((d0 >= 32) ? 1024 : 2048), sn);
                const float sg = (d0 & 16) ? 1.f : -1.f;
#pragma unroll
                for (int e = 0; e < 8; ++e) v[e] = v[e] * cs[e] + sg * pv[e] * sn[e];
                if (isq) dst = (bf16_t*)(ws + OFF_Q) + ((size_t)(b * 4 + tn * 2 + hd) * SEQ + t) * 64 + d0;
                else     dst = (bf16_t*)(ws + OFF_K) + ((size_t)(b * 2 + hd) * NKEY + CTX + t) * 64 + d0;
            } else {
                const int rc = row - ROWS_L, b = rc >> 8, t = rc & 255;
                if (isq) dst = (bf16_t*)(ws + OFF_QC) + ((size_t)(b * 4 + tn * 2 + hd) * CTX + t) * 64 + d0;
                else     dst = (bf16_t*)(ws + OFF_K) + ((size_t)(b * 2 + hd) * NKEY + t) * 64 + d0;
            }
            if (isq) {
#pragma unroll
                for (int e = 0; e < 8; ++e) v[e] *= 0.18033688011112042f;
            }
            *(uint4*)dst = pack8(v);
        }
    } else if (tn == 3) {
        int b, key0;
        if (!isctx) { b = rbase >> 13; key0 = CTX + (rbase & 8191); } else { const int rc = rbase - ROWS_L; b = rc >> 8; key0 = rc & 255; }
#pragma unroll 1
        for (int i = 0; i < 8; ++i) {
            const int q = tid + 256 * i, col = q & 127, r8 = (q >> 7) * 8;
            float v[8];
#pragma unroll
            for (int e = 0; e < 8; ++e) v[e] = st[(r8 + e) * ST_LD + col];
            bf16_t* vt = (bf16_t*)(ws + OFF_VT) + ((size_t)(b * 2 + (col >> 6)) * 64 + (col & 63)) * NKEY + key0 + r8;
            *(uint4*)vt = pack8(v);
        }
    } else {
        bf16_t* parts = (bf16_t*)(ws + OFF_PARTS);
#pragma unroll 1
        for (int i = 0; i < 8; ++i) {
            const int q = tid + 256 * i, rl = q >> 4, c8 = (q & 15) * 8;
            float v[8];
            ld8(st + rl * ST_LD + c8, v);
            *(uint4*)(parts + (size_t)(rbase + rl) * PW + tn * 128 - 512 + c8) = pack8(v);
        }
    }
}

DI void phase_inproj(const Params& p, int l, bf16_t* smem) {
    const bf16_t* H = (const bf16_t*)(p.ws + OFF_H);
    const bf16_t* W = (const bf16_t*)(p.ws + OFF_WTIN) + (size_t)l * DIN * DM;
    const int nlat = 128 * 22;
    const int ntiles = nlat + (l == 0 ? 4 * 22 : 4 * 2);
    for (XIter t = xiter(ntiles); t.u < t.end; t.u += t.step) {
        const int u = t.u;
        int tm, tn;
        if (u < nlat) { const int ch = u / 176, r = u % 176; tn = r >> 3; tm = ch * 8 + (r & 7); }
        else { const int j = u - nlat; tm = 128 + (j & 3); tn = (l == 0 ? 0 : 2) + (j >> 2); }
        f32x4 acc[4][4];
        gemm_core_dma(H + (size_t)tm * 128 * DM, DM, W + (size_t)tn * 128 * DM, DM, DM, acc, smem);
        epi_inproj(p, l, tm, tn, acc, (float*)smem);
    }
}

#define KT_E (64 * LROW)
DI void attn_item(const Params& p, const bf16_t* Qb, const bf16_t* Kb, const bf16_t* VTb, int ntiles, int rowbase, int hq, bf16_t* smem) {
    const int tid = otid(), lane = tid & 63, wave = tid >> 6;
    const int r = lane & 31, h = lane >> 5;
    const float LOG2E = 1.4426950408889634f;
    bf16x8 qf[4];
    {
        const bf16_t* qrow = Qb + (size_t)(wave * 32 + r) * 64;
#pragma unroll
        for (int s = 0; s < 4; ++s) qf[s] = *(const bf16x8*)(qrow + s * 16 + h * 8);
    }
    f32x16 ot[2], minit;
#pragma unroll
    for (int i = 0; i < 16; ++i) { ot[0][i] = 0.f; ot[1][i] = 0.f; minit[i] = 0.f; }
    float m = 0.f, lsum = 0.f;
    uint4 rk[2], rv[2];
    auto gload = [&](int kt) {
#pragma unroll
        for (int i = 0; i < 2; ++i) {
            const int q = tid + 256 * i;
            rk[i] = *(const uint4*)(Kb + (size_t)(kt * 64 + (q >> 3)) * 64 + (q & 7) * 8);
            rv[i] = *(const uint4*)(VTb + (size_t)(q >> 3) * NKEY + kt * 64 + (q & 7) * 8);
        }
    };
    auto sstore = [&](int buf) {
        bf16_t* sk = smem + buf * 2 * KT_E;
        bf16_t* sv = sk + KT_E;
#pragma unroll
        for (int i = 0; i < 2; ++i) {
            const int q = tid + 256 * i;
            *(uint4*)(sk + (q >> 3) * LROW + (q & 7) * 8) = rk[i];
            *(uint4*)(sv + (q >> 3) * LROW + (q & 7) * 8) = rv[i];
        }
    };
    __syncthreads();
    gload(0);
    sstore(0);
    __syncthreads();
    for (int kt = 0; kt < ntiles; ++kt) {
        if (kt + 1 < ntiles) gload(kt + 1);
        const bf16_t* sk = smem + (kt & 1) * 2 * KT_E;
        const bf16_t* sv = sk + KT_E;
        f32x16 st[2], pe[2];
#pragma unroll
        for (int blk = 0; blk < 2; ++blk) {
            st[blk] = __builtin_amdgcn_mfma_f32_32x32x16_bf16(*(const bf16x8*)(sk + (blk * 32 + r) * LROW + h * 8), qf[0], minit, 0, 0, 0);
#pragma unroll
            for (int s = 1; s < 4; ++s)
                st[blk] = __builtin_amdgcn_mfma_f32_32x32x16_bf16(*(const bf16x8*)(sk + (blk * 32 + r) * LROW + s * 16 + h * 8), qf[s], st[blk], 0, 0, 0);
        }
        float ls = 0.f;
#pragma unroll
        for (int i = 0; i < 16; ++i) {
            pe[0][i] = __builtin_amdgcn_exp2f(st[0][i]); ls += pe[0][i];
            pe[1][i] = __builtin_amdgcn_exp2f(st[1][i]); ls += pe[1][i];
        }
        if (kt == 0 || __any(!(ls <= 256.f))) {
            float tmx = st[0][0];
#pragma unroll
            for (int i = 0; i < 16; ++i) { tmx = fmaxf(tmx, st[0][i]); tmx = fmaxf(tmx, st[1][i]); }
            tmx = fmaxf(tmx, __shfl_xor(tmx, 32));
            const float delta = (kt == 0) ? tmx : fmaxf(tmx, 0.f);
            const float alpha = (kt == 0) ? 1.f : __builtin_amdgcn_exp2f(-delta);
            m += delta;
            lsum *= alpha;
            ls = 0.f;
#pragma unroll
            for (int i = 0; i < 16; ++i) {
                ot[0][i] *= alpha; ot[1][i] *= alpha; minit[i] = -m;
                pe[0][i] = __builtin_amdgcn_exp2f(st[0][i] - delta); ls += pe[0][i];
                pe[1][i] = __builtin_amdgcn_exp2f(st[1][i] - delta); ls += pe[1][i];
            }
        }
        lsum += ls;
        bf16x8 pk[2][2];
#pragma unroll
        for (int blk = 0; blk < 2; ++blk)
#pragma unroll
            for (int s = 0; s < 2; ++s) {
                uint4 u;
                u.x = pack2(pe[blk][8 * s + 0], pe[blk][8 * s + 1]); u.y = pack2(pe[blk][8 * s + 2], pe[blk][8 * s + 3]);
                u.z = pack2(pe[blk][8 * s + 4], pe[blk][8 * s + 5]); u.w = pack2(pe[blk][8 * s + 6], pe[blk][8 * s + 7]);
                pk[blk][s] = __builtin_bit_cast(bf16x8, u);
            }
#pragma unroll
        for (int db = 0; db < 2; ++db)
#pragma unroll
            for (int blk = 0; blk < 2; ++blk)
#pragma unroll
                for (int s = 0; s < 2; ++s) {
                    const bf16_t* vp = sv + (db * 32 + r) * LROW + blk * 32 + s * 16 + h * 4;
                    const bf16x4 lo = *(const bf16x4*)vp;
                    const bf16x4 hi = *(const bf16x4*)(vp + 8);
                    const bf16x8 vf = __builtin_shufflevector(lo, hi, 0, 1, 2, 3, 4, 5, 6, 7);
                    ot[db] = __builtin_amdgcn_mfma_f32_32x32x16_bf16(vf, pk[blk][s], ot[db], 0, 0, 0);
                }
        if (kt + 1 < ntiles) sstore((kt + 1) & 1);
        __syncthreads();
    }
    lsum += __shfl_xor(lsum, 32);
    const float inv = 1.f / lsum;
    const int row = rowbase + wave * 32 + r;
    const bf16_t* zrow = (const bf16_t*)(p.ws + OFF_PARTS) + (size_t)row * PW + PC_ZATT + hq * 64;
    bf16_t* orow = (bf16_t*)(p.ws + OFF_H) + (size_t)row * DM + 256 + hq * 64;
#pragma unroll
    for (int db = 0; db < 2; ++db)
#pragma unroll
        for (int g = 0; g < 4; ++g) {
            const int d = db * 32 + g * 8 + h * 4;
            const uint2 z = *(const uint2*)(zrow + d);
            const float o0 = silu_f(bflo(z.x)) * ot[db][4 * g + 0] * inv, o1 = silu_f(bfhi(z.x)) * ot[db][4 * g + 1] * inv;
            const float o2 = silu_f(bflo(z.y)) * ot[db][4 * g + 2] * inv, o3 = silu_f(bfhi(z.y)) * ot[db][4 * g + 3] * inv;
            *(uint2*)(orow + d) = make_uint2(pack2(o0, o1), pack2(o2, o3));
        }
}

DI void phase_attn(const Params& p, int l, bf16_t* smem) {
    const bf16_t* Q = (const bf16_t*)(p.ws + OFF_Q);
    const bf16_t* QC = (const bf16_t*)(p.ws + OFF_QC);
    const bf16_t* Kk = (const bf16_t*)(p.ws + OFF_K);
    const bf16_t* VT = (const bf16_t*)(p.ws + OFF_VT);
    for (XIter t = xiter(512); t.u < t.end; t.u += t.step) {
        const int it = t.u;
        const int b = it >> 8, hq = (it >> 6) & 3, qt = it & 63;
        const size_t kv = (size_t)(b * 2 + (hq >> 1));
        attn_item(p, Q + ((size_t)(b * 4 + hq) * SEQ + qt * 128) * 64, Kk + kv * NKEY * 64, VT + kv * 64 * NKEY, NKEY / 64, b * SEQ + qt * 128, hq, smem);
    }
    if (l == 0) {
        for (int j = blockIdx.x; j < 16; j += gridDim.x) {
            const int b = j >> 3, hq = (j >> 1) & 3, qt = j & 1;
            const size_t kv = (size_t)(b * 2 + (hq >> 1));
            attn_item(p, QC + ((size_t)(b * 4 + hq) * CTX + qt * 128) * 64, Kk + kv * NKEY * 64, VT + kv * 64 * NKEY, CTX / 64, ROWS_L + b * CTX + qt * 128, hq, smem);
        }
    }
}

template <int W>
DI void pool_task(const bf16_t* __restrict__ pu, int pos, int n, bf16_t* __restrict__ dst) {
    constexpr int LEFT = W / 2;
    uint4 raw[W];
#pragma unroll
    for (int t = 0; t < W; ++t) { int q = pos - LEFT + t; q = q < 0 ? 0 : (q >= n ? n - 1 : q); raw[t] = *(const uint4*)(pu + (size_t)q * PW); }
    float sum[8], u[8];
#pragma unroll
    for (int e = 0; e < 8; ++e) sum[e] = 0.f;
#pragma unroll
    for (int t = 0; t < W; ++t) {
        const int q = pos - LEFT + t;
        const float mk = (q >= 0 && q < n) ? 1.f : 0.f;
        unpack8(raw[t], u);
#pragma unroll
        for (int e = 0; e < 8; ++e) sum[e] += mk * u[e];
    }
    const int lo = max(pos - LEFT, 0), hi = min(pos + W - LEFT, n);
    const float ic = 1.f / (float)(hi - lo);
    unpack8(raw[LEFT], u);
#pragma unroll
    for (int e = 0; e < 8; ++e) sum[e] = sum[e] * ic - u[e];
    *(uint4*)dst = pack8(sum);
}
DI void phase_convpool(const Params& p, int l) {
    const bf16_t* __restrict__ parts = (const bf16_t*)(p.ws + OFF_PARTS);
    bf16_t* __restrict__ cat = (bf16_t*)(p.ws + OFF_H);
    bf16_t* __restrict__ dbuf = (bf16_t*)(p.ws + OFF_DBUF);
    const int nrows = (l == 0 ? ROWS : ROWS_L);
    const int gsz = gridDim.x * 256, gt = blockIdx.x * 256 + otid();
    {
        const int c8 = (gt & 31) * 8;
        float w0[8], w1[8], w2[8], bs[8];
        ld8(p.conv_w + l * 768 + c8, w0); ld8(p.conv_w + l * 768 + 256 + c8, w1); ld8(p.conv_w + l * 768 + 512 + c8, w2); ld8(p.conv_b + l * 256 + c8, bs);
        for (int i = gt; i < nrows * 32; i += gsz) {
            const int row = i >> 5;
            int seq0, n;
            if (row < ROWS_L) { seq0 = (row >> 13) << 13; n = SEQ; } else { seq0 = ROWS_L + (((row - ROWS_L) >> 8) << 8); n = CTX; }
            const int pos = row - seq0;
            const bf16_t* pr = parts + (size_t)row * PW + c8;
            const bool hp = pos > 0, hn = pos + 1 < n;
            const bf16_t* pp = hp ? pr - PW : pr;
            const bf16_t* pn = hn ? pr + PW : pr;
            const uint4 r0 = *(const uint4*)(pr + PC_CC), r1 = *(const uint4*)(pr + PC_HC), r2 = *(const uint4*)(pp + PC_CC), r3 = *(const uint4*)(pp + PC_HC);
            const uint4 r4 = *(const uint4*)(pn + PC_CC), r5 = *(const uint4*)(pn + PC_HC), r6 = *(const uint4*)(pr + PC_BC), r7 = *(const uint4*)(pr + PC_ZC);
            const float mp = hp ? 1.f : 0.f, mn = hn ? 1.f : 0.f;
            float a[8], b[8], tc[8], tp[8], tn[8], o[8];
            unpack8(r0, a); unpack8(r1, b);
#pragma unroll
            for (int e = 0; e < 8; ++e) tc[e] = a[e] * b[e];
            unpack8(r2, a); unpack8(r3, b);
#pragma unroll
            for (int e = 0; e < 8; ++e) tp[e] = a[e] * b[e] * mp;
            unpack8(r4, a); unpack8(r5, b);
#pragma unroll
            for (int e = 0; e < 8; ++e) tn[e] = a[e] * b[e] * mn;
            unpack8(r6, a); unpack8(r7, b);
#pragma unroll
            for (int e = 0; e < 8; ++e) o[e] = silu_f(b[e]) * (a[e] * (tp[e] * w0[e] + tc[e] * w1[e] + tn[e] * w2[e] + bs[e]));
            *(uint4*)(cat + (size_t)row * DM + 512 + c8) = pack8(o);
        }
    }
    for (int j = gt; j < nrows * 32; j += gsz) {
        const int g = j / (nrows * 8), rem = j - g * (nrows * 8), row = rem >> 3, c8 = g * 64 + (rem & 7) * 8;
        int seq0, n;
        if (row < ROWS_L) { seq0 = (row >> 13) << 13; n = SEQ; } else { seq0 = ROWS_L + (((row - ROWS_L) >> 8) << 8); n = CTX; }
        const bf16_t* pu = parts + (size_t)seq0 * PW + PC_UP + c8;
        bf16_t* dst = dbuf + (size_t)row * 256 + c8;
        const int pos = row - seq0;
        if (g == 0) pool_task<2>(pu, pos, n, dst);
        else if (g == 1) pool_task<4>(pu, pos, n, dst);
        else if (g == 2) pool_task<8>(pu, pos, n, dst);
        else pool_task<16>(pu, pos, n, dst);
    }
}

DI void phase_dft1(const Params& p, int l, bf16_t* smem) {
    const int tid = otid();
    float* st = (float*)smem;
    const bf16_t* parts = (const bf16_t*)(p.ws + OFF_PARTS);
    const bf16_t* F1 = (const bf16_t*)(p.ws + OFF_F1);
    const bf16_t* FC = (const bf16_t*)(p.ws + OFF_FC);
    const float* tw = (const float*)(p.ws + OFF_TW);
    bf16_t* G1 = (bf16_t*)(p.ws + OFF_G1);
    bf16_t* pcat = (bf16_t*)(p.ws + OFF_PCAT);
    const int nt1 = 2 * 64 * 4;
    const int ntot = nt1 + (l == 0 ? 16 : 0);
    for (int it = blockIdx.x; it < ntot; it += gridDim.x) {
        f32x4 acc[4][4];
        if (it < nt1) {
            const int b = it >> 8, t2 = (it >> 2) & 63, mt = (it >> 1) & 1, nt = it & 1;
            gemm_core<true>(F1 + (size_t)mt * 128 * 128, 128, parts + (size_t)(b * SEQ + t2) * PW + PC_UF + nt * 128, 64 * PW, 128, acc, smem);
            stage_acc(acc, st);
#pragma unroll 1
            for (int i = 0; i < 4; ++i) {
                const int q = tid + 256 * i, kk = q >> 4, c8 = (q & 15) * 8;
                const int rr = 32 * (kk >> 4) + (kk & 15);
                const int k1 = mt * 64 + kk;
                const float cs = tw[2 * (k1 * t2)], sn = tw[2 * (k1 * t2) + 1];
                float gr[8], gi[8], o[8];
                ld8(st + rr * ST_LD + c8, gr);
                ld8(st + (rr + 16) * ST_LD + c8, gi);
                bf16_t* dr = G1 + ((size_t)((b * 128 + k1) * 2 + 0) * 64 + t2) * 256 + nt * 128 + c8;
#pragma unroll
                for (int e = 0; e < 8; ++e) o[e] = gr[e] * cs + gi[e] * sn;
                *(uint4*)dr = pack8(o);
#pragma unroll
                for (int e = 0; e < 8; ++e) o[e] = gi[e] * cs - gr[e] * sn;
                *(uint4*)(dr + (size_t)64 * 256) = pack8(o);
            }
        } else {
            const int j0 = it - nt1, b = j0 >> 3, mt = (j0 >> 1) & 3, nt = j0 & 1;
            gemm_core<true>(FC + (size_t)mt * 128 * 256, 256, parts + (size_t)(ROWS_L + b * CTX) * PW + PC_UF + nt * 128, PW, 256, acc, smem);
            stage_acc(acc, st);
#pragma unroll 1
            for (int i = 0; i < 8; ++i) {
                const int q = tid + 256 * i, rl = q >> 4, c8 = (q & 15) * 8;
                const int m = mt * 128 + rl, c = m >> 8, k = m & 255;
                float v[8];
                ld8(st + rl * ST_LD + c8, v);
                *(uint4*)(pcat + (size_t)(ROWS_L + b * CTX + k) * 512 + c * 256 + nt * 128 + c8) = pack8(v);
            }
        }
    }
}

DI void phase_dft2_mixp(const Params& p, int l, bf16_t* smem) {
    const int tid = otid();
    float* st = (float*)smem;
    const bf16_t* F2 = (const bf16_t*)(p.ws + OFF_F2);
    const bf16_t* G1 = (const bf16_t*)(p.ws + OFF_G1);
    bf16_t* pcat = (bf16_t*)(p.ws + OFF_PCAT);
    const bf16_t* dbuf = (const bf16_t*)(p.ws + OFF_DBUF);
    const bf16_t* wp = (const bf16_t*)(p.ws + OFF_WPOOL) + (size_t)l * 65536;
    const bf16_t* parts = (const bf16_t*)(p.ws + OFF_PARTS);
    bf16_t* cat = (bf16_t*)(p.ws + OFF_H);
    const int nt2 = 2 * 128 * 2;
    const int nmt = (l == 0 ? ROWS : ROWS_L) / 128;
    const int ntot = nt2 + nmt * 2;
    for (int it = blockIdx.x; it < ntot; it += gridDim.x) {
        f32x4 acc[4][4];
        if (it < nt2) {
            const int b = it >> 8, k1 = (it >> 1) & 127, nt = it & 1;
            gemm_core<true>(F2, 128, G1 + (size_t)(b * 128 + k1) * 128 * 256 + nt * 128, 256, 128, acc, smem);
            stage_acc(acc, st);
#pragma unroll 1
            for (int i = 0; i < 8; ++i) {
                const int q = tid + 256 * i, m = q >> 4, c8 = (q & 15) * 8;
                const int c = m >> 6, k2 = m & 63;
                float v[8];
                ld8(st + m * ST_LD + c8, v);
                *(uint4*)(pcat + (size_t)(b * SEQ + k1 + 128 * k2) * 512 + c * 256 + nt * 128 + c8) = pack8(v);
            }
        } else {
            const int j0 = it - nt2, tm = j0 >> 1, nt = j0 & 1;
            gemm_core_dma(dbuf + (size_t)tm * 128 * 256 + nt * 128, 256, wp + (size_t)(nt * 128) * 256 + nt * 128, 256, 128, acc, smem);
            stage_acc(acc, st);
            {
                const int c8 = (tid & 15) * 8, r0 = tid >> 4, n = nt * 128 + c8;
                float ps[8];
                ld8(p.pool_scale + l * 256 + n, ps);
                uint4 zr[8];
#pragma unroll
                for (int i = 0; i < 8; ++i) zr[i] = *(const uint4*)(parts + (size_t)(tm * 128 + r0 + 16 * i) * PW + PC_ZP + n);
#pragma unroll
                for (int i = 0; i < 8; ++i) {
                    float v[8], z[8];
                    ld8(st + (r0 + 16 * i) * ST_LD + c8, v);
                    unpack8(zr[i], z);
#pragma unroll
                    for (int e = 0; e < 8; ++e) v[e] = silu_f(z[e]) * ps[e] * v[e];
                    *(uint4*)(cat + (size_t)(tm * 128 + r0 + 16 * i) * DM + 768 + n) = pack8(v);
                }
            }
        }
    }
}

DI void phase_mixf(const Params& p, int l, bf16_t* smem) {
    const int tid = otid();
    float* st = (float*)smem;
    const bf16_t* pcat = (const bf16_t*)(p.ws + OFF_PCAT);
    const bf16_t* wc = (const bf16_t*)(p.ws + OFF_WCOMB) + (size_t)l * 131072;
    const bf16_t* parts = (const bf16_t*)(p.ws + OFF_PARTS);
    bf16_t* cat = (bf16_t*)(p.ws + OFF_H);
    const int nmt = (l == 0 ? ROWS : ROWS_L) / 128;
    for (int it = blockIdx.x; it < nmt * 2; it += gridDim.x) {
        const int tm = it >> 1, nt = it & 1;
        f32x4 acc[4][4];
        gemm_core_dma(pcat + (size_t)tm * 128 * 512, 512, wc + (size_t)(nt * 128) * 512, 512, 512, acc, smem);
        stage_acc(acc, st);
        const float sc = (tm < 128) ? 0.001381067932004976f : 0.0078125f;
        {
            const int c8 = (tid & 15) * 8, r0 = tid >> 4, n = nt * 128 + c8;
            uint4 zr[8];
#pragma unroll
            for (int i = 0; i < 8; ++i) zr[i] = *(const uint4*)(parts + (size_t)(tm * 128 + r0 + 16 * i) * PW + PC_ZF + n);
#pragma unroll
            for (int i = 0; i < 8; ++i) {
                float v[8], z[8];
                ld8(st + (r0 + 16 * i) * ST_LD + c8, v);
                unpack8(zr[i], z);
#pragma unroll
                for (int e = 0; e < 8; ++e) v[e] = silu_f(z[e]) * sc * v[e];
                *(uint4*)(cat + (size_t)(tm * 128 + r0 + 16 * i) * DM + n) = pack8(v);
            }
        }
    }
}

DI void phase_out(const Params& p, int l, const float* xl_in, const float* xc_in, float* xl_out, float* xc_out, bf16_t* smem) {
    const int tid = otid();
    float* st = (float*)smem;
    const bf16_t* cat = (const bf16_t*)(p.ws + OFF_H);
    const bf16_t* W = (const bf16_t*)(p.ws + OFF_WTOUT) + (size_t)l * DM * DM;
    const float* modv = (const float*)(p.ws + OFF_MODV) + (size_t)l * 3 * 3072;
    const int nmt = (l == 0 ? ROWS : ROWS_L) / 128;
    for (XIter t = xiter(nmt * 8); t.u < t.end; t.u += t.step) {
        int tm, tn;
        if (t.u < 1024) { const int ch = t.u >> 6, r = t.u & 63; tn = r >> 3; tm = ch * 8 + (r & 7); }
        else { const int j = t.u - 1024; tn = j >> 2; tm = 128 + (j & 3); }
        f32x4 acc[4][4];
        gemm_core_dma(cat + (size_t)tm * 128 * DM, DM, W + (size_t)tn * 128 * DM, DM, DM, acc, smem);
        stage_acc(acc, st);
        const int rb = tm * 128;
        const int v = (rb < ROWS_L) ? (rb >> 13) : 2;
        const float* gate = modv + v * 3072 + 2048;
        const float* xin = (rb < ROWS_L) ? xl_in : xc_in - (size_t)ROWS_L * DM;
        float* xout = (rb < ROWS_L) ? xl_out : xc_out - (size_t)ROWS_L * DM;
        {
            const int c8 = (tid & 15) * 8, r0 = tid >> 4;
            const size_t o0 = (size_t)(rb + r0) * DM + tn * 128 + c8;
            float gt[8];
            ld8(gate + tn * 128 + c8, gt);
            float4 x0[8], x1[8];
#pragma unroll
            for (int i = 0; i < 8; ++i) { x0[i] = *(const float4*)(xin + o0 + (size_t)i * 16 * DM); x1[i] = *(const float4*)(xin + o0 + (size_t)i * 16 * DM + 4); }
#pragma unroll
            for (int i = 0; i < 8; ++i) {
                float a[8];
                ld8(st + (r0 + 16 * i) * ST_LD + c8, a);
                float* d = xout + o0 + (size_t)i * 16 * DM;
                *(float4*)(d) = make_float4(x0[i].x + gt[0] * a[0], x0[i].y + gt[1] * a[1], x0[i].z + gt[2] * a[2], x0[i].w + gt[3] * a[3]);
                *(float4*)(d + 4) = make_float4(x1[i].x + gt[4] * a[4], x1[i].y + gt[5] * a[5], x1[i].z + gt[6] * a[6], x1[i].w + gt[7] * a[7]);
            }
        }
    }
}

#ifndef PH_MASK
#define PH_MASK 0xFFFF
#endif
#ifndef PH_DUP
#define PH_DUP 0
#endif
__global__ void __launch_bounds__(256, 2) fwd_megakernel(Params p) {
    __shared__ __attribute__((aligned(16))) unsigned char smem_raw[SMEM_BYTES];
    bf16_t* smem = (bf16_t*)smem_raw;
    float* smf = (float*)smem_raw;
    volatile LAS unsigned* stw = (volatile LAS unsigned*)(smem_raw + SMEM_MAIN);
    if (threadIdx.x == 0) { stw[0] = 0u; stw[1] = 0u; stw[2] = 0u; stw[3] = 0u; }
    __syncthreads();
    if (p.never) cg::this_grid().sync();
    XcdBarrier bar = xcd_barrier_post((unsigned*)(p.ws + OFF_BAR), stw);

    if (PH_MASK & 1) phase0(p, smf);
    if (PH_DUP & 1) phase0(p, smf);
    xcd_barrier(bar);
    float* xc1 = (float*)(p.ws + OFF_XC1);
    for (int l = 0; l < 2; ++l) {
        const float* xl_in = (l == 0) ? p.x : p.out;
        const float* xc_in = (l == 0) ? p.ctx : xc1;
        if (PH_MASK & 2) phase_norm(p, l, xl_in, xc_in);
        if (PH_DUP & 2) phase_norm(p, l, xl_in, xc_in);
        xcd_barrier(bar);
        if (PH_MASK & 4) phase_inproj(p, l, smem);
        if (PH_DUP & 4) phase_inproj(p, l, smem);
        xcd_barrier(bar);
        if (PH_MASK & 8) phase_attn(p, l, smem);
        if (PH_DUP & 8) phase_attn(p, l, smem);
        if (PH_MASK & 16) phase_convpool(p, l);
        if (PH_DUP & 16) phase_convpool(p, l);
        if (PH_MASK & 32) phase_dft1(p, l, smem);
        if (PH_DUP & 32) phase_dft1(p, l, smem);
        xcd_barrier(bar);
        if (PH_MASK & 64) phase_dft2_mixp(p, l, smem);
        if (PH_DUP & 64) phase_dft2_mixp(p, l, smem);
        xcd_barrier(bar);
        if (PH_MASK & 128) phase_mixf(p, l, smem);
        if (PH_DUP & 128) phase_mixf(p, l, smem);
        xcd_barrier(bar);
        if (PH_MASK & 256) phase_out(p, l, xl_in, xc_in, p.out, xc1, smem);
        if (PH_DUP & 256) phase_out(p, l, xl_in, xc_in, (float*)(p.ws + OFF_G1), (float*)(p.ws + OFF_G1), smem);
        if (l == 0) xcd_barrier(bar);
    }
}

extern "C" void kernel_launch(void* const* d_in, const int* in_sizes, int n_in, void* d_out, int out_size, void* d_ws, size_t ws_size, hipStream_t stream) {
    static int grid_blocks = 0;
    if (!grid_blocks) {
        int dev = 0, cus = 0, per_cu = 0;
        hipGetDevice(&dev);
        hipDeviceGetAttribute(&cus, hipDeviceAttributeMultiprocessorCount, dev);
        hipOccupancyMaxActiveBlocksPerMultiprocessor(&per_cu, fwd_megakernel, 256, 0);
        if (per_cu > 2) per_cu = 2;
        if (per_cu < 1) per_cu = 1;
        grid_blocks = cus * per_cu;
        if (ws_size < WS_END) fprintf(stderr, "kernel_launch: workspace too small: %zu < %zu\n", ws_size, (size_t)WS_END);
    }
    hipMemsetAsync((char*)d_ws + OFF_BAR, 0, 16384, stream);
    Params p{};
    p.x = (const float*)d_in[0]; p.c = (const float*)d_in[1]; p.ctx = (const float*)d_in[2]; p.c_ctx = (const float*)d_in[3];
    p.w_mod = (const float*)d_in[4]; p.b_mod = (const float*)d_in[5]; p.norm_g = (const float*)d_in[6]; p.w_in = (const float*)d_in[7];
    p.q_gain = (const float*)d_in[8]; p.k_gain = (const float*)d_in[9]; p.w_fourier = (const float*)d_in[10]; p.conv_w = (const float*)d_in[11];
    p.conv_b = (const float*)d_in[12]; p.pool_w = (const float*)d_in[13]; p.pool_scale = (const float*)d_in[14]; p.w_out = (const float*)d_in[15];
    p.out = (float*)d_out; p.ws = (unsigned char*)d_ws; p.never = 0; p.pad = 0;
    void* args[] = {&p};
    hipError_t e = hipLaunchCooperativeKernel((void*)fwd_megakernel, dim3(grid_blocks), dim3(256), args, 0, stream);
    if (e != hipSuccess) fprintf(stderr, "cooperative launch failed: %s (grid %d)\n", hipGetErrorString(e), grid_blocks);
}
```

```cpp
#include <hip/hip_runtime.h>
#include <hip/hip_cooperative_groups.h>
#include <stdint.h>
#include <cstdio>
namespace cg = cooperative_groups;

typedef unsigned short bf16_t;
typedef __attribute__((ext_vector_type(8))) short bf16x8;
typedef __attribute__((ext_vector_type(4))) short bf16x4;
typedef __attribute__((ext_vector_type(4))) float f32x4;
typedef __attribute__((ext_vector_type(16))) float f32x16;
#define DI __device__ __forceinline__

#define SEQ 8192
#define CTX 256
#define DM 1024
#define DIN 2816
#define ROWS_L 16384
#define ROWS_C 512
#define ROWS 16896
#define NKEY 8448
#define PW 2304
#define PC_ZATT 0
#define PC_UF 256
#define PC_ZF 512
#define PC_BC 768
#define PC_CC 1024
#define PC_HC 1280
#define PC_ZC 1536
#define PC_UP 1792
#define PC_ZP 2048

constexpr size_t OFF_BAR = 0;
constexpr size_t OFF_MODV = 16384;
constexpr size_t OFF_ROPE = OFF_MODV + 2 * 3 * 3072 * 4;
constexpr size_t OFF_TW = OFF_ROPE + 6144 * 4;
constexpr size_t OFF_F1 = OFF_TW + 8192 * 2 * 4;
constexpr size_t OFF_F2 = OFF_F1 + 256 * 128 * 2;
constexpr size_t OFF_FC = OFF_F2 + 128 * 128 * 2;
constexpr size_t OFF_WCOMB = OFF_FC + 512 * 256 * 2;
constexpr size_t OFF_WPOOL = OFF_WCOMB + 2 * 256 * 512 * 2;
constexpr size_t OFF_WTIN = 2097152;
constexpr size_t OFF_WTOUT = OFF_WTIN + (size_t)2 * DIN * DM * 2;
constexpr size_t OFF_H = OFF_WTOUT + (size_t)2 * DM * DM * 2;
constexpr size_t OFF_PARTS = OFF_H + (size_t)ROWS * DM * 2;
constexpr size_t OFF_Q = OFF_PARTS + (size_t)ROWS * PW * 2;
constexpr size_t OFF_QC = OFF_Q + (size_t)2 * 4 * SEQ * 64 * 2;
constexpr size_t OFF_K = OFF_QC + (size_t)2 * 4 * CTX * 64 * 2;
constexpr size_t OFF_VT = OFF_K + (size_t)2 * 2 * NKEY * 64 * 2;
constexpr size_t OFF_DBUF = OFF_VT + (size_t)2 * 2 * NKEY * 64 * 2;
constexpr size_t OFF_G1 = OFF_DBUF + (size_t)ROWS * 256 * 2;
constexpr size_t OFF_PCAT = OFF_G1 + (size_t)2 * 128 * 2 * 64 * 256 * 2;
constexpr size_t OFF_XC1 = OFF_PCAT + (size_t)ROWS * 512 * 2;
constexpr size_t WS_END = OFF_XC1 + (size_t)ROWS_C * DM * 4;
static_assert(OFF_WPOOL + 2 * 256 * 256 * 2 <= OFF_WTIN, "ws map");

struct Params {
    const float *x, *c, *ctx, *c_ctx, *w_mod, *b_mod, *norm_g, *w_in, *q_gain, *k_gain, *w_fourier, *conv_w, *conv_b, *pool_w, *pool_scale, *w_out;
    float* out;
    unsigned char* ws;
    int never;
    int pad;
};

DI bf16_t f2bf(float x) { unsigned u = __float_as_uint(x); u += 0x7fffu + ((u >> 16) & 1u); return (bf16_t)(u >> 16); }
DI float bf2f(bf16_t h) { return __uint_as_float(((unsigned)h) << 16); }
typedef __attribute__((ext_vector_type(2))) float f32x2;
typedef __attribute__((ext_vector_type(2))) __bf16 bf16x2v;
DI unsigned pack2(float a, float b) { const f32x2 v = {a, b}; return __builtin_bit_cast(unsigned, __builtin_convertvector(v, bf16x2v)); }
struct XIter { int u, end, step; };
DI XIter xiter(int ntiles) {
    const int x = blockIdx.x & 7, j = blockIdx.x >> 3, nb = gridDim.x >> 3, per = (ntiles + 7) >> 3;
    XIter r; r.u = x * per + j; r.end = min((x + 1) * per, ntiles); r.step = nb; return r;
}
DI float silu_f(float z) { return z / (1.f + __expf(-z)); }
DI float bflo(unsigned w) { return __uint_as_float(w << 16); }
DI float bfhi(unsigned w) { return __uint_as_float(w & 0xffff0000u); }
DI int otid() { int t = threadIdx.x; asm volatile("" : "+v"(t)); return t; }

#define XB_TMO      128
#define XB_XCNT(j)  (256  + 64 * (j))
#define XB_XSUB(j)  (1280 + 64 * (j))
#define XB_XGEN(j)  (2304 + 64 * (j))
#define XB_TOP      3328
#define XB_TOPGEN   3392
#define XCD_BAR_WORDS 3456
#define XB_SPIN_CAP (1u << 20)
#define LAS __attribute__((address_space(3)))
DI unsigned xb_ld(unsigned* p) { return __hip_atomic_load(p, __ATOMIC_RELAXED, __HIP_MEMORY_SCOPE_AGENT); }
DI unsigned xb_add(unsigned* p, unsigned v) { return __hip_atomic_fetch_add(p, v, __ATOMIC_RELAXED, __HIP_MEMORY_SCOPE_AGENT); }
DI unsigned xb_xcc_id() { return (unsigned)__builtin_amdgcn_s_getreg((3 << 11) | 20) & 0xFu; }
#define XB_SPIN(cond, bar) do { unsigned _sp = 0; while (cond) { __builtin_amdgcn_s_sleep(1); \
    if ((++_sp & 255u) == 0u) { if (xb_ld(&(bar)[XB_TMO])) break; if (_sp > XB_SPIN_CAP) { atomicAdd(&(bar)[XB_TMO], 1u); break; } } } } while (0)
struct XcdBarrier { unsigned* bar; unsigned x; volatile LAS unsigned* st; };
DI XcdBarrier xcd_barrier_post(unsigned* bar, volatile LAS unsigned* st) {
    XcdBarrier b; b.bar = bar; b.x = xb_xcc_id(); b.st = st;
    if (threadIdx.x == 0) (void)xb_add(&bar[XB_XCNT(b.x)], 1u);
    return b;
}
DI void xcd_barrier_complete(unsigned* bar, unsigned x, unsigned& nloc, unsigned& nx) {
    const unsigned G = gridDim.x * gridDim.y * gridDim.z;
    unsigned sum, cnt, mine, sp = 0u;
    for (;;) {
        sum = 0u; cnt = 0u; mine = 0u;
#pragma unroll
        for (unsigned j = 0; j < 16; ++j) { const unsigned c = xb_ld(&bar[XB_XCNT(j)]); sum += c; cnt += (c > 0u) ? 1u : 0u; mine = (j == x) ? c : mine; }
        if (sum == G) break;
        __builtin_amdgcn_s_sleep(1);
        if ((++sp & 255u) == 0u) { if (xb_ld(&bar[XB_TMO])) break; if (sp > XB_SPIN_CAP) { atomicAdd(&bar[XB_TMO], 1u); break; } }
    }
    nloc = mine > 0u ? mine : 1u; nx = cnt > 0u ? cnt : 1u;
}
DI void xcd_barrier(const XcdBarrier& b) {
    asm volatile("s_waitcnt vmcnt(0)" ::: "memory");
    __syncthreads();
    if (threadIdx.x == 0) {
        unsigned* bar = b.bar;
        __builtin_amdgcn_s_waitcnt(0);
        unsigned nloc = b.st[0], nx = b.st[1];
        if (nloc == 0u) { xcd_barrier_complete(bar, b.x, nloc, nx); b.st[0] = nloc; b.st[1] = nx; }
        const unsigned old = xb_add(&bar[XB_XSUB(b.x)], 1u);
        const unsigned gen = old / nloc;
        if (old + 1u == (gen + 1u) * nloc) {
            __builtin_amdgcn_fence(__ATOMIC_RELEASE, "agent");
            asm volatile("s_waitcnt vmcnt(0)" ::: "memory");
            const unsigned og = xb_add(&bar[XB_TOP], 1u);
            const unsigned tg = og / nx;
            if (og + 1u == (tg + 1u) * nx) xb_add(&bar[XB_TOPGEN], 1u);
            else XB_SPIN(xb_ld(&bar[XB_TOPGEN]) == tg, bar);
            __builtin_amdgcn_fence(__ATOMIC_ACQUIRE, "agent");
            xb_add(&bar[XB_XGEN(b.x)], 1u);
            asm volatile("s_waitcnt vmcnt(0)" ::: "memory");
        } else {
            XB_SPIN(xb_ld(&bar[XB_XGEN(b.x)]) == gen, bar);
            __builtin_amdgcn_fence(__ATOMIC_ACQUIRE, "agent");
            asm volatile("s_waitcnt vmcnt(0)" ::: "memory");
        }
    }
    __syncthreads();
}

#define LROW 72
#define TILE_E (128 * LROW)
#define SMEM_MAIN (4 * TILE_E * 2)
#define SMEM_BYTES (SMEM_MAIN + 16)

typedef __attribute__((ext_vector_type(4))) unsigned u32x4;
struct Stg { u32x4 a0, a1, a2, a3, b0, b1, b2, b3; };
template <bool BN>
DI u32x4 g_ld_b(const bf16_t* __restrict__ B, int ldb, int kt, int q) {
    if (!BN) return *(const u32x4*)(B + (size_t)(q >> 3) * ldb + kt * 64 + (q & 7) * 8);
    else     return *(const u32x4*)(B + (size_t)(kt * 64 + (q >> 4)) * ldb + (q & 15) * 8);
}
template <bool BN>
DI void g_load(Stg& r, const bf16_t* __restrict__ A, int lda, const bf16_t* __restrict__ B, int ldb, int kt, int tid) {
    const bf16_t* ap = A + (size_t)(tid >> 3) * lda + kt * 64 + (tid & 7) * 8;
    r.a0 = *(const u32x4*)(ap);
    r.a1 = *(const u32x4*)(ap + (size_t)32 * lda);
    r.a2 = *(const u32x4*)(ap + (size_t)64 * lda);
    r.a3 = *(const u32x4*)(ap + (size_t)96 * lda);
    r.b0 = g_ld_b<BN>(B, ldb, kt, tid);
    r.b1 = g_ld_b<BN>(B, ldb, kt, tid + 256);
    r.b2 = g_ld_b<BN>(B, ldb, kt, tid + 512);
    r.b3 = g_ld_b<BN>(B, ldb, kt, tid + 768);
}
template <bool BN>
DI void s_st_b(bf16_t* b, const u32x4 v, int q) {
    if (!BN) *(u32x4*)(b + (q >> 3) * LROW + (q & 7) * 8) = v;
    else {
        const int kr = q >> 4, n0 = (q & 15) * 8;
        b[(n0 + 0) * LROW + kr] = (bf16_t)(v.x & 0xffffu); b[(n0 + 1) * LROW + kr] = (bf16_t)(v.x >> 16);
        b[(n0 + 2) * LROW + kr] = (bf16_t)(v.y & 0xffffu); b[(n0 + 3) * LROW + kr] = (bf16_t)(v.y >> 16);
        b[(n0 + 4) * LROW + kr] = (bf16_t)(v.z & 0xffffu); b[(n0 + 5) * LROW + kr] = (bf16_t)(v.z >> 16);
        b[(n0 + 6) * LROW + kr] = (bf16_t)(v.w & 0xffffu); b[(n0 + 7) * LROW + kr] = (bf16_t)(v.w >> 16);
    }
}
template <bool BN>
DI void s_store(const Stg& r, bf16_t* smem, int buf, int tid) {
    bf16_t* a = smem + buf * 2 * TILE_E;
    bf16_t* b = a + TILE_E;
    bf16_t* ap = a + (tid >> 3) * LROW + (tid & 7) * 8;
    *(u32x4*)(ap) = r.a0;
    *(u32x4*)(ap + 32 * LROW) = r.a1;
    *(u32x4*)(ap + 64 * LROW) = r.a2;
    *(u32x4*)(ap + 96 * LROW) = r.a3;
    s_st_b<BN>(b, r.b0, tid);
    s_st_b<BN>(b, r.b1, tid + 256);
    s_st_b<BN>(b, r.b2, tid + 512);
    s_st_b<BN>(b, r.b3, tid + 768);
}
DI void mma_tile(const bf16_t* smem, int buf, f32x4 (&acc)[4][4], int wm, int wn, int lane) {
    const bf16_t* a = smem + buf * 2 * TILE_E;
    const bf16_t* b = a + TILE_E;
#pragma unroll
    for (int kk = 0; kk < 2; ++kk) {
        bf16x8 af[4], bfr[4];
#pragma unroll
        for (int mi = 0; mi < 4; ++mi) af[mi] = *(const bf16x8*)(a + (wm * 64 + mi * 16 + (lane & 15)) * LROW + kk * 32 + (lane >> 4) * 8);
#pragma unroll
        for (int ni = 0; ni < 4; ++ni) bfr[ni] = *(const bf16x8*)(b + (wn * 64 + ni * 16 + (lane & 15)) * LROW + kk * 32 + (lane >> 4) * 8);
#pragma unroll
        for (int mi = 0; mi < 4; ++mi)
#pragma unroll
            for (int ni = 0; ni < 4; ++ni) acc[mi][ni] = __builtin_amdgcn_mfma_f32_16x16x32_bf16(af[mi], bfr[ni], acc[mi][ni], 0, 0, 0);
    }
}
template <bool BN>
DI void gemm_core(const bf16_t* __restrict__ A, int lda, const bf16_t* __restrict__ B, int ldb, int K, f32x4 (&acc)[4][4], bf16_t* smem) {
    const int tid = otid(), lane = tid & 63, wave = tid >> 6;
    const int wm = wave >> 1, wn = wave & 1;
#pragma unroll
    for (int mi = 0; mi < 4; ++mi)
#pragma unroll
        for (int ni = 0; ni < 4; ++ni) acc[mi][ni] = (f32x4){0.f, 0.f, 0.f, 0.f};
    const int nk = K >> 6;
    Stg r0, r1;
    __syncthreads();
    g_load<BN>(r0, A, lda, B, ldb, 0, tid);
    g_load<BN>(r1, A, lda, B, ldb, 1, tid);
    s_store<BN>(r0, smem, 0, tid);
    __syncthreads();
    for (int kt = 0; kt < nk; kt += 2) {
        if (kt + 2 < nk) g_load<BN>(r0, A, lda, B, ldb, kt + 2, tid);
        mma_tile(smem, 0, acc, wm, wn, lane);
        s_store<BN>(r1, smem, 1, tid);
        __syncthreads();
        if (kt + 3 < nk) g_load<BN>(r1, A, lda, B, ldb, kt + 3, tid);
        mma_tile(smem, 1, acc, wm, wn, lane);
        if (kt + 2 < nk) s_store<BN>(r0, smem, 0, tid);
        __syncthreads();
    }
}
#define GT_E (128 * 64)
DI void glds_tile(const bf16_t* __restrict__ G, int ld, int kt, bf16_t* lt, int tid) {
    const int c = (tid & 7) ^ ((tid >> 4) & 7);
    const bf16_t* g = G + (size_t)(tid >> 3) * ld + kt * 64 + c * 8;
    char* l = (char*)lt + tid * 16;
#pragma unroll
    for (int p = 0; p < 4; ++p)
        __builtin_amdgcn_global_load_lds((const unsigned*)(g + (size_t)(p * 32) * ld), (LAS unsigned*)(l + p * 4096), 16, 0, 0);
}
DI void mma_tile_sw(const bf16_t* smem, int buf, f32x4 (&acc)[4][4], int wm, int wn, int lane) {
    const char* a = (const char*)(smem + buf * 2 * GT_E);
    const char* b = a + GT_E * 2;
    const int sw = (lane & 15) >> 1;
#pragma unroll
    for (int kk = 0; kk < 2; ++kk) {
        bf16x8 af[4], bfr[4];
        const int co = ((kk * 4 + (lane >> 4)) ^ sw) << 4;
#pragma unroll
        for (int mi = 0; mi < 4; ++mi) af[mi] = *(const bf16x8*)(a + (wm * 64 + mi * 16 + (lane & 15)) * 128 + co);
#pragma unroll
        for (int ni = 0; ni < 4; ++ni) bfr[ni] = *(const bf16x8*)(b + (wn * 64 + ni * 16 + (lane & 15)) * 128 + co);
#pragma unroll
        for (int mi = 0; mi < 4; ++mi)
#pragma unroll
            for (int ni = 0; ni < 4; ++ni) acc[mi][ni] = __builtin_amdgcn_mfma_f32_16x16x32_bf16(af[mi], bfr[ni], acc[mi][ni], 0, 0, 0);
    }
}
DI void gemm_core_dma(const bf16_t* __restrict__ A, int lda, const bf16_t* __restrict__ B, int ldb, int K, f32x4 (&acc)[4][4], bf16_t* smem) {
    const int tid = otid(), lane = tid & 63, wave = tid >> 6;
    const int wm = wave >> 1, wn = wave & 1;
#pragma unroll
    for (int mi = 0; mi < 4; ++mi)
#pragma unroll
        for (int ni = 0; ni < 4; ++ni) acc[mi][ni] = (f32x4){0.f, 0.f, 0.f, 0.f};
    const int nk = K >> 6;
    __syncthreads();
    glds_tile(A, lda, 0, smem, tid);
    glds_tile(B, ldb, 0, smem + GT_E, tid);
    for (int kt = 0; kt < nk; ++kt) {
        asm volatile("s_waitcnt vmcnt(0)" ::: "memory");
        __syncthreads();
        if (kt + 1 < nk) {
            bf16_t* nb = smem + ((kt + 1) & 1) * 2 * GT_E;
            glds_tile(A, lda, kt + 1, nb, tid);
            glds_tile(B, ldb, kt + 1, nb + GT_E, tid);
        }
        mma_tile_sw(smem, kt & 1, acc, wm, wn, lane);
    }
    __syncthreads();
}
#define ST_LD 132
DI void stage_acc(f32x4 (&acc)[4][4], float* st) {
    const int lane = otid() & 63, wave = otid() >> 6, wm = wave >> 1, wn = wave & 1, fl = lane & 15, g4 = lane >> 4;
#pragma unroll
    for (int mi = 0; mi < 4; ++mi)
#pragma unroll
        for (int ni = 0; ni < 4; ++ni)
#pragma unroll
            for (int j = 0; j < 4; ++j) st[(wm * 64 + mi * 16 + g4 * 4 + j) * ST_LD + wn * 64 + ni * 16 + fl] = acc[mi][ni][j];
    __syncthreads();
}
DI void ld8(const float* q, float (&v)[8]) {
    const float4 a = *(const float4*)q, b = *(const float4*)(q + 4);
    v[0] = a.x; v[1] = a.y; v[2] = a.z; v[3] = a.w; v[4] = b.x; v[5] = b.y; v[6] = b.z; v[7] = b.w;
}
DI uint4 pack8(const float (&v)[8]) { return make_uint4(pack2(v[0], v[1]), pack2(v[2], v[3]), pack2(v[4], v[5]), pack2(v[6], v[7])); }
DI void unpack8(const uint4 u, float (&v)[8]) {
    v[0] = bflo(u.x); v[1] = bfhi(u.x); v[2] = bflo(u.y); v[3] = bfhi(u.y); v[4] = bflo(u.z); v[5] = bfhi(u.z); v[6] = bflo(u.w); v[7] = bfhi(u.w);
}

DI void phase0(const Params& p, float* smf) {
    const int tid = otid();
    unsigned char* ws = p.ws;
    float* modv = (float*)(ws + OFF_MODV);
    for (int it = blockIdx.x; it < 192; it += gridDim.x) {
        const int l = it / 96, n0 = (it % 96) * 32;
        __syncthreads();
        for (int i = tid; i < 3072; i += 256) {
            const int v = i >> 10, k = i & 1023;
            const float cv = (v == 0) ? p.c[k] : (v == 1) ? p.c[1024 + k] : p.c_ctx[k];
            smf[i] = silu_f(cv);
        }
        __syncthreads();
        const int col = tid & 31, kg = tid >> 5;
        float a0 = 0.f, a1 = 0.f, a2 = 0.f;
        const float* w = p.w_mod + (size_t)l * 1024 * 3072 + n0 + col;
#pragma unroll 16
        for (int kk = 0; kk < 128; ++kk) {
            const int k = kg * 128 + kk;
            const float wv = w[(size_t)k * 3072];
            a0 += smf[k] * wv; a1 += smf[1024 + k] * wv; a2 += smf[2048 + k] * wv;
        }
        __syncthreads();
        smf[3072 + (kg * 3 + 0) * 32 + col] = a0; smf[3072 + (kg * 3 + 1) * 32 + col] = a1; smf[3072 + (kg * 3 + 2) * 32 + col] = a2;
        __syncthreads();
        if (tid < 96) {
            const int v = tid >> 5, cc = tid & 31;
            float s = 0.f;
            for (int g = 0; g < 8; ++g) s += smf[3072 + (g * 3 + v) * 32 + cc];
            modv[(l * 3 + v) * 3072 + n0 + cc] = s + p.b_mod[l * 3072 + n0 + cc];
        }
    }
    {
        const int n_in = 2 * 16 * 44, n_out = 2 * 16 * 16;
        for (int it = blockIdx.x; it < n_in + n_out; it += gridDim.x) {
            const float* src; bf16_t* dst; int N, kt, nt;
            if (it < n_in) { const int l = it / 704, r = it % 704; kt = r / 44; nt = r % 44; N = DIN; src = p.w_in + (size_t)l * DM * DIN; dst = (bf16_t*)(ws + OFF_WTIN) + (size_t)l * DIN * DM; }
            else { const int j = it - n_in; const int l = j / 256, r = j % 256; kt = r / 16; nt = r % 16; N = DM; src = p.w_out + (size_t)l * DM * DM; dst = (bf16_t*)(ws + OFF_WTOUT) + (size_t)l * DM * DM; }
            __syncthreads();
#pragma unroll
            for (int ps = 0; ps < 4; ++ps) {
                const int kr = ps * 16 + (tid >> 4), c4 = (tid & 15) * 4;
                const float4 v = *(const float4*)(src + (size_t)(kt * 64 + kr) * N + nt * 64 + c4);
                smf[kr * 65 + c4 + 0] = v.x; smf[kr * 65 + c4 + 1] = v.y; smf[kr * 65 + c4 + 2] = v.z; smf[kr * 65 + c4 + 3] = v.w;
            }
            __syncthreads();
            const int n = tid >> 2, ks = (tid & 3) * 16;
            unsigned w[8];
#pragma unroll
            for (int e = 0; e < 8; ++e) w[e] = pack2(smf[(ks + 2 * e) * 65 + n], smf[(ks + 2 * e + 1) * 65 + n]);
            bf16_t* d = dst + (size_t)(nt * 64 + n) * DM + kt * 64 + ks;
            *(uint4*)d = make_uint4(w[0], w[1], w[2], w[3]);
            *(uint4*)(d + 8) = make_uint4(w[4], w[5], w[6], w[7]);
        }
    }
    const int gtid = blockIdx.x * 256 + tid, gsz = gridDim.x * 256;
    {
        bf16_t* wc = (bf16_t*)(ws + OFF_WCOMB);
        __syncthreads();
        if (tid < 64) { smf[tid] = cospif((float)tid * (1.f / 32.f)); smf[64 + tid] = sinpif((float)tid * (1.f / 32.f)); }
        __syncthreads();
        for (int i = gtid; i < 2 * 512 * 256; i += gsz) {
            const int n = i & 255, kk = (i >> 8) & 511, l = i >> 17;
            const int c = kk >> 8, head = (kk >> 6) & 3, ch = kk & 63;
            const float* wf = p.w_fourier + (size_t)l * 65536 + (size_t)(head * 64) * 256 + n;
            float s = 0.f;
#pragma unroll 16
            for (int j = 0; j < 64; ++j) s += smf[c * 64 + ((j * ch) & 63)] * wf[j * 256];
            wc[(size_t)l * 131072 + n * 512 + kk] = f2bf(s);
        }
    }
    {
        bf16_t* wp = (bf16_t*)(ws + OFF_WPOOL);
        for (int i = gtid; i < 2 * 256 * 256; i += gsz) {
            const int k = i & 255, n = (i >> 8) & 255, l = i >> 16;
            float v = 0.f;
            if ((k >> 6) == (n >> 6)) v = p.pool_w[(size_t)l * 16384 + (n >> 6) * 4096 + (k & 63) * 64 + (n & 63)];
            wp[i] = f2bf(v);
        }
    }
    {
        float* tw = (float*)(ws + OFF_TW);
        for (int i = gtid; i < 8192; i += gsz) { const float a = (float)i * (1.f / 4096.f); tw[2 * i] = cospif(a); tw[2 * i + 1] = sinpif(a); }
        bf16_t* f1 = (bf16_t*)(ws + OFF_F1);
        for (int i = gtid; i < 256 * 128; i += gsz) {
            const int t1 = i & 127, m = i >> 7;
            const int k1 = (m >> 5) * 16 + (m & 15), c = (m >> 4) & 1;
            const float a = (float)((k1 * t1) & 127) * (1.f / 64.f);
            f1[i] = f2bf(c ? -sinpif(a) : cospif(a));
        }
        bf16_t* f2 = (bf16_t*)(ws + OFF_F2);
        for (int i = gtid; i < 128 * 128; i += gsz) {
            const int kx = i & 127, m = i >> 7;
            const int c = m >> 6, k2 = m & 63, cp = kx >> 6, t2 = kx & 63;
            const float a = (float)((k2 * t2) & 63) * (1.f / 32.f);
            float v;
            if (c == cp) v = cospif(a); else if (c == 0) v = sinpif(a); else v = -sinpif(a);
            f2[i] = f2bf(v);
        }
        bf16_t* fc = (bf16_t*)(ws + OFF_FC);
        for (int i = gtid; i < 512 * 256; i += gsz) {
            const int t = i & 255, m = i >> 8;
            const int c = m >> 8, k = m & 255;
            const float a = (float)((k * t) & 255) * (1.f / 128.f);
            fc[i] = f2bf(c ? -sinpif(a) : cospif(a));
        }
        float* rp = (float*)(ws + OFF_ROPE);
        for (int i = gtid; i < 3072; i += gsz) {
            const int f = i & 15;
            const int pos = (i < 2048) ? (i >> 4) : ((i - 2048) >> 4);
            const float inv = powf(10000.f, -(float)f * (1.f / 16.f));
            const float ang = (float)pos * inv;
            const double ad = (double)ang;
            const float cs = (float)cos(ad), sn = (float)sin(ad);
            if (i < 2048) { rp[i] = cs; rp[2048 + i] = sn; }
            else { rp[4096 + (i - 2048)] = cs; rp[5120 + (i - 2048)] = sn; }
        }
    }
}

DI void phase_norm(const Params& p, int l, const float* xl, const float* xc) {
    const int lane = otid() & 63, wave = otid() >> 6;
    const float* modv = (const float*)(p.ws + OFF_MODV) + (size_t)l * 3 * 3072;
    const float* g = p.norm_g + l * 1024;
    bf16_t* H = (bf16_t*)(p.ws + OFF_H);
    for (int row = blockIdx.x * 4 + wave; row < ROWS; row += gridDim.x * 4) {
        const float* src = (row < ROWS_L) ? xl + (size_t)row * DM : xc + (size_t)(row - ROWS_L) * DM;
        const int v = (row < ROWS_L) ? (row >> 13) : 2;
        const float* mv = modv + v * 3072;
        float4 a[4];
        float ss = 0.f;
#pragma unroll
        for (int i = 0; i < 4; ++i) { a[i] = *(const float4*)(src + i * 256 + lane * 4); ss += a[i].x * a[i].x + a[i].y * a[i].y + a[i].z * a[i].z + a[i].w * a[i].w; }
#pragma unroll
        for (int o = 32; o >= 1; o >>= 1) ss += __shfl_xor(ss, o);
        const float rs = rsqrtf(ss * (1.f / 1024.f) + 1e-6f);
#pragma unroll
        for (int i = 0; i < 4; ++i) {
            const int c0 = i * 256 + lane * 4;
            const float4 gg = *(const float4*)(g + c0), sh = *(const float4*)(mv + c0), sc = *(const float4*)(mv + 1024 + c0);
            const float o0 = a[i].x * rs * gg.x * (1.f + sc.x) + sh.x, o1 = a[i].y * rs * gg.y * (1.f + sc.y) + sh.y;
            const float o2 = a[i].z * rs * gg.z * (1.f + sc.z) + sh.z, o3 = a[i].w * rs * gg.w * (1.f + sc.w) + sh.w;
            *(uint2*)(H + (size_t)row * DM + c0) = make_uint2(pack2(o0, o1), pack2(o2, o3));
        }
    }
}

DI void epi_inproj(const Params& p, int l, int tm, int tn, f32x4 (&acc)[4][4], float* st) {
    const int tid = otid();
    unsigned char* ws = p.ws;
    stage_acc(acc, st);
    const int rbase = tm * 128;
    const bool isctx = rbase >= ROWS_L;
    if (tn < 3) {
        const bool isq = tn < 2;
        const float* gain = (isq ? p.q_gain : p.k_gain) + l * 64;
        const float* rp = (const float*)(ws + OFF_ROPE);
#pragma unroll 1
        for (int i = 0; i < 8; ++i) {
            const int q = tid + 256 * i, rl = q >> 4, c8 = (q & 15) * 8;
            const int row = rbase + rl, hd = c8 >> 6, d0 = c8 & 63;
            float v[8], pv[8], g[8], pg[8];
            ld8(st + rl * ST_LD + c8, v);
            ld8(st + rl * ST_LD + (c8 ^ 16), pv);
            ld8(gain + d0, g);
            ld8(gain + (d0 ^ 16), pg);
            float ss = 0.f;
#pragma unroll
            for (int e = 0; e < 8; ++e) ss += v[e] * v[e];
            ss += __shfl_xor(ss, 1); ss += __shfl_xor(ss, 2); ss += __shfl_xor(ss, 4);
            const float rs = rsqrtf(ss * (1.f / 64.f) + 1e-6f);
#pragma unroll
            for (int e = 0; e < 8; ++e) { v[e] *= rs * g[e]; pv[e] *= rs * pg[e]; }
            bf16_t* dst;
            if (!isctx) {
                const int b = row >> 13, t = row & 8191;
                const int pos = (d0 >= 32) ? (t & 63) : (t >> 6);
                const float* ct = rp + ((d0 >= 32) ? 4096 : 0) + pos * 16 + (d0 & 8);
                float cs[8], sn[8];
                ld8(ct, cs);
                ld8(ct + ((d0 >= 32) ? 1024 : 2048), sn);
                const float sg = (d0 & 16) ? 1.f : -1.f;
#pragma unroll
                for (int e = 0; e < 8; ++e) v[e] = v[e] * cs[e] + sg * pv[e] * sn[e];
                if (isq) dst = (bf16_t*)(ws + OFF_Q) + ((size_t)(b * 4 + tn * 2 + hd) * SEQ + t) * 64 + d0;
                else     dst = (bf16_t*)(ws + OFF_K) + ((size_t)(b * 2 + hd) * NKEY + CTX + t) * 64 + d0;
            } else {
                const int rc = row - ROWS_L, b = rc >> 8, t = rc & 255;
                if (isq) dst = (bf16_t*)(ws + OFF_QC) + ((size_t)(b * 4 + tn * 2 + hd) * CTX + t) * 64 + d0;
                else     dst = (bf16_t*)(ws + OFF_K) + ((size_t)(b * 2 + hd) * NKEY + t) * 64 + d0;
            }
            if (isq) {
#pragma unroll
                for (int e = 0; e < 8; ++e) v[e] *= 0.18033688011112042f;
            }
            *(uint4*)dst = pack8(v);
        }
    } else if (tn == 3) {
        int b, key0;
        if (!isctx) { b = rbase >> 13; key0 = CTX + (rbase & 8191); } else { const int rc = rbase - ROWS_L; b = rc >> 8; key0 = rc & 255; }
#pragma unroll 1
        for (int i = 0; i < 8; ++i) {
            const int q = tid + 256 * i, col = q & 127, r8 = (q >> 7) * 8;
            float v[8];
#pragma unroll
            for (int e = 0; e < 8; ++e) v[e] = st[(r8 + e) * ST_LD + col];
            bf16_t* vt = (bf16_t*)(ws + OFF_VT) + ((size_t)(b * 2 + (col >> 6)) * 64 + (col & 63)) * NKEY + key0 + r8;
            *(uint4*)vt = pack8(v);
        }
    } else {
        bf16_t* parts = (bf16_t*)(ws + OFF_PARTS);
#pragma unroll 1
        for (int i = 0; i < 8; ++i) {
            const int q = tid + 256 * i, rl = q >> 4, c8 = (q & 15) * 8;
            float v[8];
            ld8(st + rl * ST_LD + c8, v);
            *(uint4*)(parts + (size_t)(rbase + rl) * PW + tn * 128 - 512 + c8) = pack8(v);
        }
    }
}

DI void phase_inproj(const Params& p, int l, bf16_t* smem) {
    const bf16_t* H = (const bf16_t*)(p.ws + OFF_H);
    const bf16_t* W = (const bf16_t*)(p.ws + OFF_WTIN) + (size_t)l * DIN * DM;
    const int nlat = 128 * 22;
    const int ntiles = nlat + (l == 0 ? 4 * 22 : 4 * 2);
    for (XIter t = xiter(ntiles); t.u < t.end; t.u += t.step) {
        const int u = t.u;
        int tm, tn;
        if (u < nlat) { const int ch = u / 176, r = u % 176; tn = r >> 3; tm = ch * 8 + (r & 7); }
        else { const int j = u - nlat; tm = 128 + (j & 3); tn = (l == 0 ? 0 : 2) + (j >> 2); }
        f32x4 acc[4][4];
        gemm_core_dma(H + (size_t)tm * 128 * DM, DM, W + (size_t)tn * 128 * DM, DM, DM, acc, smem);
        epi_inproj(p, l, tm, tn, acc, (float*)smem);
    }
}

#define KT_E (64 * LROW)
DI void attn_item(const Params& p, const bf16_t* Qb, const bf16_t* Kb, const bf16_t* VTb, int ntiles, int rowbase, int hq, bf16_t* smem) {
    const int tid = otid(), lane = tid & 63, wave = tid >> 6;
    const int r = lane & 31, h = lane >> 5;
    const float LOG2E = 1.4426950408889634f;
    bf16x8 qf[4];
    {
        const bf16_t* qrow = Qb + (size_t)(wave * 32 + r) * 64;
#pragma unroll
        for (int s = 0; s < 4; ++s) qf[s] = *(const bf16x8*)(qrow + s * 16 + h * 8);
    }
    f32x16 ot[2], minit;
#pragma unroll
    for (int i = 0; i < 16; ++i) { ot[0][i] = 0.f; ot[1][i] = 0.f; minit[i] = 0.f; }
    float m = 0.f, lsum = 0.f;
    uint4 rk[2], rv[2];
    auto gload = [&](int kt) {
#pragma unroll
        for (int i = 0; i < 2; ++i) {
            const int q = tid + 256 * i;
            rk[i] = *(const uint4*)(Kb + (size_t)(kt * 64 + (q >> 3)) * 64 + (q & 7) * 8);
            rv[i] = *(const uint4*)(VTb + (size_t)(q >> 3) * NKEY + kt * 64 + (q & 7) * 8);
        }
    };
    auto sstore = [&](int buf) {
        bf16_t* sk = smem + buf * 2 * KT_E;
        bf16_t* sv = sk + KT_E;
#pragma unroll
        for (int i = 0; i < 2; ++i) {
            const int q = tid + 256 * i;
            *(uint4*)(sk + (q >> 3) * LROW + (q & 7) * 8) = rk[i];
            *(uint4*)(sv + (q >> 3) * LROW + (q & 7) * 8) = rv[i];
        }
    };
    __syncthreads();
    gload(0);
    sstore(0);
    __syncthreads();
    for (int kt = 0; kt < ntiles; ++kt) {
        if (kt + 1 < ntiles) gload(kt + 1);
        const bf16_t* sk = smem + (kt & 1) * 2 * KT_E;
        const bf16_t* sv = sk + KT_E;
        f32x16 st[2], pe[2];
#pragma unroll
        for (int blk = 0; blk < 2; ++blk) {
            st[blk] = __builtin_amdgcn_mfma_f32_32x32x16_bf16(*(const bf16x8*)(sk + (blk * 32 + r) * LROW + h * 8), qf[0], minit, 0, 0, 0);
#pragma unroll
            for (int s = 1; s < 4; ++s)
                st[blk] = __builtin_amdgcn_mfma_f32_32x32x16_bf16(*(const bf16x8*)(sk + (blk * 32 + r) * LROW + s * 16 + h * 8), qf[s], st[blk], 0, 0, 0);
        }
        float ls = 0.f;
#pragma unroll
        for (int i = 0; i < 16; ++i) {
            pe[0][i] = __builtin_amdgcn_exp2f(st[0][i]); ls += pe[0][i];
            pe[1][i] = __builtin_amdgcn_exp2f(st[1][i]); ls += pe[1][i];
        }
        if (kt == 0 || __any(!(ls <= 256.f))) {
            float tmx = st[0][0];
#pragma unroll
            for (int i = 0; i < 16; ++i) { tmx = fmaxf(tmx, st[0][i]); tmx = fmaxf(tmx, st[1][i]); }
            tmx = fmaxf(tmx, __shfl_xor(tmx, 32));
            const float delta = (kt == 0) ? tmx : fmaxf(tmx, 0.f);
            const float alpha = (kt == 0) ? 1.f : __builtin_amdgcn_exp2f(-delta);
            m += delta;
            lsum *= alpha;
            ls = 0.f;
#pragma unroll
            for (int i = 0; i < 16; ++i) {
                ot[0][i] *= alpha; ot[1][i] *= alpha; minit[i] = -m;
                pe[0][i] = __builtin_amdgcn_exp2f(st[0][i] - delta); ls += pe[0][i];
                pe[1][i] = __builtin_amdgcn_exp2f(st[1][i] - delta); ls += pe[1][i];
            }
        }
        lsum += ls;
        bf16x8 pk[2][2];
#pragma unroll
        for (int blk = 0; blk < 2; ++blk)
#pragma unroll
            for (int s = 0; s < 2; ++s) {
                uint4 u;
                u.x = pack2(pe[blk][8 * s + 0], pe[blk][8 * s + 1]); u.y = pack2(pe[blk][8 * s + 2], pe[blk][8 * s + 3]);
                u.z = pack2(pe[blk][8 * s + 4], pe[blk][8 * s + 5]); u.w = pack2(pe[blk][8 * s + 6], pe[blk][8 * s + 7]);
                pk[blk][s] = __builtin_bit_cast(bf16x8, u);
            }
#pragma unroll
        for (int db = 0; db < 2; ++db)
#pragma unroll
            for (int blk = 0; blk < 2; ++blk)
#pragma unroll
                for (int s = 0; s < 2; ++s) {
                    const bf16_t* vp = sv + (db * 32 + r) * LROW + blk * 32 + s * 16 + h * 4;
                    const bf16x4 lo = *(const bf16x4*)vp;
                    const bf16x4 hi = *(const bf16x4*)(vp + 8);
                    const bf16x8 vf = __builtin_shufflevector(lo, hi, 0, 1, 2, 3, 4, 5, 6, 7);
                    ot[db] = __builtin_amdgcn_mfma_f32_32x32x16_bf16(vf, pk[blk][s], ot[db], 0, 0, 0);
                }
        if (kt + 1 < ntiles) sstore((kt + 1) & 1);
        __syncthreads();
    }
    lsum += __shfl_xor(lsum, 32);
    const float inv = 1.f / lsum;
    const int row = rowbase + wave * 32 + r;
    const bf16_t* zrow = (const bf16_t*)(p.ws + OFF_PARTS) + (size_t)row * PW + PC_ZATT + hq * 64;
    bf16_t* orow = (bf16_t*)(p.ws + OFF_H) + (size_t)row * DM + 256 + hq * 64;
#pragma unroll
    for (int db = 0; db < 2; ++db)
#pragma unroll
        for (int g = 0; g < 4; ++g) {
            const int d = db * 32 + g * 8 + h * 4;
            const uint2 z = *(const uint2*)(zrow + d);
            const float o0 = silu_f(bflo(z.x)) * ot[db][4 * g + 0] * inv, o1 = silu_f(bfhi(z.x)) * ot[db][4 * g + 1] * inv;
            const float o2 = silu_f(bflo(z.y)) * ot[db][4 * g + 2] * inv, o3 = silu_f(bfhi(z.y)) * ot[db][4 * g + 3] * inv;
            *(uint2*)(orow + d) = make_uint2(pack2(o0, o1), pack2(o2, o3));
        }
}

DI void phase_attn(const Params& p, int l, bf16_t* smem) {
    const bf16_t* Q = (const bf16_t*)(p.ws + OFF_Q);
    const bf16_t* QC = (const bf16_t*)(p.ws + OFF_QC);
    const bf16_t* Kk = (const bf16_t*)(p.ws + OFF_K);
    const bf16_t* VT = (const bf16_t*)(p.ws + OFF_VT);
    for (XIter t = xiter(512); t.u < t.end; t.u += t.step) {
        const int it = t.u;
        const int b = it >> 8, hq = (it >> 6) & 3, qt = it & 63;
        const size_t kv = (size_t)(b * 2 + (hq >> 1));
        attn_item(p, Q + ((size_t)(b * 4 + hq) * SEQ + qt * 128) * 64, Kk + kv * NKEY * 64, VT + kv * 64 * NKEY, NKEY / 64, b * SEQ + qt * 128, hq, smem);
    }
    if (l == 0) {
        for (int j = blockIdx.x; j < 16; j += gridDim.x) {
            const int b = j >> 3, hq = (j >> 1) & 3, qt = j & 1;
            const size_t kv = (size_t)(b * 2 + (hq >> 1));
            attn_item(p, QC + ((size_t)(b * 4 + hq) * CTX + qt * 128) * 64, Kk + kv * NKEY * 64, VT + kv * 64 * NKEY, CTX / 64, ROWS_L + b * CTX + qt * 128, hq, smem);
        }
    }
}

template <int W>
DI void pool_task(const bf16_t* __restrict__ pu, int pos, int n, bf16_t* __restrict__ dst) {
    constexpr int LEFT = W / 2;
    uint4 raw[W];
#pragma unroll
    for (int t = 0; t < W; ++t) { int q = pos - LEFT + t; q = q < 0 ? 0 : (q >= n ? n - 1 : q); raw[t] = *(const uint4*)(pu + (size_t)q * PW); }
    float sum[8], u[8];
#pragma unroll
    for (int e = 0; e < 8; ++e) sum[e] = 0.f;
#pragma unroll
    for (int t = 0; t < W; ++t) {
        const int q = pos - LEFT + t;
        const float mk = (q >= 0 && q < n) ? 1.f : 0.f;
        unpack8(raw[t], u);
#pragma unroll
        for (int e = 0; e < 8; ++e) sum[e] += mk * u[e];
    }
    const int lo = max(pos - LEFT, 0), hi = min(pos + W - LEFT, n);
    const float ic = 1.f / (float)(hi - lo);
    unpack8(raw[LEFT], u);
#pragma unroll
    for (int e = 0; e < 8; ++e) sum[e] = sum[e] * ic - u[e];
    *(uint4*)dst = pack8(sum);
}
DI void phase_convpool(const Params& p, int l) {
    const bf16_t* __restrict__ parts = (const bf16_t*)(p.ws + OFF_PARTS);
    bf16_t* __restrict__ cat = (bf16_t*)(p.ws + OFF_H);
    bf16_t* __restrict__ dbuf = (bf16_t*)(p.ws + OFF_DBUF);
    const int nrows = (l == 0 ? ROWS : ROWS_L);
    const int gsz = gridDim.x * 256, gt = blockIdx.x * 256 + otid();
    {
        const int c8 = (gt & 31) * 8;
        float w0[8], w1[8], w2[8], bs[8];
        ld8(p.conv_w + l * 768 + c8, w0); ld8(p.conv_w + l * 768 + 256 + c8, w1); ld8(p.conv_w + l * 768 + 512 + c8, w2); ld8(p.conv_b + l * 256 + c8, bs);
        for (int i = gt; i < nrows * 32; i += gsz) {
            const int row = i >> 5;
            int seq0, n;
            if (row < ROWS_L) { seq0 = (row >> 13) << 13; n = SEQ; } else { seq0 = ROWS_L + (((row - ROWS_L) >> 8) << 8); n = CTX; }
            const int pos = row - seq0;
            const bf16_t* pr = parts + (size_t)row * PW + c8;
            const bool hp = pos > 0, hn = pos + 1 < n;
            const bf16_t* pp = hp ? pr - PW : pr;
            const bf16_t* pn = hn ? pr + PW : pr;
            const uint4 r0 = *(const uint4*)(pr + PC_CC), r1 = *(const uint4*)(pr + PC_HC), r2 = *(const uint4*)(pp + PC_CC), r3 = *(const uint4*)(pp + PC_HC);
            const uint4 r4 = *(const uint4*)(pn + PC_CC), r5 = *(const uint4*)(pn + PC_HC), r6 = *(const uint4*)(pr + PC_BC), r7 = *(const uint4*)(pr + PC_ZC);
            const float mp = hp ? 1.f : 0.f, mn = hn ? 1.f : 0.f;
            float a[8], b[8], tc[8], tp[8], tn[8], o[8];
            unpack8(r0, a); unpack8(r1, b);
#pragma unroll
            for (int e = 0; e < 8; ++e) tc[e] = a[e] * b[e];
            unpack8(r2, a); unpack8(r3, b);
#pragma unroll
            for (int e = 0; e < 8; ++e) tp[e] = a[e] * b[e] * mp;
            unpack8(r4, a); unpack8(r5, b);
#pragma unroll
            for (int e = 0; e < 8; ++e) tn[e] = a[e] * b[e] * mn;
            unpack8(r6, a); unpack8(r7, b);
#pragma unroll
            for (int e = 0; e < 8; ++e) o[e] = silu_f(b[e]) * (a[e] * (tp[e] * w0[e] + tc[e] * w1[e] + tn[e] * w2[e] + bs[e]));
            *(uint4*)(cat + (size_t)row * DM + 512 + c8) = pack8(o);
        }
    }
    for (int j = gt; j < nrows * 32; j += gsz) {
        const int g = j / (nrows * 8), rem = j - g * (nrows * 8), row = rem >> 3, c8 = g * 64 + (rem & 7) * 8;
        int seq0, n;
        if (row < ROWS_L) { seq0 = (row >> 13) << 13; n = SEQ; } else { seq0 = ROWS_L + (((row - ROWS_L) >> 8) << 8); n = CTX; }
        const bf16_t* pu = parts + (size_t)seq0 * PW + PC_UP + c8;
        bf16_t* dst = dbuf + (size_t)row * 256 + c8;
        const int pos = row - seq0;
        if (g == 0) pool_task<2>(pu, pos, n, dst);
        else if (g == 1) pool_task<4>(pu, pos, n, dst);
        else if (g == 2) pool_task<8>(pu, pos, n, dst);
        else pool_task<16>(pu, pos, n, dst);
    }
}

DI void phase_dft1(const Params& p, int l, bf16_t* smem) {
    const int tid = otid();
    float* st = (float*)smem;
    const bf16_t* parts = (const bf16_t*)(p.ws + OFF_PARTS);
    const bf16_t* F1 = (const bf16_t*)(p.ws + OFF_F1);
    const bf16_t* FC = (const bf16_t*)(p.ws + OFF_FC);
    const float* tw = (const float*)(p.ws + OFF_TW);
    bf16_t* G1 = (bf16_t*)(p.ws + OFF_G1);
    bf16_t* pcat = (bf16_t*)(p.ws + OFF_PCAT);
    const int nt1 = 2 * 64 * 4;
    const int ntot = nt1 + (l == 0 ? 16 : 0);
    for (int it = blockIdx.x; it < ntot; it += gridDim.x) {
        f32x4 acc[4][4];
        if (it < nt1) {
            const int b = it >> 8, t2 = (it >> 2) & 63, mt = (it >> 1) & 1, nt = it & 1;
            gemm_core<true>(F1 + (size_t)mt * 128 * 128, 128, parts + (size_t)(b * SEQ + t2) * PW + PC_UF + nt * 128, 64 * PW, 128, acc, smem);
            stage_acc(acc, st);
#pragma unroll 1
            for (int i = 0; i < 4; ++i) {
                const int q = tid + 256 * i, kk = q >> 4, c8 = (q & 15) * 8;
                const int rr = 32 * (kk >> 4) + (kk & 15);
                const int k1 = mt * 64 + kk;
                const float cs = tw[2 * (k1 * t2)], sn = tw[2 * (k1 * t2) + 1];
                float gr[8], gi[8], o[8];
                ld8(st + rr * ST_LD + c8, gr);
                ld8(st + (rr + 16) * ST_LD + c8, gi);
                bf16_t* dr = G1 + ((size_t)((b * 128 + k1) * 2 + 0) * 64 + t2) * 256 + nt * 128 + c8;
#pragma unroll
                for (int e = 0; e < 8; ++e) o[e] = gr[e] * cs + gi[e] * sn;
                *(uint4*)dr = pack8(o);
#pragma unroll
                for (int e = 0; e < 8; ++e) o[e] = gi[e] * cs - gr[e] * sn;
                *(uint4*)(dr + (size_t)64 * 256) = pack8(o);
            }
        } else {
            const int j0 = it - nt1, b = j0 >> 3, mt = (j0 >> 1) & 3, nt = j0 & 1;
            gemm_core<true>(FC + (size_t)mt * 128 * 256, 256, parts + (size_t)(ROWS_L + b * CTX) * PW + PC_UF + nt * 128, PW, 256, acc, smem);
            stage_acc(acc, st);
#pragma unroll 1
            for (int i = 0; i < 8; ++i) {
                const int q = tid + 256 * i, rl = q >> 4, c8 = (q & 15) * 8;
                const int m = mt * 128 + rl, c = m >> 8, k = m & 255;
                float v[8];
                ld8(st + rl * ST_LD + c8, v);
                *(uint4*)(pcat + (size_t)(ROWS_L + b * CTX + k) * 512 + c * 256 + nt * 128 + c8) = pack8(v);
            }
        }
    }
}

DI void phase_dft2_mixp(const Params& p, int l, bf16_t* smem, int item_lo, int item_hi, int blk0, int nblk) {
    const int tid = otid();
    float* st = (float*)smem;
    const bf16_t* F2 = (const bf16_t*)(p.ws + OFF_F2);
    const bf16_t* G1 = (const bf16_t*)(p.ws + OFF_G1);
    bf16_t* pcat = (bf16_t*)(p.ws + OFF_PCAT);
    const bf16_t* dbuf = (const bf16_t*)(p.ws + OFF_DBUF);
    const bf16_t* wp = (const bf16_t*)(p.ws + OFF_WPOOL) + (size_t)l * 65536;
    const bf16_t* parts = (const bf16_t*)(p.ws + OFF_PARTS);
    bf16_t* cat = (bf16_t*)(p.ws + OFF_H);
    const int nt2 = 2 * 128 * 2;
    const int nmt = (l == 0 ? ROWS : ROWS_L) / 128;
    (void)nmt;
    if ((int)blockIdx.x < blk0) return;
    for (int it = item_lo + ((int)blockIdx.x - blk0); it < item_hi; it += nblk) {
        f32x4 acc[4][4];
        if (it < nt2) {
            const int b = it >> 8, k1 = (it >> 1) & 127, nt = it & 1;
            gemm_core<true>(F2, 128, G1 + (size_t)(b * 128 + k1) * 128 * 256 + nt * 128, 256, 128, acc, smem);
            stage_acc(acc, st);
#pragma unroll 1
            for (int i = 0; i < 8; ++i) {
                const int q = tid + 256 * i, m = q >> 4, c8 = (q & 15) * 8;
                const int c = m >> 6, k2 = m & 63;
                float v[8];
                ld8(st + m * ST_LD + c8, v);
                *(uint4*)(pcat + (size_t)(b * SEQ + k1 + 128 * k2) * 512 + c * 256 + nt * 128 + c8) = pack8(v);
            }
        } else {
            const int j0 = it - nt2, tm = j0 >> 1, nt = j0 & 1;
            gemm_core_dma(dbuf + (size_t)tm * 128 * 256 + nt * 128, 256, wp + (size_t)(nt * 128) * 256 + nt * 128, 256, 128, acc, smem);
            stage_acc(acc, st);
            {
                const int c8 = (tid & 15) * 8, r0 = tid >> 4, n = nt * 128 + c8;
                float ps[8];
                ld8(p.pool_scale + l * 256 + n, ps);
                uint4 zr[8];
#pragma unroll
                for (int i = 0; i < 8; ++i) zr[i] = *(const uint4*)(parts + (size_t)(tm * 128 + r0 + 16 * i) * PW + PC_ZP + n);
#pragma unroll
                for (int i = 0; i < 8; ++i) {
                    float v[8], z[8];
                    ld8(st + (r0 + 16 * i) * ST_LD + c8, v);
                    unpack8(zr[i], z);
#pragma unroll
                    for (int e = 0; e < 8; ++e) v[e] = silu_f(z[e]) * ps[e] * v[e];
                    *(uint4*)(cat + (size_t)(tm * 128 + r0 + 16 * i) * DM + 768 + n) = pack8(v);
                }
            }
        }
    }
}

DI void phase_mixf(const Params& p, int l, bf16_t* smem) {
    const int tid = otid();
    float* st = (float*)smem;
    const bf16_t* pcat = (const bf16_t*)(p.ws + OFF_PCAT);
    const bf16_t* wc = (const bf16_t*)(p.ws + OFF_WCOMB) + (size_t)l * 131072;
    const bf16_t* parts = (const bf16_t*)(p.ws + OFF_PARTS);
    bf16_t* cat = (bf16_t*)(p.ws + OFF_H);
    const int nmt = (l == 0 ? ROWS : ROWS_L) / 128;
    for (int it = blockIdx.x; it < nmt * 2; it += gridDim.x) {
        const int tm = it >> 1, nt = it & 1;
        f32x4 acc[4][4];
        gemm_core_dma(pcat + (size_t)tm * 128 * 512, 512, wc + (size_t)(nt * 128) * 512, 512, 512, acc, smem);
        stage_acc(acc, st);
        const float sc = (tm < 128) ? 0.001381067932004976f : 0.0078125f;
        {
            const int c8 = (tid & 15) * 8, r0 = tid >> 4, n = nt * 128 + c8;
            uint4 zr[8];
#pragma unroll
            for (int i = 0; i < 8; ++i) zr[i] = *(const uint4*)(parts + (size_t)(tm * 128 + r0 + 16 * i) * PW + PC_ZF + n);
#pragma unroll
            for (int i = 0; i < 8; ++i) {
                float v[8], z[8];
                ld8(st + (r0 + 16 * i) * ST_LD + c8, v);
                unpack8(zr[i], z);
#pragma unroll
                for (int e = 0; e < 8; ++e) v[e] = silu_f(z[e]) * sc * v[e];
                *(uint4*)(cat + (size_t)(tm * 128 + r0 + 16 * i) * DM + n) = pack8(v);
            }
        }
    }
}

DI void phase_out(const Params& p, int l, const float* xl_in, const float* xc_in, float* xl_out, float* xc_out, bf16_t* smem) {
    const int tid = otid();
    float* st = (float*)smem;
    const bf16_t* cat = (const bf16_t*)(p.ws + OFF_H);
    const bf16_t* W = (const bf16_t*)(p.ws + OFF_WTOUT) + (size_t)l * DM * DM;
    const float* modv = (const float*)(p.ws + OFF_MODV) + (size_t)l * 3 * 3072;
    const int nmt = (l == 0 ? ROWS : ROWS_L) / 128;
    for (XIter t = xiter(nmt * 8); t.u < t.end; t.u += t.step) {
        int tm, tn;
        if (t.u < 1024) { const int ch = t.u >> 6, r = t.u & 63; tn = r >> 3; tm = ch * 8 + (r & 7); }
        else { const int j = t.u - 1024; tn = j >> 2; tm = 128 + (j & 3); }
        f32x4 acc[4][4];
        gemm_core_dma(cat + (size_t)tm * 128 * DM, DM, W + (size_t)tn * 128 * DM, DM, DM, acc, smem);
        stage_acc(acc, st);
        const int rb = tm * 128;
        const int v = (rb < ROWS_L) ? (rb >> 13) : 2;
        const float* gate = modv + v * 3072 + 2048;
        const float* xin = (rb < ROWS_L) ? xl_in : xc_in - (size_t)ROWS_L * DM;
        float* xout = (rb < ROWS_L) ? xl_out : xc_out - (size_t)ROWS_L * DM;
        {
            const int c8 = (tid & 15) * 8, r0 = tid >> 4;
            const size_t o0 = (size_t)(rb + r0) * DM + tn * 128 + c8;
            float gt[8];
            ld8(gate + tn * 128 + c8, gt);
            float4 x0[8], x1[8];
#pragma unroll
            for (int i = 0; i < 8; ++i) { x0[i] = *(const float4*)(xin + o0 + (size_t)i * 16 * DM); x1[i] = *(const float4*)(xin + o0 + (size_t)i * 16 * DM + 4); }
#pragma unroll
            for (int i = 0; i < 8; ++i) {
                float a[8];
                ld8(st + (r0 + 16 * i) * ST_LD + c8, a);
                float* d = xout + o0 + (size_t)i * 16 * DM;
                *(float4*)(d) = make_float4(x0[i].x + gt[0] * a[0], x0[i].y + gt[1] * a[1], x0[i].z + gt[2] * a[2], x0[i].w + gt[3] * a[3]);
                *(float4*)(d + 4) = make_float4(x1[i].x + gt[4] * a[4], x1[i].y + gt[5] * a[5], x1[i].z + gt[6] * a[6], x1[i].w + gt[7] * a[7]);
            }
        }
    }
}

#ifndef PH_MASK
#define PH_MASK 0xFFFF
#endif
#ifndef PH_DUP
#define PH_DUP 0
#endif
__global__ void __launch_bounds__(256, 2) fwd_megakernel(Params p) {
    __shared__ __attribute__((aligned(16))) unsigned char smem_raw[SMEM_BYTES];
    bf16_t* smem = (bf16_t*)smem_raw;
    float* smf = (float*)smem_raw;
    volatile LAS unsigned* stw = (volatile LAS unsigned*)(smem_raw + SMEM_MAIN);
    if (threadIdx.x == 0) { stw[0] = 0u; stw[1] = 0u; stw[2] = 0u; stw[3] = 0u; }
    __syncthreads();
    if (p.never) cg::this_grid().sync();
    XcdBarrier bar = xcd_barrier_post((unsigned*)(p.ws + OFF_BAR), stw);

    if (PH_MASK & 1) phase0(p, smf);
    if (PH_DUP & 1) phase0(p, smf);
    xcd_barrier(bar);
    float* xc1 = (float*)(p.ws + OFF_XC1);
    for (int l = 0; l < 2; ++l) {
        const float* xl_in = (l == 0) ? p.x : p.out;
        const float* xc_in = (l == 0) ? p.ctx : xc1;
        if (PH_MASK & 2) phase_norm(p, l, xl_in, xc_in);
        if (PH_DUP & 2) phase_norm(p, l, xl_in, xc_in);
        xcd_barrier(bar);
        if (PH_MASK & 4) phase_inproj(p, l, smem);
        if (PH_DUP & 4) phase_inproj(p, l, smem);
        xcd_barrier(bar);
        if (PH_MASK & 8) phase_attn(p, l, smem);
        if (PH_DUP & 8) phase_attn(p, l, smem);
        if (PH_MASK & 16) phase_convpool(p, l);
        if (PH_DUP & 16) phase_convpool(p, l);
        if (PH_MASK & 32) phase_dft1(p, l, smem);
        if (PH_DUP & 32) phase_dft1(p, l, smem);
        xcd_barrier(bar);
        if (PH_MASK & 64) phase_dft2_mixp(p, l, smem, 0, 512, 0, gridDim.x);
        xcd_barrier(bar);
        {
            const int nmix = (l == 0 ? ROWS : ROWS_L) / 64;
            const int b0 = ((int)gridDim.x > nmix) ? nmix : 0;
            if (PH_MASK & 128) phase_mixf(p, l, smem);
            if (PH_MASK & 64) phase_dft2_mixp(p, l, smem, 512, 512 + nmix, b0, (int)gridDim.x - b0);
        }
        xcd_barrier(bar);
        if (PH_MASK & 256) phase_out(p, l, xl_in, xc_in, p.out, xc1, smem);
        if (PH_DUP & 256) phase_out(p, l, xl_in, xc_in, (float*)(p.ws + OFF_G1), (float*)(p.ws + OFF_G1), smem);
        if (l == 0) xcd_barrier(bar);
    }
}

extern "C" void kernel_launch(void* const* d_in, const int* in_sizes, int n_in, void* d_out, int out_size, void* d_ws, size_t ws_size, hipStream_t stream) {
    static int grid_blocks = 0;
    if (!grid_blocks) {
        int dev = 0, cus = 0, per_cu = 0;
        hipGetDevice(&dev);
        hipDeviceGetAttribute(&cus, hipDeviceAttributeMultiprocessorCount, dev);
        hipOccupancyMaxActiveBlocksPerMultiprocessor(&per_cu, fwd_megakernel, 256, 0);
        if (per_cu > 2) per_cu = 2;
        if (per_cu < 1) per_cu = 1;
        grid_blocks = cus * per_cu;
        if (ws_size < WS_END) fprintf(stderr, "kernel_launch: workspace too small: %zu < %zu\n", ws_size, (size_t)WS_END);
    }
    hipMemsetAsync((char*)d_ws + OFF_BAR, 0, 16384, stream);
    Params p{};
    p.x = (const float*)d_in[0]; p.c = (const float*)d_in[1]; p.ctx = (const float*)d_in[2]; p.c_ctx = (const float*)d_in[3];
    p.w_mod = (const float*)d_in[4]; p.b_mod = (const float*)d_in[5]; p.norm_g = (const float*)d_in[6]; p.w_in = (const float*)d_in[7];
    p.q_gain = (const float*)d_in[8]; p.k_gain = (const float*)d_in[9]; p.w_fourier = (const float*)d_in[10]; p.conv_w = (const float*)d_in[11];
    p.conv_b = (const float*)d_in[12]; p.pool_w = (const float*)d_in[13]; p.pool_scale = (const float*)d_in[14]; p.w_out = (const float*)d_in[15];
    p.out = (float*)d_out; p.ws = (unsigned char*)d_ws; p.never = 0; p.pad = 0;
    void* args[] = {&p};
    hipError_t e = hipLaunchCooperativeKernel((void*)fwd_megakernel, dim3(grid_blocks), dim3(256), args, 0, stream);
    if (e != hipSuccess) fprintf(stderr, "cooperative launch failed: %s (grid %d)\n", hipGetErrorString(e), grid_blocks);
}
```

```cpp
#include <hip/hip_runtime.h>
#include <hip/hip_cooperative_groups.h>
#include <stdint.h>
#include <cstdio>
namespace cg = cooperative_groups;

typedef unsigned short bf16_t;
typedef __attribute__((ext_vector_type(8))) short bf16x8;
typedef __attribute__((ext_vector_type(4))) short bf16x4;
typedef __attribute__((ext_vector_type(4))) float f32x4;
typedef __attribute__((ext_vector_type(16))) float f32x16;
#define DI __device__ __forceinline__

#define SEQ 8192
#define CTX 256
#define DM 1024
#define DIN 2816
#define ROWS_L 16384
#define ROWS_C 512
#define ROWS 16896
#define NKEY 8448
#define PW 2304
#define PC_ZATT 0
#define PC_UF 256
#define PC_ZF 512
#define PC_BC 768
#define PC_CC 1024
#define PC_HC 1280
#define PC_ZC 1536
#define PC_UP 1792
#define PC_ZP 2048

constexpr size_t OFF_BAR = 0;
constexpr size_t OFF_MODV = 16384;
constexpr size_t OFF_ROPE = OFF_MODV + 2 * 3 * 3072 * 4;
constexpr size_t OFF_TW = OFF_ROPE + 6144 * 4;
constexpr size_t OFF_F1 = OFF_TW + 8192 * 2 * 4;
constexpr size_t OFF_F2 = OFF_F1 + 256 * 128 * 2;
constexpr size_t OFF_FC = OFF_F2 + 128 * 128 * 2;
constexpr size_t OFF_WCOMB = OFF_FC + 512 * 256 * 2;
constexpr size_t OFF_WPOOL = OFF_WCOMB + 2 * 256 * 512 * 2;
constexpr size_t OFF_WTIN = 2097152;
constexpr size_t OFF_WTOUT = OFF_WTIN + (size_t)2 * DIN * DM * 2;
constexpr size_t OFF_H = OFF_WTOUT + (size_t)2 * DM * DM * 2;
constexpr size_t OFF_PARTS = OFF_H + (size_t)ROWS * DM * 2;
constexpr size_t OFF_Q = OFF_PARTS + (size_t)ROWS * PW * 2;
constexpr size_t OFF_QC = OFF_Q + (size_t)2 * 4 * SEQ * 64 * 2;
constexpr size_t OFF_K = OFF_QC + (size_t)2 * 4 * CTX * 64 * 2;
constexpr size_t OFF_VT = OFF_K + (size_t)2 * 2 * NKEY * 64 * 2;
constexpr size_t OFF_DBUF = OFF_VT + (size_t)2 * 2 * NKEY * 64 * 2;
constexpr size_t OFF_G1 = OFF_DBUF + (size_t)ROWS * 256 * 2;
constexpr size_t OFF_PCAT = OFF_G1 + (size_t)2 * 128 * 2 * 64 * 256 * 2;
constexpr size_t OFF_XC1 = OFF_PCAT + (size_t)ROWS * 512 * 2;
constexpr size_t WS_END = OFF_XC1 + (size_t)ROWS_C * DM * 4;
static_assert(OFF_WPOOL + 2 * 256 * 256 * 2 <= OFF_WTIN, "ws map");

struct Params {
    const float *x, *c, *ctx, *c_ctx, *w_mod, *b_mod, *norm_g, *w_in, *q_gain, *k_gain, *w_fourier, *conv_w, *conv_b, *pool_w, *pool_scale, *w_out;
    float* out;
    unsigned char* ws;
    int never;
    int pad;
};

DI bf16_t f2bf(float x) { unsigned u = __float_as_uint(x); u += 0x7fffu + ((u >> 16) & 1u); return (bf16_t)(u >> 16); }
DI float bf2f(bf16_t h) { return __uint_as_float(((unsigned)h) << 16); }
typedef __attribute__((ext_vector_type(2))) float f32x2;
typedef __attribute__((ext_vector_type(2))) __bf16 bf16x2v;
DI unsigned pack2(float a, float b) { const f32x2 v = {a, b}; return __builtin_bit_cast(unsigned, __builtin_convertvector(v, bf16x2v)); }
struct XIter { int u, end, step; };
DI XIter xiter(int ntiles) {
    const int x = blockIdx.x & 7, j = blockIdx.x >> 3, nb = gridDim.x >> 3, per = (ntiles + 7) >> 3;
    XIter r; r.u = x * per + j; r.end = min((x + 1) * per, ntiles); r.step = nb; return r;
}
DI float silu_f(float z) { return z / (1.f + __expf(-z)); }
DI float bflo(unsigned w) { return __uint_as_float(w << 16); }
DI float bfhi(unsigned w) { return __uint_as_float(w & 0xffff0000u); }
DI int otid() { int t = threadIdx.x; asm volatile("" : "+v"(t)); return t; }

#define XB_TMO      128
#define XB_XCNT(j)  (256  + 64 * (j))
#define XB_XSUB(j)  (1280 + 64 * (j))
#define XB_XGEN(j)  (2304 + 64 * (j))
#define XB_TOP      3328
#define XB_TOPGEN   3392
#define XCD_BAR_WORDS 3456
#define XB_SPIN_CAP (1u << 20)
#define LAS __attribute__((address_space(3)))
DI unsigned xb_ld(unsigned* p) { return __hip_atomic_load(p, __ATOMIC_RELAXED, __HIP_MEMORY_SCOPE_AGENT); }
DI unsigned xb_add(unsigned* p, unsigned v) { return __hip_atomic_fetch_add(p, v, __ATOMIC_RELAXED, __HIP_MEMORY_SCOPE_AGENT); }
DI unsigned xb_xcc_id() { return (unsigned)__builtin_amdgcn_s_getreg((3 << 11) | 20) & 0xFu; }
#define XB_SPIN(cond, bar) do { unsigned _sp = 0; while (cond) { __builtin_amdgcn_s_sleep(1); \
    if ((++_sp & 255u) == 0u) { if (xb_ld(&(bar)[XB_TMO])) break; if (_sp > XB_SPIN_CAP) { atomicAdd(&(bar)[XB_TMO], 1u); break; } } } } while (0)
struct XcdBarrier { unsigned* bar; unsigned x; volatile LAS unsigned* st; };
DI XcdBarrier xcd_barrier_post(unsigned* bar, volatile LAS unsigned* st) {
    XcdBarrier b; b.bar = bar; b.x = xb_xcc_id(); b.st = st;
    if (threadIdx.x == 0) (void)xb_add(&bar[XB_XCNT(b.x)], 1u);
    return b;
}
DI void xcd_barrier_complete(unsigned* bar, unsigned x, unsigned& nloc, unsigned& nx) {
    const unsigned G = gridDim.x * gridDim.y * gridDim.z;
    unsigned sum, cnt, mine, sp = 0u;
    for (;;) {
        sum = 0u; cnt = 0u; mine = 0u;
#pragma unroll
        for (unsigned j = 0; j < 16; ++j) { const unsigned c = xb_ld(&bar[XB_XCNT(j)]); sum += c; cnt += (c > 0u) ? 1u : 0u; mine = (j == x) ? c : mine; }
        if (sum == G) break;
        __builtin_amdgcn_s_sleep(1);
        if ((++sp & 255u) == 0u) { if (xb_ld(&bar[XB_TMO])) break; if (sp > XB_SPIN_CAP) { atomicAdd(&bar[XB_TMO], 1u); break; } }
    }
    nloc = mine > 0u ? mine : 1u; nx = cnt > 0u ? cnt : 1u;
}
DI void xcd_barrier(const XcdBarrier& b) {
    asm volatile("s_waitcnt vmcnt(0)" ::: "memory");
    __syncthreads();
    if (threadIdx.x == 0) {
        unsigned* bar = b.bar;
        __builtin_amdgcn_s_waitcnt(0);
        unsigned nloc = b.st[0], nx = b.st[1];
        if (nloc == 0u) { xcd_barrier_complete(bar, b.x, nloc, nx); b.st[0] = nloc; b.st[1] = nx; }
        const unsigned old = xb_add(&bar[XB_XSUB(b.x)], 1u);
        const unsigned gen = old / nloc;
        if (old + 1u == (gen + 1u) * nloc) {
            __builtin_amdgcn_fence(__ATOMIC_RELEASE, "agent");
            asm volatile("s_waitcnt vmcnt(0)" ::: "memory");
            const unsigned og = xb_add(&bar[XB_TOP], 1u);
            const unsigned tg = og / nx;
            if (og + 1u == (tg + 1u) * nx) xb_add(&bar[XB_TOPGEN], 1u);
            else XB_SPIN(xb_ld(&bar[XB_TOPGEN]) == tg, bar);
            __builtin_amdgcn_fence(__ATOMIC_ACQUIRE, "agent");
            xb_add(&bar[XB_XGEN(b.x)], 1u);
            asm volatile("s_waitcnt vmcnt(0)" ::: "memory");
        } else {
            XB_SPIN(xb_ld(&bar[XB_XGEN(b.x)]) == gen, bar);
            __builtin_amdgcn_fence(__ATOMIC_ACQUIRE, "agent");
            asm volatile("s_waitcnt vmcnt(0)" ::: "memory");
        }
    }
    __syncthreads();
}

#define LROW 72
#define TILE_E (128 * LROW)
#define SMEM_MAIN (4 * TILE_E * 2)
#define SMEM_BYTES (SMEM_MAIN + 16)

typedef __attribute__((ext_vector_type(4))) unsigned u32x4;
struct Stg { u32x4 a0, a1, a2, a3, b0, b1, b2, b3; };
template <bool BN>
DI u32x4 g_ld_b(const bf16_t* __restrict__ B, int ldb, int kt, int q) {
    if (!BN) return *(const u32x4*)(B + (size_t)(q >> 3) * ldb + kt * 64 + (q & 7) * 8);
    else     return *(const u32x4*)(B + (size_t)(kt * 64 + (q >> 4)) * ldb + (q & 15) * 8);
}
template <bool BN>
DI void g_load(Stg& r, const bf16_t* __restrict__ A, int lda, const bf16_t* __restrict__ B, int ldb, int kt, int tid) {
    const bf16_t* ap = A + (size_t)(tid >> 3) * lda + kt * 64 + (tid & 7) * 8;
    r.a0 = *(const u32x4*)(ap);
    r.a1 = *(const u32x4*)(ap + (size_t)32 * lda);
    r.a2 = *(const u32x4*)(ap + (size_t)64 * lda);
    r.a3 = *(const u32x4*)(ap + (size_t)96 * lda);
    r.b0 = g_ld_b<BN>(B, ldb, kt, tid);
    r.b1 = g_ld_b<BN>(B, ldb, kt, tid + 256);
    r.b2 = g_ld_b<BN>(B, ldb, kt, tid + 512);
    r.b3 = g_ld_b<BN>(B, ldb, kt, tid + 768);
}
template <bool BN>
DI void s_st_b(bf16_t* b, const u32x4 v, int q) {
    if (!BN) *(u32x4*)(b + (q >> 3) * LROW + (q & 7) * 8) = v;
    else {
        const int kr0 = q >> 4, n0 = (q & 15) * 8, kr = ((((kr0 >> 3) ^ (q & 7)) << 3) | (kr0 & 7));
        b[(n0 + 0) * LROW + kr] = (bf16_t)(v.x & 0xffffu); b[(n0 + 1) * LROW + kr] = (bf16_t)(v.x >> 16);
        b[(n0 + 2) * LROW + kr] = (bf16_t)(v.y & 0xffffu); b[(n0 + 3) * LROW + kr] = (bf16_t)(v.y >> 16);
        b[(n0 + 4) * LROW + kr] = (bf16_t)(v.z & 0xffffu); b[(n0 + 5) * LROW + kr] = (bf16_t)(v.z >> 16);
        b[(n0 + 6) * LROW + kr] = (bf16_t)(v.w & 0xffffu); b[(n0 + 7) * LROW + kr] = (bf16_t)(v.w >> 16);
    }
}
template <bool BN>
DI void s_store(const Stg& r, bf16_t* smem, int buf, int tid) {
    bf16_t* a = smem + buf * 2 * TILE_E;
    bf16_t* b = a + TILE_E;
    bf16_t* ap = a + (tid >> 3) * LROW + (tid & 7) * 8;
    *(u32x4*)(ap) = r.a0;
    *(u32x4*)(ap + 32 * LROW) = r.a1;
    *(u32x4*)(ap + 64 * LROW) = r.a2;
    *(u32x4*)(ap + 96 * LROW) = r.a3;
    s_st_b<BN>(b, r.b0, tid);
    s_st_b<BN>(b, r.b1, tid + 256);
    s_st_b<BN>(b, r.b2, tid + 512);
    s_st_b<BN>(b, r.b3, tid + 768);
}
DI void mma_tile(const bf16_t* smem, int buf, f32x4 (&acc)[4][4], int wm, int wn, int lane) {
    const bf16_t* a = smem + buf * 2 * TILE_E;
    const bf16_t* b = a + TILE_E;
#pragma unroll
    for (int kk = 0; kk < 2; ++kk) {
        bf16x8 af[4], bfr[4];
#pragma unroll
        for (int mi = 0; mi < 4; ++mi) af[mi] = *(const bf16x8*)(a + (wm * 64 + mi * 16 + (lane & 15)) * LROW + kk * 32 + (lane >> 4) * 8);
#pragma unroll
        for (int ni = 0; ni < 4; ++ni) bfr[ni] = *(const bf16x8*)(b + (wn * 64 + ni * 16 + (lane & 15)) * LROW + (((kk * 4 + (lane >> 4)) ^ ((ni * 2 + ((lane >> 3) & 1)) & 7)) << 3));
#pragma unroll
        for (int mi = 0; mi < 4; ++mi)
#pragma unroll
            for (int ni = 0; ni < 4; ++ni) acc[mi][ni] = __builtin_amdgcn_mfma_f32_16x16x32_bf16(af[mi], bfr[ni], acc[mi][ni], 0, 0, 0);
    }
}
template <bool BN>
DI void gemm_core(const bf16_t* __restrict__ A, int lda, const bf16_t* __restrict__ B, int ldb, int K, f32x4 (&acc)[4][4], bf16_t* smem) {
    const int tid = otid(), lane = tid & 63, wave = tid >> 6;
    const int wm = wave >> 1, wn = wave & 1;
#pragma unroll
    for (int mi = 0; mi < 4; ++mi)
#pragma unroll
        for (int ni = 0; ni < 4; ++ni) acc[mi][ni] = (f32x4){0.f, 0.f, 0.f, 0.f};
    const int nk = K >> 6;
    Stg r0, r1;
    __syncthreads();
    g_load<BN>(r0, A, lda, B, ldb, 0, tid);
    g_load<BN>(r1, A, lda, B, ldb, 1, tid);
    s_store<BN>(r0, smem, 0, tid);
    __syncthreads();
    for (int kt = 0; kt < nk; kt += 2) {
        if (kt + 2 < nk) g_load<BN>(r0, A, lda, B, ldb, kt + 2, tid);
        mma_tile(smem, 0, acc, wm, wn, lane);
        s_store<BN>(r1, smem, 1, tid);
        __syncthreads();
        if (kt + 3 < nk) g_load<BN>(r1, A, lda, B, ldb, kt + 3, tid);
        mma_tile(smem, 1, acc, wm, wn, lane);
        if (kt + 2 < nk) s_store<BN>(r0, smem, 0, tid);
        __syncthreads();
    }
}
#define GT_E (128 * 64)
DI void glds_tile(const bf16_t* __restrict__ G, int ld, int kt, bf16_t* lt, int tid) {
    const int c = (tid & 7) ^ ((tid >> 4) & 7);
    const bf16_t* g = G + (size_t)(tid >> 3) * ld + kt * 64 + c * 8;
    char* l = (char*)lt + tid * 16;
#pragma unroll
    for (int p = 0; p < 4; ++p)
        __builtin_amdgcn_global_load_lds((const unsigned*)(g + (size_t)(p * 32) * ld), (LAS unsigned*)(l + p * 4096), 16, 0, 0);
}
DI void mma_tile_sw(const bf16_t* smem, int buf, f32x4 (&acc)[4][4], int wm, int wn, int lane) {
    const char* a = (const char*)(smem + buf * 2 * GT_E);
    const char* b = a + GT_E * 2;
    const int sw = (lane & 15) >> 1;
#pragma unroll
    for (int kk = 0; kk < 2; ++kk) {
        bf16x8 af[4], bfr[4];
        const int co = ((kk * 4 + (lane >> 4)) ^ sw) << 4;
#pragma unroll
        for (int mi = 0; mi < 4; ++mi) af[mi] = *(const bf16x8*)(a + (wm * 64 + mi * 16 + (lane & 15)) * 128 + co);
#pragma unroll
        for (int ni = 0; ni < 4; ++ni) bfr[ni] = *(const bf16x8*)(b + (wn * 64 + ni * 16 + (lane & 15)) * 128 + co);
#pragma unroll
        for (int mi = 0; mi < 4; ++mi)
#pragma unroll
            for (int ni = 0; ni < 4; ++ni) acc[mi][ni] = __builtin_amdgcn_mfma_f32_16x16x32_bf16(af[mi], bfr[ni], acc[mi][ni], 0, 0, 0);
    }
}
DI void gemm_core_dma(const bf16_t* __restrict__ A, int lda, const bf16_t* __restrict__ B, int ldb, int K, f32x4 (&acc)[4][4], bf16_t* smem) {
    const int tid = otid(), lane = tid & 63, wave = tid >> 6;
    const int wm = wave >> 1, wn = wave & 1;
#pragma unroll
    for (int mi = 0; mi < 4; ++mi)
#pragma unroll
        for (int ni = 0; ni < 4; ++ni) acc[mi][ni] = (f32x4){0.f, 0.f, 0.f, 0.f};
    const int nk = K >> 6;
    __syncthreads();
    glds_tile(A, lda, 0, smem, tid);
    glds_tile(B, ldb, 0, smem + GT_E, tid);
    for (int kt = 0; kt < nk; ++kt) {
        asm volatile("s_waitcnt vmcnt(0)" ::: "memory");
        __syncthreads();
        if (kt + 1 < nk) {
            bf16_t* nb = smem + ((kt + 1) & 1) * 2 * GT_E;
            glds_tile(A, lda, kt + 1, nb, tid);
            glds_tile(B, ldb, kt + 1, nb + GT_E, tid);
        }
        mma_tile_sw(smem, kt & 1, acc, wm, wn, lane);
    }
    __syncthreads();
}
#define ST_LD 132
DI void stage_acc(f32x4 (&acc)[4][4], float* st) {
    const int lane = otid() & 63, wave = otid() >> 6, wm = wave >> 1, wn = wave & 1, fl = lane & 15, g4 = lane >> 4;
#pragma unroll
    for (int mi = 0; mi < 4; ++mi)
#pragma unroll
        for (int ni = 0; ni < 4; ++ni)
#pragma unroll
            for (int j = 0; j < 4; ++j) st[(wm * 64 + mi * 16 + g4 * 4 + j) * ST_LD + wn * 64 + ni * 16 + fl] = acc[mi][ni][j];
    __syncthreads();
}
DI void ld8(const float* q, float (&v)[8]) {
    const float4 a = *(const float4*)q, b = *(const float4*)(q + 4);
    v[0] = a.x; v[1] = a.y; v[2] = a.z; v[3] = a.w; v[4] = b.x; v[5] = b.y; v[6] = b.z; v[7] = b.w;
}
DI uint4 pack8(const float (&v)[8]) { return make_uint4(pack2(v[0], v[1]), pack2(v[2], v[3]), pack2(v[4], v[5]), pack2(v[6], v[7])); }
DI void unpack8(const uint4 u, float (&v)[8]) {
    v[0] = bflo(u.x); v[1] = bfhi(u.x); v[2] = bflo(u.y); v[3] = bfhi(u.y); v[4] = bflo(u.z); v[5] = bfhi(u.z); v[6] = bflo(u.w); v[7] = bfhi(u.w);
}

DI void phase0(const Params& p, float* smf) {
    const int tid = otid();
    unsigned char* ws = p.ws;
    float* modv = (float*)(ws + OFF_MODV);
    for (int it = blockIdx.x; it < 192; it += gridDim.x) {
        const int l = it / 96, n0 = (it % 96) * 32;
        __syncthreads();
        for (int i = tid; i < 3072; i += 256) {
            const int v = i >> 10, k = i & 1023;
            const float cv = (v == 0) ? p.c[k] : (v == 1) ? p.c[1024 + k] : p.c_ctx[k];
            smf[i] = silu_f(cv);
        }
        __syncthreads();
        const int col = tid & 31, kg = tid >> 5;
        float a0 = 0.f, a1 = 0.f, a2 = 0.f;
        const float* w = p.w_mod + (size_t)l * 1024 * 3072 + n0 + col;
#pragma unroll 16
        for (int kk = 0; kk < 128; ++kk) {
            const int k = kg * 128 + kk;
            const float wv = w[(size_t)k * 3072];
            a0 += smf[k] * wv; a1 += smf[1024 + k] * wv; a2 += smf[2048 + k] * wv;
        }
        __syncthreads();
        smf[3072 + (kg * 3 + 0) * 32 + col] = a0; smf[3072 + (kg * 3 + 1) * 32 + col] = a1; smf[3072 + (kg * 3 + 2) * 32 + col] = a2;
        __syncthreads();
        if (tid < 96) {
            const int v = tid >> 5, cc = tid & 31;
            float s = 0.f;
            for (int g = 0; g < 8; ++g) s += smf[3072 + (g * 3 + v) * 32 + cc];
            modv[(l * 3 + v) * 3072 + n0 + cc] = s + p.b_mod[l * 3072 + n0 + cc];
        }
    }
    {
        const int n_in = 2 * 16 * 44, n_out = 2 * 16 * 16;
        for (int it = blockIdx.x; it < n_in + n_out; it += gridDim.x) {
            const float* src; bf16_t* dst; int N, kt, nt;
            if (it < n_in) { const int l = it / 704, r = it % 704; kt = r / 44; nt = r % 44; N = DIN; src = p.w_in + (size_t)l * DM * DIN; dst = (bf16_t*)(ws + OFF_WTIN) + (size_t)l * DIN * DM; }
            else { const int j = it - n_in; const int l = j / 256, r = j % 256; kt = r / 16; nt = r % 16; N = DM; src = p.w_out + (size_t)l * DM * DM; dst = (bf16_t*)(ws + OFF_WTOUT) + (size_t)l * DM * DM; }
            __syncthreads();
#pragma unroll
            for (int ps = 0; ps < 4; ++ps) {
                const int kr = ps * 16 + (tid >> 4), c4 = (tid & 15) * 4;
                const float4 v = *(const float4*)(src + (size_t)(kt * 64 + kr) * N + nt * 64 + c4);
                smf[kr * 65 + c4 + 0] = v.x; smf[kr * 65 + c4 + 1] = v.y; smf[kr * 65 + c4 + 2] = v.z; smf[kr * 65 + c4 + 3] = v.w;
            }
            __syncthreads();
            const int n = tid >> 2, ks = (tid & 3) * 16;
            unsigned w[8];
#pragma unroll
            for (int e = 0; e < 8; ++e) w[e] = pack2(smf[(ks + 2 * e) * 65 + n], smf[(ks + 2 * e + 1) * 65 + n]);
            bf16_t* d = dst + (size_t)(nt * 64 + n) * DM + kt * 64 + ks;
            *(uint4*)d = make_uint4(w[0], w[1], w[2], w[3]);
            *(uint4*)(d + 8) = make_uint4(w[4], w[5], w[6], w[7]);
        }
    }
    const int gtid = blockIdx.x * 256 + tid, gsz = gridDim.x * 256;
    {
        bf16_t* wc = (bf16_t*)(ws + OFF_WCOMB);
        __syncthreads();
        if (tid < 64) { smf[tid] = cospif((float)tid * (1.f / 32.f)); smf[64 + tid] = sinpif((float)tid * (1.f / 32.f)); }
        __syncthreads();
        for (int i = gtid; i < 2 * 512 * 256; i += gsz) {
            const int n = i & 255, kk = (i >> 8) & 511, l = i >> 17;
            const int c = kk >> 8, head = (kk >> 6) & 3, ch = kk & 63;
            const float* wf = p.w_fourier + (size_t)l * 65536 + (size_t)(head * 64) * 256 + n;
            float s = 0.f;
#pragma unroll 16
            for (int j = 0; j < 64; ++j) s += smf[c * 64 + ((j * ch) & 63)] * wf[j * 256];
            wc[(size_t)l * 131072 + n * 512 + kk] = f2bf(s);
        }
    }
    {
        bf16_t* wp = (bf16_t*)(ws + OFF_WPOOL);
        for (int i = gtid; i < 2 * 256 * 256; i += gsz) {
            const int k = i & 255, n = (i >> 8) & 255, l = i >> 16;
            float v = 0.f;
            if ((k >> 6) == (n >> 6)) v = p.pool_w[(size_t)l * 16384 + (n >> 6) * 4096 + (k & 63) * 64 + (n & 63)];
            wp[i] = f2bf(v);
        }
    }
    {
        float* tw = (float*)(ws + OFF_TW);
        for (int i = gtid; i < 8192; i += gsz) { const float a = (float)i * (1.f / 4096.f); tw[2 * i] = cospif(a); tw[2 * i + 1] = sinpif(a); }
        bf16_t* f1 = (bf16_t*)(ws + OFF_F1);
        for (int i = gtid; i < 256 * 128; i += gsz) {
            const int t1 = i & 127, m = i >> 7;
            const int k1 = (m >> 5) * 16 + (m & 15), c = (m >> 4) & 1;
            const float a = (float)((k1 * t1) & 127) * (1.f / 64.f);
            f1[i] = f2bf(c ? -sinpif(a) : cospif(a));
        }
        bf16_t* f2 = (bf16_t*)(ws + OFF_F2);
        for (int i = gtid; i < 128 * 128; i += gsz) {
            const int kx = i & 127, m = i >> 7;
            const int c = m >> 6, k2 = m & 63, cp = kx >> 6, t2 = kx & 63;
            const float a = (float)((k2 * t2) & 63) * (1.f / 32.f);
            float v;
            if (c == cp) v = cospif(a); else if (c == 0) v = sinpif(a); else v = -sinpif(a);
            f2[i] = f2bf(v);
        }
        bf16_t* fc = (bf16_t*)(ws + OFF_FC);
        for (int i = gtid; i < 512 * 256; i += gsz) {
            const int t = i & 255, m = i >> 8;
            const int c = m >> 8, k = m & 255;
            const float a = (float)((k * t) & 255) * (1.f / 128.f);
            fc[i] = f2bf(c ? -sinpif(a) : cospif(a));
        }
        float* rp = (float*)(ws + OFF_ROPE);
        for (int i = gtid; i < 3072; i += gsz) {
            const int f = i & 15;
            const int pos = (i < 2048) ? (i >> 4) : ((i - 2048) >> 4);
            const float inv = powf(10000.f, -(float)f * (1.f / 16.f));
            const float ang = (float)pos * inv;
            const double ad = (double)ang;
            const float cs = (float)cos(ad), sn = (float)sin(ad);
            if (i < 2048) { rp[i] = cs; rp[2048 + i] = sn; }
            else { rp[4096 + (i - 2048)] = cs; rp[5120 + (i - 2048)] = sn; }
        }
    }
}

DI void phase_norm(const Params& p, int l, const float* xl, const float* xc) {
    const int lane = otid() & 63, wave = otid() >> 6;
    const float* modv = (const float*)(p.ws + OFF_MODV) + (size_t)l * 3 * 3072;
    const float* g = p.norm_g + l * 1024;
    bf16_t* H = (bf16_t*)(p.ws + OFF_H);
    for (int row = blockIdx.x * 4 + wave; row < ROWS; row += gridDim.x * 4) {
        const float* src = (row < ROWS_L) ? xl + (size_t)row * DM : xc + (size_t)(row - ROWS_L) * DM;
        const int v = (row < ROWS_L) ? (row >> 13) : 2;
        const float* mv = modv + v * 3072;
        float4 a[4];
        float ss = 0.f;
#pragma unroll
        for (int i = 0; i < 4; ++i) { a[i] = *(const float4*)(src + i * 256 + lane * 4); ss += a[i].x * a[i].x + a[i].y * a[i].y + a[i].z * a[i].z + a[i].w * a[i].w; }
#pragma unroll
        for (int o = 32; o >= 1; o >>= 1) ss += __shfl_xor(ss, o);
        const float rs = rsqrtf(ss * (1.f / 1024.f) + 1e-6f);
#pragma unroll
        for (int i = 0; i < 4; ++i) {
            const int c0 = i * 256 + lane * 4;
            const float4 gg = *(const float4*)(g + c0), sh = *(const float4*)(mv + c0), sc = *(const float4*)(mv + 1024 + c0);
            const float o0 = a[i].x * rs * gg.x * (1.f + sc.x) + sh.x, o1 = a[i].y * rs * gg.y * (1.f + sc.y) + sh.y;
            const float o2 = a[i].z * rs * gg.z * (1.f + sc.z) + sh.z, o3 = a[i].w * rs * gg.w * (1.f + sc.w) + sh.w;
            *(uint2*)(H + (size_t)row * DM + c0) = make_uint2(pack2(o0, o1), pack2(o2, o3));
        }
    }
}

DI void epi_inproj(const Params& p, int l, int tm, int tn, f32x4 (&acc)[4][4], float* st) {
    const int tid = otid();
    unsigned char* ws = p.ws;
    stage_acc(acc, st);
    const int rbase = tm * 128;
    const bool isctx = rbase >= ROWS_L;
    if (tn < 3) {
        const bool isq = tn < 2;
        const float* gain = (isq ? p.q_gain : p.k_gain) + l * 64;
        const float* rp = (const float*)(ws + OFF_ROPE);
#pragma unroll 1
        for (int i = 0; i < 8; ++i) {
            const int q = tid + 256 * i, rl = q >> 4, c8 = (q & 15) * 8;
            const int row = rbase + rl, hd = c8 >> 6, d0 = c8 & 63;
            float v[8], pv[8], g[8], pg[8];
            ld8(st + rl * ST_LD + c8, v);
            ld8(st + rl * ST_LD + (c8 ^ 16), pv);
            ld8(gain + d0, g);
            ld8(gain + (d0 ^ 16), pg);
            float ss = 0.f;
#pragma unroll
            for (int e = 0; e < 8; ++e) ss += v[e] * v[e];
            ss += __shfl_xor(ss, 1); ss += __shfl_xor(ss, 2); ss += __shfl_xor(ss, 4);
            const float rs = rsqrtf(ss * (1.f / 64.f) + 1e-6f);
#pragma unroll
            for (int e = 0; e < 8; ++e) { v[e] *= rs * g[e]; pv[e] *= rs * pg[e]; }
            bf16_t* dst;
            if (!isctx) {
                const int b = row >> 13, t = row & 8191;
                const int pos = (d0 >= 32) ? (t & 63) : (t >> 6);
                const float* ct = rp + ((d0 >= 32) ? 4096 : 0) + pos * 16 + (d0 & 8);
                float cs[8], sn[8];
                ld8(ct, cs);
                ld8(ct + ((d0 >= 32) ? 1024 : 2048), sn);
                const float sg = (d0 & 16) ? 1.f : -1.f;
#pragma unroll
                for (int e = 0; e < 8; ++e) v[e] = v[e] * cs[e] + sg * pv[e] * sn[e];
                if (isq) dst = (bf16_t*)(ws + OFF_Q) + ((size_t)(b * 4 + tn * 2 + hd) * SEQ + t) * 64 + d0;
                else     dst = (bf16_t*)(ws + OFF_K) + ((size_t)(b * 2 + hd) * NKEY + CTX + t) * 64 + d0;
            } else {
                const int rc = row - ROWS_L, b = rc >> 8, t = rc & 255;
                if (isq) dst = (bf16_t*)(ws + OFF_QC) + ((size_t)(b * 4 + tn * 2 + hd) * CTX + t) * 64 + d0;
                else     dst = (bf16_t*)(ws + OFF_K) + ((size_t)(b * 2 + hd) * NKEY + t) * 64 + d0;
            }
            if (isq) {
#pragma unroll
                for (int e = 0; e < 8; ++e) v[e] *= 0.18033688011112042f;
            }
            *(uint4*)dst = pack8(v);
        }
    } else if (tn == 3) {
        int b, key0;
        if (!isctx) { b = rbase >> 13; key0 = CTX + (rbase & 8191); } else { const int rc = rbase - ROWS_L; b = rc >> 8; key0 = rc & 255; }
#pragma unroll 1
        for (int i = 0; i < 8; ++i) {
            const int q = tid + 256 * i, col = q & 127, r8 = (q >> 7) * 8;
            float v[8];
#pragma unroll
            for (int e = 0; e < 8; ++e) v[e] = st[(r8 + e) * ST_LD + col];
            bf16_t* vt = (bf16_t*)(ws + OFF_VT) + ((size_t)(b * 2 + (col >> 6)) * 64 + (col & 63)) * NKEY + key0 + r8;
            *(uint4*)vt = pack8(v);
        }
    } else {
        bf16_t* parts = (bf16_t*)(ws + OFF_PARTS);
#pragma unroll 1
        for (int i = 0; i < 8; ++i) {
            const int q = tid + 256 * i, rl = q >> 4, c8 = (q & 15) * 8;
            float v[8];
            ld8(st + rl * ST_LD + c8, v);
            *(uint4*)(parts + (size_t)(rbase + rl) * PW + tn * 128 - 512 + c8) = pack8(v);
        }
    }
}

DI void phase_inproj(const Params& p, int l, bf16_t* smem) {
    const bf16_t* H = (const bf16_t*)(p.ws + OFF_H);
    const bf16_t* W = (const bf16_t*)(p.ws + OFF_WTIN) + (size_t)l * DIN * DM;
    const int nlat = 128 * 22;
    const int ntiles = nlat + (l == 0 ? 4 * 22 : 4 * 2);
    for (XIter t = xiter(ntiles); t.u < t.end; t.u += t.step) {
        const int u = t.u;
        int tm, tn;
        if (u < nlat) { const int ch = u / 176, r = u % 176; tn = r >> 3; tm = ch * 8 + (r & 7); }
        else { const int j = u - nlat; tm = 128 + (j & 3); tn = (l == 0 ? 0 : 2) + (j >> 2); }
        f32x4 acc[4][4];
        gemm_core_dma(H + (size_t)tm * 128 * DM, DM, W + (size_t)tn * 128 * DM, DM, DM, acc, smem);
        epi_inproj(p, l, tm, tn, acc, (float*)smem);
    }
}

#define KT_E (64 * LROW)
DI void attn_item(const Params& p, const bf16_t* Qb, const bf16_t* Kb, const bf16_t* VTb, int ntiles, int rowbase, int hq, bf16_t* smem) {
    const int tid = otid(), lane = tid & 63, wave = tid >> 6;
    const int r = lane & 31, h = lane >> 5;
    const float LOG2E = 1.4426950408889634f;
    bf16x8 qf[4];
    {
        const bf16_t* qrow = Qb + (size_t)(wave * 32 + r) * 64;
#pragma unroll
        for (int s = 0; s < 4; ++s) qf[s] = *(const bf16x8*)(qrow + s * 16 + h * 8);
    }
    f32x16 ot[2], minit;
#pragma unroll
    for (int i = 0; i < 16; ++i) { ot[0][i] = 0.f; ot[1][i] = 0.f; minit[i] = 0.f; }
    float m = 0.f, lsum = 0.f;
    uint4 rk[2], rv[2];
    auto gload = [&](int kt) {
#pragma unroll
        for (int i = 0; i < 2; ++i) {
            const int q = tid + 256 * i;
            rk[i] = *(const uint4*)(Kb + (size_t)(kt * 64 + (q >> 3)) * 64 + (q & 7) * 8);
            rv[i] = *(const uint4*)(VTb + (size_t)(q >> 3) * NKEY + kt * 64 + (q & 7) * 8);
        }
    };
    auto sstore = [&](int buf) {
        bf16_t* sk = smem + buf * 2 * KT_E;
        bf16_t* sv = sk + KT_E;
#pragma unroll
        for (int i = 0; i < 2; ++i) {
            const int q = tid + 256 * i;
            *(uint4*)(sk + (q >> 3) * LROW + (q & 7) * 8) = rk[i];
            *(uint4*)(sv + (q >> 3) * LROW + (q & 7) * 8) = rv[i];
        }
    };
    __syncthreads();
    gload(0);
    sstore(0);
    __syncthreads();
    for (int kt = 0; kt < ntiles; ++kt) {
        if (kt + 1 < ntiles) gload(kt + 1);
        const bf16_t* sk = smem + (kt & 1) * 2 * KT_E;
        const bf16_t* sv = sk + KT_E;
        f32x16 st[2], pe[2];
#pragma unroll
        for (int blk = 0; blk < 2; ++blk) {
            st[blk] = __builtin_amdgcn_mfma_f32_32x32x16_bf16(*(const bf16x8*)(sk + (blk * 32 + r) * LROW + h * 8), qf[0], minit, 0, 0, 0);
#pragma unroll
            for (int s = 1; s < 4; ++s)
                st[blk] = __builtin_amdgcn_mfma_f32_32x32x16_bf16(*(const bf16x8*)(sk + (blk * 32 + r) * LROW + s * 16 + h * 8), qf[s], st[blk], 0, 0, 0);
        }
        float ls = 0.f;
#pragma unroll
        for (int i = 0; i < 16; ++i) {
            pe[0][i] = __builtin_amdgcn_exp2f(st[0][i]); ls += pe[0][i];
            pe[1][i] = __builtin_amdgcn_exp2f(st[1][i]); ls += pe[1][i];
        }
        if (kt == 0 || __any(!(ls <= 256.f))) {
            float tmx = st[0][0];
#pragma unroll
            for (int i = 0; i < 16; ++i) { tmx = fmaxf(tmx, st[0][i]); tmx = fmaxf(tmx, st[1][i]); }
            tmx = fmaxf(tmx, __shfl_xor(tmx, 32));
            const float delta = (kt == 0) ? tmx : fmaxf(tmx, 0.f);
            const float alpha = (kt == 0) ? 1.f : __builtin_amdgcn_exp2f(-delta);
            m += delta;
            lsum *= alpha;
            ls = 0.f;
#pragma unroll
            for (int i = 0; i < 16; ++i) {
                ot[0][i] *= alpha; ot[1][i] *= alpha; minit[i] = -m;
                pe[0][i] = __builtin_amdgcn_exp2f(st[0][i] - delta); ls += pe[0][i];
                pe[1][i] = __builtin_amdgcn_exp2f(st[1][i] - delta); ls += pe[1][i];
            }
        }
        lsum += ls;
        bf16x8 pk[2][2];
#pragma unroll
        for (int blk = 0; blk < 2; ++blk)
#pragma unroll
            for (int s = 0; s < 2; ++s) {
                uint4 u;
                u.x = pack2(pe[blk][8 * s + 0], pe[blk][8 * s + 1]); u.y = pack2(pe[blk][8 * s + 2], pe[blk][8 * s + 3]);
                u.z = pack2(pe[blk][8 * s + 4], pe[blk][8 * s + 5]); u.w = pack2(pe[blk][8 * s + 6], pe[blk][8 * s + 7]);
                pk[blk][s] = __builtin_bit_cast(bf16x8, u);
            }
#pragma unroll
        for (int db = 0; db < 2; ++db)
#pragma unroll
            for (int blk = 0; blk < 2; ++blk)
#pragma unroll
                for (int s = 0; s < 2; ++s) {
                    const bf16_t* vp = sv + (db * 32 + r) * LROW + blk * 32 + s * 16 + h * 4;
                    const bf16x4 lo = *(const bf16x4*)vp;
                    const bf16x4 hi = *(const bf16x4*)(vp + 8);
                    const bf16x8 vf = __builtin_shufflevector(lo, hi, 0, 1, 2, 3, 4, 5, 6, 7);
                    ot[db] = __builtin_amdgcn_mfma_f32_32x32x16_bf16(vf, pk[blk][s], ot[db], 0, 0, 0);
                }
        if (kt + 1 < ntiles) sstore((kt + 1) & 1);
        __syncthreads();
    }
    lsum += __shfl_xor(lsum, 32);
    const float inv = 1.f / lsum;
    const int row = rowbase + wave * 32 + r;
    const bf16_t* zrow = (const bf16_t*)(p.ws + OFF_PARTS) + (size_t)row * PW + PC_ZATT + hq * 64;
    bf16_t* orow = (bf16_t*)(p.ws + OFF_H) + (size_t)row * DM + 256 + hq * 64;
#pragma unroll
    for (int db = 0; db < 2; ++db)
#pragma unroll
        for (int g = 0; g < 4; ++g) {
            const int d = db * 32 + g * 8 + h * 4;
            const uint2 z = *(const uint2*)(zrow + d);
            const float o0 = silu_f(bflo(z.x)) * ot[db][4 * g + 0] * inv, o1 = silu_f(bfhi(z.x)) * ot[db][4 * g + 1] * inv;
            const float o2 = silu_f(bflo(z.y)) * ot[db][4 * g + 2] * inv, o3 = silu_f(bfhi(z.y)) * ot[db][4 * g + 3] * inv;
            *(uint2*)(orow + d) = make_uint2(pack2(o0, o1), pack2(o2, o3));
        }
}

DI void phase_attn(const Params& p, int l, bf16_t* smem) {
    const bf16_t* Q = (const bf16_t*)(p.ws + OFF_Q);
    const bf16_t* QC = (const bf16_t*)(p.ws + OFF_QC);
    const bf16_t* Kk = (const bf16_t*)(p.ws + OFF_K);
    const bf16_t* VT = (const bf16_t*)(p.ws + OFF_VT);
    for (XIter t = xiter(512); t.u < t.end; t.u += t.step) {
        const int it = t.u;
        const int b = it >> 8, hq = (it >> 6) & 3, qt = it & 63;
        const size_t kv = (size_t)(b * 2 + (hq >> 1));
        attn_item(p, Q + ((size_t)(b * 4 + hq) * SEQ + qt * 128) * 64, Kk + kv * NKEY * 64, VT + kv * 64 * NKEY, NKEY / 64, b * SEQ + qt * 128, hq, smem);
    }
    if (l == 0) {
        for (int j = blockIdx.x; j < 16; j += gridDim.x) {
            const int b = j >> 3, hq = (j >> 1) & 3, qt = j & 1;
            const size_t kv = (size_t)(b * 2 + (hq >> 1));
            attn_item(p, QC + ((size_t)(b * 4 + hq) * CTX + qt * 128) * 64, Kk + kv * NKEY * 64, VT + kv * 64 * NKEY, CTX / 64, ROWS_L + b * CTX + qt * 128, hq, smem);
        }
    }
}

template <int W>
DI void pool_task(const bf16_t* __restrict__ pu, int pos, int n, bf16_t* __restrict__ dst) {
    constexpr int LEFT = W / 2;
    uint4 raw[W];
#pragma unroll
    for (int t = 0; t < W; ++t) { int q = pos - LEFT + t; q = q < 0 ? 0 : (q >= n ? n - 1 : q); raw[t] = *(const uint4*)(pu + (size_t)q * PW); }
    float sum[8], u[8];
#pragma unroll
    for (int e = 0; e < 8; ++e) sum[e] = 0.f;
#pragma unroll
    for (int t = 0; t < W; ++t) {
        const int q = pos - LEFT + t;
        const float mk = (q >= 0 && q < n) ? 1.f : 0.f;
        unpack8(raw[t], u);
#pragma unroll
        for (int e = 0; e < 8; ++e) sum[e] += mk * u[e];
    }
    const int lo = max(pos - LEFT, 0), hi = min(pos + W - LEFT, n);
    const float ic = 1.f / (float)(hi - lo);
    unpack8(raw[LEFT], u);
#pragma unroll
    for (int e = 0; e < 8; ++e) sum[e] = sum[e] * ic - u[e];
    *(uint4*)dst = pack8(sum);
}
DI void phase_convpool(const Params& p, int l) {
    const bf16_t* __restrict__ parts = (const bf16_t*)(p.ws + OFF_PARTS);
    bf16_t* __restrict__ cat = (bf16_t*)(p.ws + OFF_H);
    bf16_t* __restrict__ dbuf = (bf16_t*)(p.ws + OFF_DBUF);
    const int nrows = (l == 0 ? ROWS : ROWS_L);
    const int gsz = gridDim.x * 256, gt = blockIdx.x * 256 + otid();
    {
        const int c8 = (gt & 31) * 8;
        float w0[8], w1[8], w2[8], bs[8];
        ld8(p.conv_w + l * 768 + c8, w0); ld8(p.conv_w + l * 768 + 256 + c8, w1); ld8(p.conv_w + l * 768 + 512 + c8, w2); ld8(p.conv_b + l * 256 + c8, bs);
        for (int i = gt; i < nrows * 32; i += gsz) {
            const int row = i >> 5;
            int seq0, n;
            if (row < ROWS_L) { seq0 = (row >> 13) << 13; n = SEQ; } else { seq0 = ROWS_L + (((row - ROWS_L) >> 8) << 8); n = CTX; }
            const int pos = row - seq0;
            const bf16_t* pr = parts + (size_t)row * PW + c8;
            const bool hp = pos > 0, hn = pos + 1 < n;
            const bf16_t* pp = hp ? pr - PW : pr;
            const bf16_t* pn = hn ? pr + PW : pr;
            const uint4 r0 = *(const uint4*)(pr + PC_CC), r1 = *(const uint4*)(pr + PC_HC), r2 = *(const uint4*)(pp + PC_CC), r3 = *(const uint4*)(pp + PC_HC);
            const uint4 r4 = *(const uint4*)(pn + PC_CC), r5 = *(const uint4*)(pn + PC_HC), r6 = *(const uint4*)(pr + PC_BC), r7 = *(const uint4*)(pr + PC_ZC);
            const float mp = hp ? 1.f : 0.f, mn = hn ? 1.f : 0.f;
            float a[8], b[8], tc[8], tp[8], tn[8], o[8];
            unpack8(r0, a); unpack8(r1, b);
#pragma unroll
            for (int e = 0; e < 8; ++e) tc[e] = a[e] * b[e];
            unpack8(r2, a); unpack8(r3, b);
#pragma unroll
            for (int e = 0; e < 8; ++e) tp[e] = a[e] * b[e] * mp;
            unpack8(r4, a); unpack8(r5, b);
#pragma unroll
            for (int e = 0; e < 8; ++e) tn[e] = a[e] * b[e] * mn;
            unpack8(r6, a); unpack8(r7, b);
#pragma unroll
            for (int e = 0; e < 8; ++e) o[e] = silu_f(b[e]) * (a[e] * (tp[e] * w0[e] + tc[e] * w1[e] + tn[e] * w2[e] + bs[e]));
            *(uint4*)(cat + (size_t)row * DM + 512 + c8) = pack8(o);
        }
    }
    for (int j = gt; j < nrows * 32; j += gsz) {
        const int g = j / (nrows * 8), rem = j - g * (nrows * 8), row = rem >> 3, c8 = g * 64 + (rem & 7) * 8;
        int seq0, n;
        if (row < ROWS_L) { seq0 = (row >> 13) << 13; n = SEQ; } else { seq0 = ROWS_L + (((row - ROWS_L) >> 8) << 8); n = CTX; }
        const bf16_t* pu = parts + (size_t)seq0 * PW + PC_UP + c8;
        bf16_t* dst = dbuf + (size_t)row * 256 + c8;
        const int pos = row - seq0;
        if (g == 0) pool_task<2>(pu, pos, n, dst);
        else if (g == 1) pool_task<4>(pu, pos, n, dst);
        else if (g == 2) pool_task<8>(pu, pos, n, dst);
        else pool_task<16>(pu, pos, n, dst);
    }
}

DI void phase_dft1(const Params& p, int l, bf16_t* smem) {
    const int tid = otid();
    float* st = (float*)smem;
    const bf16_t* parts = (const bf16_t*)(p.ws + OFF_PARTS);
    const bf16_t* F1 = (const bf16_t*)(p.ws + OFF_F1);
    const bf16_t* FC = (const bf16_t*)(p.ws + OFF_FC);
    const float* tw = (const float*)(p.ws + OFF_TW);
    bf16_t* G1 = (bf16_t*)(p.ws + OFF_G1);
    bf16_t* pcat = (bf16_t*)(p.ws + OFF_PCAT);
    const int nt1 = 2 * 64 * 4;
    const int ntot = nt1 + (l == 0 ? 16 : 0);
    for (int it = blockIdx.x; it < ntot; it += gridDim.x) {
        f32x4 acc[4][4];
        if (it < nt1) {
            const int b = it >> 8, t2 = (it >> 2) & 63, mt = (it >> 1) & 1, nt = it & 1;
            gemm_core<true>(F1 + (size_t)mt * 128 * 128, 128, parts + (size_t)(b * SEQ + t2) * PW + PC_UF + nt * 128, 64 * PW, 128, acc, smem);
            stage_acc(acc, st);
#pragma unroll 1
            for (int i = 0; i < 4; ++i) {
                const int q = tid + 256 * i, kk = q >> 4, c8 = (q & 15) * 8;
                const int rr = 32 * (kk >> 4) + (kk & 15);
                const int k1 = mt * 64 + kk;
                const float cs = tw[2 * (k1 * t2)], sn = tw[2 * (k1 * t2) + 1];
                float gr[8], gi[8], o[8];
                ld8(st + rr * ST_LD + c8, gr);
                ld8(st + (rr + 16) * ST_LD + c8, gi);
                bf16_t* dr = G1 + ((size_t)((b * 128 + k1) * 2 + 0) * 64 + t2) * 256 + nt * 128 + c8;
#pragma unroll
                for (int e = 0; e < 8; ++e) o[e] = gr[e] * cs + gi[e] * sn;
                *(uint4*)dr = pack8(o);
#pragma unroll
                for (int e = 0; e < 8; ++e) o[e] = gi[e] * cs - gr[e] * sn;
                *(uint4*)(dr + (size_t)64 * 256) = pack8(o);
            }
        } else {
            const int j0 = it - nt1, b = j0 >> 3, mt = (j0 >> 1) & 3, nt = j0 & 1;
            gemm_core<true>(FC + (size_t)mt * 128 * 256, 256, parts + (size_t)(ROWS_L + b * CTX) * PW + PC_UF + nt * 128, PW, 256, acc, smem);
            stage_acc(acc, st);
#pragma unroll 1
            for (int i = 0; i < 8; ++i) {
                const int q = tid + 256 * i, rl = q >> 4, c8 = (q & 15) * 8;
                const int m = mt * 128 + rl, c = m >> 8, k = m & 255;
                float v[8];
                ld8(st + rl * ST_LD + c8, v);
                *(uint4*)(pcat + (size_t)(ROWS_L + b * CTX + k) * 512 + c * 256 + nt * 128 + c8) = pack8(v);
            }
        }
    }
}

DI void phase_dft2_mixp(const Params& p, int l, bf16_t* smem, int item_lo, int item_hi, int blk0, int nblk) {
    const int tid = otid();
    float* st = (float*)smem;
    const bf16_t* F2 = (const bf16_t*)(p.ws + OFF_F2);
    const bf16_t* G1 = (const bf16_t*)(p.ws + OFF_G1);
    bf16_t* pcat = (bf16_t*)(p.ws + OFF_PCAT);
    const bf16_t* dbuf = (const bf16_t*)(p.ws + OFF_DBUF);
    const bf16_t* wp = (const bf16_t*)(p.ws + OFF_WPOOL) + (size_t)l * 65536;
    const bf16_t* parts = (const bf16_t*)(p.ws + OFF_PARTS);
    bf16_t* cat = (bf16_t*)(p.ws + OFF_H);
    const int nt2 = 2 * 128 * 2;
    const int nmt = (l == 0 ? ROWS : ROWS_L) / 128;
    (void)nmt;
    if ((int)blockIdx.x < blk0) return;
    for (int it = item_lo + ((int)blockIdx.x - blk0); it < item_hi; it += nblk) {
        f32x4 acc[4][4];
        if (it < nt2) {
            const int b = it >> 8, k1 = (it >> 1) & 127, nt = it & 1;
            gemm_core<true>(F2, 128, G1 + (size_t)(b * 128 + k1) * 128 * 256 + nt * 128, 256, 128, acc, smem);
            stage_acc(acc, st);
#pragma unroll 1
            for (int i = 0; i < 8; ++i) {
                const int q = tid + 256 * i, m = q >> 4, c8 = (q & 15) * 8;
                const int c = m >> 6, k2 = m & 63;
                float v[8];
                ld8(st + m * ST_LD + c8, v);
                *(uint4*)(pcat + (size_t)(b * SEQ + k1 + 128 * k2) * 512 + c * 256 + nt * 128 + c8) = pack8(v);
            }
        } else {
            const int j0 = it - nt2, tm = j0 >> 1, nt = j0 & 1;
            gemm_core_dma(dbuf + (size_t)tm * 128 * 256 + nt * 128, 256, wp + (size_t)(nt * 128) * 256 + nt * 128, 256, 128, acc, smem);
            stage_acc(acc, st);
            {
                const int c8 = (tid & 15) * 8, r0 = tid >> 4, n = nt * 128 + c8;
                float ps[8];
                ld8(p.pool_scale + l * 256 + n, ps);
                uint4 zr[8];
#pragma unroll
                for (int i = 0; i < 8; ++i) zr[i] = *(const uint4*)(parts + (size_t)(tm * 128 + r0 + 16 * i) * PW + PC_ZP + n);
#pragma unroll
                for (int i = 0; i < 8; ++i) {
                    float v[8], z[8];
                    ld8(st + (r0 + 16 * i) * ST_LD + c8, v);
                    unpack8(zr[i], z);
#pragma unroll
                    for (int e = 0; e < 8; ++e) v[e] = silu_f(z[e]) * ps[e] * v[e];
                    *(uint4*)(cat + (size_t)(tm * 128 + r0 + 16 * i) * DM + 768 + n) = pack8(v);
                }
            }
        }
    }
}

DI void phase_mixf(const Params& p, int l, bf16_t* smem) {
    const int tid = otid();
    float* st = (float*)smem;
    const bf16_t* pcat = (const bf16_t*)(p.ws + OFF_PCAT);
    const bf16_t* wc = (const bf16_t*)(p.ws + OFF_WCOMB) + (size_t)l * 131072;
    const bf16_t* parts = (const bf16_t*)(p.ws + OFF_PARTS);
    bf16_t* cat = (bf16_t*)(p.ws + OFF_H);
    const int nmt = (l == 0 ? ROWS : ROWS_L) / 128;
    for (int it = blockIdx.x; it < nmt * 2; it += gridDim.x) {
        const int tm = it >> 1, nt = it & 1;
        f32x4 acc[4][4];
        gemm_core_dma(pcat + (size_t)tm * 128 * 512, 512, wc + (size_t)(nt * 128) * 512, 512, 512, acc, smem);
        stage_acc(acc, st);
        const float sc = (tm < 128) ? 0.001381067932004976f : 0.0078125f;
        {
            const int c8 = (tid & 15) * 8, r0 = tid >> 4, n = nt * 128 + c8;
            uint4 zr[8];
#pragma unroll
            for (int i = 0; i < 8; ++i) zr[i] = *(const uint4*)(parts + (size_t)(tm * 128 + r0 + 16 * i) * PW + PC_ZF + n);
#pragma unroll
            for (int i = 0; i < 8; ++i) {
                float v[8], z[8];
                ld8(st + (r0 + 16 * i) * ST_LD + c8, v);
                unpack8(zr[i], z);
#pragma unroll
                for (int e = 0; e < 8; ++e) v[e] = silu_f(z[e]) * sc * v[e];
                *(uint4*)(cat + (size_t)(tm * 128 + r0 + 16 * i) * DM + n) = pack8(v);
            }
        }
    }
}

DI void phase_out(const Params& p, int l, const float* xl_in, const float* xc_in, float* xl_out, float* xc_out, bf16_t* smem) {
    const int tid = otid();
    float* st = (float*)smem;
    const bf16_t* cat = (const bf16_t*)(p.ws + OFF_H);
    const bf16_t* W = (const bf16_t*)(p.ws + OFF_WTOUT) + (size_t)l * DM * DM;
    const float* modv = (const float*)(p.ws + OFF_MODV) + (size_t)l * 3 * 3072;
    const int nmt = (l == 0 ? ROWS : ROWS_L) / 128;
    for (XIter t = xiter(nmt * 8); t.u < t.end; t.u += t.step) {
        int tm, tn;
        if (t.u < 1024) { const int ch = t.u >> 6, r = t.u & 63; tn = r >> 3; tm = ch * 8 + (r & 7); }
        else { const int j = t.u - 1024; tn = j >> 2; tm = 128 + (j & 3); }
        f32x4 acc[4][4];
        gemm_core_dma(cat + (size_t)tm * 128 * DM, DM, W + (size_t)tn * 128 * DM, DM, DM, acc, smem);
        stage_acc(acc, st);
        const int rb = tm * 128;
        const int v = (rb < ROWS_L) ? (rb >> 13) : 2;
        const float* gate = modv + v * 3072 + 2048;
        const float* xin = (rb < ROWS_L) ? xl_in : xc_in - (size_t)ROWS_L * DM;
        float* xout = (rb < ROWS_L) ? xl_out : xc_out - (size_t)ROWS_L * DM;
        {
            const int c8 = (tid & 15) * 8, r0 = tid >> 4;
            const size_t o0 = (size_t)(rb + r0) * DM + tn * 128 + c8;
            float gt[8];
            ld8(gate + tn * 128 + c8, gt);
            float4 x0[8], x1[8];
#pragma unroll
            for (int i = 0; i < 8; ++i) { x0[i] = *(const float4*)(xin + o0 + (size_t)i * 16 * DM); x1[i] = *(const float4*)(xin + o0 + (size_t)i * 16 * DM + 4); }
#pragma unroll
            for (int i = 0; i < 8; ++i) {
                float a[8];
                ld8(st + (r0 + 16 * i) * ST_LD + c8, a);
                float* d = xout + o0 + (size_t)i * 16 * DM;
                *(float4*)(d) = make_float4(x0[i].x + gt[0] * a[0], x0[i].y + gt[1] * a[1], x0[i].z + gt[2] * a[2], x0[i].w + gt[3] * a[3]);
                *(float4*)(d + 4) = make_float4(x1[i].x + gt[4] * a[4], x1[i].y + gt[5] * a[5], x1[i].z + gt[6] * a[6], x1[i].w + gt[7] * a[7]);
            }
        }
    }
}

#ifndef PH_MASK
#define PH_MASK 0xFFFF
#endif
#ifndef PH_DUP
#define PH_DUP 0
#endif
__global__ void __launch_bounds__(256, 2) fwd_megakernel(Params p) {
    __shared__ __attribute__((aligned(16))) unsigned char smem_raw[SMEM_BYTES];
    bf16_t* smem = (bf16_t*)smem_raw;
    float* smf = (float*)smem_raw;
    volatile LAS unsigned* stw = (volatile LAS unsigned*)(smem_raw + SMEM_MAIN);
    if (threadIdx.x == 0) { stw[0] = 0u; stw[1] = 0u; stw[2] = 0u; stw[3] = 0u; }
    __syncthreads();
    if (p.never) cg::this_grid().sync();
    XcdBarrier bar = xcd_barrier_post((unsigned*)(p.ws + OFF_BAR), stw);

    if (PH_MASK & 1) phase0(p, smf);
    if (PH_DUP & 1) phase0(p, smf);
    xcd_barrier(bar);
    float* xc1 = (float*)(p.ws + OFF_XC1);
    for (int l = 0; l < 2; ++l) {
        const float* xl_in = (l == 0) ? p.x : p.out;
        const float* xc_in = (l == 0) ? p.ctx : xc1;
        if (PH_MASK & 2) phase_norm(p, l, xl_in, xc_in);
        if (PH_DUP & 2) phase_norm(p, l, xl_in, xc_in);
        xcd_barrier(bar);
        if (PH_MASK & 4) phase_inproj(p, l, smem);
        if (PH_DUP & 4) phase_inproj(p, l, smem);
        xcd_barrier(bar);
        if (PH_MASK & 8) phase_attn(p, l, smem);
        if (PH_DUP & 8) phase_attn(p, l, smem);
        if (PH_MASK & 16) phase_convpool(p, l);
        if (PH_DUP & 16) phase_convpool(p, l);
        if (PH_MASK & 32) phase_dft1(p, l, smem);
        if (PH_DUP & 32) phase_dft1(p, l, smem);
        xcd_barrier(bar);
        if (PH_MASK & 64) phase_dft2_mixp(p, l, smem, 0, 512, 0, gridDim.x);
        xcd_barrier(bar);
        {
            const int nmix = (l == 0 ? ROWS : ROWS_L) / 64;
            const int b0 = ((int)gridDim.x > nmix) ? nmix : 0;
            if (PH_MASK & 128) phase_mixf(p, l, smem);
            if (PH_MASK & 64) phase_dft2_mixp(p, l, smem, 512, 512 + nmix, b0, (int)gridDim.x - b0);
        }
        xcd_barrier(bar);
        if (PH_MASK & 256) phase_out(p, l, xl_in, xc_in, p.out, xc1, smem);
        if (PH_DUP & 256) phase_out(p, l, xl_in, xc_in, (float*)(p.ws + OFF_G1), (float*)(p.ws + OFF_G1), smem);
        if (l == 0) xcd_barrier(bar);
    }
}

extern "C" void kernel_launch(void* const* d_in, const int* in_sizes, int n_in, void* d_out, int out_size, void* d_ws, size_t ws_size, hipStream_t stream) {
    static int grid_blocks = 0;
    if (!grid_blocks) {
        int dev = 0, cus = 0, per_cu = 0;
        hipGetDevice(&dev);
        hipDeviceGetAttribute(&cus, hipDeviceAttributeMultiprocessorCount, dev);
        hipOccupancyMaxActiveBlocksPerMultiprocessor(&per_cu, fwd_megakernel, 256, 0);
        if (per_cu > 2) per_cu = 2;
        if (per_cu < 1) per_cu = 1;
        grid_blocks = cus * per_cu;
        if (ws_size < WS_END) fprintf(stderr, "kernel_launch: workspace too small: %zu < %zu\n", ws_size, (size_t)WS_END);
    }
    hipMemsetAsync((char*)d_ws + OFF_BAR, 0, 16384, stream);
    Params p{};
    p.x = (const float*)d_in[0]; p.c = (const float*)d_in[1]; p.ctx = (const float*)d_in[2]; p.c_ctx = (const float*)d_in[3];
    p.w_mod = (const float*)d_in[4]; p.b_mod = (const float*)d_in[5]; p.norm_g = (const float*)d_in[6]; p.w_in = (const float*)d_in[7];
    p.q_gain = (const float*)d_in[8]; p.k_gain = (const float*)d_in[9]; p.w_fourier = (const float*)d_in[10]; p.conv_w = (const float*)d_in[11];
    p.conv_b = (const float*)d_in[12]; p.pool_w = (const float*)d_in[13]; p.pool_scale = (const float*)d_in[14]; p.w_out = (const float*)d_in[15];
    p.out = (float*)d_out; p.ws = (unsigned char*)d_ws; p.never = 0; p.pad = 0;
    void* args[] = {&p};
    hipError_t e = hipLaunchCooperativeKernel((void*)fwd_megakernel, dim3(grid_blocks), dim3(256), args, 0, stream);
    if (e != hipSuccess) fprintf(stderr, "cooperative launch failed: %s (grid %d)\n", hipGetErrorString(e), grid_blocks);
}
```

```cpp
#include <hip/hip_runtime.h>
#include <hip/hip_cooperative_groups.h>
#include <stdint.h>
#include <cstdio>
namespace cg = cooperative_groups;

typedef unsigned short bf16_t;
typedef __attribute__((ext_vector_type(8))) short bf16x8;
typedef __attribute__((ext_vector_type(4))) short bf16x4;
typedef __attribute__((ext_vector_type(4))) float f32x4;
typedef __attribute__((ext_vector_type(16))) float f32x16;
#define DI __device__ __forceinline__

#define SEQ 8192
#define CTX 256
#define DM 1024
#define DIN 2816
#define ROWS_L 16384
#define ROWS_C 512
#define ROWS 16896
#define NKEY 8448
#define PW 2304
#define PC_ZATT 0
#define PC_UF 256
#define PC_ZF 512
#define PC_BC 768
#define PC_CC 1024
#define PC_HC 1280
#define PC_ZC 1536
#define PC_UP 1792
#define PC_ZP 2048

constexpr size_t OFF_BAR = 0;
constexpr size_t OFF_MODV = 16384;
constexpr size_t OFF_ROPE = OFF_MODV + 2 * 3 * 3072 * 4;
constexpr size_t OFF_TW = OFF_ROPE + 6144 * 4;
constexpr size_t OFF_F1 = OFF_TW + 8192 * 2 * 4;
constexpr size_t OFF_F2 = OFF_F1 + 256 * 128 * 2;
constexpr size_t OFF_FC = OFF_F2 + 128 * 128 * 2;
constexpr size_t OFF_WCOMB = OFF_FC + 512 * 256 * 2;
constexpr size_t OFF_WPOOL = OFF_WCOMB + 2 * 256 * 512 * 2;
constexpr size_t OFF_WTIN = 2097152;
constexpr size_t OFF_WTOUT = OFF_WTIN + (size_t)2 * DIN * DM * 2;
constexpr size_t OFF_H = OFF_WTOUT + (size_t)2 * DM * DM * 2;
constexpr size_t OFF_PARTS = OFF_H + (size_t)ROWS * DM * 2;
constexpr size_t OFF_Q = OFF_PARTS + (size_t)ROWS * PW * 2;
constexpr size_t OFF_QC = OFF_Q + (size_t)2 * 4 * SEQ * 64 * 2;
constexpr size_t OFF_K = OFF_QC + (size_t)2 * 4 * CTX * 64 * 2;
constexpr size_t OFF_VT = OFF_K + (size_t)2 * 2 * NKEY * 64 * 2;
constexpr size_t OFF_DBUF = OFF_VT + (size_t)2 * 2 * NKEY * 64 * 2;
constexpr size_t OFF_G1 = OFF_DBUF + (size_t)ROWS * 256 * 2;
constexpr size_t OFF_PCAT = OFF_G1 + (size_t)2 * 128 * 2 * 64 * 256 * 2;
constexpr size_t OFF_XC1 = OFF_PCAT + (size_t)ROWS * 512 * 2;
constexpr size_t OFF_X1B = OFF_XC1 + (size_t)ROWS_C * DM * 4;
constexpr size_t WS_END = OFF_X1B + (size_t)ROWS_L * DM * 2;
static_assert(OFF_WPOOL + 2 * 256 * 256 * 2 <= OFF_WTIN, "ws map");

struct Params {
    const float *x, *c, *ctx, *c_ctx, *w_mod, *b_mod, *norm_g, *w_in, *q_gain, *k_gain, *w_fourier, *conv_w, *conv_b, *pool_w, *pool_scale, *w_out;
    float* out;
    unsigned char* ws;
    int never;
    int pad;
};

DI bf16_t f2bf(float x) { unsigned u = __float_as_uint(x); u += 0x7fffu + ((u >> 16) & 1u); return (bf16_t)(u >> 16); }
DI float bf2f(bf16_t h) { return __uint_as_float(((unsigned)h) << 16); }
typedef __attribute__((ext_vector_type(2))) float f32x2;
typedef __attribute__((ext_vector_type(2))) __bf16 bf16x2v;
DI unsigned pack2(float a, float b) { const f32x2 v = {a, b}; return __builtin_bit_cast(unsigned, __builtin_convertvector(v, bf16x2v)); }
struct XIter { int u, end, step; };
DI XIter xiter(int ntiles) {
    const int x = blockIdx.x & 7, j = blockIdx.x >> 3, nb = gridDim.x >> 3, per = (ntiles + 7) >> 3;
    XIter r; r.u = x * per + j; r.end = min((x + 1) * per, ntiles); r.step = nb; return r;
}
DI float silu_f(float z) { return z / (1.f + __expf(-z)); }
DI float bflo(unsigned w) { return __uint_as_float(w << 16); }
DI float bfhi(unsigned w) { return __uint_as_float(w & 0xffff0000u); }
DI int otid() { int t = threadIdx.x; asm volatile("" : "+v"(t)); return t; }

#define XB_TMO      128
#define XB_XCNT(j)  (256  + 64 * (j))
#define XB_XSUB(j)  (1280 + 64 * (j))
#define XB_XGEN(j)  (2304 + 64 * (j))
#define XB_TOP      3328
#define XB_TOPGEN   3392
#define XCD_BAR_WORDS 3456
#define XB_SPIN_CAP (1u << 20)
#define LAS __attribute__((address_space(3)))
DI unsigned xb_ld(unsigned* p) { return __hip_atomic_load(p, __ATOMIC_RELAXED, __HIP_MEMORY_SCOPE_AGENT); }
DI unsigned xb_add(unsigned* p, unsigned v) { return __hip_atomic_fetch_add(p, v, __ATOMIC_RELAXED, __HIP_MEMORY_SCOPE_AGENT); }
DI unsigned xb_xcc_id() { return (unsigned)__builtin_amdgcn_s_getreg((3 << 11) | 20) & 0xFu; }
#define XB_SPIN(cond, bar) do { unsigned _sp = 0; while (cond) { __builtin_amdgcn_s_sleep(1); \
    if ((++_sp & 255u) == 0u) { if (xb_ld(&(bar)[XB_TMO])) break; if (_sp > XB_SPIN_CAP) { atomicAdd(&(bar)[XB_TMO], 1u); break; } } } } while (0)
struct XcdBarrier { unsigned* bar; unsigned x; volatile LAS unsigned* st; };
DI XcdBarrier xcd_barrier_post(unsigned* bar, volatile LAS unsigned* st) {
    XcdBarrier b; b.bar = bar; b.x = xb_xcc_id(); b.st = st;
    if (threadIdx.x == 0) (void)xb_add(&bar[XB_XCNT(b.x)], 1u);
    return b;
}
DI void xcd_barrier_complete(unsigned* bar, unsigned x, unsigned& nloc, unsigned& nx) {
    const unsigned G = gridDim.x * gridDim.y * gridDim.z;
    unsigned sum, cnt, mine, sp = 0u;
    for (;;) {
        sum = 0u; cnt = 0u; mine = 0u;
#pragma unroll
        for (unsigned j = 0; j < 16; ++j) { const unsigned c = xb_ld(&bar[XB_XCNT(j)]); sum += c; cnt += (c > 0u) ? 1u : 0u; mine = (j == x) ? c : mine; }
        if (sum == G) break;
        __builtin_amdgcn_s_sleep(1);
        if ((++sp & 255u) == 0u) { if (xb_ld(&bar[XB_TMO])) break; if (sp > XB_SPIN_CAP) { atomicAdd(&bar[XB_TMO], 1u); break; } }
    }
    nloc = mine > 0u ? mine : 1u; nx = cnt > 0u ? cnt : 1u;
}
DI void xcd_barrier(const XcdBarrier& b) {
    asm volatile("s_waitcnt vmcnt(0)" ::: "memory");
    __syncthreads();
    if (threadIdx.x == 0) {
        unsigned* bar = b.bar;
        __builtin_amdgcn_s_waitcnt(0);
        unsigned nloc = b.st[0], nx = b.st[1];
        if (nloc == 0u) { xcd_barrier_complete(bar, b.x, nloc, nx); b.st[0] = nloc; b.st[1] = nx; }
        const unsigned old = xb_add(&bar[XB_XSUB(b.x)], 1u);
        const unsigned gen = old / nloc;
        if (old + 1u == (gen + 1u) * nloc) {
            __builtin_amdgcn_fence(__ATOMIC_RELEASE, "agent");
            asm volatile("s_waitcnt vmcnt(0)" ::: "memory");
            const unsigned og = xb_add(&bar[XB_TOP], 1u);
            const unsigned tg = og / nx;
            if (og + 1u == (tg + 1u) * nx) xb_add(&bar[XB_TOPGEN], 1u);
            else XB_SPIN(xb_ld(&bar[XB_TOPGEN]) == tg, bar);
            __builtin_amdgcn_fence(__ATOMIC_ACQUIRE, "agent");
            xb_add(&bar[XB_XGEN(b.x)], 1u);
            asm volatile("s_waitcnt vmcnt(0)" ::: "memory");
        } else {
            XB_SPIN(xb_ld(&bar[XB_XGEN(b.x)]) == gen, bar);
            __builtin_amdgcn_fence(__ATOMIC_ACQUIRE, "agent");
            asm volatile("s_waitcnt vmcnt(0)" ::: "memory");
        }
    }
    __syncthreads();
}

#define LROW 72
#define TILE_E (128 * LROW)
#define SMEM_MAIN (4 * TILE_E * 2)
#define SMEM_BYTES (SMEM_MAIN + 16)

typedef __attribute__((ext_vector_type(4))) unsigned u32x4;
struct Stg { u32x4 a0, a1, a2, a3, b0, b1, b2, b3; };
template <bool BN>
DI u32x4 g_ld_b(const bf16_t* __restrict__ B, int ldb, int kt, int q) {
    if (!BN) return *(const u32x4*)(B + (size_t)(q >> 3) * ldb + kt * 64 + (q & 7) * 8);
    else     return *(const u32x4*)(B + (size_t)(kt * 64 + (q >> 4)) * ldb + (q & 15) * 8);
}
template <bool BN>
DI void g_load(Stg& r, const bf16_t* __restrict__ A, int lda, const bf16_t* __restrict__ B, int ldb, int kt, int tid) {
    const bf16_t* ap = A + (size_t)(tid >> 3) * lda + kt * 64 + (tid & 7) * 8;
    r.a0 = *(const u32x4*)(ap);
    r.a1 = *(const u32x4*)(ap + (size_t)32 * lda);
    r.a2 = *(const u32x4*)(ap + (size_t)64 * lda);
    r.a3 = *(const u32x4*)(ap + (size_t)96 * lda);
    r.b0 = g_ld_b<BN>(B, ldb, kt, tid);
    r.b1 = g_ld_b<BN>(B, ldb, kt, tid + 256);
    r.b2 = g_ld_b<BN>(B, ldb, kt, tid + 512);
    r.b3 = g_ld_b<BN>(B, ldb, kt, tid + 768);
}
template <bool BN>
DI void s_st_b(bf16_t* b, const u32x4 v, int q) {
    if (!BN) *(u32x4*)(b + (q >> 3) * LROW + (q & 7) * 8) = v;
    else {
        const int kr0 = q >> 4, n0 = (q & 15) * 8, kr = ((((kr0 >> 3) ^ (q & 7)) << 3) | (kr0 & 7));
        b[(n0 + 0) * LROW + kr] = (bf16_t)(v.x & 0xffffu); b[(n0 + 1) * LROW + kr] = (bf16_t)(v.x >> 16);
        b[(n0 + 2) * LROW + kr] = (bf16_t)(v.y & 0xffffu); b[(n0 + 3) * LROW + kr] = (bf16_t)(v.y >> 16);
        b[(n0 + 4) * LROW + kr] = (bf16_t)(v.z & 0xffffu); b[(n0 + 5) * LROW + kr] = (bf16_t)(v.z >> 16);
        b[(n0 + 6) * LROW + kr] = (bf16_t)(v.w & 0xffffu); b[(n0 + 7) * LROW + kr] = (bf16_t)(v.w >> 16);
    }
}
template <bool BN>
DI void s_store(const Stg& r, bf16_t* smem, int buf, int tid) {
    bf16_t* a = smem + buf * 2 * TILE_E;
    bf16_t* b = a + TILE_E;
    bf16_t* ap = a + (tid >> 3) * LROW + (tid & 7) * 8;
    *(u32x4*)(ap) = r.a0;
    *(u32x4*)(ap + 32 * LROW) = r.a1;
    *(u32x4*)(ap + 64 * LROW) = r.a2;
    *(u32x4*)(ap + 96 * LROW) = r.a3;
    s_st_b<BN>(b, r.b0, tid);
    s_st_b<BN>(b, r.b1, tid + 256);
    s_st_b<BN>(b, r.b2, tid + 512);
    s_st_b<BN>(b, r.b3, tid + 768);
}
DI void mma_tile(const bf16_t* smem, int buf, f32x4 (&acc)[4][4], int wm, int wn, int lane) {
    const bf16_t* a = smem + buf * 2 * TILE_E;
    const bf16_t* b = a + TILE_E;
#pragma unroll
    for (int kk = 0; kk < 2; ++kk) {
        bf16x8 af[4], bfr[4];
#pragma unroll
        for (int mi = 0; mi < 4; ++mi) af[mi] = *(const bf16x8*)(a + (wm * 64 + mi * 16 + (lane & 15)) * LROW + kk * 32 + (lane >> 4) * 8);
#pragma unroll
        for (int ni = 0; ni < 4; ++ni) bfr[ni] = *(const bf16x8*)(b + (wn * 64 + ni * 16 + (lane & 15)) * LROW + (((kk * 4 + (lane >> 4)) ^ ((ni * 2 + ((lane >> 3) & 1)) & 7)) << 3));
#pragma unroll
        for (int mi = 0; mi < 4; ++mi)
#pragma unroll
            for (int ni = 0; ni < 4; ++ni) acc[mi][ni] = __builtin_amdgcn_mfma_f32_16x16x32_bf16(af[mi], bfr[ni], acc[mi][ni], 0, 0, 0);
    }
}
template <bool BN>
DI void gemm_core(const bf16_t* __restrict__ A, int lda, const bf16_t* __restrict__ B, int ldb, int K, f32x4 (&acc)[4][4], bf16_t* smem) {
    const int tid = otid(), lane = tid & 63, wave = tid >> 6;
    const int wm = wave >> 1, wn = wave & 1;
#pragma unroll
    for (int mi = 0; mi < 4; ++mi)
#pragma unroll
        for (int ni = 0; ni < 4; ++ni) acc[mi][ni] = (f32x4){0.f, 0.f, 0.f, 0.f};
    const int nk = K >> 6;
    Stg r0, r1;
    __syncthreads();
    g_load<BN>(r0, A, lda, B, ldb, 0, tid);
    g_load<BN>(r1, A, lda, B, ldb, 1, tid);
    s_store<BN>(r0, smem, 0, tid);
    __syncthreads();
    for (int kt = 0; kt < nk; kt += 2) {
        if (kt + 2 < nk) g_load<BN>(r0, A, lda, B, ldb, kt + 2, tid);
        mma_tile(smem, 0, acc, wm, wn, lane);
        s_store<BN>(r1, smem, 1, tid);
        __syncthreads();
        if (kt + 3 < nk) g_load<BN>(r1, A, lda, B, ldb, kt + 3, tid);
        mma_tile(smem, 1, acc, wm, wn, lane);
        if (kt + 2 < nk) s_store<BN>(r0, smem, 0, tid);
        __syncthreads();
    }
}
#define GT_E (128 * 64)
DI void glds_tile(const bf16_t* __restrict__ G, int ld, int kt, bf16_t* lt, int tid) {
    const int c = (tid & 7) ^ ((tid >> 4) & 7);
    const bf16_t* g = G + (size_t)(tid >> 3) * ld + kt * 64 + c * 8;
    char* l = (char*)lt + tid * 16;
#pragma unroll
    for (int p = 0; p < 4; ++p)
        __builtin_amdgcn_global_load_lds((const unsigned*)(g + (size_t)(p * 32) * ld), (LAS unsigned*)(l + p * 4096), 16, 0, 0);
}
DI void mma_tile_sw(const bf16_t* smem, int buf, f32x4 (&acc)[4][4], int wm, int wn, int lane) {
    const char* a = (const char*)(smem + buf * 2 * GT_E);
    const char* b = a + GT_E * 2;
    const int sw = (lane & 15) >> 1;
#pragma unroll
    for (int kk = 0; kk < 2; ++kk) {
        bf16x8 af[4], bfr[4];
        const int co = ((kk * 4 + (lane >> 4)) ^ sw) << 4;
#pragma unroll
        for (int mi = 0; mi < 4; ++mi) af[mi] = *(const bf16x8*)(a + (wm * 64 + mi * 16 + (lane & 15)) * 128 + co);
#pragma unroll
        for (int ni = 0; ni < 4; ++ni) bfr[ni] = *(const bf16x8*)(b + (wn * 64 + ni * 16 + (lane & 15)) * 128 + co);
#pragma unroll
        for (int mi = 0; mi < 4; ++mi)
#pragma unroll
            for (int ni = 0; ni < 4; ++ni) acc[mi][ni] = __builtin_amdgcn_mfma_f32_16x16x32_bf16(af[mi], bfr[ni], acc[mi][ni], 0, 0, 0);
    }
}
DI void gemm_core_dma(const bf16_t* __restrict__ A, int lda, const bf16_t* __restrict__ B, int ldb, int K, f32x4 (&acc)[4][4], bf16_t* smem) {
    const int tid = otid(), lane = tid & 63, wave = tid >> 6;
    const int wm = wave >> 1, wn = wave & 1;
#pragma unroll
    for (int mi = 0; mi < 4; ++mi)
#pragma unroll
        for (int ni = 0; ni < 4; ++ni) acc[mi][ni] = (f32x4){0.f, 0.f, 0.f, 0.f};
    const int nk = K >> 6;
    __syncthreads();
    glds_tile(A, lda, 0, smem, tid);
    glds_tile(B, ldb, 0, smem + GT_E, tid);
    for (int kt = 0; kt < nk; ++kt) {
        asm volatile("s_waitcnt vmcnt(0)" ::: "memory");
        __syncthreads();
        if (kt + 1 < nk) {
            bf16_t* nb = smem + ((kt + 1) & 1) * 2 * GT_E;
            glds_tile(A, lda, kt + 1, nb, tid);
            glds_tile(B, ldb, kt + 1, nb + GT_E, tid);
        }
        mma_tile_sw(smem, kt & 1, acc, wm, wn, lane);
    }
    __syncthreads();
}
#define ST_LD 132
DI void stage_acc(f32x4 (&acc)[4][4], float* st) {
    const int lane = otid() & 63, wave = otid() >> 6, wm = wave >> 1, wn = wave & 1, fl = lane & 15, g4 = lane >> 4;
#pragma unroll
    for (int mi = 0; mi < 4; ++mi)
#pragma unroll
        for (int ni = 0; ni < 4; ++ni)
#pragma unroll
            for (int j = 0; j < 4; ++j) st[(wm * 64 + mi * 16 + g4 * 4 + j) * ST_LD + wn * 64 + ni * 16 + fl] = acc[mi][ni][j];
    __syncthreads();
}
DI void ld8(const float* q, float (&v)[8]) {
    const float4 a = *(const float4*)q, b = *(const float4*)(q + 4);
    v[0] = a.x; v[1] = a.y; v[2] = a.z; v[3] = a.w; v[4] = b.x; v[5] = b.y; v[6] = b.z; v[7] = b.w;
}
DI uint4 pack8(const float (&v)[8]) { return make_uint4(pack2(v[0], v[1]), pack2(v[2], v[3]), pack2(v[4], v[5]), pack2(v[6], v[7])); }
DI void unpack8(const uint4 u, float (&v)[8]) {
    v[0] = bflo(u.x); v[1] = bfhi(u.x); v[2] = bflo(u.y); v[3] = bfhi(u.y); v[4] = bflo(u.z); v[5] = bfhi(u.z); v[6] = bflo(u.w); v[7] = bfhi(u.w);
}

DI void phase0(const Params& p, float* smf) {
    const int tid = otid();
    unsigned char* ws = p.ws;
    float* modv = (float*)(ws + OFF_MODV);
    for (int it = blockIdx.x; it < 192; it += gridDim.x) {
        const int l = it / 96, n0 = (it % 96) * 32;
        __syncthreads();
        for (int i = tid; i < 3072; i += 256) {
            const int v = i >> 10, k = i & 1023;
            const float cv = (v == 0) ? p.c[k] : (v == 1) ? p.c[1024 + k] : p.c_ctx[k];
            smf[i] = silu_f(cv);
        }
        __syncthreads();
        const int col = tid & 31, kg = tid >> 5;
        float a0 = 0.f, a1 = 0.f, a2 = 0.f;
        const float* w = p.w_mod + (size_t)l * 1024 * 3072 + n0 + col;
#pragma unroll 16
        for (int kk = 0; kk < 128; ++kk) {
            const int k = kg * 128 + kk;
            const float wv = w[(size_t)k * 3072];
            a0 += smf[k] * wv; a1 += smf[1024 + k] * wv; a2 += smf[2048 + k] * wv;
        }
        __syncthreads();
        smf[3072 + (kg * 3 + 0) * 32 + col] = a0; smf[3072 + (kg * 3 + 1) * 32 + col] = a1; smf[3072 + (kg * 3 + 2) * 32 + col] = a2;
        __syncthreads();
        if (tid < 96) {
            const int v = tid >> 5, cc = tid & 31;
            float s = 0.f;
            for (int g = 0; g < 8; ++g) s += smf[3072 + (g * 3 + v) * 32 + cc];
            modv[(l * 3 + v) * 3072 + n0 + cc] = s + p.b_mod[l * 3072 + n0 + cc];
        }
    }
    {
        const int n_in = 2 * 16 * 44, n_out = 2 * 16 * 16;
        for (int it = blockIdx.x; it < n_in + n_out; it += gridDim.x) {
            const float* src; bf16_t* dst; int N, kt, nt;
            if (it < n_in) { const int l = it / 704, r = it % 704; kt = r / 44; nt = r % 44; N = DIN; src = p.w_in + (size_t)l * DM * DIN; dst = (bf16_t*)(ws + OFF_WTIN) + (size_t)l * DIN * DM; }
            else { const int j = it - n_in; const int l = j / 256, r = j % 256; kt = r / 16; nt = r % 16; N = DM; src = p.w_out + (size_t)l * DM * DM; dst = (bf16_t*)(ws + OFF_WTOUT) + (size_t)l * DM * DM; }
            __syncthreads();
#pragma unroll
            for (int ps = 0; ps < 4; ++ps) {
                const int kr = ps * 16 + (tid >> 4), c4 = (tid & 15) * 4;
                const float4 v = *(const float4*)(src + (size_t)(kt * 64 + kr) * N + nt * 64 + c4);
                smf[kr * 65 + c4 + 0] = v.x; smf[kr * 65 + c4 + 1] = v.y; smf[kr * 65 + c4 + 2] = v.z; smf[kr * 65 + c4 + 3] = v.w;
            }
            __syncthreads();
            const int n = tid >> 2, ks = (tid & 3) * 16;
            unsigned w[8];
#pragma unroll
            for (int e = 0; e < 8; ++e) w[e] = pack2(smf[(ks + 2 * e) * 65 + n], smf[(ks + 2 * e + 1) * 65 + n]);
            bf16_t* d = dst + (size_t)(nt * 64 + n) * DM + kt * 64 + ks;
            *(uint4*)d = make_uint4(w[0], w[1], w[2], w[3]);
            *(uint4*)(d + 8) = make_uint4(w[4], w[5], w[6], w[7]);
        }
    }
    const int gtid = blockIdx.x * 256 + tid, gsz = gridDim.x * 256;
    {
        bf16_t* wc = (bf16_t*)(ws + OFF_WCOMB);
        __syncthreads();
        if (tid < 64) { smf[tid] = cospif((float)tid * (1.f / 32.f)); smf[64 + tid] = sinpif((float)tid * (1.f / 32.f)); }
        __syncthreads();
        for (int i = gtid; i < 2 * 512 * 256; i += gsz) {
            const int n = i & 255, kk = (i >> 8) & 511, l = i >> 17;
            const int c = kk >> 8, head = (kk >> 6) & 3, ch = kk & 63;
            const float* wf = p.w_fourier + (size_t)l * 65536 + (size_t)(head * 64) * 256 + n;
            float s = 0.f;
#pragma unroll 16
            for (int j = 0; j < 64; ++j) s += smf[c * 64 + ((j * ch) & 63)] * wf[j * 256];
            wc[(size_t)l * 131072 + n * 512 + kk] = f2bf(s);
        }
    }
    {
        bf16_t* wp = (bf16_t*)(ws + OFF_WPOOL);
        for (int i = gtid; i < 2 * 256 * 256; i += gsz) {
            const int k = i & 255, n = (i >> 8) & 255, l = i >> 16;
            float v = 0.f;
            if ((k >> 6) == (n >> 6)) v = p.pool_w[(size_t)l * 16384 + (n >> 6) * 4096 + (k & 63) * 64 + (n & 63)];
            wp[i] = f2bf(v);
        }
    }
    {
        float* tw = (float*)(ws + OFF_TW);
        for (int i = gtid; i < 8192; i += gsz) { const float a = (float)i * (1.f / 4096.f); tw[2 * i] = cospif(a); tw[2 * i + 1] = sinpif(a); }
        bf16_t* f1 = (bf16_t*)(ws + OFF_F1);
        for (int i = gtid; i < 256 * 128; i += gsz) {
            const int t1 = i & 127, m = i >> 7;
            const int k1 = (m >> 5) * 16 + (m & 15), c = (m >> 4) & 1;
            const float a = (float)((k1 * t1) & 127) * (1.f / 64.f);
            f1[i] = f2bf(c ? -sinpif(a) : cospif(a));
        }
        bf16_t* f2 = (bf16_t*)(ws + OFF_F2);
        for (int i = gtid; i < 128 * 128; i += gsz) {
            const int kx = i & 127, m = i >> 7;
            const int c = m >> 6, k2 = m & 63, cp = kx >> 6, t2 = kx & 63;
            const float a = (float)((k2 * t2) & 63) * (1.f / 32.f);
            float v;
            if (c == cp) v = cospif(a); else if (c == 0) v = sinpif(a); else v = -sinpif(a);
            f2[i] = f2bf(v);
        }
        bf16_t* fc = (bf16_t*)(ws + OFF_FC);
        for (int i = gtid; i < 512 * 256; i += gsz) {
            const int t = i & 255, m = i >> 8;
            const int c = m >> 8, k = m & 255;
            const float a = (float)((k * t) & 255) * (1.f / 128.f);
            fc[i] = f2bf(c ? -sinpif(a) : cospif(a));
        }
        float* rp = (float*)(ws + OFF_ROPE);
        for (int i = gtid; i < 3072; i += gsz) {
            const int f = i & 15;
            const int pos = (i < 2048) ? (i >> 4) : ((i - 2048) >> 4);
            const float inv = powf(10000.f, -(float)f * (1.f / 16.f));
            const float ang = (float)pos * inv;
            const double ad = (double)ang;
            const float cs = (float)cos(ad), sn = (float)sin(ad);
            if (i < 2048) { rp[i] = cs; rp[2048 + i] = sn; }
            else { rp[4096 + (i - 2048)] = cs; rp[5120 + (i - 2048)] = sn; }
        }
    }
}

DI void phase_norm(const Params& p, int l, const float* xl, const float* xc, const bf16_t* xlb) {
    const int lane = otid() & 63, wave = otid() >> 6;
    const float* modv = (const float*)(p.ws + OFF_MODV) + (size_t)l * 3 * 3072;
    const float* g = p.norm_g + l * 1024;
    bf16_t* H = (bf16_t*)(p.ws + OFF_H);
    for (int row = blockIdx.x * 4 + wave; row < ROWS; row += gridDim.x * 4) {
        const float* src = (row < ROWS_L) ? xl + (size_t)row * DM : xc + (size_t)(row - ROWS_L) * DM;
        const int v = (row < ROWS_L) ? (row >> 13) : 2;
        const float* mv = modv + v * 3072;
        float4 a[4];
        float ss = 0.f;
        if (xlb != nullptr && row < ROWS_L) {
            const bf16_t* sb = xlb + (size_t)row * DM;
#pragma unroll
            for (int i = 0; i < 4; ++i) { const uint2 u = *(const uint2*)(sb + i * 256 + lane * 4); a[i] = make_float4(bflo(u.x), bfhi(u.x), bflo(u.y), bfhi(u.y)); }
        } else {
#pragma unroll
            for (int i = 0; i < 4; ++i) a[i] = *(const float4*)(src + i * 256 + lane * 4);
        }
#pragma unroll
        for (int i = 0; i < 4; ++i) ss += a[i].x * a[i].x + a[i].y * a[i].y + a[i].z * a[i].z + a[i].w * a[i].w;
#pragma unroll
        for (int o = 32; o >= 1; o >>= 1) ss += __shfl_xor(ss, o);
        const float rs = rsqrtf(ss * (1.f / 1024.f) + 1e-6f);
#pragma unroll
        for (int i = 0; i < 4; ++i) {
            const int c0 = i * 256 + lane * 4;
            const float4 gg = *(const float4*)(g + c0), sh = *(const float4*)(mv + c0), sc = *(const float4*)(mv + 1024 + c0);
            const float o0 = a[i].x * rs * gg.x * (1.f + sc.x) + sh.x, o1 = a[i].y * rs * gg.y * (1.f + sc.y) + sh.y;
            const float o2 = a[i].z * rs * gg.z * (1.f + sc.z) + sh.z, o3 = a[i].w * rs * gg.w * (1.f + sc.w) + sh.w;
            *(uint2*)(H + (size_t)row * DM + c0) = make_uint2(pack2(o0, o1), pack2(o2, o3));
        }
    }
}

DI void epi_inproj(const Params& p, int l, int tm, int tn, f32x4 (&acc)[4][4], float* st) {
    const int tid = otid();
    unsigned char* ws = p.ws;
    stage_acc(acc, st);
    const int rbase = tm * 128;
    const bool isctx = rbase >= ROWS_L;
    if (tn < 3) {
        const bool isq = tn < 2;
        const float* gain = (isq ? p.q_gain : p.k_gain) + l * 64;
        const float* rp = (const float*)(ws + OFF_ROPE);
#pragma unroll 1
        for (int i = 0; i < 8; ++i) {
            const int q = tid + 256 * i, rl = q >> 4, c8 = (q & 15) * 8;
            const int row = rbase + rl, hd = c8 >> 6, d0 = c8 & 63;
            float v[8], pv[8], g[8], pg[8];
            ld8(st + rl * ST_LD + c8, v);
            ld8(st + rl * ST_LD + (c8 ^ 16), pv);
            ld8(gain + d0, g);
            ld8(gain + (d0 ^ 16), pg);
            float ss = 0.f;
#pragma unroll
            for (int e = 0; e < 8; ++e) ss += v[e] * v[e];
            ss += __shfl_xor(ss, 1); ss += __shfl_xor(ss, 2); ss += __shfl_xor(ss, 4);
            const float rs = rsqrtf(ss * (1.f / 64.f) + 1e-6f);
#pragma unroll
            for (int e = 0; e < 8; ++e) { v[e] *= rs * g[e]; pv[e] *= rs * pg[e]; }
            bf16_t* dst;
            if (!isctx) {
                const int b = row >> 13, t = row & 8191;
                const int pos = (d0 >= 32) ? (t & 63) : (t >> 6);
                const float* ct = rp + ((d0 >= 32) ? 4096 : 0) + pos * 16 + (d0 & 8);
                float cs[8], sn[8];
                ld8(ct, cs);
                ld8(ct + ((d0 >= 32) ? 1024 : 2048), sn);
                const float sg = (d0 & 16) ? 1.f : -1.f;
#pragma unroll
                for (int e = 0; e < 8; ++e) v[e] = v[e] * cs[e] + sg * pv[e] * sn[e];
                if (isq) dst = (bf16_t*)(ws + OFF_Q) + ((size_t)(b * 4 + tn * 2 + hd) * SEQ + t) * 64 + d0;
                else     dst = (bf16_t*)(ws + OFF_K) + ((size_t)(b * 2 + hd) * NKEY + CTX + t) * 64 + d0;
            } else {
                const int rc = row - ROWS_L, b = rc >> 8, t = rc & 255;
                if (isq) dst = (bf16_t*)(ws + OFF_QC) + ((size_t)(b * 4 + tn * 2 + hd) * CTX + t) * 64 + d0;
                else     dst = (bf16_t*)(ws + OFF_K) + ((size_t)(b * 2 + hd) * NKEY + t) * 64 + d0;
            }
            if (isq) {
#pragma unroll
                for (int e = 0; e < 8; ++e) v[e] *= 0.18033688011112042f;
            }
            *(uint4*)dst = pack8(v);
        }
    } else if (tn == 3) {
        int b, key0;
        if (!isctx) { b = rbase >> 13; key0 = CTX + (rbase & 8191); } else { const int rc = rbase - ROWS_L; b = rc >> 8; key0 = rc & 255; }
#pragma unroll 1
        for (int i = 0; i < 8; ++i) {
            const int q = tid + 256 * i, col = q & 127, r8 = (q >> 7) * 8;
            float v[8];
#pragma unroll
            for (int e = 0; e < 8; ++e) v[e] = st[(r8 + e) * ST_LD + col];
            bf16_t* vt = (bf16_t*)(ws + OFF_VT) + ((size_t)(b * 2 + (col >> 6)) * 64 + (col & 63)) * NKEY + key0 + r8;
            *(uint4*)vt = pack8(v);
        }
    } else {
        bf16_t* parts = (bf16_t*)(ws + OFF_PARTS);
#pragma unroll 1
        for (int i = 0; i < 8; ++i) {
            const int q = tid + 256 * i, rl = q >> 4, c8 = (q & 15) * 8;
            float v[8];
            ld8(st + rl * ST_LD + c8, v);
            *(uint4*)(parts + (size_t)(rbase + rl) * PW + tn * 128 - 512 + c8) = pack8(v);
        }
    }
}

DI void phase_inproj(const Params& p, int l, bf16_t* smem) {
    const bf16_t* H = (const bf16_t*)(p.ws + OFF_H);
    const bf16_t* W = (const bf16_t*)(p.ws + OFF_WTIN) + (size_t)l * DIN * DM;
    const int nlat = 128 * 22;
    const int ntiles = nlat + (l == 0 ? 4 * 22 : 4 * 2);
    for (XIter t = xiter(ntiles); t.u < t.end; t.u += t.step) {
        const int u = t.u;
        int tm, tn;
        if (u < nlat) { const int ch = u / 176, r = u % 176; tn = r >> 3; tm = ch * 8 + (r & 7); }
        else { const int j = u - nlat; tm = 128 + (j & 3); tn = (l == 0 ? 0 : 2) + (j >> 2); }
        f32x4 acc[4][4];
        gemm_core_dma(H + (size_t)tm * 128 * DM, DM, W + (size_t)tn * 128 * DM, DM, DM, acc, smem);
        epi_inproj(p, l, tm, tn, acc, (float*)smem);
    }
}

#define KT_E (64 * LROW)
DI void attn_item(const Params& p, const bf16_t* Qb, const bf16_t* Kb, const bf16_t* VTb, int ntiles, int rowbase, int hq, bf16_t* smem) {
    const int tid = otid(), lane = tid & 63, wave = tid >> 6;
    const int r = lane & 31, h = lane >> 5;
    const float LOG2E = 1.4426950408889634f;
    bf16x8 qf[4];
    {
        const bf16_t* qrow = Qb + (size_t)(wave * 32 + r) * 64;
#pragma unroll
        for (int s = 0; s < 4; ++s) qf[s] = *(const bf16x8*)(qrow + s * 16 + h * 8);
    }
    f32x16 ot[2], minit;
#pragma unroll
    for (int i = 0; i < 16; ++i) { ot[0][i] = 0.f; ot[1][i] = 0.f; minit[i] = 0.f; }
    float m = 0.f, lsum = 0.f;
    uint4 rk[2], rv[2];
    auto gload = [&](int kt) {
#pragma unroll
        for (int i = 0; i < 2; ++i) {
            const int q = tid + 256 * i;
            rk[i] = *(const uint4*)(Kb + (size_t)(kt * 64 + (q >> 3)) * 64 + (q & 7) * 8);
            rv[i] = *(const uint4*)(VTb + (size_t)(q >> 3) * NKEY + kt * 64 + (q & 7) * 8);
        }
    };
    auto sstore = [&](int buf) {
        bf16_t* sk = smem + buf * 2 * KT_E;
        bf16_t* sv = sk + KT_E;
#pragma unroll
        for (int i = 0; i < 2; ++i) {
            const int q = tid + 256 * i;
            *(uint4*)(sk + (q >> 3) * LROW + (q & 7) * 8) = rk[i];
            *(uint4*)(sv + (q >> 3) * LROW + (q & 7) * 8) = rv[i];
        }
    };
    __syncthreads();
    gload(0);
    sstore(0);
    __syncthreads();
    for (int kt = 0; kt < ntiles; ++kt) {
        if (kt + 1 < ntiles) gload(kt + 1);
        const bf16_t* sk = smem + (kt & 1) * 2 * KT_E;
        const bf16_t* sv = sk + KT_E;
        f32x16 st[2], pe[2];
#pragma unroll
        for (int blk = 0; blk < 2; ++blk) {
            st[blk] = __builtin_amdgcn_mfma_f32_32x32x16_bf16(*(const bf16x8*)(sk + (blk * 32 + r) * LROW + h * 8), qf[0], minit, 0, 0, 0);
#pragma unroll
            for (int s = 1; s < 4; ++s)
                st[blk] = __builtin_amdgcn_mfma_f32_32x32x16_bf16(*(const bf16x8*)(sk + (blk * 32 + r) * LROW + s * 16 + h * 8), qf[s], st[blk], 0, 0, 0);
        }
        float ls = 0.f;
#pragma unroll
        for (int i = 0; i < 16; ++i) {
            pe[0][i] = __builtin_amdgcn_exp2f(st[0][i]); ls += pe[0][i];
            pe[1][i] = __builtin_amdgcn_exp2f(st[1][i]); ls += pe[1][i];
        }
        if (kt == 0 || __any(!(ls <= 256.f))) {
            float tmx = st[0][0];
#pragma unroll
            for (int i = 0; i < 16; ++i) { tmx = fmaxf(tmx, st[0][i]); tmx = fmaxf(tmx, st[1][i]); }
            tmx = fmaxf(tmx, __shfl_xor(tmx, 32));
            const float delta = (kt == 0) ? tmx : fmaxf(tmx, 0.f);
            const float alpha = (kt == 0) ? 1.f : __builtin_amdgcn_exp2f(-delta);
            m += delta;
            lsum *= alpha;
            ls = 0.f;
#pragma unroll
            for (int i = 0; i < 16; ++i) {
                ot[0][i] *= alpha; ot[1][i] *= alpha; minit[i] = -m;
                pe[0][i] = __builtin_amdgcn_exp2f(st[0][i] - delta); ls += pe[0][i];
                pe[1][i] = __builtin_amdgcn_exp2f(st[1][i] - delta); ls += pe[1][i];
            }
        }
        lsum += ls;
        bf16x8 pk[2][2];
#pragma unroll
        for (int blk = 0; blk < 2; ++blk)
#pragma unroll
            for (int s = 0; s < 2; ++s) {
                uint4 u;
                u.x = pack2(pe[blk][8 * s + 0], pe[blk][8 * s + 1]); u.y = pack2(pe[blk][8 * s + 2], pe[blk][8 * s + 3]);
                u.z = pack2(pe[blk][8 * s + 4], pe[blk][8 * s + 5]); u.w = pack2(pe[blk][8 * s + 6], pe[blk][8 * s + 7]);
                pk[blk][s] = __builtin_bit_cast(bf16x8, u);
            }
#pragma unroll
        for (int db = 0; db < 2; ++db)
#pragma unroll
            for (int blk = 0; blk < 2; ++blk)
#pragma unroll
                for (int s = 0; s < 2; ++s) {
                    const bf16_t* vp = sv + (db * 32 + r) * LROW + blk * 32 + s * 16 + h * 4;
                    const bf16x4 lo = *(const bf16x4*)vp;
                    const bf16x4 hi = *(const bf16x4*)(vp + 8);
                    const bf16x8 vf = __builtin_shufflevector(lo, hi, 0, 1, 2, 3, 4, 5, 6, 7);
                    ot[db] = __builtin_amdgcn_mfma_f32_32x32x16_bf16(vf, pk[blk][s], ot[db], 0, 0, 0);
                }
        if (kt + 1 < ntiles) sstore((kt + 1) & 1);
        __syncthreads();
    }
    lsum += __shfl_xor(lsum, 32);
    const float inv = 1.f / lsum;
    const int row = rowbase + wave * 32 + r;
    const bf16_t* zrow = (const bf16_t*)(p.ws + OFF_PARTS) + (size_t)row * PW + PC_ZATT + hq * 64;
    bf16_t* orow = (bf16_t*)(p.ws + OFF_H) + (size_t)row * DM + 256 + hq * 64;
#pragma unroll
    for (int db = 0; db < 2; ++db)
#pragma unroll
        for (int g = 0; g < 4; ++g) {
            const int d = db * 32 + g * 8 + h * 4;
            const uint2 z = *(const uint2*)(zrow + d);
            const float o0 = silu_f(bflo(z.x)) * ot[db][4 * g + 0] * inv, o1 = silu_f(bfhi(z.x)) * ot[db][4 * g + 1] * inv;
            const float o2 = silu_f(bflo(z.y)) * ot[db][4 * g + 2] * inv, o3 = silu_f(bfhi(z.y)) * ot[db][4 * g + 3] * inv;
            *(uint2*)(orow + d) = make_uint2(pack2(o0, o1), pack2(o2, o3));
        }
}

DI void phase_attn(const Params& p, int l, bf16_t* smem) {
    const bf16_t* Q = (const bf16_t*)(p.ws + OFF_Q);
    const bf16_t* QC = (const bf16_t*)(p.ws + OFF_QC);
    const bf16_t* Kk = (const bf16_t*)(p.ws + OFF_K);
    const bf16_t* VT = (const bf16_t*)(p.ws + OFF_VT);
    for (XIter t = xiter(512); t.u < t.end; t.u += t.step) {
        const int it = t.u;
        const int b = it >> 8, hq = (it >> 6) & 3, qt = it & 63;
        const size_t kv = (size_t)(b * 2 + (hq >> 1));
        attn_item(p, Q + ((size_t)(b * 4 + hq) * SEQ + qt * 128) * 64, Kk + kv * NKEY * 64, VT + kv * 64 * NKEY, NKEY / 64, b * SEQ + qt * 128, hq, smem);
    }
    if (l == 0) {
        for (int j = blockIdx.x; j < 16; j += gridDim.x) {
            const int b = j >> 3, hq = (j >> 1) & 3, qt = j & 1;
            const size_t kv = (size_t)(b * 2 + (hq >> 1));
            attn_item(p, QC + ((size_t)(b * 4 + hq) * CTX + qt * 128) * 64, Kk + kv * NKEY * 64, VT + kv * 64 * NKEY, CTX / 64, ROWS_L + b * CTX + qt * 128, hq, smem);
        }
    }
}

template <int W>
DI void pool_task(const bf16_t* __restrict__ pu, int pos, int n, bf16_t* __restrict__ dst) {
    constexpr int LEFT = W / 2;
    uint4 raw[W];
#pragma unroll
    for (int t = 0; t < W; ++t) { int q = pos - LEFT + t; q = q < 0 ? 0 : (q >= n ? n - 1 : q); raw[t] = *(const uint4*)(pu + (size_t)q * PW); }
    float sum[8], u[8];
#pragma unroll
    for (int e = 0; e < 8; ++e) sum[e] = 0.f;
#pragma unroll
    for (int t = 0; t < W; ++t) {
        const int q = pos - LEFT + t;
        const float mk = (q >= 0 && q < n) ? 1.f : 0.f;
        unpack8(raw[t], u);
#pragma unroll
        for (int e = 0; e < 8; ++e) sum[e] += mk * u[e];
    }
    const int lo = max(pos - LEFT, 0), hi = min(pos + W - LEFT, n);
    const float ic = 1.f / (float)(hi - lo);
    unpack8(raw[LEFT], u);
#pragma unroll
    for (int e = 0; e < 8; ++e) sum[e] = sum[e] * ic - u[e];
    *(uint4*)dst = pack8(sum);
}
DI void phase_convpool(const Params& p, int l) {
    const bf16_t* __restrict__ parts = (const bf16_t*)(p.ws + OFF_PARTS);
    bf16_t* __restrict__ cat = (bf16_t*)(p.ws + OFF_H);
    bf16_t* __restrict__ dbuf = (bf16_t*)(p.ws + OFF_DBUF);
    const int nrows = (l == 0 ? ROWS : ROWS_L);
    const int gsz = gridDim.x * 256, gt = blockIdx.x * 256 + otid();
    {
        const int c8 = (gt & 31) * 8;
        float w0[8], w1[8], w2[8], bs[8];
        ld8(p.conv_w + l * 768 + c8, w0); ld8(p.conv_w + l * 768 + 256 + c8, w1); ld8(p.conv_w + l * 768 + 512 + c8, w2); ld8(p.conv_b + l * 256 + c8, bs);
        for (int i = gt; i < nrows * 32; i += gsz) {
            const int row = i >> 5;
            int seq0, n;
            if (row < ROWS_L) { seq0 = (row >> 13) << 13; n = SEQ; } else { seq0 = ROWS_L + (((row - ROWS_L) >> 8) << 8); n = CTX; }
            const int pos = row - seq0;
            const bf16_t* pr = parts + (size_t)row * PW + c8;
            const bool hp = pos > 0, hn = pos + 1 < n;
            const bf16_t* pp = hp ? pr - PW : pr;
            const bf16_t* pn = hn ? pr + PW : pr;
            const uint4 r0 = *(const uint4*)(pr + PC_CC), r1 = *(const uint4*)(pr + PC_HC), r2 = *(const uint4*)(pp + PC_CC), r3 = *(const uint4*)(pp + PC_HC);
            const uint4 r4 = *(const uint4*)(pn + PC_CC), r5 = *(const uint4*)(pn + PC_HC), r6 = *(const uint4*)(pr + PC_BC), r7 = *(const uint4*)(pr + PC_ZC);
            const float mp = hp ? 1.f : 0.f, mn = hn ? 1.f : 0.f;
            float a[8], b[8], tc[8], tp[8], tn[8], o[8];
            unpack8(r0, a); unpack8(r1, b);
#pragma unroll
            for (int e = 0; e < 8; ++e) tc[e] = a[e] * b[e];
            unpack8(r2, a); unpack8(r3, b);
#pragma unroll
            for (int e = 0; e < 8; ++e) tp[e] = a[e] * b[e] * mp;
            unpack8(r4, a); unpack8(r5, b);
#pragma unroll
            for (int e = 0; e < 8; ++e) tn[e] = a[e] * b[e] * mn;
            unpack8(r6, a); unpack8(r7, b);
#pragma unroll
            for (int e = 0; e < 8; ++e) o[e] = silu_f(b[e]) * (a[e] * (tp[e] * w0[e] + tc[e] * w1[e] + tn[e] * w2[e] + bs[e]));
            *(uint4*)(cat + (size_t)row * DM + 512 + c8) = pack8(o);
        }
    }
    for (int j = gt; j < nrows * 32; j += gsz) {
        const int g = j / (nrows * 8), rem = j - g * (nrows * 8), row = rem >> 3, c8 = g * 64 + (rem & 7) * 8;
        int seq0, n;
        if (row < ROWS_L) { seq0 = (row >> 13) << 13; n = SEQ; } else { seq0 = ROWS_L + (((row - ROWS_L) >> 8) << 8); n = CTX; }
        const bf16_t* pu = parts + (size_t)seq0 * PW + PC_UP + c8;
        bf16_t* dst = dbuf + (size_t)row * 256 + c8;
        const int pos = row - seq0;
        if (g == 0) pool_task<2>(pu, pos, n, dst);
        else if (g == 1) pool_task<4>(pu, pos, n, dst);
        else if (g == 2) pool_task<8>(pu, pos, n, dst);
        else pool_task<16>(pu, pos, n, dst);
    }
}

DI void phase_dft1(const Params& p, int l, bf16_t* smem) {
    const int tid = otid();
    float* st = (float*)smem;
    const bf16_t* parts = (const bf16_t*)(p.ws + OFF_PARTS);
    const bf16_t* F1 = (const bf16_t*)(p.ws + OFF_F1);
    const bf16_t* FC = (const bf16_t*)(p.ws + OFF_FC);
    const float* tw = (const float*)(p.ws + OFF_TW);
    bf16_t* G1 = (bf16_t*)(p.ws + OFF_G1);
    bf16_t* pcat = (bf16_t*)(p.ws + OFF_PCAT);
    const int nt1 = 2 * 64 * 4;
    const int ntot = nt1 + (l == 0 ? 16 : 0);
    for (int it = blockIdx.x; it < ntot; it += gridDim.x) {
        f32x4 acc[4][4];
        if (it < nt1) {
            const int b = it >> 8, t2 = (it >> 2) & 63, mt = (it >> 1) & 1, nt = it & 1;
            gemm_core<true>(F1 + (size_t)mt * 128 * 128, 128, parts + (size_t)(b * SEQ + t2) * PW + PC_UF + nt * 128, 64 * PW, 128, acc, smem);
            stage_acc(acc, st);
#pragma unroll 1
            for (int i = 0; i < 4; ++i) {
                const int q = tid + 256 * i, kk = q >> 4, c8 = (q & 15) * 8;
                const int rr = 32 * (kk >> 4) + (kk & 15);
                const int k1 = mt * 64 + kk;
                const float cs = tw[2 * (k1 * t2)], sn = tw[2 * (k1 * t2) + 1];
                float gr[8], gi[8], o[8];
                ld8(st + rr * ST_LD + c8, gr);
                ld8(st + (rr + 16) * ST_LD + c8, gi);
                bf16_t* dr = G1 + ((size_t)((b * 128 + k1) * 2 + 0) * 64 + t2) * 256 + nt * 128 + c8;
#pragma unroll
                for (int e = 0; e < 8; ++e) o[e] = gr[e] * cs + gi[e] * sn;
                *(uint4*)dr = pack8(o);
#pragma unroll
                for (int e = 0; e < 8; ++e) o[e] = gi[e] * cs - gr[e] * sn;
                *(uint4*)(dr + (size_t)64 * 256) = pack8(o);
            }
        } else {
            const int j0 = it - nt1, b = j0 >> 3, mt = (j0 >> 1) & 3, nt = j0 & 1;
            gemm_core<true>(FC + (size_t)mt * 128 * 256, 256, parts + (size_t)(ROWS_L + b * CTX) * PW + PC_UF + nt * 128, PW, 256, acc, smem);
            stage_acc(acc, st);
#pragma unroll 1
            for (int i = 0; i < 8; ++i) {
                const int q = tid + 256 * i, rl = q >> 4, c8 = (q & 15) * 8;
                const int m = mt * 128 + rl, c = m >> 8, k = m & 255;
                float v[8];
                ld8(st + rl * ST_LD + c8, v);
                *(uint4*)(pcat + (size_t)(ROWS_L + b * CTX + k) * 512 + c * 256 + nt * 128 + c8) = pack8(v);
            }
        }
    }
}

DI void phase_dft2_mixp(const Params& p, int l, bf16_t* smem, int item_lo, int item_hi, int blk0, int nblk) {
    const int tid = otid();
    float* st = (float*)smem;
    const bf16_t* F2 = (const bf16_t*)(p.ws + OFF_F2);
    const bf16_t* G1 = (const bf16_t*)(p.ws + OFF_G1);
    bf16_t* pcat = (bf16_t*)(p.ws + OFF_PCAT);
    const bf16_t* dbuf = (const bf16_t*)(p.ws + OFF_DBUF);
    const bf16_t* wp = (const bf16_t*)(p.ws + OFF_WPOOL) + (size_t)l * 65536;
    const bf16_t* parts = (const bf16_t*)(p.ws + OFF_PARTS);
    bf16_t* cat = (bf16_t*)(p.ws + OFF_H);
    const int nt2 = 2 * 128 * 2;
    const int nmt = (l == 0 ? ROWS : ROWS_L) / 128;
    (void)nmt;
    if ((int)blockIdx.x < blk0) return;
    for (int it = item_lo + ((int)blockIdx.x - blk0); it < item_hi; it += nblk) {
        f32x4 acc[4][4];
        if (it < nt2) {
            const int b = it >> 8, k1 = (it >> 1) & 127, nt = it & 1;
            gemm_core<true>(F2, 128, G1 + (size_t)(b * 128 + k1) * 128 * 256 + nt * 128, 256, 128, acc, smem);
            stage_acc(acc, st);
#pragma unroll 1
            for (int i = 0; i < 8; ++i) {
                const int q = tid + 256 * i, m = q >> 4, c8 = (q & 15) * 8;
                const int c = m >> 6, k2 = m & 63;
                float v[8];
                ld8(st + m * ST_LD + c8, v);
                *(uint4*)(pcat + (size_t)(b * SEQ + k1 + 128 * k2) * 512 + c * 256 + nt * 128 + c8) = pack8(v);
            }
        } else {
            const int j0 = it - nt2, tm = j0 >> 1, nt = j0 & 1;
            gemm_core_dma(dbuf + (size_t)tm * 128 * 256 + nt * 128, 256, wp + (size_t)(nt * 128) * 256 + nt * 128, 256, 128, acc, smem);
            stage_acc(acc, st);
            {
                const int c8 = (tid & 15) * 8, r0 = tid >> 4, n = nt * 128 + c8;
                float ps[8];
                ld8(p.pool_scale + l * 256 + n, ps);
                uint4 zr[8];
#pragma unroll
                for (int i = 0; i < 8; ++i) zr[i] = *(const uint4*)(parts + (size_t)(tm * 128 + r0 + 16 * i) * PW + PC_ZP + n);
#pragma unroll
                for (int i = 0; i < 8; ++i) {
                    float v[8], z[8];
                    ld8(st + (r0 + 16 * i) * ST_LD + c8, v);
                    unpack8(zr[i], z);
#pragma unroll
                    for (int e = 0; e < 8; ++e) v[e] = silu_f(z[e]) * ps[e] * v[e];
                    *(uint4*)(cat + (size_t)(tm * 128 + r0 + 16 * i) * DM + 768 + n) = pack8(v);
                }
            }
        }
    }
}

DI void phase_mixf(const Params& p, int l, bf16_t* smem) {
    const int tid = otid();
    float* st = (float*)smem;
    const bf16_t* pcat = (const bf16_t*)(p.ws + OFF_PCAT);
    const bf16_t* wc = (const bf16_t*)(p.ws + OFF_WCOMB) + (size_t)l * 131072;
    const bf16_t* parts = (const bf16_t*)(p.ws + OFF_PARTS);
    bf16_t* cat = (bf16_t*)(p.ws + OFF_H);
    const int nmt = (l == 0 ? ROWS : ROWS_L) / 128;
    for (int it = blockIdx.x; it < nmt * 2; it += gridDim.x) {
        const int tm = it >> 1, nt = it & 1;
        f32x4 acc[4][4];
        gemm_core_dma(pcat + (size_t)tm * 128 * 512, 512, wc + (size_t)(nt * 128) * 512, 512, 512, acc, smem);
        stage_acc(acc, st);
        const float sc = (tm < 128) ? 0.001381067932004976f : 0.0078125f;
        {
            const int c8 = (tid & 15) * 8, r0 = tid >> 4, n = nt * 128 + c8;
            uint4 zr[8];
#pragma unroll
            for (int i = 0; i < 8; ++i) zr[i] = *(const uint4*)(parts + (size_t)(tm * 128 + r0 + 16 * i) * PW + PC_ZF + n);
#pragma unroll
            for (int i = 0; i < 8; ++i) {
                float v[8], z[8];
                ld8(st + (r0 + 16 * i) * ST_LD + c8, v);
                unpack8(zr[i], z);
#pragma unroll
                for (int e = 0; e < 8; ++e) v[e] = silu_f(z[e]) * sc * v[e];
                *(uint4*)(cat + (size_t)(tm * 128 + r0 + 16 * i) * DM + n) = pack8(v);
            }
        }
    }
}

DI void phase_out(const Params& p, int l, const float* xl_in, const float* xc_in, float* xl_out, float* xc_out, bf16_t* smem) {
    const int tid = otid();
    float* st = (float*)smem;
    const bf16_t* cat = (const bf16_t*)(p.ws + OFF_H);
    const bf16_t* W = (const bf16_t*)(p.ws + OFF_WTOUT) + (size_t)l * DM * DM;
    const float* modv = (const float*)(p.ws + OFF_MODV) + (size_t)l * 3 * 3072;
    const int nmt = (l == 0 ? ROWS : ROWS_L) / 128;
    for (XIter t = xiter(nmt * 8); t.u < t.end; t.u += t.step) {
        int tm, tn;
        if (t.u < 1024) { const int ch = t.u >> 6, r = t.u & 63; tn = r >> 3; tm = ch * 8 + (r & 7); }
        else { const int j = t.u - 1024; tn = j >> 2; tm = 128 + (j & 3); }
        f32x4 acc[4][4];
        gemm_core_dma(cat + (size_t)tm * 128 * DM, DM, W + (size_t)tn * 128 * DM, DM, DM, acc, smem);
        stage_acc(acc, st);
        const int rb = tm * 128;
        const int v = (rb < ROWS_L) ? (rb >> 13) : 2;
        const float* gate = modv + v * 3072 + 2048;
        const float* xin = (rb < ROWS_L) ? xl_in : xc_in - (size_t)ROWS_L * DM;
        float* xout = (rb < ROWS_L) ? xl_out : xc_out - (size_t)ROWS_L * DM;
        {
            const int c8 = (tid & 15) * 8, r0 = tid >> 4;
            const size_t o0 = (size_t)(rb + r0) * DM + tn * 128 + c8;
            float gt[8];
            ld8(gate + tn * 128 + c8, gt);
            const bool lat = rb < ROWS_L;
            bf16_t* x1b = (bf16_t*)(p.ws + OFF_X1B);
            float4 x0[8], x1[8];
            if (lat && l == 1) {
#pragma unroll
                for (int i = 0; i < 8; ++i) { const uint4 u = *(const uint4*)(x1b + o0 + (size_t)i * 16 * DM);
                    x0[i] = make_float4(bflo(u.x), bfhi(u.x), bflo(u.y), bfhi(u.y)); x1[i] = make_float4(bflo(u.z), bfhi(u.z), bflo(u.w), bfhi(u.w)); }
            } else {
#pragma unroll
                for (int i = 0; i < 8; ++i) { x0[i] = *(const float4*)(xin + o0 + (size_t)i * 16 * DM); x1[i] = *(const float4*)(xin + o0 + (size_t)i * 16 * DM + 4); }
            }
#pragma unroll
            for (int i = 0; i < 8; ++i) {
                float a[8];
                ld8(st + (r0 + 16 * i) * ST_LD + c8, a);
                const float y0 = x0[i].x + gt[0] * a[0], y1 = x0[i].y + gt[1] * a[1], y2 = x0[i].z + gt[2] * a[2], y3 = x0[i].w + gt[3] * a[3];
                const float y4 = x1[i].x + gt[4] * a[4], y5 = x1[i].y + gt[5] * a[5], y6 = x1[i].z + gt[6] * a[6], y7 = x1[i].w + gt[7] * a[7];
                if (lat && l == 0) {
                    *(uint4*)(x1b + o0 + (size_t)i * 16 * DM) = make_uint4(pack2(y0, y1), pack2(y2, y3), pack2(y4, y5), pack2(y6, y7));
                } else {
                    float* d = xout + o0 + (size_t)i * 16 * DM;
                    *(float4*)(d) = make_float4(y0, y1, y2, y3);
                    *(float4*)(d + 4) = make_float4(y4, y5, y6, y7);
                }
            }
        }
    }
}

#ifndef PH_MASK
#define PH_MASK 0xFFFF
#endif
#ifndef PH_DUP
#define PH_DUP 0
#endif
__global__ void __launch_bounds__(256, 2) fwd_megakernel(Params p) {
    __shared__ __attribute__((aligned(16))) unsigned char smem_raw[SMEM_BYTES];
    bf16_t* smem = (bf16_t*)smem_raw;
    float* smf = (float*)smem_raw;
    volatile LAS unsigned* stw = (volatile LAS unsigned*)(smem_raw + SMEM_MAIN);
    if (threadIdx.x == 0) { stw[0] = 0u; stw[1] = 0u; stw[2] = 0u; stw[3] = 0u; }
    __syncthreads();
    if (p.never) cg::this_grid().sync();
    XcdBarrier bar = xcd_barrier_post((unsigned*)(p.ws + OFF_BAR), stw);

    if (PH_MASK & 1) phase0(p, smf);
    if (PH_DUP & 1) phase0(p, smf);
    xcd_barrier(bar);
    float* xc1 = (float*)(p.ws + OFF_XC1);
    for (int l = 0; l < 2; ++l) {
        const float* xl_in = (l == 0) ? p.x : p.out;
        const float* xc_in = (l == 0) ? p.ctx : xc1;
        if (PH_MASK & 2) phase_norm(p, l, xl_in, xc_in, (l == 1) ? (const bf16_t*)(p.ws + OFF_X1B) : nullptr);
        xcd_barrier(bar);
        if (PH_MASK & 4) phase_inproj(p, l, smem);
        if (PH_DUP & 4) phase_inproj(p, l, smem);
        xcd_barrier(bar);
        if (PH_MASK & 8) phase_attn(p, l, smem);
        if (PH_DUP & 8) phase_attn(p, l, smem);
        if (PH_MASK & 16) phase_convpool(p, l);
        if (PH_DUP & 16) phase_convpool(p, l);
        if (PH_MASK & 32) phase_dft1(p, l, smem);
        if (PH_DUP & 32) phase_dft1(p, l, smem);
        xcd_barrier(bar);
        if (PH_MASK & 64) phase_dft2_mixp(p, l, smem, 0, 512, 0, gridDim.x);
        xcd_barrier(bar);
        {
            const int nmix = (l == 0 ? ROWS : ROWS_L) / 64;
            const int b0 = ((int)gridDim.x > nmix) ? nmix : 0;
            if (PH_MASK & 128) phase_mixf(p, l, smem);
            if (PH_MASK & 64) phase_dft2_mixp(p, l, smem, 512, 512 + nmix, b0, (int)gridDim.x - b0);
        }
        xcd_barrier(bar);
        if (PH_MASK & 256) phase_out(p, l, xl_in, xc_in, p.out, xc1, smem);
        if (PH_DUP & 256) phase_out(p, l, xl_in, xc_in, (float*)(p.ws + OFF_G1), (float*)(p.ws + OFF_G1), smem);
        if (l == 0) xcd_barrier(bar);
    }
}

extern "C" void kernel_launch(void* const* d_in, const int* in_sizes, int n_in, void* d_out, int out_size, void* d_ws, size_t ws_size, hipStream_t stream) {
    static int grid_blocks = 0;
    if (!grid_blocks) {
        int dev = 0, cus = 0, per_cu = 0;
        hipGetDevice(&dev);
        hipDeviceGetAttribute(&cus, hipDeviceAttributeMultiprocessorCount, dev);
        hipOccupancyMaxActiveBlocksPerMultiprocessor(&per_cu, fwd_megakernel, 256, 0);
        if (per_cu > 2) per_cu = 2;
        if (per_cu < 1) per_cu = 1;
        grid_blocks = cus * per_cu;
        if (ws_size < WS_END) fprintf(stderr, "kernel_launch: workspace too small: %zu < %zu\n", ws_size, (size_t)WS_END);
    }
    hipMemsetAsync((char*)d_ws + OFF_BAR, 0, 16384, stream);
    Params p{};
    p.x = (const float*)d_in[0]; p.c = (const float*)d_in[1]; p.ctx = (const float*)d_in[2]; p.c_ctx = (const float*)d_in[3];
    p.w_mod = (const float*)d_in[4]; p.b_mod = (const float*)d_in[5]; p.norm_g = (const float*)d_in[6]; p.w_in = (const float*)d_in[7];
    p.q_gain = (const float*)d_in[8]; p.k_gain = (const float*)d_in[9]; p.w_fourier = (const float*)d_in[10]; p.conv_w = (const float*)d_in[11];
    p.conv_b = (const float*)d_in[12]; p.pool_w = (const float*)d_in[13]; p.pool_scale = (const float*)d_in[14]; p.w_out = (const float*)d_in[15];
    p.out = (float*)d_out; p.ws = (unsigned char*)d_ws; p.never = 0; p.pad = 0;
    void* args[] = {&p};
    hipError_t e = hipLaunchCooperativeKernel((void*)fwd_megakernel, dim3(grid_blocks), dim3(256), args, 0, stream);
    if (e != hipSuccess) fprintf(stderr, "cooperative launch failed: %s (grid %d)\n", hipGetErrorString(e), grid_blocks);
}
```

```cpp
#include <hip/hip_runtime.h>
#include <hip/hip_cooperative_groups.h>
#include <stdint.h>
#include <cstdio>
namespace cg = cooperative_groups;

typedef unsigned short bf16_t;
typedef __attribute__((ext_vector_type(8))) short bf16x8;
typedef __attribute__((ext_vector_type(4))) short bf16x4;
typedef __attribute__((ext_vector_type(4))) float f32x4;
typedef __attribute__((ext_vector_type(16))) float f32x16;
#define DI __device__ __forceinline__

#define SEQ 8192
#define CTX 256
#define DM 1024
#define DIN 2816
#define ROWS_L 16384
#define ROWS_C 512
#define ROWS 16896
#define NKEY 8448
#define PW 1792
#define PC_ZATT 0
#define PC_UF 256
#define PC_ZF 512
#define PC_T 768
#define PC_GC 1024
#define PC_UP 1280
#define PC_ZP 1536

constexpr size_t OFF_BAR = 0;
constexpr size_t OFF_MODV = 16384;
constexpr size_t OFF_ROPE = OFF_MODV + 2 * 3 * 3072 * 4;
constexpr size_t OFF_TW = OFF_ROPE + 6144 * 4;
constexpr size_t OFF_F1 = OFF_TW + 8192 * 2 * 4;
constexpr size_t OFF_F2 = OFF_F1 + 256 * 128 * 2;
constexpr size_t OFF_FC = OFF_F2 + 128 * 128 * 2;
constexpr size_t OFF_WCOMB = OFF_FC + 512 * 256 * 2;
constexpr size_t OFF_WPOOL = OFF_WCOMB + 2 * 256 * 512 * 2;
constexpr size_t OFF_WTIN = 2097152;
constexpr size_t OFF_WTOUT = OFF_WTIN + (size_t)2 * DIN * DM * 2;
constexpr size_t OFF_H = OFF_WTOUT + (size_t)2 * DM * DM * 2;
constexpr size_t OFF_PARTS = OFF_H + (size_t)ROWS * DM * 2;
constexpr size_t OFF_Q = OFF_PARTS + (size_t)ROWS * PW * 2;
constexpr size_t OFF_QC = OFF_Q + (size_t)2 * 4 * SEQ * 64 * 2;
constexpr size_t OFF_K = OFF_QC + (size_t)2 * 4 * CTX * 64 * 2;
constexpr size_t OFF_VT = OFF_K + (size_t)2 * 2 * NKEY * 64 * 2;
constexpr size_t OFF_DBUF = OFF_VT + (size_t)2 * 2 * NKEY * 64 * 2;
constexpr size_t OFF_G1 = OFF_DBUF + (size_t)ROWS * 256 * 2;
constexpr size_t OFF_PCAT = OFF_G1 + (size_t)2 * 128 * 2 * 64 * 256 * 2;
constexpr size_t OFF_XC1 = OFF_PCAT + (size_t)ROWS * 512 * 2;
constexpr size_t OFF_X1B = OFF_XC1 + (size_t)ROWS_C * DM * 4;
constexpr size_t WS_END = OFF_X1B + (size_t)ROWS_L * DM * 2;
static_assert(OFF_WPOOL + 2 * 256 * 256 * 2 <= OFF_WTIN, "ws map");

struct Params {
    const float *x, *c, *ctx, *c_ctx, *w_mod, *b_mod, *norm_g, *w_in, *q_gain, *k_gain, *w_fourier, *conv_w, *conv_b, *pool_w, *pool_scale, *w_out;
    float* out;
    unsigned char* ws;
    int never;
    int pad;
};

DI bf16_t f2bf(float x) { unsigned u = __float_as_uint(x); u += 0x7fffu + ((u >> 16) & 1u); return (bf16_t)(u >> 16); }
DI float bf2f(bf16_t h) { return __uint_as_float(((unsigned)h) << 16); }
typedef __attribute__((ext_vector_type(2))) float f32x2;
typedef __attribute__((ext_vector_type(2))) __bf16 bf16x2v;
DI unsigned pack2(float a, float b) { const f32x2 v = {a, b}; return __builtin_bit_cast(unsigned, __builtin_convertvector(v, bf16x2v)); }
struct XIter { int u, end, step; };
DI XIter xiter(int ntiles) {
    const int x = blockIdx.x & 7, j = blockIdx.x >> 3, nb = gridDim.x >> 3, per = (ntiles + 7) >> 3;
    XIter r; r.u = x * per + j; r.end = min((x + 1) * per, ntiles); r.step = nb; return r;
}
DI float silu_f(float z) { return z / (1.f + __expf(-z)); }
DI float bflo(unsigned w) { return __uint_as_float(w << 16); }
DI float bfhi(unsigned w) { return __uint_as_float(w & 0xffff0000u); }
DI int otid() { int t = threadIdx.x; asm volatile("" : "+v"(t)); return t; }

#define XB_TMO      128
#define XB_XCNT(j)  (256  + 64 * (j))
#define XB_XSUB(j)  (1280 + 64 * (j))
#define XB_XGEN(j)  (2304 + 64 * (j))
#define XB_TOP      3328
#define XB_TOPGEN   3392
#define XCD_BAR_WORDS 3456
#define XB_SPIN_CAP (1u << 20)
#define LAS __attribute__((address_space(3)))
DI unsigned xb_ld(unsigned* p) { return __hip_atomic_load(p, __ATOMIC_RELAXED, __HIP_MEMORY_SCOPE_AGENT); }
DI unsigned xb_add(unsigned* p, unsigned v) { return __hip_atomic_fetch_add(p, v, __ATOMIC_RELAXED, __HIP_MEMORY_SCOPE_AGENT); }
DI unsigned xb_xcc_id() { return (unsigned)__builtin_amdgcn_s_getreg((3 << 11) | 20) & 0xFu; }
#define XB_SPIN(cond, bar) do { unsigned _sp = 0; while (cond) { __builtin_amdgcn_s_sleep(1); \
    if ((++_sp & 255u) == 0u) { if (xb_ld(&(bar)[XB_TMO])) break; if (_sp > XB_SPIN_CAP) { atomicAdd(&(bar)[XB_TMO], 1u); break; } } } } while (0)
struct XcdBarrier { unsigned* bar; unsigned x; volatile LAS unsigned* st; };
DI XcdBarrier xcd_barrier_post(unsigned* bar, volatile LAS unsigned* st) {
    XcdBarrier b; b.bar = bar; b.x = xb_xcc_id(); b.st = st;
    if (threadIdx.x == 0) (void)xb_add(&bar[XB_XCNT(b.x)], 1u);
    return b;
}
DI void xcd_barrier_complete(unsigned* bar, unsigned x, unsigned& nloc, unsigned& nx) {
    const unsigned G = gridDim.x * gridDim.y * gridDim.z;
    unsigned sum, cnt, mine, sp = 0u;
    for (;;) {
        sum = 0u; cnt = 0u; mine = 0u;
#pragma unroll
        for (unsigned j = 0; j < 16; ++j) { const unsigned c = xb_ld(&bar[XB_XCNT(j)]); sum += c; cnt += (c > 0u) ? 1u : 0u; mine = (j == x) ? c : mine; }
        if (sum == G) break;
        __builtin_amdgcn_s_sleep(1);
        if ((++sp & 255u) == 0u) { if (xb_ld(&bar[XB_TMO])) break; if (sp > XB_SPIN_CAP) { atomicAdd(&bar[XB_TMO], 1u); break; } }
    }
    nloc = mine > 0u ? mine : 1u; nx = cnt > 0u ? cnt : 1u;
}
DI void xcd_barrier(const XcdBarrier& b) {
    asm volatile("s_waitcnt vmcnt(0)" ::: "memory");
    __syncthreads();
    if (threadIdx.x == 0) {
        unsigned* bar = b.bar;
        __builtin_amdgcn_s_waitcnt(0);
        unsigned nloc = b.st[0], nx = b.st[1];
        if (nloc == 0u) { xcd_barrier_complete(bar, b.x, nloc, nx); b.st[0] = nloc; b.st[1] = nx; }
        const unsigned old = xb_add(&bar[XB_XSUB(b.x)], 1u);
        const unsigned gen = old / nloc;
        if (old + 1u == (gen + 1u) * nloc) {
            __builtin_amdgcn_fence(__ATOMIC_RELEASE, "agent");
            asm volatile("s_waitcnt vmcnt(0)" ::: "memory");
            const unsigned og = xb_add(&bar[XB_TOP], 1u);
            const unsigned tg = og / nx;
            if (og + 1u == (tg + 1u) * nx) xb_add(&bar[XB_TOPGEN], 1u);
            else XB_SPIN(xb_ld(&bar[XB_TOPGEN]) == tg, bar);
            __builtin_amdgcn_fence(__ATOMIC_ACQUIRE, "agent");
            xb_add(&bar[XB_XGEN(b.x)], 1u);
            asm volatile("s_waitcnt vmcnt(0)" ::: "memory");
        } else {
            XB_SPIN(xb_ld(&bar[XB_XGEN(b.x)]) == gen, bar);
            __builtin_amdgcn_fence(__ATOMIC_ACQUIRE, "agent");
            asm volatile("s_waitcnt vmcnt(0)" ::: "memory");
        }
    }
    __syncthreads();
}

#define LROW 72
#define TILE_E (128 * LROW)
#define SMEM_MAIN (4 * TILE_E * 2)
#define SMEM_BYTES (SMEM_MAIN + 16)

typedef __attribute__((ext_vector_type(4))) unsigned u32x4;
struct Stg { u32x4 a0, a1, a2, a3, b0, b1, b2, b3; };
template <bool BN>
DI u32x4 g_ld_b(const bf16_t* __restrict__ B, int ldb, int kt, int q) {
    if (!BN) return *(const u32x4*)(B + (size_t)(q >> 3) * ldb + kt * 64 + (q & 7) * 8);
    else     return *(const u32x4*)(B + (size_t)(kt * 64 + (q >> 4)) * ldb + (q & 15) * 8);
}
template <bool BN>
DI void g_load(Stg& r, const bf16_t* __restrict__ A, int lda, const bf16_t* __restrict__ B, int ldb, int kt, int tid) {
    const bf16_t* ap = A + (size_t)(tid >> 3) * lda + kt * 64 + (tid & 7) * 8;
    r.a0 = *(const u32x4*)(ap);
    r.a1 = *(const u32x4*)(ap + (size_t)32 * lda);
    r.a2 = *(const u32x4*)(ap + (size_t)64 * lda);
    r.a3 = *(const u32x4*)(ap + (size_t)96 * lda);
    r.b0 = g_ld_b<BN>(B, ldb, kt, tid);
    r.b1 = g_ld_b<BN>(B, ldb, kt, tid + 256);
    r.b2 = g_ld_b<BN>(B, ldb, kt, tid + 512);
    r.b3 = g_ld_b<BN>(B, ldb, kt, tid + 768);
}
template <bool BN>
DI void s_st_b(bf16_t* b, const u32x4 v, int q) {
    if (!BN) *(u32x4*)(b + (q >> 3) * LROW + (q & 7) * 8) = v;
    else {
        const int kr0 = q >> 4, n0 = (q & 15) * 8, kr = ((((kr0 >> 3) ^ (q & 7)) << 3) | (kr0 & 7));
        b[(n0 + 0) * LROW + kr] = (bf16_t)(v.x & 0xffffu); b[(n0 + 1) * LROW + kr] = (bf16_t)(v.x >> 16);
        b[(n0 + 2) * LROW + kr] = (bf16_t)(v.y & 0xffffu); b[(n0 + 3) * LROW + kr] = (bf16_t)(v.y >> 16);
        b[(n0 + 4) * LROW + kr] = (bf16_t)(v.z & 0xffffu); b[(n0 + 5) * LROW + kr] = (bf16_t)(v.z >> 16);
        b[(n0 + 6) * LROW + kr] = (bf16_t)(v.w & 0xffffu); b[(n0 + 7) * LROW + kr] = (bf16_t)(v.w >> 16);
    }
}
template <bool BN>
DI void s_store(const Stg& r, bf16_t* smem, int buf, int tid) {
    bf16_t* a = smem + buf * 2 * TILE_E;
    bf16_t* b = a + TILE_E;
    bf16_t* ap = a + (tid >> 3) * LROW + (tid & 7) * 8;
    *(u32x4*)(ap) = r.a0;
    *(u32x4*)(ap + 32 * LROW) = r.a1;
    *(u32x4*)(ap + 64 * LROW) = r.a2;
    *(u32x4*)(ap + 96 * LROW) = r.a3;
    s_st_b<BN>(b, r.b0, tid);
    s_st_b<BN>(b, r.b1, tid + 256);
    s_st_b<BN>(b, r.b2, tid + 512);
    s_st_b<BN>(b, r.b3, tid + 768);
}
DI void mma_tile(const bf16_t* smem, int buf, f32x4 (&acc)[4][4], int wm, int wn, int lane) {
    const bf16_t* a = smem + buf * 2 * TILE_E;
    const bf16_t* b = a + TILE_E;
#pragma unroll
    for (int kk = 0; kk < 2; ++kk) {
        bf16x8 af[4], bfr[4];
#pragma unroll
        for (int mi = 0; mi < 4; ++mi) af[mi] = *(const bf16x8*)(a + (wm * 64 + mi * 16 + (lane & 15)) * LROW + kk * 32 + (lane >> 4) * 8);
#pragma unroll
        for (int ni = 0; ni < 4; ++ni) bfr[ni] = *(const bf16x8*)(b + (wn * 64 + ni * 16 + (lane & 15)) * LROW + (((kk * 4 + (lane >> 4)) ^ ((ni * 2 + ((lane >> 3) & 1)) & 7)) << 3));
#pragma unroll
        for (int mi = 0; mi < 4; ++mi)
#pragma unroll
            for (int ni = 0; ni < 4; ++ni) acc[mi][ni] = __builtin_amdgcn_mfma_f32_16x16x32_bf16(af[mi], bfr[ni], acc[mi][ni], 0, 0, 0);
    }
}
template <bool BN>
DI void gemm_core(const bf16_t* __restrict__ A, int lda, const bf16_t* __restrict__ B, int ldb, int K, f32x4 (&acc)[4][4], bf16_t* smem) {
    const int tid = otid(), lane = tid & 63, wave = tid >> 6;
    const int wm = wave >> 1, wn = wave & 1;
#pragma unroll
    for (int mi = 0; mi < 4; ++mi)
#pragma unroll
        for (int ni = 0; ni < 4; ++ni) acc[mi][ni] = (f32x4){0.f, 0.f, 0.f, 0.f};
    const int nk = K >> 6;
    Stg r0, r1;
    __syncthreads();
    g_load<BN>(r0, A, lda, B, ldb, 0, tid);
    g_load<BN>(r1, A, lda, B, ldb, 1, tid);
    s_store<BN>(r0, smem, 0, tid);
    __syncthreads();
    for (int kt = 0; kt < nk; kt += 2) {
        if (kt + 2 < nk) g_load<BN>(r0, A, lda, B, ldb, kt + 2, tid);
        mma_tile(smem, 0, acc, wm, wn, lane);
        s_store<BN>(r1, smem, 1, tid);
        __syncthreads();
        if (kt + 3 < nk) g_load<BN>(r1, A, lda, B, ldb, kt + 3, tid);
        mma_tile(smem, 1, acc, wm, wn, lane);
        if (kt + 2 < nk) s_store<BN>(r0, smem, 0, tid);
        __syncthreads();
    }
}
#define GT_E (128 * 64)
DI void glds_tile(const bf16_t* __restrict__ G, int ld, int kt, bf16_t* lt, int tid) {
    const int c = (tid & 7) ^ ((tid >> 4) & 7);
    const bf16_t* g = G + (size_t)(tid >> 3) * ld + kt * 64 + c * 8;
    char* l = (char*)lt + tid * 16;
#pragma unroll
    for (int p = 0; p < 4; ++p)
        __builtin_amdgcn_global_load_lds((const unsigned*)(g + (size_t)(p * 32) * ld), (LAS unsigned*)(l + p * 4096), 16, 0, 0);
}
DI void mma_tile_sw(const bf16_t* smem, int buf, f32x4 (&acc)[4][4], int wm, int wn, int lane) {
    const char* a = (const char*)(smem + buf * 2 * GT_E);
    const char* b = a + GT_E * 2;
    const int sw = (lane & 15) >> 1;
#pragma unroll
    for (int kk = 0; kk < 2; ++kk) {
        bf16x8 af[4], bfr[4];
        const int co = ((kk * 4 + (lane >> 4)) ^ sw) << 4;
#pragma unroll
        for (int mi = 0; mi < 4; ++mi) af[mi] = *(const bf16x8*)(a + (wm * 64 + mi * 16 + (lane & 15)) * 128 + co);
#pragma unroll
        for (int ni = 0; ni < 4; ++ni) bfr[ni] = *(const bf16x8*)(b + (wn * 64 + ni * 16 + (lane & 15)) * 128 + co);
#pragma unroll
        for (int mi = 0; mi < 4; ++mi)
#pragma unroll
            for (int ni = 0; ni < 4; ++ni) acc[mi][ni] = __builtin_amdgcn_mfma_f32_16x16x32_bf16(af[mi], bfr[ni], acc[mi][ni], 0, 0, 0);
    }
}
DI void gemm_core_dma(const bf16_t* __restrict__ A, int lda, const bf16_t* __restrict__ B, int ldb, int K, f32x4 (&acc)[4][4], bf16_t* smem) {
    const int tid = otid(), lane = tid & 63, wave = tid >> 6;
    const int wm = wave >> 1, wn = wave & 1;
#pragma unroll
    for (int mi = 0; mi < 4; ++mi)
#pragma unroll
        for (int ni = 0; ni < 4; ++ni) acc[mi][ni] = (f32x4){0.f, 0.f, 0.f, 0.f};
    const int nk = K >> 6;
    __syncthreads();
    glds_tile(A, lda, 0, smem, tid);
    glds_tile(B, ldb, 0, smem + GT_E, tid);
    for (int kt = 0; kt < nk; ++kt) {
        asm volatile("s_waitcnt vmcnt(0)" ::: "memory");
        __syncthreads();
        if (kt + 1 < nk) {
            bf16_t* nb = smem + ((kt + 1) & 1) * 2 * GT_E;
            glds_tile(A, lda, kt + 1, nb, tid);
            glds_tile(B, ldb, kt + 1, nb + GT_E, tid);
        }
        mma_tile_sw(smem, kt & 1, acc, wm, wn, lane);
    }
    __syncthreads();
}
#define ST_LD 132
DI void stage_acc(f32x4 (&acc)[4][4], float* st) {
    const int lane = otid() & 63, wave = otid() >> 6, wm = wave >> 1, wn = wave & 1, fl = lane & 15, g4 = lane >> 4;
#pragma unroll
    for (int mi = 0; mi < 4; ++mi)
#pragma unroll
        for (int ni = 0; ni < 4; ++ni)
#pragma unroll
            for (int j = 0; j < 4; ++j) st[(wm * 64 + mi * 16 + g4 * 4 + j) * ST_LD + wn * 64 + ni * 16 + fl] = acc[mi][ni][j];
    __syncthreads();
}
DI void ld8(const float* q, float (&v)[8]) {
    const float4 a = *(const float4*)q, b = *(const float4*)(q + 4);
    v[0] = a.x; v[1] = a.y; v[2] = a.z; v[3] = a.w; v[4] = b.x; v[5] = b.y; v[6] = b.z; v[7] = b.w;
}
DI uint4 pack8(const float (&v)[8]) { return make_uint4(pack2(v[0], v[1]), pack2(v[2], v[3]), pack2(v[4], v[5]), pack2(v[6], v[7])); }
DI void unpack8(const uint4 u, float (&v)[8]) {
    v[0] = bflo(u.x); v[1] = bfhi(u.x); v[2] = bflo(u.y); v[3] = bfhi(u.y); v[4] = bflo(u.z); v[5] = bfhi(u.z); v[6] = bflo(u.w); v[7] = bfhi(u.w);
}

DI void phase0(const Params& p, float* smf) {
    const int tid = otid();
    unsigned char* ws = p.ws;
    float* modv = (float*)(ws + OFF_MODV);
    for (int it = blockIdx.x; it < 192; it += gridDim.x) {
        const int l = it / 96, n0 = (it % 96) * 32;
        __syncthreads();
        for (int i = tid; i < 3072; i += 256) {
            const int v = i >> 10, k = i & 1023;
            const float cv = (v == 0) ? p.c[k] : (v == 1) ? p.c[1024 + k] : p.c_ctx[k];
            smf[i] = silu_f(cv);
        }
        __syncthreads();
        const int col = tid & 31, kg = tid >> 5;
        float a0 = 0.f, a1 = 0.f, a2 = 0.f;
        const float* w = p.w_mod + (size_t)l * 1024 * 3072 + n0 + col;
#pragma unroll 16
        for (int kk = 0; kk < 128; ++kk) {
            const int k = kg * 128 + kk;
            const float wv = w[(size_t)k * 3072];
            a0 += smf[k] * wv; a1 += smf[1024 + k] * wv; a2 += smf[2048 + k] * wv;
        }
        __syncthreads();
        smf[3072 + (kg * 3 + 0) * 32 + col] = a0; smf[3072 + (kg * 3 + 1) * 32 + col] = a1; smf[3072 + (kg * 3 + 2) * 32 + col] = a2;
        __syncthreads();
        if (tid < 96) {
            const int v = tid >> 5, cc = tid & 31;
            float s = 0.f;
            for (int g = 0; g < 8; ++g) s += smf[3072 + (g * 3 + v) * 32 + cc];
            modv[(l * 3 + v) * 3072 + n0 + cc] = s + p.b_mod[l * 3072 + n0 + cc];
        }
    }
    {
        const int n_in = 2 * 16 * 44, n_out = 2 * 16 * 16;
        for (int it = blockIdx.x; it < n_in + n_out; it += gridDim.x) {
            const float* src; bf16_t* dst; int N, kt, nt;
            if (it < n_in) { const int l = it / 704, r = it % 704; kt = r / 44; nt = r % 44; N = DIN; src = p.w_in + (size_t)l * DM * DIN; dst = (bf16_t*)(ws + OFF_WTIN) + (size_t)l * DIN * DM; }
            else { const int j = it - n_in; const int l = j / 256, r = j % 256; kt = r / 16; nt = r % 16; N = DM; src = p.w_out + (size_t)l * DM * DM; dst = (bf16_t*)(ws + OFF_WTOUT) + (size_t)l * DM * DM; }
            __syncthreads();
#pragma unroll
            for (int ps = 0; ps < 4; ++ps) {
                const int kr = ps * 16 + (tid >> 4), c4 = (tid & 15) * 4;
                const float4 v = *(const float4*)(src + (size_t)(kt * 64 + kr) * N + nt * 64 + c4);
                smf[kr * 65 + c4 + 0] = v.x; smf[kr * 65 + c4 + 1] = v.y; smf[kr * 65 + c4 + 2] = v.z; smf[kr * 65 + c4 + 3] = v.w;
            }
            __syncthreads();
            const int n = tid >> 2, ks = (tid & 3) * 16;
            unsigned w[8];
#pragma unroll
            for (int e = 0; e < 8; ++e) w[e] = pack2(smf[(ks + 2 * e) * 65 + n], smf[(ks + 2 * e + 1) * 65 + n]);
            int ntd = nt;
            if (it < n_in && nt >= 20 && nt < 36) { const int grp = (nt - 20) >> 2, q4 = (nt - 20) & 3; ntd = (grp == 0) ? 28 + 2 * q4 : (grp == 1) ? 20 + 2 * q4 : (grp == 2) ? 21 + 2 * q4 : 29 + 2 * q4; }
            bf16_t* d = dst + (size_t)(ntd * 64 + n) * DM + kt * 64 + ks;
            *(uint4*)d = make_uint4(w[0], w[1], w[2], w[3]);
            *(uint4*)(d + 8) = make_uint4(w[4], w[5], w[6], w[7]);
        }
    }
    const int gtid = blockIdx.x * 256 + tid, gsz = gridDim.x * 256;
    {
        bf16_t* wc = (bf16_t*)(ws + OFF_WCOMB);
        __syncthreads();
        if (tid < 64) { smf[tid] = cospif((float)tid * (1.f / 32.f)); smf[64 + tid] = sinpif((float)tid * (1.f / 32.f)); }
        __syncthreads();
        for (int i = gtid; i < 2 * 512 * 256; i += gsz) {
            const int n = i & 255, kk = (i >> 8) & 511, l = i >> 17;
            const int c = kk >> 8, head = (kk >> 6) & 3, ch = kk & 63;
            const float* wf = p.w_fourier + (size_t)l * 65536 + (size_t)(head * 64) * 256 + n;
            float s = 0.f;
#pragma unroll 16
            for (int j = 0; j < 64; ++j) s += smf[c * 64 + ((j * ch) & 63)] * wf[j * 256];
            wc[(size_t)l * 131072 + n * 512 + kk] = f2bf(s);
        }
    }
    {
        bf16_t* wp = (bf16_t*)(ws + OFF_WPOOL);
        for (int i = gtid; i < 2 * 256 * 256; i += gsz) {
            const int k = i & 255, n = (i >> 8) & 255, l = i >> 16;
            float v = 0.f;
            if ((k >> 6) == (n >> 6)) v = p.pool_w[(size_t)l * 16384 + (n >> 6) * 4096 + (k & 63) * 64 + (n & 63)];
            wp[i] = f2bf(v);
        }
    }
    {
        float* tw = (float*)(ws + OFF_TW);
        for (int i = gtid; i < 8192; i += gsz) { const float a = (float)i * (1.f / 4096.f); tw[2 * i] = cospif(a); tw[2 * i + 1] = sinpif(a); }
        bf16_t* f1 = (bf16_t*)(ws + OFF_F1);
        for (int i = gtid; i < 256 * 128; i += gsz) {
            const int t1 = i & 127, m = i >> 7;
            const int k1 = (m >> 5) * 16 + (m & 15), c = (m >> 4) & 1;
            const float a = (float)((k1 * t1) & 127) * (1.f / 64.f);
            f1[i] = f2bf(c ? -sinpif(a) : cospif(a));
        }
        bf16_t* f2 = (bf16_t*)(ws + OFF_F2);
        for (int i = gtid; i < 128 * 128; i += gsz) {
            const int kx = i & 127, m = i >> 7;
            const int c = m >> 6, k2 = m & 63, cp = kx >> 6, t2 = kx & 63;
            const float a = (float)((k2 * t2) & 63) * (1.f / 32.f);
            float v;
            if (c == cp) v = cospif(a); else if (c == 0) v = sinpif(a); else v = -sinpif(a);
            f2[i] = f2bf(v);
        }
        bf16_t* fc = (bf16_t*)(ws + OFF_FC);
        for (int i = gtid; i < 512 * 256; i += gsz) {
            const int t = i & 255, m = i >> 8;
            const int c = m >> 8, k = m & 255;
            const float a = (float)((k * t) & 255) * (1.f / 128.f);
            fc[i] = f2bf(c ? -sinpif(a) : cospif(a));
        }
        float* rp = (float*)(ws + OFF_ROPE);
        for (int i = gtid; i < 3072; i += gsz) {
            const int f = i & 15;
            const int pos = (i < 2048) ? (i >> 4) : ((i - 2048) >> 4);
            const float inv = powf(10000.f, -(float)f * (1.f / 16.f));
            const float ang = (float)pos * inv;
            const double ad = (double)ang;
            const float cs = (float)cos(ad), sn = (float)sin(ad);
            if (i < 2048) { rp[i] = cs; rp[2048 + i] = sn; }
            else { rp[4096 + (i - 2048)] = cs; rp[5120 + (i - 2048)] = sn; }
        }
    }
}

DI void phase_norm(const Params& p, int l, const float* xl, const float* xc, const bf16_t* xlb) {
    const int lane = otid() & 63, wave = otid() >> 6;
    const float* modv = (const float*)(p.ws + OFF_MODV) + (size_t)l * 3 * 3072;
    const float* g = p.norm_g + l * 1024;
    bf16_t* H = (bf16_t*)(p.ws + OFF_H);
    for (int row = blockIdx.x * 4 + wave; row < ROWS; row += gridDim.x * 4) {
        const float* src = (row < ROWS_L) ? xl + (size_t)row * DM : xc + (size_t)(row - ROWS_L) * DM;
        const int v = (row < ROWS_L) ? (row >> 13) : 2;
        const float* mv = modv + v * 3072;
        float4 a[4];
        float ss = 0.f;
        if (xlb != nullptr && row < ROWS_L) {
            const bf16_t* sb = xlb + (size_t)row * DM;
#pragma unroll
            for (int i = 0; i < 4; ++i) { const uint2 u = *(const uint2*)(sb + i * 256 + lane * 4); a[i] = make_float4(bflo(u.x), bfhi(u.x), bflo(u.y), bfhi(u.y)); }
        } else {
#pragma unroll
            for (int i = 0; i < 4; ++i) a[i] = *(const float4*)(src + i * 256 + lane * 4);
        }
#pragma unroll
        for (int i = 0; i < 4; ++i) ss += a[i].x * a[i].x + a[i].y * a[i].y + a[i].z * a[i].z + a[i].w * a[i].w;
#pragma unroll
        for (int o = 32; o >= 1; o >>= 1) ss += __shfl_xor(ss, o);
        const float rs = rsqrtf(ss * (1.f / 1024.f) + 1e-6f);
#pragma unroll
        for (int i = 0; i < 4; ++i) {
            const int c0 = i * 256 + lane * 4;
            const float4 gg = *(const float4*)(g + c0), sh = *(const float4*)(mv + c0), sc = *(const float4*)(mv + 1024 + c0);
            const float o0 = a[i].x * rs * gg.x * (1.f + sc.x) + sh.x, o1 = a[i].y * rs * gg.y * (1.f + sc.y) + sh.y;
            const float o2 = a[i].z * rs * gg.z * (1.f + sc.z) + sh.z, o3 = a[i].w * rs * gg.w * (1.f + sc.w) + sh.w;
            *(uint2*)(H + (size_t)row * DM + c0) = make_uint2(pack2(o0, o1), pack2(o2, o3));
        }
    }
}

DI void epi_inproj(const Params& p, int l, int tm, int tn, f32x4 (&acc)[4][4], float* st) {
    const int tid = otid();
    unsigned char* ws = p.ws;
    stage_acc(acc, st);
    const int rbase = tm * 128;
    const bool isctx = rbase >= ROWS_L;
    if (tn < 3) {
        const bool isq = tn < 2;
        const float* gain = (isq ? p.q_gain : p.k_gain) + l * 64;
        const float* rp = (const float*)(ws + OFF_ROPE);
#pragma unroll 1
        for (int i = 0; i < 8; ++i) {
            const int q = tid + 256 * i, rl = q >> 4, c8 = (q & 15) * 8;
            const int row = rbase + rl, hd = c8 >> 6, d0 = c8 & 63;
            float v[8], pv[8], g[8], pg[8];
            ld8(st + rl * ST_LD + c8, v);
            ld8(st + rl * ST_LD + (c8 ^ 16), pv);
            ld8(gain + d0, g);
            ld8(gain + (d0 ^ 16), pg);
            float ss = 0.f;
#pragma unroll
            for (int e = 0; e < 8; ++e) ss += v[e] * v[e];
            ss += __shfl_xor(ss, 1); ss += __shfl_xor(ss, 2); ss += __shfl_xor(ss, 4);
            const float rs = rsqrtf(ss * (1.f / 64.f) + 1e-6f);
#pragma unroll
            for (int e = 0; e < 8; ++e) { v[e] *= rs * g[e]; pv[e] *= rs * pg[e]; }
            bf16_t* dst;
            if (!isctx) {
                const int b = row >> 13, t = row & 8191;
                const int pos = (d0 >= 32) ? (t & 63) : (t >> 6);
                const float* ct = rp + ((d0 >= 32) ? 4096 : 0) + pos * 16 + (d0 & 8);
                float cs[8], sn[8];
                ld8(ct, cs);
                ld8(ct + ((d0 >= 32) ? 1024 : 2048), sn);
                const float sg = (d0 & 16) ? 1.f : -1.f;
#pragma unroll
                for (int e = 0; e < 8; ++e) v[e] = v[e] * cs[e] + sg * pv[e] * sn[e];
                if (isq) dst = (bf16_t*)(ws + OFF_Q) + ((size_t)(b * 4 + tn * 2 + hd) * SEQ + t) * 64 + d0;
                else     dst = (bf16_t*)(ws + OFF_K) + ((size_t)(b * 2 + hd) * NKEY + CTX + t) * 64 + d0;
            } else {
                const int rc = row - ROWS_L, b = rc >> 8, t = rc & 255;
                if (isq) dst = (bf16_t*)(ws + OFF_QC) + ((size_t)(b * 4 + tn * 2 + hd) * CTX + t) * 64 + d0;
                else     dst = (bf16_t*)(ws + OFF_K) + ((size_t)(b * 2 + hd) * NKEY + t) * 64 + d0;
            }
            if (isq) {
#pragma unroll
                for (int e = 0; e < 8; ++e) v[e] *= 0.18033688011112042f;
            }
            *(uint4*)dst = pack8(v);
        }
    } else if (tn == 3) {
        int b, key0;
        if (!isctx) { b = rbase >> 13; key0 = CTX + (rbase & 8191); } else { const int rc = rbase - ROWS_L; b = rc >> 8; key0 = rc & 255; }
#pragma unroll 1
        for (int i = 0; i < 8; ++i) {
            const int q = tid + 256 * i, col = q & 127, r8 = (q >> 7) * 8;
            float v[8];
#pragma unroll
            for (int e = 0; e < 8; ++e) v[e] = st[(r8 + e) * ST_LD + col];
            bf16_t* vt = (bf16_t*)(ws + OFF_VT) + ((size_t)(b * 2 + (col >> 6)) * 64 + (col & 63)) * NKEY + key0 + r8;
            *(uint4*)vt = pack8(v);
        }
    } else {
        bf16_t* parts = (bf16_t*)(ws + OFF_PARTS);
        if (tn >= 10 && tn < 18) {
            const bool isg = tn >= 14;
            const int dcol = (isg ? PC_GC + (tn - 14) * 64 : PC_T + (tn - 10) * 64);
#pragma unroll 1
            for (int i = 0; i < 4; ++i) {
                const int q = tid + 256 * i, rl = q >> 3, c8 = (q & 7) * 8;
                float v[8], w[8];
                ld8(st + rl * ST_LD + c8, v);
                ld8(st + rl * ST_LD + 64 + c8, w);
#pragma unroll
                for (int e = 0; e < 8; ++e) v[e] = isg ? silu_f(w[e]) * v[e] : v[e] * w[e];
                *(uint4*)(parts + (size_t)(rbase + rl) * PW + dcol + c8) = pack8(v);
            }
        } else {
            const int dbase = (tn < 10) ? tn * 128 - 512 : PC_UP + (tn - 18) * 128;
#pragma unroll 1
            for (int i = 0; i < 8; ++i) {
                const int q = tid + 256 * i, rl = q >> 4, c8 = (q & 15) * 8;
                float v[8];
                ld8(st + rl * ST_LD + c8, v);
                *(uint4*)(parts + (size_t)(rbase + rl) * PW + dbase + c8) = pack8(v);
            }
        }
    }
}

DI void phase_inproj(const Params& p, int l, bf16_t* smem) {
    const bf16_t* H = (const bf16_t*)(p.ws + OFF_H);
    const bf16_t* W = (const bf16_t*)(p.ws + OFF_WTIN) + (size_t)l * DIN * DM;
    const int nlat = 128 * 22;
    const int ntiles = nlat + (l == 0 ? 4 * 22 : 4 * 2);
    for (XIter t = xiter(ntiles); t.u < t.end; t.u += t.step) {
        const int u = t.u;
        int tm, tn;
        if (u < nlat) { const int ch = u / 176, r = u % 176; tn = r >> 3; tm = ch * 8 + (r & 7); }
        else { const int j = u - nlat; tm = 128 + (j & 3); tn = (l == 0 ? 0 : 2) + (j >> 2); }
        f32x4 acc[4][4];
        gemm_core_dma(H + (size_t)tm * 128 * DM, DM, W + (size_t)tn * 128 * DM, DM, DM, acc, smem);
        epi_inproj(p, l, tm, tn, acc, (float*)smem);
    }
}

#define KT_E (64 * LROW)
DI void attn_item(const Params& p, const bf16_t* Qb, const bf16_t* Kb, const bf16_t* VTb, int ntiles, int rowbase, int hq, bf16_t* smem) {
    const int tid = otid(), lane = tid & 63, wave = tid >> 6;
    const int r = lane & 31, h = lane >> 5;
    const float LOG2E = 1.4426950408889634f;
    bf16x8 qf[4];
    {
        const bf16_t* qrow = Qb + (size_t)(wave * 32 + r) * 64;
#pragma unroll
        for (int s = 0; s < 4; ++s) qf[s] = *(const bf16x8*)(qrow + s * 16 + h * 8);
    }
    f32x16 ot[2], minit;
#pragma unroll
    for (int i = 0; i < 16; ++i) { ot[0][i] = 0.f; ot[1][i] = 0.f; minit[i] = 0.f; }
    float m = 0.f, lsum = 0.f;
    uint4 rk[2], rv[2];
    auto gload = [&](int kt) {
#pragma unroll
        for (int i = 0; i < 2; ++i) {
            const int q = tid + 256 * i;
            rk[i] = *(const uint4*)(Kb + (size_t)(kt * 64 + (q >> 3)) * 64 + (q & 7) * 8);
            rv[i] = *(const uint4*)(VTb + (size_t)(q >> 3) * NKEY + kt * 64 + (q & 7) * 8);
        }
    };
    auto sstore = [&](int buf) {
        bf16_t* sk = smem + buf * 2 * KT_E;
        bf16_t* sv = sk + KT_E;
#pragma unroll
        for (int i = 0; i < 2; ++i) {
            const int q = tid + 256 * i;
            *(uint4*)(sk + (q >> 3) * LROW + (q & 7) * 8) = rk[i];
            *(uint4*)(sv + (q >> 3) * LROW + (q & 7) * 8) = rv[i];
        }
    };
    __syncthreads();
    gload(0);
    sstore(0);
    __syncthreads();
    for (int kt = 0; kt < ntiles; ++kt) {
        if (kt + 1 < ntiles) gload(kt + 1);
        const bf16_t* sk = smem + (kt & 1) * 2 * KT_E;
        const bf16_t* sv = sk + KT_E;
        f32x16 st[2], pe[2];
#pragma unroll
        for (int blk = 0; blk < 2; ++blk) {
            st[blk] = __builtin_amdgcn_mfma_f32_32x32x16_bf16(*(const bf16x8*)(sk + (blk * 32 + r) * LROW + h * 8), qf[0], minit, 0, 0, 0);
#pragma unroll
            for (int s = 1; s < 4; ++s)
                st[blk] = __builtin_amdgcn_mfma_f32_32x32x16_bf16(*(const bf16x8*)(sk + (blk * 32 + r) * LROW + s * 16 + h * 8), qf[s], st[blk], 0, 0, 0);
        }
        float ls = 0.f;
#pragma unroll
        for (int i = 0; i < 16; ++i) {
            pe[0][i] = __builtin_amdgcn_exp2f(st[0][i]); ls += pe[0][i];
            pe[1][i] = __builtin_amdgcn_exp2f(st[1][i]); ls += pe[1][i];
        }
        if (kt == 0 || __any(!(ls <= 256.f))) {
            float tmx = st[0][0];
#pragma unroll
            for (int i = 0; i < 16; ++i) { tmx = fmaxf(tmx, st[0][i]); tmx = fmaxf(tmx, st[1][i]); }
            tmx = fmaxf(tmx, __shfl_xor(tmx, 32));
            const float delta = (kt == 0) ? tmx : fmaxf(tmx, 0.f);
            const float alpha = (kt == 0) ? 1.f : __builtin_amdgcn_exp2f(-delta);
            m += delta;
            lsum *= alpha;
            ls = 0.f;
#pragma unroll
            for (int i = 0; i < 16; ++i) {
                ot[0][i] *= alpha; ot[1][i] *= alpha; minit[i] = -m;
                pe[0][i] = __builtin_amdgcn_exp2f(st[0][i] - delta); ls += pe[0][i];
                pe[1][i] = __builtin_amdgcn_exp2f(st[1][i] - delta); ls += pe[1][i];
            }
        }
        lsum += ls;
        bf16x8 pk[2][2];
#pragma unroll
        for (int blk = 0; blk < 2; ++blk)
#pragma unroll
            for (int s = 0; s < 2; ++s) {
                uint4 u;
                u.x = pack2(pe[blk][8 * s + 0], pe[blk][8 * s + 1]); u.y = pack2(pe[blk][8 * s + 2], pe[blk][8 * s + 3]);
                u.z = pack2(pe[blk][8 * s + 4], pe[blk][8 * s + 5]); u.w = pack2(pe[blk][8 * s + 6], pe[blk][8 * s + 7]);
                pk[blk][s] = __builtin_bit_cast(bf16x8, u);
            }
#pragma unroll
        for (int db = 0; db < 2; ++db)
#pragma unroll
            for (int blk = 0; blk < 2; ++blk)
#pragma unroll
                for (int s = 0; s < 2; ++s) {
                    const bf16_t* vp = sv + (db * 32 + r) * LROW + blk * 32 + s * 16 + h * 4;
                    const bf16x4 lo = *(const bf16x4*)vp;
                    const bf16x4 hi = *(const bf16x4*)(vp + 8);
                    const bf16x8 vf = __builtin_shufflevector(lo, hi, 0, 1, 2, 3, 4, 5, 6, 7);
                    ot[db] = __builtin_amdgcn_mfma_f32_32x32x16_bf16(vf, pk[blk][s], ot[db], 0, 0, 0);
                }
        if (kt + 1 < ntiles) sstore((kt + 1) & 1);
        __syncthreads();
    }
    lsum += __shfl_xor(lsum, 32);
    const float inv = 1.f / lsum;
    const int row = rowbase + wave * 32 + r;
    const bf16_t* zrow = (const bf16_t*)(p.ws + OFF_PARTS) + (size_t)row * PW + PC_ZATT + hq * 64;
    bf16_t* orow = (bf16_t*)(p.ws + OFF_H) + (size_t)row * DM + 256 + hq * 64;
#pragma unroll
    for (int db = 0; db < 2; ++db)
#pragma unroll
        for (int g = 0; g < 4; ++g) {
            const int d = db * 32 + g * 8 + h * 4;
            const uint2 z = *(const uint2*)(zrow + d);
            const float o0 = silu_f(bflo(z.x)) * ot[db][4 * g + 0] * inv, o1 = silu_f(bfhi(z.x)) * ot[db][4 * g + 1] * inv;
            const float o2 = silu_f(bflo(z.y)) * ot[db][4 * g + 2] * inv, o3 = silu_f(bfhi(z.y)) * ot[db][4 * g + 3] * inv;
            *(uint2*)(orow + d) = make_uint2(pack2(o0, o1), pack2(o2, o3));
        }
}

DI void phase_attn(const Params& p, int l, bf16_t* smem) {
    const bf16_t* Q = (const bf16_t*)(p.ws + OFF_Q);
    const bf16_t* QC = (const bf16_t*)(p.ws + OFF_QC);
    const bf16_t* Kk = (const bf16_t*)(p.ws + OFF_K);
    const bf16_t* VT = (const bf16_t*)(p.ws + OFF_VT);
    for (XIter t = xiter(512); t.u < t.end; t.u += t.step) {
        const int it = t.u;
        const int b = it >> 8, hq = (it >> 6) & 3, qt = it & 63;
        const size_t kv = (size_t)(b * 2 + (hq >> 1));
        attn_item(p, Q + ((size_t)(b * 4 + hq) * SEQ + qt * 128) * 64, Kk + kv * NKEY * 64, VT + kv * 64 * NKEY, NKEY / 64, b * SEQ + qt * 128, hq, smem);
    }
    if (l == 0) {
        for (int j = blockIdx.x; j < 16; j += gridDim.x) {
            const int b = j >> 3, hq = (j >> 1) & 3, qt = j & 1;
            const size_t kv = (size_t)(b * 2 + (hq >> 1));
            attn_item(p, QC + ((size_t)(b * 4 + hq) * CTX + qt * 128) * 64, Kk + kv * NKEY * 64, VT + kv * 64 * NKEY, CTX / 64, ROWS_L + b * CTX + qt * 128, hq, smem);
        }
    }
}

template <int W>
DI void pool_task(const bf16_t* __restrict__ pu, int pos, int n, bf16_t* __restrict__ dst) {
    constexpr int LEFT = W / 2;
    uint4 raw[W];
#pragma unroll
    for (int t = 0; t < W; ++t) { int q = pos - LEFT + t; q = q < 0 ? 0 : (q >= n ? n - 1 : q); raw[t] = *(const uint4*)(pu + (size_t)q * PW); }
    float sum[8], u[8];
#pragma unroll
    for (int e = 0; e < 8; ++e) sum[e] = 0.f;
#pragma unroll
    for (int t = 0; t < W; ++t) {
        const int q = pos - LEFT + t;
        const float mk = (q >= 0 && q < n) ? 1.f : 0.f;
        unpack8(raw[t], u);
#pragma unroll
        for (int e = 0; e < 8; ++e) sum[e] += mk * u[e];
    }
    const int lo = max(pos - LEFT, 0), hi = min(pos + W - LEFT, n);
    const float ic = 1.f / (float)(hi - lo);
    unpack8(raw[LEFT], u);
#pragma unroll
    for (int e = 0; e < 8; ++e) sum[e] = sum[e] * ic - u[e];
    *(uint4*)dst = pack8(sum);
}
DI void phase_convpool(const Params& p, int l) {
    const bf16_t* __restrict__ parts = (const bf16_t*)(p.ws + OFF_PARTS);
    bf16_t* __restrict__ cat = (bf16_t*)(p.ws + OFF_H);
    bf16_t* __restrict__ dbuf = (bf16_t*)(p.ws + OFF_DBUF);
    const int nrows = (l == 0 ? ROWS : ROWS_L);
    const int gsz = gridDim.x * 256, gt = blockIdx.x * 256 + otid();
    {
        const int c8 = (gt & 31) * 8;
        float w0[8], w1[8], w2[8], bs[8];
        ld8(p.conv_w + l * 768 + c8, w0); ld8(p.conv_w + l * 768 + 256 + c8, w1); ld8(p.conv_w + l * 768 + 512 + c8, w2); ld8(p.conv_b + l * 256 + c8, bs);
        for (int i = gt; i < nrows * 32; i += gsz) {
            const int row = i >> 5;
            int seq0, n;
            if (row < ROWS_L) { seq0 = (row >> 13) << 13; n = SEQ; } else { seq0 = ROWS_L + (((row - ROWS_L) >> 8) << 8); n = CTX; }
            const int pos = row - seq0;
            const bf16_t* pr = parts + (size_t)row * PW + c8;
            const bool hp = pos > 0, hn = pos + 1 < n;
            const bf16_t* pp = hp ? pr - PW : pr;
            const bf16_t* pn = hn ? pr + PW : pr;
            const uint4 r0 = *(const uint4*)(pr + PC_T), r2 = *(const uint4*)(pp + PC_T), r4 = *(const uint4*)(pn + PC_T), r6 = *(const uint4*)(pr + PC_GC);
            const float mp = hp ? 1.f : 0.f, mn = hn ? 1.f : 0.f;
            float tc[8], tp[8], tn[8], gg[8], o[8];
            unpack8(r0, tc); unpack8(r2, tp); unpack8(r4, tn); unpack8(r6, gg);
#pragma unroll
            for (int e = 0; e < 8; ++e) o[e] = gg[e] * (mp * tp[e] * w0[e] + tc[e] * w1[e] + mn * tn[e] * w2[e] + bs[e]);
            *(uint4*)(cat + (size_t)row * DM + 512 + c8) = pack8(o);
        }
    }
    for (int j = gt; j < nrows * 32; j += gsz) {
        const int g = j / (nrows * 8), rem = j - g * (nrows * 8), row = rem >> 3, c8 = g * 64 + (rem & 7) * 8;
        int seq0, n;
        if (row < ROWS_L) { seq0 = (row >> 13) << 13; n = SEQ; } else { seq0 = ROWS_L + (((row - ROWS_L) >> 8) << 8); n = CTX; }
        const bf16_t* pu = parts + (size_t)seq0 * PW + PC_UP + c8;
        bf16_t* dst = dbuf + (size_t)row * 256 + c8;
        const int pos = row - seq0;
        if (g == 0) pool_task<2>(pu, pos, n, dst);
        else if (g == 1) pool_task<4>(pu, pos, n, dst);
        else if (g == 2) pool_task<8>(pu, pos, n, dst);
        else pool_task<16>(pu, pos, n, dst);
    }
}

DI void phase_dft1(const Params& p, int l, bf16_t* smem) {
    const int tid = otid();
    float* st = (float*)smem;
    const bf16_t* parts = (const bf16_t*)(p.ws + OFF_PARTS);
    const bf16_t* F1 = (const bf16_t*)(p.ws + OFF_F1);
    const bf16_t* FC = (const bf16_t*)(p.ws + OFF_FC);
    const float* tw = (const float*)(p.ws + OFF_TW);
    bf16_t* G1 = (bf16_t*)(p.ws + OFF_G1);
    bf16_t* pcat = (bf16_t*)(p.ws + OFF_PCAT);
    const int nt1 = 2 * 64 * 4;
    const int ntot = nt1 + (l == 0 ? 16 : 0);
    for (int it = blockIdx.x; it < ntot; it += gridDim.x) {
        f32x4 acc[4][4];
        if (it < nt1) {
            const int b = it >> 8, t2 = (it >> 2) & 63, mt = (it >> 1) & 1, nt = it & 1;
            gemm_core<true>(F1 + (size_t)mt * 128 * 128, 128, parts + (size_t)(b * SEQ + t2) * PW + PC_UF + nt * 128, 64 * PW, 128, acc, smem);
            stage_acc(acc, st);
#pragma unroll 1
            for (int i = 0; i < 4; ++i) {
                const int q = tid + 256 * i, kk = q >> 4, c8 = (q & 15) * 8;
                const int rr = 32 * (kk >> 4) + (kk & 15);
                const int k1 = mt * 64 + kk;
                const float cs = tw[2 * (k1 * t2)], sn = tw[2 * (k1 * t2) + 1];
                float gr[8], gi[8], o[8];
                ld8(st + rr * ST_LD + c8, gr);
                ld8(st + (rr + 16) * ST_LD + c8, gi);
                bf16_t* dr = G1 + ((size_t)((b * 128 + k1) * 2 + 0) * 64 + t2) * 256 + nt * 128 + c8;
#pragma unroll
                for (int e = 0; e < 8; ++e) o[e] = gr[e] * cs + gi[e] * sn;
                *(uint4*)dr = pack8(o);
#pragma unroll
                for (int e = 0; e < 8; ++e) o[e] = gi[e] * cs - gr[e] * sn;
                *(uint4*)(dr + (size_t)64 * 256) = pack8(o);
            }
        } else {
            const int j0 = it - nt1, b = j0 >> 3, mt = (j0 >> 1) & 3, nt = j0 & 1;
            gemm_core<true>(FC + (size_t)mt * 128 * 256, 256, parts + (size_t)(ROWS_L + b * CTX) * PW + PC_UF + nt * 128, PW, 256, acc, smem);
            stage_acc(acc, st);
#pragma unroll 1
            for (int i = 0; i < 8; ++i) {
                const int q = tid + 256 * i, rl = q >> 4, c8 = (q & 15) * 8;
                const int m = mt * 128 + rl, c = m >> 8, k = m & 255;
                float v[8];
                ld8(st + rl * ST_LD + c8, v);
                *(uint4*)(pcat + (size_t)(ROWS_L + b * CTX + k) * 512 + c * 256 + nt * 128 + c8) = pack8(v);
            }
        }
    }
}

DI void phase_dft2_mixp(const Params& p, int l, bf16_t* smem, int item_lo, int item_hi, int blk0, int nblk) {
    const int tid = otid();
    float* st = (float*)smem;
    const bf16_t* F2 = (const bf16_t*)(p.ws + OFF_F2);
    const bf16_t* G1 = (const bf16_t*)(p.ws + OFF_G1);
    bf16_t* pcat = (bf16_t*)(p.ws + OFF_PCAT);
    const bf16_t* dbuf = (const bf16_t*)(p.ws + OFF_DBUF);
    const bf16_t* wp = (const bf16_t*)(p.ws + OFF_WPOOL) + (size_t)l * 65536;
    const bf16_t* parts = (const bf16_t*)(p.ws + OFF_PARTS);
    bf16_t* cat = (bf16_t*)(p.ws + OFF_H);
    const int nt2 = 2 * 128 * 2;
    const int nmt = (l == 0 ? ROWS : ROWS_L) / 128;
    (void)nmt;
    if ((int)blockIdx.x < blk0) return;
    for (int it = item_lo + ((int)blockIdx.x - blk0); it < item_hi; it += nblk) {
        f32x4 acc[4][4];
        if (it < nt2) {
            const int b = it >> 8, k1 = (it >> 1) & 127, nt = it & 1;
            gemm_core<true>(F2, 128, G1 + (size_t)(b * 128 + k1) * 128 * 256 + nt * 128, 256, 128, acc, smem);
            stage_acc(acc, st);
#pragma unroll 1
            for (int i = 0; i < 8; ++i) {
                const int q = tid + 256 * i, m = q >> 4, c8 = (q & 15) * 8;
                const int c = m >> 6, k2 = m & 63;
                float v[8];
                ld8(st + m * ST_LD + c8, v);
                *(uint4*)(pcat + (size_t)(b * SEQ + k1 + 128 * k2) * 512 + c * 256 + nt * 128 + c8) = pack8(v);
            }
        } else {
            const int j0 = it - nt2, tm = j0 >> 1, nt = j0 & 1;
            gemm_core_dma(dbuf + (size_t)tm * 128 * 256 + nt * 128, 256, wp + (size_t)(nt * 128) * 256 + nt * 128, 256, 128, acc, smem);
            stage_acc(acc, st);
            {
                const int c8 = (tid & 15) * 8, r0 = tid >> 4, n = nt * 128 + c8;
                float ps[8];
                ld8(p.pool_scale + l * 256 + n, ps);
                uint4 zr[8];
#pragma unroll
                for (int i = 0; i < 8; ++i) zr[i] = *(const uint4*)(parts + (size_t)(tm * 128 + r0 + 16 * i) * PW + PC_ZP + n);
#pragma unroll
                for (int i = 0; i < 8; ++i) {
                    float v[8], z[8];
                    ld8(st + (r0 + 16 * i) * ST_LD + c8, v);
                    unpack8(zr[i], z);
#pragma unroll
                    for (int e = 0; e < 8; ++e) v[e] = silu_f(z[e]) * ps[e] * v[e];
                    *(uint4*)(cat + (size_t)(tm * 128 + r0 + 16 * i) * DM + 768 + n) = pack8(v);
                }
            }
        }
    }
}

DI void phase_mixf(const Params& p, int l, bf16_t* smem) {
    const int tid = otid();
    float* st = (float*)smem;
    const bf16_t* pcat = (const bf16_t*)(p.ws + OFF_PCAT);
    const bf16_t* wc = (const bf16_t*)(p.ws + OFF_WCOMB) + (size_t)l * 131072;
    const bf16_t* parts = (const bf16_t*)(p.ws + OFF_PARTS);
    bf16_t* cat = (bf16_t*)(p.ws + OFF_H);
    const int nmt = (l == 0 ? ROWS : ROWS_L) / 128;
    for (int it = blockIdx.x; it < nmt * 2; it += gridDim.x) {
        const int tm = it >> 1, nt = it & 1;
        f32x4 acc[4][4];
        gemm_core_dma(pcat + (size_t)tm * 128 * 512, 512, wc + (size_t)(nt * 128) * 512, 512, 512, acc, smem);
        stage_acc(acc, st);
        const float sc = (tm < 128) ? 0.001381067932004976f : 0.0078125f;
        {
            const int c8 = (tid & 15) * 8, r0 = tid >> 4, n = nt * 128 + c8;
            uint4 zr[8];
#pragma unroll
            for (int i = 0; i < 8; ++i) zr[i] = *(const uint4*)(parts + (size_t)(tm * 128 + r0 + 16 * i) * PW + PC_ZF + n);
#pragma unroll
            for (int i = 0; i < 8; ++i) {
                float v[8], z[8];
                ld8(st + (r0 + 16 * i) * ST_LD + c8, v);
                unpack8(zr[i], z);
#pragma unroll
                for (int e = 0; e < 8; ++e) v[e] = silu_f(z[e]) * sc * v[e];
                *(uint4*)(cat + (size_t)(tm * 128 + r0 + 16 * i) * DM + n) = pack8(v);
            }
        }
    }
}

DI void phase_out(const Params& p, int l, const float* xl_in, const float* xc_in, float* xl_out, float* xc_out, bf16_t* smem) {
    const int tid = otid();
    float* st = (float*)smem;
    const bf16_t* cat = (const bf16_t*)(p.ws + OFF_H);
    const bf16_t* W = (const bf16_t*)(p.ws + OFF_WTOUT) + (size_t)l * DM * DM;
    const float* modv = (const float*)(p.ws + OFF_MODV) + (size_t)l * 3 * 3072;
    const int nmt = (l == 0 ? ROWS : ROWS_L) / 128;
    for (XIter t = xiter(nmt * 8); t.u < t.end; t.u += t.step) {
        int tm, tn;
        if (t.u < 1024) { const int ch = t.u >> 6, r = t.u & 63; tn = r >> 3; tm = ch * 8 + (r & 7); }
        else { const int j = t.u - 1024; tn = j >> 2; tm = 128 + (j & 3); }
        f32x4 acc[4][4];
        gemm_core_dma(cat + (size_t)tm * 128 * DM, DM, W + (size_t)tn * 128 * DM, DM, DM, acc, smem);
        stage_acc(acc, st);
        const int rb = tm * 128;
        const int v = (rb < ROWS_L) ? (rb >> 13) : 2;
        const float* gate = modv + v * 3072 + 2048;
        const float* xin = (rb < ROWS_L) ? xl_in : xc_in - (size_t)ROWS_L * DM;
        float* xout = (rb < ROWS_L) ? xl_out : xc_out - (size_t)ROWS_L * DM;
        {
            const int c8 = (tid & 15) * 8, r0 = tid >> 4;
            const size_t o0 = (size_t)(rb + r0) * DM + tn * 128 + c8;
            float gt[8];
            ld8(gate + tn * 128 + c8, gt);
            const bool lat = rb < ROWS_L;
            bf16_t* x1b = (bf16_t*)(p.ws + OFF_X1B);
            float4 x0[8], x1[8];
            if (lat && l == 1) {
#pragma unroll
                for (int i = 0; i < 8; ++i) { const uint4 u = *(const uint4*)(x1b + o0 + (size_t)i * 16 * DM);
                    x0[i] = make_float4(bflo(u.x), bfhi(u.x), bflo(u.y), bfhi(u.y)); x1[i] = make_float4(bflo(u.z), bfhi(u.z), bflo(u.w), bfhi(u.w)); }
            } else {
#pragma unroll
                for (int i = 0; i < 8; ++i) { x0[i] = *(const float4*)(xin + o0 + (size_t)i * 16 * DM); x1[i] = *(const float4*)(xin + o0 + (size_t)i * 16 * DM + 4); }
            }
#pragma unroll
            for (int i = 0; i < 8; ++i) {
                float a[8];
                ld8(st + (r0 + 16 * i) * ST_LD + c8, a);
                const float y0 = x0[i].x + gt[0] * a[0], y1 = x0[i].y + gt[1] * a[1], y2 = x0[i].z + gt[2] * a[2], y3 = x0[i].w + gt[3] * a[3];
                const float y4 = x1[i].x + gt[4] * a[4], y5 = x1[i].y + gt[5] * a[5], y6 = x1[i].z + gt[6] * a[6], y7 = x1[i].w + gt[7] * a[7];
                if (lat && l == 0) {
                    *(uint4*)(x1b + o0 + (size_t)i * 16 * DM) = make_uint4(pack2(y0, y1), pack2(y2, y3), pack2(y4, y5), pack2(y6, y7));
                } else {
                    float* d = xout + o0 + (size_t)i * 16 * DM;
                    *(float4*)(d) = make_float4(y0, y1, y2, y3);
                    *(float4*)(d + 4) = make_float4(y4, y5, y6, y7);
                }
            }
        }
    }
}

#ifndef PH_MASK
#define PH_MASK 0xFFFF
#endif
#ifndef PH_DUP
#define PH_DUP 0
#endif
__global__ void __launch_bounds__(256, 2) fwd_megakernel(Params p) {
    __shared__ __attribute__((aligned(16))) unsigned char smem_raw[SMEM_BYTES];
    bf16_t* smem = (bf16_t*)smem_raw;
    float* smf = (float*)smem_raw;
    volatile LAS unsigned* stw = (volatile LAS unsigned*)(smem_raw + SMEM_MAIN);
    if (threadIdx.x == 0) { stw[0] = 0u; stw[1] = 0u; stw[2] = 0u; stw[3] = 0u; }
    __syncthreads();
    if (p.never) cg::this_grid().sync();
    XcdBarrier bar = xcd_barrier_post((unsigned*)(p.ws + OFF_BAR), stw);

    if (PH_MASK & 1) phase0(p, smf);
    if (PH_DUP & 1) phase0(p, smf);
    xcd_barrier(bar);
    float* xc1 = (float*)(p.ws + OFF_XC1);
    for (int l = 0; l < 2; ++l) {
        const float* xl_in = (l == 0) ? p.x : p.out;
        const float* xc_in = (l == 0) ? p.ctx : xc1;
        if (PH_MASK & 2) phase_norm(p, l, xl_in, xc_in, (l == 1) ? (const bf16_t*)(p.ws + OFF_X1B) : nullptr);
        xcd_barrier(bar);
        if (PH_MASK & 4) phase_inproj(p, l, smem);
        if (PH_DUP & 4) phase_inproj(p, l, smem);
        xcd_barrier(bar);
        if (PH_MASK & 8) phase_attn(p, l, smem);
        if (PH_DUP & 8) phase_attn(p, l, smem);
        if (PH_MASK & 16) phase_convpool(p, l);
        if (PH_DUP & 16) phase_convpool(p, l);
        if (PH_MASK & 32) phase_dft1(p, l, smem);
        if (PH_DUP & 32) phase_dft1(p, l, smem);
        xcd_barrier(bar);
        if (PH_MASK & 64) phase_dft2_mixp(p, l, smem, 0, 512, 0, gridDim.x);
        xcd_barrier(bar);
        {
            const int nmix = (l == 0 ? ROWS : ROWS_L) / 64;
            const int b0 = ((int)gridDim.x > nmix) ? nmix : 0;
            if (PH_MASK & 128) phase_mixf(p, l, smem);
            if (PH_MASK & 64) phase_dft2_mixp(p, l, smem, 512, 512 + nmix, b0, (int)gridDim.x - b0);
        }
        xcd_barrier(bar);
        if (PH_MASK & 256) phase_out(p, l, xl_in, xc_in, p.out, xc1, smem);
        if (PH_DUP & 256) phase_out(p, l, xl_in, xc_in, (float*)(p.ws + OFF_G1), (float*)(p.ws + OFF_G1), smem);
        if (l == 0) xcd_barrier(bar);
    }
}

extern "C" void kernel_launch(void* const* d_in, const int* in_sizes, int n_in, void* d_out, int out_size, void* d_ws, size_t ws_size, hipStream_t stream) {
    static int grid_blocks = 0;
    if (!grid_blocks) {
        int dev = 0, cus = 0, per_cu = 0;
        hipGetDevice(&dev);
        hipDeviceGetAttribute(&cus, hipDeviceAttributeMultiprocessorCount, dev);
        hipOccupancyMaxActiveBlocksPerMultiprocessor(&per_cu, fwd_megakernel, 256, 0);
        if (per_cu > 2) per_cu = 2;
        if (per_cu < 1) per_cu = 1;
        grid_blocks = cus * per_cu;
        if (ws_size < WS_END) fprintf(stderr, "kernel_launch: workspace too small: %zu < %zu\n", ws_size, (size_t)WS_END);
    }
    hipMemsetAsync((char*)d_ws + OFF_BAR, 0, 16384, stream);
    Params p{};
    p.x = (const float*)d_in[0]; p.c = (const float*)d_in[1]; p.ctx = (const float*)d_in[2]; p.c_ctx = (const float*)d_in[3];
    p.w_mod = (const float*)d_in[4]; p.b_mod = (const float*)d_in[5]; p.norm_g = (const float*)d_in[6]; p.w_in = (const float*)d_in[7];
    p.q_gain = (const float*)d_in[8]; p.k_gain = (const float*)d_in[9]; p.w_fourier = (const float*)d_in[10]; p.conv_w = (const float*)d_in[11];
    p.conv_b = (const float*)d_in[12]; p.pool_w = (const float*)d_in[13]; p.pool_scale = (const float*)d_in[14]; p.w_out = (const float*)d_in[15];
    p.out = (float*)d_out; p.ws = (unsigned char*)d_ws; p.never = 0; p.pad = 0;
    void* args[] = {&p};
    hipError_t e = hipLaunchCooperativeKernel((void*)fwd_megakernel, dim3(grid_blocks), dim3(256), args, 0, stream);
    if (e != hipSuccess) fprintf(stderr, "cooperative launch failed: %s (grid %d)\n", hipGetErrorString(e), grid_blocks);
}
```

```cpp
#include <hip/hip_runtime.h>
#include <hip/hip_cooperative_groups.h>
#include <stdint.h>
#include <cstdio>
namespace cg = cooperative_groups;

typedef unsigned short bf16_t;
typedef __attribute__((ext_vector_type(8))) short bf16x8;
typedef __attribute__((ext_vector_type(4))) short bf16x4;
typedef __attribute__((ext_vector_type(4))) float f32x4;
typedef __attribute__((ext_vector_type(16))) float f32x16;
#define DI __device__ __forceinline__

#define SEQ 8192
#define CTX 256
#define DM 1024
#define DIN 2816
#define ROWS_L 16384
#define ROWS_C 512
#define ROWS 16896
#define NKEY 8448
#define PW 1792
#define PC_ZATT 0
#define PC_UF 256
#define PC_ZF 512
#define PC_T 768
#define PC_GC 1024
#define PC_UP 1280
#define PC_ZP 1536

constexpr size_t OFF_BAR = 0;
constexpr size_t OFF_MODV = 16384;
constexpr size_t OFF_ROPE = OFF_MODV + 2 * 3 * 3072 * 4;
constexpr size_t OFF_TW = OFF_ROPE + 6144 * 4;
constexpr size_t OFF_F1 = OFF_TW + 8192 * 2 * 4;
constexpr size_t OFF_F2 = OFF_F1 + 256 * 128 * 2;
constexpr size_t OFF_FC = OFF_F2 + 128 * 128 * 2;
constexpr size_t OFF_WCOMB = OFF_FC + 512 * 256 * 2;
constexpr size_t OFF_WPOOL = OFF_WCOMB + 2 * 256 * 512 * 2;
constexpr size_t OFF_WTIN = 2097152;
constexpr size_t OFF_WTOUT = OFF_WTIN + (size_t)2 * DIN * DM * 2;
constexpr size_t OFF_H = OFF_WTOUT + (size_t)2 * DM * DM * 2;
constexpr size_t OFF_PARTS = OFF_H + (size_t)ROWS * DM * 2;
constexpr size_t OFF_Q = OFF_PARTS + (size_t)ROWS * PW * 2;
constexpr size_t OFF_QC = OFF_Q + (size_t)2 * 4 * SEQ * 64 * 2;
constexpr size_t OFF_K = OFF_QC + (size_t)2 * 4 * CTX * 64 * 2;
constexpr size_t OFF_VT = OFF_K + (size_t)2 * 2 * NKEY * 64 * 2;
constexpr size_t OFF_DBUF = OFF_VT + (size_t)2 * 2 * NKEY * 64 * 2;
constexpr size_t OFF_G1 = OFF_DBUF + (size_t)ROWS * 256 * 2;
constexpr size_t OFF_PCAT = OFF_G1 + (size_t)2 * 128 * 2 * 64 * 256 * 2;
constexpr size_t OFF_XC1 = OFF_PCAT + (size_t)ROWS * 512 * 2;
constexpr size_t OFF_X1B = OFF_XC1 + (size_t)ROWS_C * DM * 4;
constexpr size_t WS_END = OFF_X1B + (size_t)ROWS_L * DM * 2;
static_assert(OFF_WPOOL + 2 * 256 * 256 * 2 <= OFF_WTIN, "ws map");

struct Params {
    const float *x, *c, *ctx, *c_ctx, *w_mod, *b_mod, *norm_g, *w_in, *q_gain, *k_gain, *w_fourier, *conv_w, *conv_b, *pool_w, *pool_scale, *w_out;
    float* out;
    unsigned char* ws;
    int never;
    int pad;
};

DI bf16_t f2bf(float x) { unsigned u = __float_as_uint(x); u += 0x7fffu + ((u >> 16) & 1u); return (bf16_t)(u >> 16); }
DI float bf2f(bf16_t h) { return __uint_as_float(((unsigned)h) << 16); }
typedef __attribute__((ext_vector_type(2))) float f32x2;
typedef __attribute__((ext_vector_type(2))) __bf16 bf16x2v;
DI unsigned pack2(float a, float b) { const f32x2 v = {a, b}; return __builtin_bit_cast(unsigned, __builtin_convertvector(v, bf16x2v)); }
struct XIter { int u, end, step; };
DI XIter xiter(int ntiles) {
    const int x = blockIdx.x & 7, j = blockIdx.x >> 3, nb = gridDim.x >> 3, per = (ntiles + 7) >> 3;
    XIter r; r.u = x * per + j; r.end = min((x + 1) * per, ntiles); r.step = nb; return r;
}
DI float silu_f(float z) { return z / (1.f + __expf(-z)); }
DI float bflo(unsigned w) { return __uint_as_float(w << 16); }
DI float bfhi(unsigned w) { return __uint_as_float(w & 0xffff0000u); }
DI int otid() { int t = threadIdx.x; asm volatile("" : "+v"(t)); return t; }

#define XB_TMO      128
#define XB_XCNT(j)  (256  + 64 * (j))
#define XB_XSUB(j)  (1280 + 64 * (j))
#define XB_XGEN(j)  (2304 + 64 * (j))
#define XB_TOP      3328
#define XB_TOPGEN   3392
#define XCD_BAR_WORDS 3456
#define XB_SPIN_CAP (1u << 20)
#define LAS __attribute__((address_space(3)))
DI unsigned xb_ld(unsigned* p) { return __hip_atomic_load(p, __ATOMIC_RELAXED, __HIP_MEMORY_SCOPE_AGENT); }
DI unsigned xb_add(unsigned* p, unsigned v) { return __hip_atomic_fetch_add(p, v, __ATOMIC_RELAXED, __HIP_MEMORY_SCOPE_AGENT); }
DI unsigned xb_xcc_id() { return (unsigned)__builtin_amdgcn_s_getreg((3 << 11) | 20) & 0xFu; }
#define XB_SPIN(cond, bar) do { unsigned _sp = 0; while (cond) { __builtin_amdgcn_s_sleep(1); \
    if ((++_sp & 255u) == 0u) { if (xb_ld(&(bar)[XB_TMO])) break; if (_sp > XB_SPIN_CAP) { atomicAdd(&(bar)[XB_TMO], 1u); break; } } } } while (0)
struct XcdBarrier { unsigned* bar; unsigned x; volatile LAS unsigned* st; };
DI XcdBarrier xcd_barrier_post(unsigned* bar, volatile LAS unsigned* st) {
    XcdBarrier b; b.bar = bar; b.x = xb_xcc_id(); b.st = st;
    if (threadIdx.x == 0) (void)xb_add(&bar[XB_XCNT(b.x)], 1u);
    return b;
}
DI void xcd_barrier_complete(unsigned* bar, unsigned x, unsigned& nloc, unsigned& nx) {
    const unsigned G = gridDim.x * gridDim.y * gridDim.z;
    unsigned sum, cnt, mine, sp = 0u;
    for (;;) {
        sum = 0u; cnt = 0u; mine = 0u;
#pragma unroll
        for (unsigned j = 0; j < 16; ++j) { const unsigned c = xb_ld(&bar[XB_XCNT(j)]); sum += c; cnt += (c > 0u) ? 1u : 0u; mine = (j == x) ? c : mine; }
        if (sum == G) break;
        __builtin_amdgcn_s_sleep(1);
        if ((++sp & 255u) == 0u) { if (xb_ld(&bar[XB_TMO])) break; if (sp > XB_SPIN_CAP) { atomicAdd(&bar[XB_TMO], 1u); break; } }
    }
    nloc = mine > 0u ? mine : 1u; nx = cnt > 0u ? cnt : 1u;
}
DI void xcd_barrier(const XcdBarrier& b) {
    asm volatile("s_waitcnt vmcnt(0)" ::: "memory");
    __syncthreads();
    if (threadIdx.x == 0) {
        unsigned* bar = b.bar;
        __builtin_amdgcn_s_waitcnt(0);
        unsigned nloc = b.st[0], nx = b.st[1];
        if (nloc == 0u) { xcd_barrier_complete(bar, b.x, nloc, nx); b.st[0] = nloc; b.st[1] = nx; }
        const unsigned old = xb_add(&bar[XB_XSUB(b.x)], 1u);
        const unsigned gen = old / nloc;
        if (old + 1u == (gen + 1u) * nloc) {
            __builtin_amdgcn_fence(__ATOMIC_RELEASE, "agent");
            asm volatile("s_waitcnt vmcnt(0)" ::: "memory");
            const unsigned og = xb_add(&bar[XB_TOP], 1u);
            const unsigned tg = og / nx;
            if (og + 1u == (tg + 1u) * nx) xb_add(&bar[XB_TOPGEN], 1u);
            else XB_SPIN(xb_ld(&bar[XB_TOPGEN]) == tg, bar);
            __builtin_amdgcn_fence(__ATOMIC_ACQUIRE, "agent");
            xb_add(&bar[XB_XGEN(b.x)], 1u);
            asm volatile("s_waitcnt vmcnt(0)" ::: "memory");
        } else {
            XB_SPIN(xb_ld(&bar[XB_XGEN(b.x)]) == gen, bar);
            __builtin_amdgcn_fence(__ATOMIC_ACQUIRE, "agent");
            asm volatile("s_waitcnt vmcnt(0)" ::: "memory");
        }
    }
    __syncthreads();
}

#define LROW 72
#define TILE_E (128 * LROW)
#define SMEM_MAIN (4 * TILE_E * 2)
#define SMEM_BYTES (SMEM_MAIN + 16)

typedef __attribute__((ext_vector_type(4))) unsigned u32x4;
struct Stg { u32x4 a0, a1, a2, a3, b0, b1, b2, b3; };
template <bool BN>
DI u32x4 g_ld_b(const bf16_t* __restrict__ B, int ldb, int kt, int q) {
    if (!BN) return *(const u32x4*)(B + (size_t)(q >> 3) * ldb + kt * 64 + (q & 7) * 8);
    else     return *(const u32x4*)(B + (size_t)(kt * 64 + (q >> 4)) * ldb + (q & 15) * 8);
}
template <bool BN>
DI void g_load(Stg& r, const bf16_t* __restrict__ A, int lda, const bf16_t* __restrict__ B, int ldb, int kt, int tid) {
    const bf16_t* ap = A + (size_t)(tid >> 3) * lda + kt * 64 + (tid & 7) * 8;
    r.a0 = *(const u32x4*)(ap);
    r.a1 = *(const u32x4*)(ap + (size_t)32 * lda);
    r.a2 = *(const u32x4*)(ap + (size_t)64 * lda);
    r.a3 = *(const u32x4*)(ap + (size_t)96 * lda);
    r.b0 = g_ld_b<BN>(B, ldb, kt, tid);
    r.b1 = g_ld_b<BN>(B, ldb, kt, tid + 256);
    r.b2 = g_ld_b<BN>(B, ldb, kt, tid + 512);
    r.b3 = g_ld_b<BN>(B, ldb, kt, tid + 768);
}
template <bool BN>
DI void s_st_b(bf16_t* b, const u32x4 v, int q) {
    if (!BN) *(u32x4*)(b + (q >> 3) * LROW + (q & 7) * 8) = v;
    else {
        const int kr0 = q >> 4, n0 = (q & 15) * 8, kr = ((((kr0 >> 3) ^ (q & 7)) << 3) | (kr0 & 7));
        b[(n0 + 0) * LROW + kr] = (bf16_t)(v.x & 0xffffu); b[(n0 + 1) * LROW + kr] = (bf16_t)(v.x >> 16);
        b[(n0 + 2) * LROW + kr] = (bf16_t)(v.y & 0xffffu); b[(n0 + 3) * LROW + kr] = (bf16_t)(v.y >> 16);
        b[(n0 + 4) * LROW + kr] = (bf16_t)(v.z & 0xffffu); b[(n0 + 5) * LROW + kr] = (bf16_t)(v.z >> 16);
        b[(n0 + 6) * LROW + kr] = (bf16_t)(v.w & 0xffffu); b[(n0 + 7) * LROW + kr] = (bf16_t)(v.w >> 16);
    }
}
template <bool BN>
DI void s_store(const Stg& r, bf16_t* smem, int buf, int tid) {
    bf16_t* a = smem + buf * 2 * TILE_E;
    bf16_t* b = a + TILE_E;
    bf16_t* ap = a + (tid >> 3) * LROW + (tid & 7) * 8;
    *(u32x4*)(ap) = r.a0;
    *(u32x4*)(ap + 32 * LROW) = r.a1;
    *(u32x4*)(ap + 64 * LROW) = r.a2;
    *(u32x4*)(ap + 96 * LROW) = r.a3;
    s_st_b<BN>(b, r.b0, tid);
    s_st_b<BN>(b, r.b1, tid + 256);
    s_st_b<BN>(b, r.b2, tid + 512);
    s_st_b<BN>(b, r.b3, tid + 768);
}
DI void mma_tile(const bf16_t* smem, int buf, f32x4 (&acc)[4][4], int wm, int wn, int lane) {
    const bf16_t* a = smem + buf * 2 * TILE_E;
    const bf16_t* b = a + TILE_E;
#pragma unroll
    for (int kk = 0; kk < 2; ++kk) {
        bf16x8 af[4], bfr[4];
#pragma unroll
        for (int mi = 0; mi < 4; ++mi) af[mi] = *(const bf16x8*)(a + (wm * 64 + mi * 16 + (lane & 15)) * LROW + kk * 32 + (lane >> 4) * 8);
#pragma unroll
        for (int ni = 0; ni < 4; ++ni) bfr[ni] = *(const bf16x8*)(b + (wn * 64 + ni * 16 + (lane & 15)) * LROW + (((kk * 4 + (lane >> 4)) ^ ((ni * 2 + ((lane >> 3) & 1)) & 7)) << 3));
#pragma unroll
        for (int mi = 0; mi < 4; ++mi)
#pragma unroll
            for (int ni = 0; ni < 4; ++ni) acc[mi][ni] = __builtin_amdgcn_mfma_f32_16x16x32_bf16(af[mi], bfr[ni], acc[mi][ni], 0, 0, 0);
    }
}
template <bool BN>
DI void gemm_core(const bf16_t* __restrict__ A, int lda, const bf16_t* __restrict__ B, int ldb, int K, f32x4 (&acc)[4][4], bf16_t* smem) {
    const int tid = otid(), lane = tid & 63, wave = tid >> 6;
    const int wm = wave >> 1, wn = wave & 1;
#pragma unroll
    for (int mi = 0; mi < 4; ++mi)
#pragma unroll
        for (int ni = 0; ni < 4; ++ni) acc[mi][ni] = (f32x4){0.f, 0.f, 0.f, 0.f};
    const int nk = K >> 6;
    Stg r0, r1;
    __syncthreads();
    g_load<BN>(r0, A, lda, B, ldb, 0, tid);
    g_load<BN>(r1, A, lda, B, ldb, 1, tid);
    s_store<BN>(r0, smem, 0, tid);
    __syncthreads();
    for (int kt = 0; kt < nk; kt += 2) {
        if (kt + 2 < nk) g_load<BN>(r0, A, lda, B, ldb, kt + 2, tid);
        mma_tile(smem, 0, acc, wm, wn, lane);
        s_store<BN>(r1, smem, 1, tid);
        __syncthreads();
        if (kt + 3 < nk) g_load<BN>(r1, A, lda, B, ldb, kt + 3, tid);
        mma_tile(smem, 1, acc, wm, wn, lane);
        if (kt + 2 < nk) s_store<BN>(r0, smem, 0, tid);
        __syncthreads();
    }
}
#define GT_E (128 * 64)
DI void glds_tile(const bf16_t* __restrict__ G, int ld, int kt, bf16_t* lt, int tid) {
    const int c = (tid & 7) ^ ((tid >> 4) & 7);
    const bf16_t* g = G + (size_t)(tid >> 3) * ld + kt * 64 + c * 8;
    char* l = (char*)lt + tid * 16;
#pragma unroll
    for (int p = 0; p < 4; ++p)
        __builtin_amdgcn_global_load_lds((const unsigned*)(g + (size_t)(p * 32) * ld), (LAS unsigned*)(l + p * 4096), 16, 0, 0);
}
DI void mma_tile_sw(const bf16_t* smem, int buf, f32x4 (&acc)[4][4], int wm, int wn, int lane) {
    const char* a = (const char*)(smem + buf * 2 * GT_E);
    const char* b = a + GT_E * 2;
    const int sw = (lane & 15) >> 1;
#pragma unroll
    for (int kk = 0; kk < 2; ++kk) {
        bf16x8 af[4], bfr[4];
        const int co = ((kk * 4 + (lane >> 4)) ^ sw) << 4;
#pragma unroll
        for (int mi = 0; mi < 4; ++mi) af[mi] = *(const bf16x8*)(a + (wm * 64 + mi * 16 + (lane & 15)) * 128 + co);
#pragma unroll
        for (int ni = 0; ni < 4; ++ni) bfr[ni] = *(const bf16x8*)(b + (wn * 64 + ni * 16 + (lane & 15)) * 128 + co);
#pragma unroll
        for (int mi = 0; mi < 4; ++mi)
#pragma unroll
            for (int ni = 0; ni < 4; ++ni) acc[mi][ni] = __builtin_amdgcn_mfma_f32_16x16x32_bf16(af[mi], bfr[ni], acc[mi][ni], 0, 0, 0);
    }
}
DI void gemm_core_dma(const bf16_t* __restrict__ A, int lda, const bf16_t* __restrict__ B, int ldb, int K, f32x4 (&acc)[4][4], bf16_t* smem) {
    const int tid = otid(), lane = tid & 63, wave = tid >> 6;
    const int wm = wave >> 1, wn = wave & 1;
#pragma unroll
    for (int mi = 0; mi < 4; ++mi)
#pragma unroll
        for (int ni = 0; ni < 4; ++ni) acc[mi][ni] = (f32x4){0.f, 0.f, 0.f, 0.f};
    const int nk = K >> 6;
    __syncthreads();
    glds_tile(A, lda, 0, smem, tid);
    glds_tile(B, ldb, 0, smem + GT_E, tid);
    for (int kt = 0; kt < nk; ++kt) {
        asm volatile("s_waitcnt vmcnt(0)" ::: "memory");
        __syncthreads();
        if (kt + 1 < nk) {
            bf16_t* nb = smem + ((kt + 1) & 1) * 2 * GT_E;
            glds_tile(A, lda, kt + 1, nb, tid);
            glds_tile(B, ldb, kt + 1, nb + GT_E, tid);
        }
        mma_tile_sw(smem, kt & 1, acc, wm, wn, lane);
    }
    __syncthreads();
}
#define ST_LD 132
DI void stage_acc(f32x4 (&acc)[4][4], float* st) {
    const int lane = otid() & 63, wave = otid() >> 6, wm = wave >> 1, wn = wave & 1, fl = lane & 15, g4 = lane >> 4;
#pragma unroll
    for (int mi = 0; mi < 4; ++mi)
#pragma unroll
        for (int ni = 0; ni < 4; ++ni)
#pragma unroll
            for (int j = 0; j < 4; ++j) st[(wm * 64 + mi * 16 + g4 * 4 + j) * ST_LD + wn * 64 + ni * 16 + fl] = acc[mi][ni][j];
    __syncthreads();
}
DI void ld8(const float* q, float (&v)[8]) {
    const float4 a = *(const float4*)q, b = *(const float4*)(q + 4);
    v[0] = a.x; v[1] = a.y; v[2] = a.z; v[3] = a.w; v[4] = b.x; v[5] = b.y; v[6] = b.z; v[7] = b.w;
}
DI uint4 pack8(const float (&v)[8]) { return make_uint4(pack2(v[0], v[1]), pack2(v[2], v[3]), pack2(v[4], v[5]), pack2(v[6], v[7])); }
DI void unpack8(const uint4 u, float (&v)[8]) {
    v[0] = bflo(u.x); v[1] = bfhi(u.x); v[2] = bflo(u.y); v[3] = bfhi(u.y); v[4] = bflo(u.z); v[5] = bfhi(u.z); v[6] = bflo(u.w); v[7] = bfhi(u.w);
}

DI void phase0(const Params& p, float* smf) {
    const int tid = otid();
    unsigned char* ws = p.ws;
    float* modv = (float*)(ws + OFF_MODV);
    for (int it = blockIdx.x; it < 192; it += gridDim.x) {
        const int l = it / 96, n0 = (it % 96) * 32;
        __syncthreads();
        for (int i = tid; i < 3072; i += 256) {
            const int v = i >> 10, k = i & 1023;
            const float cv = (v == 0) ? p.c[k] : (v == 1) ? p.c[1024 + k] : p.c_ctx[k];
            smf[i] = silu_f(cv);
        }
        __syncthreads();
        const int col = tid & 31, kg = tid >> 5;
        float a0 = 0.f, a1 = 0.f, a2 = 0.f;
        const float* w = p.w_mod + (size_t)l * 1024 * 3072 + n0 + col;
#pragma unroll 16
        for (int kk = 0; kk < 128; ++kk) {
            const int k = kg * 128 + kk;
            const float wv = w[(size_t)k * 3072];
            a0 += smf[k] * wv; a1 += smf[1024 + k] * wv; a2 += smf[2048 + k] * wv;
        }
        __syncthreads();
        smf[3072 + (kg * 3 + 0) * 32 + col] = a0; smf[3072 + (kg * 3 + 1) * 32 + col] = a1; smf[3072 + (kg * 3 + 2) * 32 + col] = a2;
        __syncthreads();
        if (tid < 96) {
            const int v = tid >> 5, cc = tid & 31;
            float s = 0.f;
            for (int g = 0; g < 8; ++g) s += smf[3072 + (g * 3 + v) * 32 + cc];
            modv[(l * 3 + v) * 3072 + n0 + cc] = s + p.b_mod[l * 3072 + n0 + cc];
        }
    }
    {
        const int n_in = 2 * 16 * 44, n_out = 2 * 16 * 16;
        for (int it = blockIdx.x; it < n_in + n_out; it += gridDim.x) {
            const float* src; bf16_t* dst; int N, kt, nt;
            if (it < n_in) { const int l = it / 704, r = it % 704; kt = r / 44; nt = r % 44; N = DIN; src = p.w_in + (size_t)l * DM * DIN; dst = (bf16_t*)(ws + OFF_WTIN) + (size_t)l * DIN * DM; }
            else { const int j = it - n_in; const int l = j / 256, r = j % 256; kt = r / 16; nt = r % 16; N = DM; src = p.w_out + (size_t)l * DM * DM; dst = (bf16_t*)(ws + OFF_WTOUT) + (size_t)l * DM * DM; }
            __syncthreads();
#pragma unroll
            for (int ps = 0; ps < 4; ++ps) {
                const int kr = ps * 16 + (tid >> 4), c4 = (tid & 15) * 4;
                const float4 v = *(const float4*)(src + (size_t)(kt * 64 + kr) * N + nt * 64 + c4);
                smf[kr * 65 + c4 + 0] = v.x; smf[kr * 65 + c4 + 1] = v.y; smf[kr * 65 + c4 + 2] = v.z; smf[kr * 65 + c4 + 3] = v.w;
            }
            __syncthreads();
            const int n = tid >> 2, ks = (tid & 3) * 16;
            unsigned w[8];
#pragma unroll
            for (int e = 0; e < 8; ++e) w[e] = pack2(smf[(ks + 2 * e) * 65 + n], smf[(ks + 2 * e + 1) * 65 + n]);
            int ntd = nt;
            if (it < n_in && nt >= 20 && nt < 36) { const int grp = (nt - 20) >> 2, q4 = (nt - 20) & 3; ntd = (grp == 0) ? 28 + 2 * q4 : (grp == 1) ? 20 + 2 * q4 : (grp == 2) ? 21 + 2 * q4 : 29 + 2 * q4; }
            bf16_t* d = dst + (size_t)(ntd * 64 + n) * DM + kt * 64 + ks;
            *(uint4*)d = make_uint4(w[0], w[1], w[2], w[3]);
            *(uint4*)(d + 8) = make_uint4(w[4], w[5], w[6], w[7]);
        }
    }
    const int gtid = blockIdx.x * 256 + tid, gsz = gridDim.x * 256;
    {
        bf16_t* wc = (bf16_t*)(ws + OFF_WCOMB);
        __syncthreads();
        if (tid < 64) { smf[tid] = cospif((float)tid * (1.f / 32.f)); smf[64 + tid] = sinpif((float)tid * (1.f / 32.f)); }
        __syncthreads();
        for (int i = gtid; i < 2 * 512 * 256; i += gsz) {
            const int n = i & 255, kk = (i >> 8) & 511, l = i >> 17;
            const int c = kk >> 8, head = (kk >> 6) & 3, ch = kk & 63;
            const float* wf = p.w_fourier + (size_t)l * 65536 + (size_t)(head * 64) * 256 + n;
            float s = 0.f;
#pragma unroll 16
            for (int j = 0; j < 64; ++j) s += smf[c * 64 + ((j * ch) & 63)] * wf[j * 256];
            wc[(size_t)l * 131072 + n * 512 + kk] = f2bf(s);
        }
    }
    {
        bf16_t* wp = (bf16_t*)(ws + OFF_WPOOL);
        for (int i = gtid; i < 2 * 256 * 256; i += gsz) {
            const int k = i & 255, n = (i >> 8) & 255, l = i >> 16;
            float v = 0.f;
            if ((k >> 6) == (n >> 6)) v = p.pool_w[(size_t)l * 16384 + (n >> 6) * 4096 + (k & 63) * 64 + (n & 63)];
            wp[i] = f2bf(v);
        }
    }
    {
        float* tw = (float*)(ws + OFF_TW);
        for (int i = gtid; i < 8192; i += gsz) { const float a = (float)i * (1.f / 4096.f); tw[2 * i] = cospif(a); tw[2 * i + 1] = sinpif(a); }
        bf16_t* f1 = (bf16_t*)(ws + OFF_F1);
        for (int i = gtid; i < 256 * 128; i += gsz) {
            const int t1 = i & 127, m = i >> 7;
            const int k1 = (m >> 5) * 16 + (m & 15), c = (m >> 4) & 1;
            const float a = (float)((k1 * t1) & 127) * (1.f / 64.f);
            f1[i] = f2bf(c ? -sinpif(a) : cospif(a));
        }
        bf16_t* f2 = (bf16_t*)(ws + OFF_F2);
        for (int i = gtid; i < 128 * 128; i += gsz) {
            const int kx = i & 127, m = i >> 7;
            const int c = m >> 6, k2 = m & 63, cp = kx >> 6, t2 = kx & 63;
            const float a = (float)((k2 * t2) & 63) * (1.f / 32.f);
            float v;
            if (c == cp) v = cospif(a); else if (c == 0) v = sinpif(a); else v = -sinpif(a);
            f2[i] = f2bf(v);
        }
        bf16_t* fc = (bf16_t*)(ws + OFF_FC);
        for (int i = gtid; i < 512 * 256; i += gsz) {
            const int t = i & 255, m = i >> 8;
            const int c = m >> 8, k = m & 255;
            const float a = (float)((k * t) & 255) * (1.f / 128.f);
            fc[i] = f2bf(c ? -sinpif(a) : cospif(a));
        }
        float* rp = (float*)(ws + OFF_ROPE);
        for (int i = gtid; i < 3072; i += gsz) {
            const int f = i & 15;
            const int pos = (i < 2048) ? (i >> 4) : ((i - 2048) >> 4);
            const float inv = powf(10000.f, -(float)f * (1.f / 16.f));
            const float ang = (float)pos * inv;
            const double ad = (double)ang;
            const float cs = (float)cos(ad), sn = (float)sin(ad);
            if (i < 2048) { rp[i] = cs; rp[2048 + i] = sn; }
            else { rp[4096 + (i - 2048)] = cs; rp[5120 + (i - 2048)] = sn; }
        }
    }
}

DI void phase_norm(const Params& p, int l, const float* xl, const float* xc, const bf16_t* xlb) {
    const int lane = otid() & 63, wave = otid() >> 6;
    const float* modv = (const float*)(p.ws + OFF_MODV) + (size_t)l * 3 * 3072;
    const float* g = p.norm_g + l * 1024;
    bf16_t* H = (bf16_t*)(p.ws + OFF_H);
    for (int row = blockIdx.x * 4 + wave; row < ROWS; row += gridDim.x * 4) {
        const float* src = (row < ROWS_L) ? xl + (size_t)row * DM : xc + (size_t)(row - ROWS_L) * DM;
        const int v = (row < ROWS_L) ? (row >> 13) : 2;
        const float* mv = modv + v * 3072;
        float4 a[4];
        float ss = 0.f;
        if (xlb != nullptr && row < ROWS_L) {
            const bf16_t* sb = xlb + (size_t)row * DM;
#pragma unroll
            for (int i = 0; i < 4; ++i) { const uint2 u = *(const uint2*)(sb + i * 256 + lane * 4); a[i] = make_float4(bflo(u.x), bfhi(u.x), bflo(u.y), bfhi(u.y)); }
        } else {
#pragma unroll
            for (int i = 0; i < 4; ++i) a[i] = *(const float4*)(src + i * 256 + lane * 4);
        }
#pragma unroll
        for (int i = 0; i < 4; ++i) ss += a[i].x * a[i].x + a[i].y * a[i].y + a[i].z * a[i].z + a[i].w * a[i].w;
#pragma unroll
        for (int o = 32; o >= 1; o >>= 1) ss += __shfl_xor(ss, o);
        const float rs = rsqrtf(ss * (1.f / 1024.f) + 1e-6f);
#pragma unroll
        for (int i = 0; i < 4; ++i) {
            const int c0 = i * 256 + lane * 4;
            const float4 gg = *(const float4*)(g + c0), sh = *(const float4*)(mv + c0), sc = *(const float4*)(mv + 1024 + c0);
            const float o0 = a[i].x * rs * gg.x * (1.f + sc.x) + sh.x, o1 = a[i].y * rs * gg.y * (1.f + sc.y) + sh.y;
            const float o2 = a[i].z * rs * gg.z * (1.f + sc.z) + sh.z, o3 = a[i].w * rs * gg.w * (1.f + sc.w) + sh.w;
            *(uint2*)(H + (size_t)row * DM + c0) = make_uint2(pack2(o0, o1), pack2(o2, o3));
        }
    }
}

DI void epi_inproj(const Params& p, int l, int tm, int tn, f32x4 (&acc)[4][4], float* st) {
    const int tid = otid();
    unsigned char* ws = p.ws;
    stage_acc(acc, st);
    const int rbase = tm * 128;
    const bool isctx = rbase >= ROWS_L;
    if (tn < 3) {
        const bool isq = tn < 2;
        const float* gain = (isq ? p.q_gain : p.k_gain) + l * 64;
        const float* rp = (const float*)(ws + OFF_ROPE);
#pragma unroll 1
        for (int i = 0; i < 8; ++i) {
            const int q = tid + 256 * i, rl = q >> 4, c8 = (q & 15) * 8;
            const int row = rbase + rl, hd = c8 >> 6, d0 = c8 & 63;
            float v[8], pv[8], g[8], pg[8];
            ld8(st + rl * ST_LD + c8, v);
            ld8(st + rl * ST_LD + (c8 ^ 16), pv);
            ld8(gain + d0, g);
            ld8(gain + (d0 ^ 16), pg);
            float ss = 0.f;
#pragma unroll
            for (int e = 0; e < 8; ++e) ss += v[e] * v[e];
            ss += __shfl_xor(ss, 1); ss += __shfl_xor(ss, 2); ss += __shfl_xor(ss, 4);
            const float rs = rsqrtf(ss * (1.f / 64.f) + 1e-6f);
#pragma unroll
            for (int e = 0; e < 8; ++e) { v[e] *= rs * g[e]; pv[e] *= rs * pg[e]; }
            bf16_t* dst;
            if (!isctx) {
                const int b = row >> 13, t = row & 8191;
                const int pos = (d0 >= 32) ? (t & 63) : (t >> 6);
                const float* ct = rp + ((d0 >= 32) ? 4096 : 0) + pos * 16 + (d0 & 8);
                float cs[8], sn[8];
                ld8(ct, cs);
                ld8(ct + ((d0 >= 32) ? 1024 : 2048), sn);
                const float sg = (d0 & 16) ? 1.f : -1.f;
#pragma unroll
                for (int e = 0; e < 8; ++e) v[e] = v[e] * cs[e] + sg * pv[e] * sn[e];
                if (isq) dst = (bf16_t*)(ws + OFF_Q) + ((size_t)(b * 4 + tn * 2 + hd) * SEQ + t) * 64 + d0;
                else     dst = (bf16_t*)(ws + OFF_K) + ((size_t)(b * 2 + hd) * NKEY + CTX + t) * 64 + d0;
            } else {
                const int rc = row - ROWS_L, b = rc >> 8, t = rc & 255;
                if (isq) dst = (bf16_t*)(ws + OFF_QC) + ((size_t)(b * 4 + tn * 2 + hd) * CTX + t) * 64 + d0;
                else     dst = (bf16_t*)(ws + OFF_K) + ((size_t)(b * 2 + hd) * NKEY + t) * 64 + d0;
            }
            if (isq) {
#pragma unroll
                for (int e = 0; e < 8; ++e) v[e] *= 0.18033688011112042f;
            }
            *(uint4*)dst = pack8(v);
        }
    } else if (tn == 3) {
        int b, key0;
        if (!isctx) { b = rbase >> 13; key0 = CTX + (rbase & 8191); } else { const int rc = rbase - ROWS_L; b = rc >> 8; key0 = rc & 255; }
#pragma unroll 1
        for (int i = 0; i < 8; ++i) {
            const int q = tid + 256 * i, col = q & 127, r8 = (q >> 7) * 8;
            float v[8];
#pragma unroll
            for (int e = 0; e < 8; ++e) v[e] = st[(r8 + e) * ST_LD + col];
            bf16_t* vt = (bf16_t*)(ws + OFF_VT) + ((size_t)(b * 2 + (col >> 6)) * 64 + (col & 63)) * NKEY + key0 + r8;
            *(uint4*)vt = pack8(v);
        }
    } else {
        bf16_t* parts = (bf16_t*)(ws + OFF_PARTS);
        if (tn >= 10 && tn < 18) {
            const bool isg = tn >= 14;
            const int dcol = (isg ? PC_GC + (tn - 14) * 64 : PC_T + (tn - 10) * 64);
#pragma unroll 1
            for (int i = 0; i < 4; ++i) {
                const int q = tid + 256 * i, rl = q >> 3, c8 = (q & 7) * 8;
                float v[8], w[8];
                ld8(st + rl * ST_LD + c8, v);
                ld8(st + rl * ST_LD + 64 + c8, w);
#pragma unroll
                for (int e = 0; e < 8; ++e) v[e] = isg ? silu_f(w[e]) * v[e] : v[e] * w[e];
                *(uint4*)(parts + (size_t)(rbase + rl) * PW + dcol + c8) = pack8(v);
            }
        } else {
            const int dbase = (tn < 10) ? tn * 128 - 512 : PC_UP + (tn - 18) * 128;
#pragma unroll 1
            for (int i = 0; i < 8; ++i) {
                const int q = tid + 256 * i, rl = q >> 4, c8 = (q & 15) * 8;
                float v[8];
                ld8(st + rl * ST_LD + c8, v);
                *(uint4*)(parts + (size_t)(rbase + rl) * PW + dbase + c8) = pack8(v);
            }
        }
    }
}

DI void phase_inproj(const Params& p, int l, bf16_t* smem) {
    const bf16_t* H = (const bf16_t*)(p.ws + OFF_H);
    const bf16_t* W = (const bf16_t*)(p.ws + OFF_WTIN) + (size_t)l * DIN * DM;
    const int nlat = 128 * 22;
    const int ntiles = nlat + (l == 0 ? 4 * 22 : 4 * 2);
    for (XIter t = xiter(ntiles); t.u < t.end; t.u += t.step) {
        const int u = t.u;
        int tm, tn;
        if (u < nlat) { const int ch = u / 176, r = u % 176; tn = r >> 3; tm = ch * 8 + (r & 7); }
        else { const int j = u - nlat; tm = 128 + (j & 3); tn = (l == 0 ? 0 : 2) + (j >> 2); }
        f32x4 acc[4][4];
        gemm_core_dma(H + (size_t)tm * 128 * DM, DM, W + (size_t)tn * 128 * DM, DM, DM, acc, smem);
        epi_inproj(p, l, tm, tn, acc, (float*)smem);
    }
}

#define KT_E (64 * LROW)
DI void attn_item(const Params& p, const bf16_t* Qb, const bf16_t* Kb, const bf16_t* VTb, int ntiles, int rowbase, int hq, bf16_t* smem) {
    const int tid = otid(), lane = tid & 63, wave = tid >> 6;
    const int r = lane & 31, h = lane >> 5;
    const float LOG2E = 1.4426950408889634f;
    bf16x8 qf[4];
    {
        const bf16_t* qrow = Qb + (size_t)(wave * 32 + r) * 64;
#pragma unroll
        for (int s = 0; s < 4; ++s) qf[s] = *(const bf16x8*)(qrow + s * 16 + h * 8);
    }
    f32x16 ot[2], zacc;
#pragma unroll
    for (int i = 0; i < 16; ++i) { ot[0][i] = 0.f; ot[1][i] = 0.f; zacc[i] = 0.f; }
    float m = 0.f, lsum = 0.f;
    bool stab = false;
    uint4 rk[2], rv[2];
    auto gload = [&](int kt) {
#pragma unroll
        for (int i = 0; i < 2; ++i) {
            const int q = tid + 256 * i;
            rk[i] = *(const uint4*)(Kb + (size_t)(kt * 64 + (q >> 3)) * 64 + (q & 7) * 8);
            rv[i] = *(const uint4*)(VTb + (size_t)(q >> 3) * NKEY + kt * 64 + (q & 7) * 8);
        }
    };
    auto sstore = [&](int buf) {
        bf16_t* sk = smem + buf * 2 * KT_E;
        bf16_t* sv = sk + KT_E;
#pragma unroll
        for (int i = 0; i < 2; ++i) {
            const int q = tid + 256 * i;
            *(uint4*)(sk + (q >> 3) * LROW + (q & 7) * 8) = rk[i];
            *(uint4*)(sv + (q >> 3) * LROW + (q & 7) * 8) = rv[i];
        }
    };
    __syncthreads();
    gload(0);
    sstore(0);
    __syncthreads();
    for (int kt = 0; kt < ntiles; ++kt) {
        if (kt + 1 < ntiles) gload(kt + 1);
        const bf16_t* sk = smem + (kt & 1) * 2 * KT_E;
        const bf16_t* sv = sk + KT_E;
        f32x16 st[2], pe[2];
#pragma unroll
        for (int blk = 0; blk < 2; ++blk) {
            st[blk] = __builtin_amdgcn_mfma_f32_32x32x16_bf16(*(const bf16x8*)(sk + (blk * 32 + r) * LROW + h * 8), qf[0], zacc, 0, 0, 0);
#pragma unroll
            for (int s = 1; s < 4; ++s)
                st[blk] = __builtin_amdgcn_mfma_f32_32x32x16_bf16(*(const bf16x8*)(sk + (blk * 32 + r) * LROW + s * 16 + h * 8), qf[s], st[blk], 0, 0, 0);
        }
        if (stab) {
#pragma unroll
            for (int i = 0; i < 16; ++i) { st[0][i] -= m; st[1][i] -= m; }
        }
        float ls = 0.f;
#pragma unroll
        for (int i = 0; i < 16; ++i) {
            pe[0][i] = __builtin_amdgcn_exp2f(st[0][i]); ls += pe[0][i];
            pe[1][i] = __builtin_amdgcn_exp2f(st[1][i]); ls += pe[1][i];
        }
        if (__any(!(ls <= 1.0e12f) || (ls < 1.0e-25f))) {
            float tmx = st[0][0];
#pragma unroll
            for (int i = 0; i < 16; ++i) { tmx = fmaxf(tmx, st[0][i]); tmx = fmaxf(tmx, st[1][i]); }
            tmx = fmaxf(tmx, __shfl_xor(tmx, 32));
            const float lrow = lsum + __shfl_xor(lsum, 32);
            const bool rebase = !(lrow >= 1.0e-20f);
            const float delta = rebase ? tmx : fmaxf(tmx, 0.f);
            const float alpha = rebase ? 0.f : __builtin_amdgcn_exp2f(-delta);
            m += delta;
            stab = true;
            lsum *= alpha;
            ls = 0.f;
#pragma unroll
            for (int i = 0; i < 16; ++i) {
                ot[0][i] *= alpha; ot[1][i] *= alpha;
                pe[0][i] = __builtin_amdgcn_exp2f(st[0][i] - delta); ls += pe[0][i];
                pe[1][i] = __builtin_amdgcn_exp2f(st[1][i] - delta); ls += pe[1][i];
            }
        }
        lsum += ls;
        bf16x8 pk[2][2];
#pragma unroll
        for (int blk = 0; blk < 2; ++blk)
#pragma unroll
            for (int s = 0; s < 2; ++s) {
                uint4 u;
                u.x = pack2(pe[blk][8 * s + 0], pe[blk][8 * s + 1]); u.y = pack2(pe[blk][8 * s + 2], pe[blk][8 * s + 3]);
                u.z = pack2(pe[blk][8 * s + 4], pe[blk][8 * s + 5]); u.w = pack2(pe[blk][8 * s + 6], pe[blk][8 * s + 7]);
                pk[blk][s] = __builtin_bit_cast(bf16x8, u);
            }
#pragma unroll
        for (int db = 0; db < 2; ++db)
#pragma unroll
            for (int blk = 0; blk < 2; ++blk)
#pragma unroll
                for (int s = 0; s < 2; ++s) {
                    const bf16_t* vp = sv + (db * 32 + r) * LROW + blk * 32 + s * 16 + h * 4;
                    const bf16x4 lo = *(const bf16x4*)vp;
                    const bf16x4 hi = *(const bf16x4*)(vp + 8);
                    const bf16x8 vf = __builtin_shufflevector(lo, hi, 0, 1, 2, 3, 4, 5, 6, 7);
                    ot[db] = __builtin_amdgcn_mfma_f32_32x32x16_bf16(vf, pk[blk][s], ot[db], 0, 0, 0);
                }
        if (kt + 1 < ntiles) sstore((kt + 1) & 1);
        __syncthreads();
    }
    lsum += __shfl_xor(lsum, 32);
    const float inv = 1.f / lsum;
    const int row = rowbase + wave * 32 + r;
    const bf16_t* zrow = (const bf16_t*)(p.ws + OFF_PARTS) + (size_t)row * PW + PC_ZATT + hq * 64;
    bf16_t* orow = (bf16_t*)(p.ws + OFF_H) + (size_t)row * DM + 256 + hq * 64;
#pragma unroll
    for (int db = 0; db < 2; ++db)
#pragma unroll
        for (int g = 0; g < 4; ++g) {
            const int d = db * 32 + g * 8 + h * 4;
            const uint2 z = *(const uint2*)(zrow + d);
            const float o0 = silu_f(bflo(z.x)) * ot[db][4 * g + 0] * inv, o1 = silu_f(bfhi(z.x)) * ot[db][4 * g + 1] * inv;
            const float o2 = silu_f(bflo(z.y)) * ot[db][4 * g + 2] * inv, o3 = silu_f(bfhi(z.y)) * ot[db][4 * g + 3] * inv;
            *(uint2*)(orow + d) = make_uint2(pack2(o0, o1), pack2(o2, o3));
        }
}

DI void phase_attn(const Params& p, int l, bf16_t* smem) {
    const bf16_t* Q = (const bf16_t*)(p.ws + OFF_Q);
    const bf16_t* QC = (const bf16_t*)(p.ws + OFF_QC);
    const bf16_t* Kk = (const bf16_t*)(p.ws + OFF_K);
    const bf16_t* VT = (const bf16_t*)(p.ws + OFF_VT);
    for (XIter t = xiter(512); t.u < t.end; t.u += t.step) {
        const int it = t.u;
        const int b = it >> 8, hq = (it >> 6) & 3, qt = it & 63;
        const size_t kv = (size_t)(b * 2 + (hq >> 1));
        attn_item(p, Q + ((size_t)(b * 4 + hq) * SEQ + qt * 128) * 64, Kk + kv * NKEY * 64, VT + kv * 64 * NKEY, NKEY / 64, b * SEQ + qt * 128, hq, smem);
    }
    if (l == 0) {
        for (int j = blockIdx.x; j < 16; j += gridDim.x) {
            const int b = j >> 3, hq = (j >> 1) & 3, qt = j & 1;
            const size_t kv = (size_t)(b * 2 + (hq >> 1));
            attn_item(p, QC + ((size_t)(b * 4 + hq) * CTX + qt * 128) * 64, Kk + kv * NKEY * 64, VT + kv * 64 * NKEY, CTX / 64, ROWS_L + b * CTX + qt * 128, hq, smem);
        }
    }
}

template <int W>
DI void pool_task(const bf16_t* __restrict__ pu, int pos, int n, bf16_t* __restrict__ dst) {
    constexpr int LEFT = W / 2;
    uint4 raw[W];
#pragma unroll
    for (int t = 0; t < W; ++t) { int q = pos - LEFT + t; q = q < 0 ? 0 : (q >= n ? n - 1 : q); raw[t] = *(const uint4*)(pu + (size_t)q * PW); }
    float sum[8], u[8];
#pragma unroll
    for (int e = 0; e < 8; ++e) sum[e] = 0.f;
#pragma unroll
    for (int t = 0; t < W; ++t) {
        const int q = pos - LEFT + t;
        const float mk = (q >= 0 && q < n) ? 1.f : 0.f;
        unpack8(raw[t], u);
#pragma unroll
        for (int e = 0; e < 8; ++e) sum[e] += mk * u[e];
    }
    const int lo = max(pos - LEFT, 0), hi = min(pos + W - LEFT, n);
    const float ic = 1.f / (float)(hi - lo);
    unpack8(raw[LEFT], u);
#pragma unroll
    for (int e = 0; e < 8; ++e) sum[e] = sum[e] * ic - u[e];
    *(uint4*)dst = pack8(sum);
}
DI void phase_convpool(const Params& p, int l) {
    const bf16_t* __restrict__ parts = (const bf16_t*)(p.ws + OFF_PARTS);
    bf16_t* __restrict__ cat = (bf16_t*)(p.ws + OFF_H);
    bf16_t* __restrict__ dbuf = (bf16_t*)(p.ws + OFF_DBUF);
    const int nrows = (l == 0 ? ROWS : ROWS_L);
    const int gsz = gridDim.x * 256, gt = blockIdx.x * 256 + otid();
    {
        const int c8 = (gt & 31) * 8;
        float w0[8], w1[8], w2[8], bs[8];
        ld8(p.conv_w + l * 768 + c8, w0); ld8(p.conv_w + l * 768 + 256 + c8, w1); ld8(p.conv_w + l * 768 + 512 + c8, w2); ld8(p.conv_b + l * 256 + c8, bs);
        for (int i = gt; i < nrows * 32; i += gsz) {
            const int row = i >> 5;
            int seq0, n;
            if (row < ROWS_L) { seq0 = (row >> 13) << 13; n = SEQ; } else { seq0 = ROWS_L + (((row - ROWS_L) >> 8) << 8); n = CTX; }
            const int pos = row - seq0;
            const bf16_t* pr = parts + (size_t)row * PW + c8;
            const bool hp = pos > 0, hn = pos + 1 < n;
            const bf16_t* pp = hp ? pr - PW : pr;
            const bf16_t* pn = hn ? pr + PW : pr;
            const uint4 r0 = *(const uint4*)(pr + PC_T), r2 = *(const uint4*)(pp + PC_T), r4 = *(const uint4*)(pn + PC_T), r6 = *(const uint4*)(pr + PC_GC);
            const float mp = hp ? 1.f : 0.f, mn = hn ? 1.f : 0.f;
            float tc[8], tp[8], tn[8], gg[8], o[8];
            unpack8(r0, tc); unpack8(r2, tp); unpack8(r4, tn); unpack8(r6, gg);
#pragma unroll
            for (int e = 0; e < 8; ++e) o[e] = gg[e] * (mp * tp[e] * w0[e] + tc[e] * w1[e] + mn * tn[e] * w2[e] + bs[e]);
            *(uint4*)(cat + (size_t)row * DM + 512 + c8) = pack8(o);
        }
    }
    for (int j = gt; j < nrows * 32; j += gsz) {
        const int g = j / (nrows * 8), rem = j - g * (nrows * 8), row = rem >> 3, c8 = g * 64 + (rem & 7) * 8;
        int seq0, n;
        if (row < ROWS_L) { seq0 = (row >> 13) << 13; n = SEQ; } else { seq0 = ROWS_L + (((row - ROWS_L) >> 8) << 8); n = CTX; }
        const bf16_t* pu = parts + (size_t)seq0 * PW + PC_UP + c8;
        bf16_t* dst = dbuf + (size_t)row * 256 + c8;
        const int pos = row - seq0;
        if (g == 0) pool_task<2>(pu, pos, n, dst);
        else if (g == 1) pool_task<4>(pu, pos, n, dst);
        else if (g == 2) pool_task<8>(pu, pos, n, dst);
        else pool_task<16>(pu, pos, n, dst);
    }
}

DI void phase_dft1(const Params& p, int l, bf16_t* smem) {
    const int tid = otid();
    float* st = (float*)smem;
    const bf16_t* parts = (const bf16_t*)(p.ws + OFF_PARTS);
    const bf16_t* F1 = (const bf16_t*)(p.ws + OFF_F1);
    const bf16_t* FC = (const bf16_t*)(p.ws + OFF_FC);
    const float* tw = (const float*)(p.ws + OFF_TW);
    bf16_t* G1 = (bf16_t*)(p.ws + OFF_G1);
    bf16_t* pcat = (bf16_t*)(p.ws + OFF_PCAT);
    const int nt1 = 2 * 64 * 4;
    const int ntot = nt1 + (l == 0 ? 16 : 0);
    for (int it = blockIdx.x; it < ntot; it += gridDim.x) {
        f32x4 acc[4][4];
        if (it < nt1) {
            const int b = it >> 8, t2 = (it >> 2) & 63, mt = (it >> 1) & 1, nt = it & 1;
            gemm_core<true>(F1 + (size_t)mt * 128 * 128, 128, parts + (size_t)(b * SEQ + t2) * PW + PC_UF + nt * 128, 64 * PW, 128, acc, smem);
            stage_acc(acc, st);
#pragma unroll 1
            for (int i = 0; i < 4; ++i) {
                const int q = tid + 256 * i, kk = q >> 4, c8 = (q & 15) * 8;
                const int rr = 32 * (kk >> 4) + (kk & 15);
                const int k1 = mt * 64 + kk;
                const float cs = tw[2 * (k1 * t2)], sn = tw[2 * (k1 * t2) + 1];
                float gr[8], gi[8], o[8];
                ld8(st + rr * ST_LD + c8, gr);
                ld8(st + (rr + 16) * ST_LD + c8, gi);
                bf16_t* dr = G1 + ((size_t)((b * 128 + k1) * 2 + 0) * 64 + t2) * 256 + nt * 128 + c8;
#pragma unroll
                for (int e = 0; e < 8; ++e) o[e] = gr[e] * cs + gi[e] * sn;
                *(uint4*)dr = pack8(o);
#pragma unroll
                for (int e = 0; e < 8; ++e) o[e] = gi[e] * cs - gr[e] * sn;
                *(uint4*)(dr + (size_t)64 * 256) = pack8(o);
            }
        } else {
            const int j0 = it - nt1, b = j0 >> 3, mt = (j0 >> 1) & 3, nt = j0 & 1;
            gemm_core<true>(FC + (size_t)mt * 128 * 256, 256, parts + (size_t)(ROWS_L + b * CTX) * PW + PC_UF + nt * 128, PW, 256, acc, smem);
            stage_acc(acc, st);
#pragma unroll 1
            for (int i = 0; i < 8; ++i) {
                const int q = tid + 256 * i, rl = q >> 4, c8 = (q & 15) * 8;
                const int m = mt * 128 + rl, c = m >> 8, k = m & 255;
                float v[8];
                ld8(st + rl * ST_LD + c8, v);
                *(uint4*)(pcat + (size_t)(ROWS_L + b * CTX + k) * 512 + c * 256 + nt * 128 + c8) = pack8(v);
            }
        }
    }
}

DI void phase_dft2_mixp(const Params& p, int l, bf16_t* smem, int item_lo, int item_hi, int blk0, int nblk) {
    const int tid = otid();
    float* st = (float*)smem;
    const bf16_t* F2 = (const bf16_t*)(p.ws + OFF_F2);
    const bf16_t* G1 = (const bf16_t*)(p.ws + OFF_G1);
    bf16_t* pcat = (bf16_t*)(p.ws + OFF_PCAT);
    const bf16_t* dbuf = (const bf16_t*)(p.ws + OFF_DBUF);
    const bf16_t* wp = (const bf16_t*)(p.ws + OFF_WPOOL) + (size_t)l * 65536;
    const bf16_t* parts = (const bf16_t*)(p.ws + OFF_PARTS);
    bf16_t* cat = (bf16_t*)(p.ws + OFF_H);
    const int nt2 = 2 * 128 * 2;
    const int nmt = (l == 0 ? ROWS : ROWS_L) / 128;
    (void)nmt;
    if ((int)blockIdx.x < blk0) return;
    for (int it = item_lo + ((int)blockIdx.x - blk0); it < item_hi; it += nblk) {
        f32x4 acc[4][4];
        if (it < nt2) {
            const int b = it >> 8, k1 = (it >> 1) & 127, nt = it & 1;
            gemm_core<true>(F2, 128, G1 + (size_t)(b * 128 + k1) * 128 * 256 + nt * 128, 256, 128, acc, smem);
            stage_acc(acc, st);
#pragma unroll 1
            for (int i = 0; i < 8; ++i) {
                const int q = tid + 256 * i, m = q >> 4, c8 = (q & 15) * 8;
                const int c = m >> 6, k2 = m & 63;
                float v[8];
                ld8(st + m * ST_LD + c8, v);
                *(uint4*)(pcat + (size_t)(b * SEQ + k1 + 128 * k2) * 512 + c * 256 + nt * 128 + c8) = pack8(v);
            }
        } else {
            const int j0 = it - nt2, tm = j0 >> 1, nt = j0 & 1;
            gemm_core_dma(dbuf + (size_t)tm * 128 * 256 + nt * 128, 256, wp + (size_t)(nt * 128) * 256 + nt * 128, 256, 128, acc, smem);
            stage_acc(acc, st);
            {
                const int c8 = (tid & 15) * 8, r0 = tid >> 4, n = nt * 128 + c8;
                float ps[8];
                ld8(p.pool_scale + l * 256 + n, ps);
                uint4 zr[8];
#pragma unroll
                for (int i = 0; i < 8; ++i) zr[i] = *(const uint4*)(parts + (size_t)(tm * 128 + r0 + 16 * i) * PW + PC_ZP + n);
#pragma unroll
                for (int i = 0; i < 8; ++i) {
                    float v[8], z[8];
                    ld8(st + (r0 + 16 * i) * ST_LD + c8, v);
                    unpack8(zr[i], z);
#pragma unroll
                    for (int e = 0; e < 8; ++e) v[e] = silu_f(z[e]) * ps[e] * v[e];
                    *(uint4*)(cat + (size_t)(tm * 128 + r0 + 16 * i) * DM + 768 + n) = pack8(v);
                }
            }
        }
    }
}

DI void phase_mixf(const Params& p, int l, bf16_t* smem) {
    const int tid = otid();
    float* st = (float*)smem;
    const bf16_t* pcat = (const bf16_t*)(p.ws + OFF_PCAT);
    const bf16_t* wc = (const bf16_t*)(p.ws + OFF_WCOMB) + (size_t)l * 131072;
    const bf16_t* parts = (const bf16_t*)(p.ws + OFF_PARTS);
    bf16_t* cat = (bf16_t*)(p.ws + OFF_H);
    const int nmt = (l == 0 ? ROWS : ROWS_L) / 128;
    for (int it = blockIdx.x; it < nmt * 2; it += gridDim.x) {
        const int tm = it >> 1, nt = it & 1;
        f32x4 acc[4][4];
        gemm_core_dma(pcat + (size_t)tm * 128 * 512, 512, wc + (size_t)(nt * 128) * 512, 512, 512, acc, smem);
        stage_acc(acc, st);
        const float sc = (tm < 128) ? 0.001381067932004976f : 0.0078125f;
        {
            const int c8 = (tid & 15) * 8, r0 = tid >> 4, n = nt * 128 + c8;
            uint4 zr[8];
#pragma unroll
            for (int i = 0; i < 8; ++i) zr[i] = *(const uint4*)(parts + (size_t)(tm * 128 + r0 + 16 * i) * PW + PC_ZF + n);
#pragma unroll
            for (int i = 0; i < 8; ++i) {
                float v[8], z[8];
                ld8(st + (r0 + 16 * i) * ST_LD + c8, v);
                unpack8(zr[i], z);
#pragma unroll
                for (int e = 0; e < 8; ++e) v[e] = silu_f(z[e]) * sc * v[e];
                *(uint4*)(cat + (size_t)(tm * 128 + r0 + 16 * i) * DM + n) = pack8(v);
            }
        }
    }
}

DI void phase_out(const Params& p, int l, const float* xl_in, const float* xc_in, float* xl_out, float* xc_out, bf16_t* smem) {
    const int tid = otid();
    float* st = (float*)smem;
    const bf16_t* cat = (const bf16_t*)(p.ws + OFF_H);
    const bf16_t* W = (const bf16_t*)(p.ws + OFF_WTOUT) + (size_t)l * DM * DM;
    const float* modv = (const float*)(p.ws + OFF_MODV) + (size_t)l * 3 * 3072;
    const int nmt = (l == 0 ? ROWS : ROWS_L) / 128;
    for (XIter t = xiter(nmt * 8); t.u < t.end; t.u += t.step) {
        int tm, tn;
        if (t.u < 1024) { const int ch = t.u >> 6, r = t.u & 63; tn = r >> 3; tm = ch * 8 + (r & 7); }
        else { const int j = t.u - 1024; tn = j >> 2; tm = 128 + (j & 3); }
        f32x4 acc[4][4];
        gemm_core_dma(cat + (size_t)tm * 128 * DM, DM, W + (size_t)tn * 128 * DM, DM, DM, acc, smem);
        stage_acc(acc, st);
        const int rb = tm * 128;
        const int v = (rb < ROWS_L) ? (rb >> 13) : 2;
        const float* gate = modv + v * 3072 + 2048;
        const float* xin = (rb < ROWS_L) ? xl_in : xc_in - (size_t)ROWS_L * DM;
        float* xout = (rb < ROWS_L) ? xl_out : xc_out - (size_t)ROWS_L * DM;
        {
            const int c8 = (tid & 15) * 8, r0 = tid >> 4;
            const size_t o0 = (size_t)(rb + r0) * DM + tn * 128 + c8;
            float gt[8];
            ld8(gate + tn * 128 + c8, gt);
            const bool lat = rb < ROWS_L;
            bf16_t* x1b = (bf16_t*)(p.ws + OFF_X1B);
            float4 x0[8], x1[8];
            if (lat && l == 1) {
#pragma unroll
                for (int i = 0; i < 8; ++i) { const uint4 u = *(const uint4*)(x1b + o0 + (size_t)i * 16 * DM);
                    x0[i] = make_float4(bflo(u.x), bfhi(u.x), bflo(u.y), bfhi(u.y)); x1[i] = make_float4(bflo(u.z), bfhi(u.z), bflo(u.w), bfhi(u.w)); }
            } else {
#pragma unroll
                for (int i = 0; i < 8; ++i) { x0[i] = *(const float4*)(xin + o0 + (size_t)i * 16 * DM); x1[i] = *(const float4*)(xin + o0 + (size_t)i * 16 * DM + 4); }
            }
#pragma unroll
            for (int i = 0; i < 8; ++i) {
                float a[8];
                ld8(st + (r0 + 16 * i) * ST_LD + c8, a);
                const float y0 = x0[i].x + gt[0] * a[0], y1 = x0[i].y + gt[1] * a[1], y2 = x0[i].z + gt[2] * a[2], y3 = x0[i].w + gt[3] * a[3];
                const float y4 = x1[i].x + gt[4] * a[4], y5 = x1[i].y + gt[5] * a[5], y6 = x1[i].z + gt[6] * a[6], y7 = x1[i].w + gt[7] * a[7];
                if (lat && l == 0) {
                    *(uint4*)(x1b + o0 + (size_t)i * 16 * DM) = make_uint4(pack2(y0, y1), pack2(y2, y3), pack2(y4, y5), pack2(y6, y7));
                } else {
                    float* d = xout + o0 + (size_t)i * 16 * DM;
                    *(float4*)(d) = make_float4(y0, y1, y2, y3);
                    *(float4*)(d + 4) = make_float4(y4, y5, y6, y7);
                }
            }
        }
    }
}

#ifndef PH_MASK
#define PH_MASK 0xFFFF
#endif
#ifndef PH_DUP
#define PH_DUP 0
#endif
__global__ void __launch_bounds__(256, 2) fwd_megakernel(Params p) {
    __shared__ __attribute__((aligned(16))) unsigned char smem_raw[SMEM_BYTES];
    bf16_t* smem = (bf16_t*)smem_raw;
    float* smf = (float*)smem_raw;
    volatile LAS unsigned* stw = (volatile LAS unsigned*)(smem_raw + SMEM_MAIN);
    if (threadIdx.x == 0) { stw[0] = 0u; stw[1] = 0u; stw[2] = 0u; stw[3] = 0u; }
    __syncthreads();
    if (p.never) cg::this_grid().sync();
    XcdBarrier bar = xcd_barrier_post((unsigned*)(p.ws + OFF_BAR), stw);

    if (PH_MASK & 1) phase0(p, smf);
    if (PH_DUP & 1) phase0(p, smf);
    xcd_barrier(bar);
    float* xc1 = (float*)(p.ws + OFF_XC1);
    for (int l = 0; l < 2; ++l) {
        const float* xl_in = (l == 0) ? p.x : p.out;
        const float* xc_in = (l == 0) ? p.ctx : xc1;
        if (PH_MASK & 2) phase_norm(p, l, xl_in, xc_in, (l == 1) ? (const bf16_t*)(p.ws + OFF_X1B) : nullptr);
        xcd_barrier(bar);
        if (PH_MASK & 4) phase_inproj(p, l, smem);
        if (PH_DUP & 4) phase_inproj(p, l, smem);
        xcd_barrier(bar);
        if (PH_MASK & 8) phase_attn(p, l, smem);
        if (PH_DUP & 8) phase_attn(p, l, smem);
        if (PH_MASK & 16) phase_convpool(p, l);
        if (PH_DUP & 16) phase_convpool(p, l);
        if (PH_MASK & 32) phase_dft1(p, l, smem);
        if (PH_DUP & 32) phase_dft1(p, l, smem);
        xcd_barrier(bar);
        if (PH_MASK & 64) phase_dft2_mixp(p, l, smem, 0, 512, 0, gridDim.x);
        xcd_barrier(bar);
        {
            const int nmix = (l == 0 ? ROWS : ROWS_L) / 64;
            const int b0 = ((int)gridDim.x > nmix) ? nmix : 0;
            if (PH_MASK & 128) phase_mixf(p, l, smem);
            if (PH_MASK & 64) phase_dft2_mixp(p, l, smem, 512, 512 + nmix, b0, (int)gridDim.x - b0);
        }
        xcd_barrier(bar);
        if (PH_MASK & 256) phase_out(p, l, xl_in, xc_in, p.out, xc1, smem);
        if (PH_DUP & 256) phase_out(p, l, xl_in, xc_in, (float*)(p.ws + OFF_G1), (float*)(p.ws + OFF_G1), smem);
        if (l == 0) xcd_barrier(bar);
    }
}

extern "C" void kernel_launch(void* const* d_in, const int* in_sizes, int n_in, void* d_out, int out_size, void* d_ws, size_t ws_size, hipStream_t stream) {
    static int grid_blocks = 0;
    if (!grid_blocks) {
        int dev = 0, cus = 0, per_cu = 0;
        hipGetDevice(&dev);
        hipDeviceGetAttribute(&cus, hipDeviceAttributeMultiprocessorCount, dev);
        hipOccupancyMaxActiveBlocksPerMultiprocessor(&per_cu, fwd_megakernel, 256, 0);
        if (per_cu > 2) per_cu = 2;
        if (per_cu < 1) per_cu = 1;
        grid_blocks = cus * per_cu;
        if (ws_size < WS_END) fprintf(stderr, "kernel_launch: workspace too small: %zu < %zu\n", ws_size, (size_t)WS_END);
    }
    hipMemsetAsync((char*)d_ws + OFF_BAR, 0, 16384, stream);
    Params p{};
    p.x = (const float*)d_in[0]; p.c = (const float*)d_in[1]; p.ctx = (const float*)d_in[2]; p.c_ctx = (const float*)d_in[3];
    p.w_mod = (const float*)d_in[4]; p.b_mod = (const float*)d_in[5]; p.norm_g = (const float*)d_in[6]; p.w_in = (const float*)d_in[7];
    p.q_gain = (const float*)d_in[8]; p.k_gain = (const float*)d_in[9]; p.w_fourier = (const float*)d_in[10]; p.conv_w = (const float*)d_in[11];
    p.conv_b = (const float*)d_in[12]; p.pool_w = (const float*)d_in[13]; p.pool_scale = (const float*)d_in[14]; p.w_out = (const float*)d_in[15];
    p.out = (float*)d_out; p.ws = (unsigned char*)d_ws; p.never = 0; p.pad = 0;
    void* args[] = {&p};
    hipError_t e = hipLaunchCooperativeKernel((void*)fwd_megakernel, dim3(grid_blocks), dim3(256), args, 0, stream);
    if (e != hipSuccess) fprintf(stderr, "cooperative launch failed: %s (grid %d)\n", hipGetErrorString(e), grid_blocks);
}
```

```cpp
#include <hip/hip_runtime.h>
#include <hip/hip_cooperative_groups.h>
#include <stdint.h>
#include <cstdio>
namespace cg = cooperative_groups;

typedef unsigned short bf16_t;
typedef __attribute__((ext_vector_type(8))) short bf16x8;
typedef __attribute__((ext_vector_type(4))) short bf16x4;
typedef __attribute__((ext_vector_type(4))) float f32x4;
typedef __attribute__((ext_vector_type(16))) float f32x16;
#define DI __device__ __forceinline__

#define SEQ 8192
#define CTX 256
#define DM 1024
#define DIN 2816
#define ROWS_L 16384
#define ROWS_C 512
#define ROWS 16896
#define NKEY 8448
#define PW 1792
#define PC_ZATT 0
#define PC_UF 256
#define PC_ZF 512
#define PC_T 768
#define PC_GC 1024
#define PC_UP 1280
#define PC_ZP 1536

constexpr size_t OFF_BAR = 0;
constexpr size_t OFF_MODV = 16384;
constexpr size_t OFF_ROPE = OFF_MODV + 2 * 3 * 3072 * 4;
constexpr size_t OFF_TW = OFF_ROPE + 6144 * 4;
constexpr size_t OFF_F1 = OFF_TW + 8192 * 2 * 4;
constexpr size_t OFF_F2 = OFF_F1 + 256 * 128 * 2;
constexpr size_t OFF_FC = OFF_F2 + 128 * 128 * 2;
constexpr size_t OFF_WCOMB = OFF_FC + 512 * 256 * 2;
constexpr size_t OFF_WPOOL = OFF_WCOMB + 2 * 256 * 512 * 2;
constexpr size_t OFF_WTIN = 2097152;
constexpr size_t OFF_WTOUT = OFF_WTIN + (size_t)2 * DIN * DM * 2;
constexpr size_t OFF_H = OFF_WTOUT + (size_t)2 * DM * DM * 2;
constexpr size_t OFF_PARTS = OFF_H + (size_t)ROWS * DM * 2;
constexpr size_t OFF_Q = OFF_PARTS + (size_t)ROWS * PW * 2;
constexpr size_t OFF_QC = OFF_Q + (size_t)2 * 4 * SEQ * 64 * 2;
constexpr size_t OFF_K = OFF_QC + (size_t)2 * 4 * CTX * 64 * 2;
constexpr size_t OFF_VT = OFF_K + (size_t)2 * 2 * NKEY * 64 * 2;
constexpr size_t OFF_DBUF = OFF_VT + (size_t)2 * 2 * NKEY * 64 * 2;
constexpr size_t OFF_G1 = OFF_DBUF + (size_t)ROWS * 256 * 2;
constexpr size_t OFF_PCAT = OFF_G1 + (size_t)2 * 128 * 2 * 64 * 256 * 2;
constexpr size_t OFF_XC1 = OFF_PCAT + (size_t)ROWS * 512 * 2;
constexpr size_t OFF_X1B = OFF_XC1 + (size_t)ROWS_C * DM * 4;
constexpr size_t WS_END = OFF_X1B + (size_t)ROWS_L * DM * 2;
static_assert(OFF_WPOOL + 2 * 256 * 256 * 2 <= OFF_WTIN, "ws map");

struct Params {
    const float *x, *c, *ctx, *c_ctx, *w_mod, *b_mod, *norm_g, *w_in, *q_gain, *k_gain, *w_fourier, *conv_w, *conv_b, *pool_w, *pool_scale, *w_out;
    float* out;
    unsigned char* ws;
    int never;
    int pad;
};

DI bf16_t f2bf(float x) { unsigned u = __float_as_uint(x); u += 0x7fffu + ((u >> 16) & 1u); return (bf16_t)(u >> 16); }
DI float bf2f(bf16_t h) { return __uint_as_float(((unsigned)h) << 16); }
typedef __attribute__((ext_vector_type(2))) float f32x2;
typedef __attribute__((ext_vector_type(2))) __bf16 bf16x2v;
DI unsigned pack2(float a, float b) { const f32x2 v = {a, b}; return __builtin_bit_cast(unsigned, __builtin_convertvector(v, bf16x2v)); }
struct XIter { int u, end, step; };
DI XIter xiter(int ntiles) {
    const int x = blockIdx.x & 7, j = blockIdx.x >> 3, nb = gridDim.x >> 3, per = (ntiles + 7) >> 3;
    XIter r; r.u = x * per + j; r.end = min((x + 1) * per, ntiles); r.step = nb; return r;
}
DI float silu_f(float z) { return z / (1.f + __expf(-z)); }
DI float bflo(unsigned w) { return __uint_as_float(w << 16); }
DI float bfhi(unsigned w) { return __uint_as_float(w & 0xffff0000u); }
DI int otid() { int t = threadIdx.x; asm volatile("" : "+v"(t)); return t; }

#define XB_TMO      128
#define XB_XCNT(j)  (256  + 64 * (j))
#define XB_XSUB(j)  (1280 + 64 * (j))
#define XB_XGEN(j)  (2304 + 64 * (j))
#define XB_TOP      3328
#define XB_TOPGEN   3392
#define XCD_BAR_WORDS 3456
#define XB_SPIN_CAP (1u << 20)
#define LAS __attribute__((address_space(3)))
DI unsigned xb_ld(unsigned* p) { return __hip_atomic_load(p, __ATOMIC_RELAXED, __HIP_MEMORY_SCOPE_AGENT); }
DI unsigned xb_add(unsigned* p, unsigned v) { return __hip_atomic_fetch_add(p, v, __ATOMIC_RELAXED, __HIP_MEMORY_SCOPE_AGENT); }
DI unsigned xb_xcc_id() { return (unsigned)__builtin_amdgcn_s_getreg((3 << 11) | 20) & 0xFu; }
#define XB_SPIN(cond, bar) do { unsigned _sp = 0; while (cond) { __builtin_amdgcn_s_sleep(1); \
    if ((++_sp & 255u) == 0u) { if (xb_ld(&(bar)[XB_TMO])) break; if (_sp > XB_SPIN_CAP) { atomicAdd(&(bar)[XB_TMO], 1u); break; } } } } while (0)
struct XcdBarrier { unsigned* bar; unsigned x; volatile LAS unsigned* st; };
DI XcdBarrier xcd_barrier_post(unsigned* bar, volatile LAS unsigned* st) {
    XcdBarrier b; b.bar = bar; b.x = xb_xcc_id(); b.st = st;
    if (threadIdx.x == 0) (void)xb_add(&bar[XB_XCNT(b.x)], 1u);
    return b;
}
DI void xcd_barrier_complete(unsigned* bar, unsigned x, unsigned& nloc, unsigned& nx) {
    const unsigned G = gridDim.x * gridDim.y * gridDim.z;
    unsigned sum, cnt, mine, sp = 0u;
    for (;;) {
        sum = 0u; cnt = 0u; mine = 0u;
#pragma unroll
        for (unsigned j = 0; j < 16; ++j) { const unsigned c = xb_ld(&bar[XB_XCNT(j)]); sum += c; cnt += (c > 0u) ? 1u : 0u; mine = (j == x) ? c : mine; }
        if (sum == G) break;
        __builtin_amdgcn_s_sleep(1);
        if ((++sp & 255u) == 0u) { if (xb_ld(&bar[XB_TMO])) break; if (sp > XB_SPIN_CAP) { atomicAdd(&bar[XB_TMO], 1u); break; } }
    }
    nloc = mine > 0u ? mine : 1u; nx = cnt > 0u ? cnt : 1u;
}
DI void xcd_barrier(const XcdBarrier& b) {
    asm volatile("s_waitcnt vmcnt(0)" ::: "memory");
    __syncthreads();
    if (threadIdx.x == 0) {
        unsigned* bar = b.bar;
        __builtin_amdgcn_s_waitcnt(0);
        unsigned nloc = b.st[0], nx = b.st[1];
        if (nloc == 0u) { xcd_barrier_complete(bar, b.x, nloc, nx); b.st[0] = nloc; b.st[1] = nx; }
        const unsigned old = xb_add(&bar[XB_XSUB(b.x)], 1u);
        const unsigned gen = old / nloc;
        if (old + 1u == (gen + 1u) * nloc) {
            __builtin_amdgcn_fence(__ATOMIC_RELEASE, "agent");
            asm volatile("s_waitcnt vmcnt(0)" ::: "memory");
            const unsigned og = xb_add(&bar[XB_TOP], 1u);
            const unsigned tg = og / nx;
            if (og + 1u == (tg + 1u) * nx) xb_add(&bar[XB_TOPGEN], 1u);
            else XB_SPIN(xb_ld(&bar[XB_TOPGEN]) == tg, bar);
            __builtin_amdgcn_fence(__ATOMIC_ACQUIRE, "agent");
            xb_add(&bar[XB_XGEN(b.x)], 1u);
            asm volatile("s_waitcnt vmcnt(0)" ::: "memory");
        } else {
            XB_SPIN(xb_ld(&bar[XB_TOPGEN]) == gen, bar);
            __builtin_amdgcn_fence(__ATOMIC_ACQUIRE, "agent");
            asm volatile("s_waitcnt vmcnt(0)" ::: "memory");
        }
    }
    __syncthreads();
}

#define LROW 72
#define TILE_E (128 * LROW)
#define SMEM_MAIN (4 * TILE_E * 2)
#define SMEM_BYTES (SMEM_MAIN + 16)

typedef __attribute__((ext_vector_type(4))) unsigned u32x4;
struct Stg { u32x4 a0, a1, a2, a3, b0, b1, b2, b3; };
template <bool BN>
DI u32x4 g_ld_b(const bf16_t* __restrict__ B, int ldb, int kt, int q) {
    if (!BN) return *(const u32x4*)(B + (size_t)(q >> 3) * ldb + kt * 64 + (q & 7) * 8);
    else     return *(const u32x4*)(B + (size_t)(kt * 64 + (q >> 4)) * ldb + (q & 15) * 8);
}
template <bool BN>
DI void g_load(Stg& r, const bf16_t* __restrict__ A, int lda, const bf16_t* __restrict__ B, int ldb, int kt, int tid) {
    const bf16_t* ap = A + (size_t)(tid >> 3) * lda + kt * 64 + (tid & 7) * 8;
    r.a0 = *(const u32x4*)(ap);
    r.a1 = *(const u32x4*)(ap + (size_t)32 * lda);
    r.a2 = *(const u32x4*)(ap + (size_t)64 * lda);
    r.a3 = *(const u32x4*)(ap + (size_t)96 * lda);
    r.b0 = g_ld_b<BN>(B, ldb, kt, tid);
    r.b1 = g_ld_b<BN>(B, ldb, kt, tid + 256);
    r.b2 = g_ld_b<BN>(B, ldb, kt, tid + 512);
    r.b3 = g_ld_b<BN>(B, ldb, kt, tid + 768);
}
template <bool BN>
DI void s_st_b(bf16_t* b, const u32x4 v, int q) {
    if (!BN) *(u32x4*)(b + (q >> 3) * LROW + (q & 7) * 8) = v;
    else {
        const int kr0 = q >> 4, n0 = (q & 15) * 8, kr = ((((kr0 >> 3) ^ (q & 7)) << 3) | (kr0 & 7));
        b[(n0 + 0) * LROW + kr] = (bf16_t)(v.x & 0xffffu); b[(n0 + 1) * LROW + kr] = (bf16_t)(v.x >> 16);
        b[(n0 + 2) * LROW + kr] = (bf16_t)(v.y & 0xffffu); b[(n0 + 3) * LROW + kr] = (bf16_t)(v.y >> 16);
        b[(n0 + 4) * LROW + kr] = (bf16_t)(v.z & 0xffffu); b[(n0 + 5) * LROW + kr] = (bf16_t)(v.z >> 16);
        b[(n0 + 6) * LROW + kr] = (bf16_t)(v.w & 0xffffu); b[(n0 + 7) * LROW + kr] = (bf16_t)(v.w >> 16);
    }
}
template <bool BN>
DI void s_store(const Stg& r, bf16_t* smem, int buf, int tid) {
    bf16_t* a = smem + buf * 2 * TILE_E;
    bf16_t* b = a + TILE_E;
    bf16_t* ap = a + (tid >> 3) * LROW + (tid & 7) * 8;
    *(u32x4*)(ap) = r.a0;
    *(u32x4*)(ap + 32 * LROW) = r.a1;
    *(u32x4*)(ap + 64 * LROW) = r.a2;
    *(u32x4*)(ap + 96 * LROW) = r.a3;
    s_st_b<BN>(b, r.b0, tid);
    s_st_b<BN>(b, r.b1, tid + 256);
    s_st_b<BN>(b, r.b2, tid + 512);
    s_st_b<BN>(b, r.b3, tid + 768);
}
DI void mma_tile(const bf16_t* smem, int buf, f32x4 (&acc)[4][4], int wm, int wn, int lane) {
    const bf16_t* a = smem + buf * 2 * TILE_E;
    const bf16_t* b = a + TILE_E;
#pragma unroll
    for (int kk = 0; kk < 2; ++kk) {
        bf16x8 af[4], bfr[4];
#pragma unroll
        for (int mi = 0; mi < 4; ++mi) af[mi] = *(const bf16x8*)(a + (wm * 64 + mi * 16 + (lane & 15)) * LROW + kk * 32 + (lane >> 4) * 8);
#pragma unroll
        for (int ni = 0; ni < 4; ++ni) bfr[ni] = *(const bf16x8*)(b + (wn * 64 + ni * 16 + (lane & 15)) * LROW + (((kk * 4 + (lane >> 4)) ^ ((ni * 2 + ((lane >> 3) & 1)) & 7)) << 3));
#pragma unroll
        for (int mi = 0; mi < 4; ++mi)
#pragma unroll
            for (int ni = 0; ni < 4; ++ni) acc[mi][ni] = __builtin_amdgcn_mfma_f32_16x16x32_bf16(af[mi], bfr[ni], acc[mi][ni], 0, 0, 0);
    }
}
template <bool BN>
DI void gemm_core(const bf16_t* __restrict__ A, int lda, const bf16_t* __restrict__ B, int ldb, int K, f32x4 (&acc)[4][4], bf16_t* smem) {
    const int tid = otid(), lane = tid & 63, wave = tid >> 6;
    const int wm = wave >> 1, wn = wave & 1;
#pragma unroll
    for (int mi = 0; mi < 4; ++mi)
#pragma unroll
        for (int ni = 0; ni < 4; ++ni) acc[mi][ni] = (f32x4){0.f, 0.f, 0.f, 0.f};
    const int nk = K >> 6;
    Stg r0, r1;
    __syncthreads();
    g_load<BN>(r0, A, lda, B, ldb, 0, tid);
    g_load<BN>(r1, A, lda, B, ldb, 1, tid);
    s_store<BN>(r0, smem, 0, tid);
    __syncthreads();
    for (int kt = 0; kt < nk; kt += 2) {
        if (kt + 2 < nk) g_load<BN>(r0, A, lda, B, ldb, kt + 2, tid);
        mma_tile(smem, 0, acc, wm, wn, lane);
        s_store<BN>(r1, smem, 1, tid);
        __syncthreads();
        if (kt + 3 < nk) g_load<BN>(r1, A, lda, B, ldb, kt + 3, tid);
        mma_tile(smem, 1, acc, wm, wn, lane);
        if (kt + 2 < nk) s_store<BN>(r0, smem, 0, tid);
        __syncthreads();
    }
}
#define GT_E (128 * 64)
DI void glds_tile(const bf16_t* __restrict__ G, int ld, int kt, bf16_t* lt, int tid) {
    const int c = (tid & 7) ^ ((tid >> 4) & 7);
    const bf16_t* g = G + (size_t)(tid >> 3) * ld + kt * 64 + c * 8;
    char* l = (char*)lt + tid * 16;
#pragma unroll
    for (int p = 0; p < 4; ++p)
        __builtin_amdgcn_global_load_lds((const unsigned*)(g + (size_t)(p * 32) * ld), (LAS unsigned*)(l + p * 4096), 16, 0, 0);
}
DI void mma_tile_sw(const bf16_t* smem, int buf, f32x4 (&acc)[4][4], int wm, int wn, int lane) {
    const char* a = (const char*)(smem + buf * 2 * GT_E);
    const char* b = a + GT_E * 2;
    const int sw = (lane & 15) >> 1;
#pragma unroll
    for (int kk = 0; kk < 2; ++kk) {
        bf16x8 af[4], bfr[4];
        const int co = ((kk * 4 + (lane >> 4)) ^ sw) << 4;
#pragma unroll
        for (int mi = 0; mi < 4; ++mi) af[mi] = *(const bf16x8*)(a + (wm * 64 + mi * 16 + (lane & 15)) * 128 + co);
#pragma unroll
        for (int ni = 0; ni < 4; ++ni) bfr[ni] = *(const bf16x8*)(b + (wn * 64 + ni * 16 + (lane & 15)) * 128 + co);
#pragma unroll
        for (int mi = 0; mi < 4; ++mi)
#pragma unroll
            for (int ni = 0; ni < 4; ++ni) acc[mi][ni] = __builtin_amdgcn_mfma_f32_16x16x32_bf16(af[mi], bfr[ni], acc[mi][ni], 0, 0, 0);
    }
}
DI void gemm_core_dma(const bf16_t* __restrict__ A, int lda, const bf16_t* __restrict__ B, int ldb, int K, f32x4 (&acc)[4][4], bf16_t* smem) {
    const int tid = otid(), lane = tid & 63, wave = tid >> 6;
    const int wm = wave >> 1, wn = wave & 1;
#pragma unroll
    for (int mi = 0; mi < 4; ++mi)
#pragma unroll
        for (int ni = 0; ni < 4; ++ni) acc[mi][ni] = (f32x4){0.f, 0.f, 0.f, 0.f};
    const int nk = K >> 6;
    __syncthreads();
    glds_tile(A, lda, 0, smem, tid);
    glds_tile(B, ldb, 0, smem + GT_E, tid);
    for (int kt = 0; kt < nk; ++kt) {
        asm volatile("s_waitcnt vmcnt(0)" ::: "memory");
        __syncthreads();
        if (kt + 1 < nk) {
            bf16_t* nb = smem + ((kt + 1) & 1) * 2 * GT_E;
            glds_tile(A, lda, kt + 1, nb, tid);
            glds_tile(B, ldb, kt + 1, nb + GT_E, tid);
        }
        mma_tile_sw(smem, kt & 1, acc, wm, wn, lane);
    }
    __syncthreads();
}
#define ST_LD 132
DI void stage_acc(f32x4 (&acc)[4][4], float* st) {
    const int lane = otid() & 63, wave = otid() >> 6, wm = wave >> 1, wn = wave & 1, fl = lane & 15, g4 = lane >> 4;
#pragma unroll
    for (int mi = 0; mi < 4; ++mi)
#pragma unroll
        for (int ni = 0; ni < 4; ++ni)
#pragma unroll
            for (int j = 0; j < 4; ++j) st[(wm * 64 + mi * 16 + g4 * 4 + j) * ST_LD + wn * 64 + ni * 16 + fl] = acc[mi][ni][j];
    __syncthreads();
}
DI void ld8(const float* q, float (&v)[8]) {
    const float4 a = *(const float4*)q, b = *(const float4*)(q + 4);
    v[0] = a.x; v[1] = a.y; v[2] = a.z; v[3] = a.w; v[4] = b.x; v[5] = b.y; v[6] = b.z; v[7] = b.w;
}
DI uint4 pack8(const float (&v)[8]) { return make_uint4(pack2(v[0], v[1]), pack2(v[2], v[3]), pack2(v[4], v[5]), pack2(v[6], v[7])); }
DI void unpack8(const uint4 u, float (&v)[8]) {
    v[0] = bflo(u.x); v[1] = bfhi(u.x); v[2] = bflo(u.y); v[3] = bfhi(u.y); v[4] = bflo(u.z); v[5] = bfhi(u.z); v[6] = bflo(u.w); v[7] = bfhi(u.w);
}

DI void phase0(const Params& p, float* smf) {
    const int tid = otid();
    unsigned char* ws = p.ws;
    float* modv = (float*)(ws + OFF_MODV);
    for (int it = blockIdx.x; it < 192; it += gridDim.x) {
        const int l = it / 96, n0 = (it % 96) * 32;
        __syncthreads();
        for (int i = tid; i < 3072; i += 256) {
            const int v = i >> 10, k = i & 1023;
            const float cv = (v == 0) ? p.c[k] : (v == 1) ? p.c[1024 + k] : p.c_ctx[k];
            smf[i] = silu_f(cv);
        }
        __syncthreads();
        const int col = tid & 31, kg = tid >> 5;
        float a0 = 0.f, a1 = 0.f, a2 = 0.f;
        const float* w = p.w_mod + (size_t)l * 1024 * 3072 + n0 + col;
#pragma unroll 16
        for (int kk = 0; kk < 128; ++kk) {
            const int k = kg * 128 + kk;
            const float wv = w[(size_t)k * 3072];
            a0 += smf[k] * wv; a1 += smf[1024 + k] * wv; a2 += smf[2048 + k] * wv;
        }
        __syncthreads();
        smf[3072 + (kg * 3 + 0) * 32 + col] = a0; smf[3072 + (kg * 3 + 1) * 32 + col] = a1; smf[3072 + (kg * 3 + 2) * 32 + col] = a2;
        __syncthreads();
        if (tid < 96) {
            const int v = tid >> 5, cc = tid & 31;
            float s = 0.f;
            for (int g = 0; g < 8; ++g) s += smf[3072 + (g * 3 + v) * 32 + cc];
            modv[(l * 3 + v) * 3072 + n0 + cc] = s + p.b_mod[l * 3072 + n0 + cc];
        }
    }
    {
        const int n_in = 2 * 16 * 44, n_out = 2 * 16 * 16;
        for (int it = blockIdx.x; it < n_in + n_out; it += gridDim.x) {
            const float* src; bf16_t* dst; int N, kt, nt;
            if (it < n_in) { const int l = it / 704, r = it % 704; kt = r / 44; nt = r % 44; N = DIN; src = p.w_in + (size_t)l * DM * DIN; dst = (bf16_t*)(ws + OFF_WTIN) + (size_t)l * DIN * DM; }
            else { const int j = it - n_in; const int l = j / 256, r = j % 256; kt = r / 16; nt = r % 16; N = DM; src = p.w_out + (size_t)l * DM * DM; dst = (bf16_t*)(ws + OFF_WTOUT) + (size_t)l * DM * DM; }
            __syncthreads();
#pragma unroll
            for (int ps = 0; ps < 4; ++ps) {
                const int kr = ps * 16 + (tid >> 4), c4 = (tid & 15) * 4;
                const float4 v = *(const float4*)(src + (size_t)(kt * 64 + kr) * N + nt * 64 + c4);
                smf[kr * 65 + c4 + 0] = v.x; smf[kr * 65 + c4 + 1] = v.y; smf[kr * 65 + c4 + 2] = v.z; smf[kr * 65 + c4 + 3] = v.w;
            }
            __syncthreads();
            const int n = tid >> 2, ks = (tid & 3) * 16;
            unsigned w[8];
#pragma unroll
            for (int e = 0; e < 8; ++e) w[e] = pack2(smf[(ks + 2 * e) * 65 + n], smf[(ks + 2 * e + 1) * 65 + n]);
            int ntd = nt;
            if (it < n_in && nt >= 20 && nt < 36) { const int grp = (nt - 20) >> 2, q4 = (nt - 20) & 3; ntd = (grp == 0) ? 28 + 2 * q4 : (grp == 1) ? 20 + 2 * q4 : (grp == 2) ? 21 + 2 * q4 : 29 + 2 * q4; }
            bf16_t* d = dst + (size_t)(ntd * 64 + n) * DM + kt * 64 + ks;
            *(uint4*)d = make_uint4(w[0], w[1], w[2], w[3]);
            *(uint4*)(d + 8) = make_uint4(w[4], w[5], w[6], w[7]);
        }
    }
    const int gtid = blockIdx.x * 256 + tid, gsz = gridDim.x * 256;
    {
        bf16_t* wc = (bf16_t*)(ws + OFF_WCOMB);
        __syncthreads();
        if (tid < 64) { smf[tid] = cospif((float)tid * (1.f / 32.f)); smf[64 + tid] = sinpif((float)tid * (1.f / 32.f)); }
        __syncthreads();
        for (int i = gtid; i < 2 * 512 * 256; i += gsz) {
            const int n = i & 255, kk = (i >> 8) & 511, l = i >> 17;
            const int c = kk >> 8, head = (kk >> 6) & 3, ch = kk & 63;
            const float* wf = p.w_fourier + (size_t)l * 65536 + (size_t)(head * 64) * 256 + n;
            float s = 0.f;
#pragma unroll 16
            for (int j = 0; j < 64; ++j) s += smf[c * 64 + ((j * ch) & 63)] * wf[j * 256];
            wc[(size_t)l * 131072 + n * 512 + kk] = f2bf(s);
        }
    }
    {
        bf16_t* wp = (bf16_t*)(ws + OFF_WPOOL);
        for (int i = gtid; i < 2 * 256 * 256; i += gsz) {
            const int k = i & 255, n = (i >> 8) & 255, l = i >> 16;
            float v = 0.f;
            if ((k >> 6) == (n >> 6)) v = p.pool_w[(size_t)l * 16384 + (n >> 6) * 4096 + (k & 63) * 64 + (n & 63)];
            wp[i] = f2bf(v);
        }
    }
    {
        float* tw = (float*)(ws + OFF_TW);
        for (int i = gtid; i < 8192; i += gsz) { const float a = (float)i * (1.f / 4096.f); tw[2 * i] = cospif(a); tw[2 * i + 1] = sinpif(a); }
        bf16_t* f1 = (bf16_t*)(ws + OFF_F1);
        for (int i = gtid; i < 256 * 128; i += gsz) {
            const int t1 = i & 127, m = i >> 7;
            const int k1 = (m >> 5) * 16 + (m & 15), c = (m >> 4) & 1;
            const float a = (float)((k1 * t1) & 127) * (1.f / 64.f);
            f1[i] = f2bf(c ? -sinpif(a) : cospif(a));
        }
        bf16_t* f2 = (bf16_t*)(ws + OFF_F2);
        for (int i = gtid; i < 128 * 128; i += gsz) {
            const int kx = i & 127, m = i >> 7;
            const int c = m >> 6, k2 = m & 63, cp = kx >> 6, t2 = kx & 63;
            const float a = (float)((k2 * t2) & 63) * (1.f / 32.f);
            float v;
            if (c == cp) v = cospif(a); else if (c == 0) v = sinpif(a); else v = -sinpif(a);
            f2[i] = f2bf(v);
        }
        bf16_t* fc = (bf16_t*)(ws + OFF_FC);
        for (int i = gtid; i < 512 * 256; i += gsz) {
            const int t = i & 255, m = i >> 8;
            const int c = m >> 8, k = m & 255;
            const float a = (float)((k * t) & 255) * (1.f / 128.f);
            fc[i] = f2bf(c ? -sinpif(a) : cospif(a));
        }
        float* rp = (float*)(ws + OFF_ROPE);
        for (int i = gtid; i < 3072; i += gsz) {
            const int f = i & 15;
            const int pos = (i < 2048) ? (i >> 4) : ((i - 2048) >> 4);
            const float inv = powf(10000.f, -(float)f * (1.f / 16.f));
            const float ang = (float)pos * inv;
            const double ad = (double)ang;
            const float cs = (float)cos(ad), sn = (float)sin(ad);
            if (i < 2048) { rp[i] = cs; rp[2048 + i] = sn; }
            else { rp[4096 + (i - 2048)] = cs; rp[5120 + (i - 2048)] = sn; }
        }
    }
}

DI void phase_norm(const Params& p, int l, const float* xl, const float* xc, const bf16_t* xlb) {
    const int lane = otid() & 63, wave = otid() >> 6;
    const float* modv = (const float*)(p.ws + OFF_MODV) + (size_t)l * 3 * 3072;
    const float* g = p.norm_g + l * 1024;
    bf16_t* H = (bf16_t*)(p.ws + OFF_H);
    for (int row = blockIdx.x * 4 + wave; row < ROWS; row += gridDim.x * 4) {
        const float* src = (row < ROWS_L) ? xl + (size_t)row * DM : xc + (size_t)(row - ROWS_L) * DM;
        const int v = (row < ROWS_L) ? (row >> 13) : 2;
        const float* mv = modv + v * 3072;
        float4 a[4];
        float ss = 0.f;
        if (xlb != nullptr && row < ROWS_L) {
            const bf16_t* sb = xlb + (size_t)row * DM;
#pragma unroll
            for (int i = 0; i < 4; ++i) { const uint2 u = *(const uint2*)(sb + i * 256 + lane * 4); a[i] = make_float4(bflo(u.x), bfhi(u.x), bflo(u.y), bfhi(u.y)); }
        } else {
#pragma unroll
            for (int i = 0; i < 4; ++i) a[i] = *(const float4*)(src + i * 256 + lane * 4);
        }
#pragma unroll
        for (int i = 0; i < 4; ++i) ss += a[i].x * a[i].x + a[i].y * a[i].y + a[i].z * a[i].z + a[i].w * a[i].w;
#pragma unroll
        for (int o = 32; o >= 1; o >>= 1) ss += __shfl_xor(ss, o);
        const float rs = rsqrtf(ss * (1.f / 1024.f) + 1e-6f);
#pragma unroll
        for (int i = 0; i < 4; ++i) {
            const int c0 = i * 256 + lane * 4;
            const float4 gg = *(const float4*)(g + c0), sh = *(const float4*)(mv + c0), sc = *(const float4*)(mv + 1024 + c0);
            const float o0 = a[i].x * rs * gg.x * (1.f + sc.x) + sh.x, o1 = a[i].y * rs * gg.y * (1.f + sc.y) + sh.y;
            const float o2 = a[i].z * rs * gg.z * (1.f + sc.z) + sh.z, o3 = a[i].w * rs * gg.w * (1.f + sc.w) + sh.w;
            *(uint2*)(H + (size_t)row * DM + c0) = make_uint2(pack2(o0, o1), pack2(o2, o3));
        }
    }
}

DI void epi_inproj(const Params& p, int l, int tm, int tn, f32x4 (&acc)[4][4], float* st) {
    const int tid = otid();
    unsigned char* ws = p.ws;
    stage_acc(acc, st);
    const int rbase = tm * 128;
    const bool isctx = rbase >= ROWS_L;
    if (tn < 3) {
        const bool isq = tn < 2;
        const float* gain = (isq ? p.q_gain : p.k_gain) + l * 64;
        const float* rp = (const float*)(ws + OFF_ROPE);
#pragma unroll 1
        for (int i = 0; i < 8; ++i) {
            const int q = tid + 256 * i, rl = q >> 4, c8 = (q & 15) * 8;
            const int row = rbase + rl, hd = c8 >> 6, d0 = c8 & 63;
            float v[8], pv[8], g[8], pg[8];
            ld8(st + rl * ST_LD + c8, v);
            ld8(st + rl * ST_LD + (c8 ^ 16), pv);
            ld8(gain + d0, g);
            ld8(gain + (d0 ^ 16), pg);
            float ss = 0.f;
#pragma unroll
            for (int e = 0; e < 8; ++e) ss += v[e] * v[e];
            ss += __shfl_xor(ss, 1); ss += __shfl_xor(ss, 2); ss += __shfl_xor(ss, 4);
            const float rs = rsqrtf(ss * (1.f / 64.f) + 1e-6f);
#pragma unroll
            for (int e = 0; e < 8; ++e) { v[e] *= rs * g[e]; pv[e] *= rs * pg[e]; }
            bf16_t* dst;
            if (!isctx) {
                const int b = row >> 13, t = row & 8191;
                const int pos = (d0 >= 32) ? (t & 63) : (t >> 6);
                const float* ct = rp + ((d0 >= 32) ? 4096 : 0) + pos * 16 + (d0 & 8);
                float cs[8], sn[8];
                ld8(ct, cs);
                ld8(ct + ((d0 >= 32) ? 1024 : 2048), sn);
                const float sg = (d0 & 16) ? 1.f : -1.f;
#pragma unroll
                for (int e = 0; e < 8; ++e) v[e] = v[e] * cs[e] + sg * pv[e] * sn[e];
                if (isq) dst = (bf16_t*)(ws + OFF_Q) + ((size_t)(b * 4 + tn * 2 + hd) * SEQ + t) * 64 + d0;
                else     dst = (bf16_t*)(ws + OFF_K) + ((size_t)(b * 2 + hd) * NKEY + CTX + t) * 64 + d0;
            } else {
                const int rc = row - ROWS_L, b = rc >> 8, t = rc & 255;
                if (isq) dst = (bf16_t*)(ws + OFF_QC) + ((size_t)(b * 4 + tn * 2 + hd) * CTX + t) * 64 + d0;
                else     dst = (bf16_t*)(ws + OFF_K) + ((size_t)(b * 2 + hd) * NKEY + t) * 64 + d0;
            }
            if (isq) {
#pragma unroll
                for (int e = 0; e < 8; ++e) v[e] *= 0.18033688011112042f;
            }
            *(uint4*)dst = pack8(v);
        }
    } else if (tn == 3) {
        int b, key0;
        if (!isctx) { b = rbase >> 13; key0 = CTX + (rbase & 8191); } else { const int rc = rbase - ROWS_L; b = rc >> 8; key0 = rc & 255; }
#pragma unroll 1
        for (int i = 0; i < 8; ++i) {
            const int q = tid + 256 * i, col = q & 127, r8 = (q >> 7) * 8;
            float v[8];
#pragma unroll
            for (int e = 0; e < 8; ++e) v[e] = st[(r8 + e) * ST_LD + col];
            bf16_t* vt = (bf16_t*)(ws + OFF_VT) + ((size_t)(b * 2 + (col >> 6)) * 64 + (col & 63)) * NKEY + key0 + r8;
            *(uint4*)vt = pack8(v);
        }
    } else {
        bf16_t* parts = (bf16_t*)(ws + OFF_PARTS);
        if (tn >= 10 && tn < 18) {
            const bool isg = tn >= 14;
            const int dcol = (isg ? PC_GC + (tn - 14) * 64 : PC_T + (tn - 10) * 64);
#pragma unroll 1
            for (int i = 0; i < 4; ++i) {
                const int q = tid + 256 * i, rl = q >> 3, c8 = (q & 7) * 8;
                float v[8], w[8];
                ld8(st + rl * ST_LD + c8, v);
                ld8(st + rl * ST_LD + 64 + c8, w);
#pragma unroll
                for (int e = 0; e < 8; ++e) v[e] = isg ? silu_f(w[e]) * v[e] : v[e] * w[e];
                *(uint4*)(parts + (size_t)(rbase + rl) * PW + dcol + c8) = pack8(v);
            }
        } else {
            const int dbase = (tn < 10) ? tn * 128 - 512 : PC_UP + (tn - 18) * 128;
#pragma unroll 1
            for (int i = 0; i < 8; ++i) {
                const int q = tid + 256 * i, rl = q >> 4, c8 = (q & 15) * 8;
                float v[8];
                ld8(st + rl * ST_LD + c8, v);
                *(uint4*)(parts + (size_t)(rbase + rl) * PW + dbase + c8) = pack8(v);
            }
        }
    }
}

DI void phase_inproj(const Params& p, int l, bf16_t* smem) {
    const bf16_t* H = (const bf16_t*)(p.ws + OFF_H);
    const bf16_t* W = (const bf16_t*)(p.ws + OFF_WTIN) + (size_t)l * DIN * DM;
    const int nlat = 128 * 22;
    const int ntiles = nlat + (l == 0 ? 4 * 22 : 4 * 2);
    for (XIter t = xiter(ntiles); t.u < t.end; t.u += t.step) {
        const int u = t.u;
        int tm, tn;
        if (u < nlat) { const int ch = u / 176, r = u % 176; tn = r >> 3; tm = ch * 8 + (r & 7); }
        else { const int j = u - nlat; tm = 128 + (j & 3); tn = (l == 0 ? 0 : 2) + (j >> 2); }
        f32x4 acc[4][4];
        gemm_core_dma(H + (size_t)tm * 128 * DM, DM, W + (size_t)tn * 128 * DM, DM, DM, acc, smem);
        epi_inproj(p, l, tm, tn, acc, (float*)smem);
    }
}

#define KT_E (64 * LROW)
DI void attn_item(const Params& p, const bf16_t* Qb, const bf16_t* Kb, const bf16_t* VTb, int ntiles, int rowbase, int hq, bf16_t* smem) {
    const int tid = otid(), lane = tid & 63, wave = tid >> 6;
    const int r = lane & 31, h = lane >> 5;
    const float LOG2E = 1.4426950408889634f;
    bf16x8 qf[4];
    {
        const bf16_t* qrow = Qb + (size_t)(wave * 32 + r) * 64;
#pragma unroll
        for (int s = 0; s < 4; ++s) qf[s] = *(const bf16x8*)(qrow + s * 16 + h * 8);
    }
    f32x16 ot[2], zacc;
#pragma unroll
    for (int i = 0; i < 16; ++i) { ot[0][i] = 0.f; ot[1][i] = 0.f; zacc[i] = 0.f; }
    float m = 0.f, lsum = 0.f;
    bool stab = false;
    uint4 rk[2], rv[2];
    auto gload = [&](int kt) {
#pragma unroll
        for (int i = 0; i < 2; ++i) {
            const int q = tid + 256 * i;
            rk[i] = *(const uint4*)(Kb + (size_t)(kt * 64 + (q >> 3)) * 64 + (q & 7) * 8);
            rv[i] = *(const uint4*)(VTb + (size_t)(q >> 3) * NKEY + kt * 64 + (q & 7) * 8);
        }
    };
    auto sstore = [&](int buf) {
        bf16_t* sk = smem + buf * 2 * KT_E;
        bf16_t* sv = sk + KT_E;
#pragma unroll
        for (int i = 0; i < 2; ++i) {
            const int q = tid + 256 * i;
            *(uint4*)(sk + (q >> 3) * LROW + (q & 7) * 8) = rk[i];
            *(uint4*)(sv + (q >> 3) * LROW + (q & 7) * 8) = rv[i];
        }
    };
    __syncthreads();
    gload(0);
    sstore(0);
    __syncthreads();
    for (int kt = 0; kt < ntiles; ++kt) {
        if (kt + 1 < ntiles) gload(kt + 1);
        const bf16_t* sk = smem + (kt & 1) * 2 * KT_E;
        const bf16_t* sv = sk + KT_E;
        f32x16 st[2], pe[2];
#pragma unroll
        for (int blk = 0; blk < 2; ++blk) {
            st[blk] = __builtin_amdgcn_mfma_f32_32x32x16_bf16(*(const bf16x8*)(sk + (blk * 32 + r) * LROW + h * 8), qf[0], zacc, 0, 0, 0);
#pragma unroll
            for (int s = 1; s < 4; ++s)
                st[blk] = __builtin_amdgcn_mfma_f32_32x32x16_bf16(*(const bf16x8*)(sk + (blk * 32 + r) * LROW + s * 16 + h * 8), qf[s], st[blk], 0, 0, 0);
        }
        if (stab) {
#pragma unroll
            for (int i = 0; i < 16; ++i) { st[0][i] -= m; st[1][i] -= m; }
        }
        float ls = 0.f;
#pragma unroll
        for (int i = 0; i < 16; ++i) {
            pe[0][i] = __builtin_amdgcn_exp2f(st[0][i]); ls += pe[0][i];
            pe[1][i] = __builtin_amdgcn_exp2f(st[1][i]); ls += pe[1][i];
        }
        if (__any(!(ls <= 1.0e12f) || (ls < 1.0e-25f))) {
            float tmx = st[0][0];
#pragma unroll
            for (int i = 0; i < 16; ++i) { tmx = fmaxf(tmx, st[0][i]); tmx = fmaxf(tmx, st[1][i]); }
            tmx = fmaxf(tmx, __shfl_xor(tmx, 32));
            const float lrow = lsum + __shfl_xor(lsum, 32);
            const bool rebase = !(lrow >= 1.0e-20f);
            const float delta = rebase ? tmx : fmaxf(tmx, 0.f);
            const float alpha = rebase ? 0.f : __builtin_amdgcn_exp2f(-delta);
            m += delta;
            stab = true;
            lsum *= alpha;
            ls = 0.f;
#pragma unroll
            for (int i = 0; i < 16; ++i) {
                ot[0][i] *= alpha; ot[1][i] *= alpha;
                pe[0][i] = __builtin_amdgcn_exp2f(st[0][i] - delta); ls += pe[0][i];
                pe[1][i] = __builtin_amdgcn_exp2f(st[1][i] - delta); ls += pe[1][i];
            }
        }
        lsum += ls;
        bf16x8 pk[2][2];
#pragma unroll
        for (int blk = 0; blk < 2; ++blk)
#pragma unroll
            for (int s = 0; s < 2; ++s) {
                uint4 u;
                u.x = pack2(pe[blk][8 * s + 0], pe[blk][8 * s + 1]); u.y = pack2(pe[blk][8 * s + 2], pe[blk][8 * s + 3]);
                u.z = pack2(pe[blk][8 * s + 4], pe[blk][8 * s + 5]); u.w = pack2(pe[blk][8 * s + 6], pe[blk][8 * s + 7]);
                pk[blk][s] = __builtin_bit_cast(bf16x8, u);
            }
#pragma unroll
        for (int db = 0; db < 2; ++db)
#pragma unroll
            for (int blk = 0; blk < 2; ++blk)
#pragma unroll
                for (int s = 0; s < 2; ++s) {
                    const bf16_t* vp = sv + (db * 32 + r) * LROW + blk * 32 + s * 16 + h * 4;
                    const bf16x4 lo = *(const bf16x4*)vp;
                    const bf16x4 hi = *(const bf16x4*)(vp + 8);
                    const bf16x8 vf = __builtin_shufflevector(lo, hi, 0, 1, 2, 3, 4, 5, 6, 7);
                    ot[db] = __builtin_amdgcn_mfma_f32_32x32x16_bf16(vf, pk[blk][s], ot[db], 0, 0, 0);
                }
        if (kt + 1 < ntiles) sstore((kt + 1) & 1);
        __syncthreads();
    }
    lsum += __shfl_xor(lsum, 32);
    const float inv = 1.f / lsum;
    const int row = rowbase + wave * 32 + r;
    const bf16_t* zrow = (const bf16_t*)(p.ws + OFF_PARTS) + (size_t)row * PW + PC_ZATT + hq * 64;
    bf16_t* orow = (bf16_t*)(p.ws + OFF_H) + (size_t)row * DM + 256 + hq * 64;
#pragma unroll
    for (int db = 0; db < 2; ++db)
#pragma unroll
        for (int g = 0; g < 4; ++g) {
            const int d = db * 32 + g * 8 + h * 4;
            const uint2 z = *(const uint2*)(zrow + d);
            const float o0 = silu_f(bflo(z.x)) * ot[db][4 * g + 0] * inv, o1 = silu_f(bfhi(z.x)) * ot[db][4 * g + 1] * inv;
            const float o2 = silu_f(bflo(z.y)) * ot[db][4 * g + 2] * inv, o3 = silu_f(bfhi(z.y)) * ot[db][4 * g + 3] * inv;
            *(uint2*)(orow + d) = make_uint2(pack2(o0, o1), pack2(o2, o3));
        }
}

DI void phase_attn(const Params& p, int l, bf16_t* smem) {
    const bf16_t* Q = (const bf16_t*)(p.ws + OFF_Q);
    const bf16_t* QC = (const bf16_t*)(p.ws + OFF_QC);
    const bf16_t* Kk = (const bf16_t*)(p.ws + OFF_K);
    const bf16_t* VT = (const bf16_t*)(p.ws + OFF_VT);
    for (XIter t = xiter(512); t.u < t.end; t.u += t.step) {
        const int it = t.u;
        const int b = it >> 8, hq = (it >> 6) & 3, qt = it & 63;
        const size_t kv = (size_t)(b * 2 + (hq >> 1));
        attn_item(p, Q + ((size_t)(b * 4 + hq) * SEQ + qt * 128) * 64, Kk + kv * NKEY * 64, VT + kv * 64 * NKEY, NKEY / 64, b * SEQ + qt * 128, hq, smem);
    }
    if (l == 0) {
        for (int j = blockIdx.x; j < 16; j += gridDim.x) {
            const int b = j >> 3, hq = (j >> 1) & 3, qt = j & 1;
            const size_t kv = (size_t)(b * 2 + (hq >> 1));
            attn_item(p, QC + ((size_t)(b * 4 + hq) * CTX + qt * 128) * 64, Kk + kv * NKEY * 64, VT + kv * 64 * NKEY, CTX / 64, ROWS_L + b * CTX + qt * 128, hq, smem);
        }
    }
}

template <int W>
DI void pool_task(const bf16_t* __restrict__ pu, int pos, int n, bf16_t* __restrict__ dst) {
    constexpr int LEFT = W / 2;
    uint4 raw[W];
#pragma unroll
    for (int t = 0; t < W; ++t) { int q = pos - LEFT + t; q = q < 0 ? 0 : (q >= n ? n - 1 : q); raw[t] = *(const uint4*)(pu + (size_t)q * PW); }
    float sum[8], u[8];
#pragma unroll
    for (int e = 0; e < 8; ++e) sum[e] = 0.f;
#pragma unroll
    for (int t = 0; t < W; ++t) {
        const int q = pos - LEFT + t;
        const float mk = (q >= 0 && q < n) ? 1.f : 0.f;
        unpack8(raw[t], u);
#pragma unroll
        for (int e = 0; e < 8; ++e) sum[e] += mk * u[e];
    }
    const int lo = max(pos - LEFT, 0), hi = min(pos + W - LEFT, n);
    const float ic = 1.f / (float)(hi - lo);
    unpack8(raw[LEFT], u);
#pragma unroll
    for (int e = 0; e < 8; ++e) sum[e] = sum[e] * ic - u[e];
    *(uint4*)dst = pack8(sum);
}
DI void phase_convpool(const Params& p, int l) {
    const bf16_t* __restrict__ parts = (const bf16_t*)(p.ws + OFF_PARTS);
    bf16_t* __restrict__ cat = (bf16_t*)(p.ws + OFF_H);
    bf16_t* __restrict__ dbuf = (bf16_t*)(p.ws + OFF_DBUF);
    const int nrows = (l == 0 ? ROWS : ROWS_L);
    const int gsz = gridDim.x * 256, gt = blockIdx.x * 256 + otid();
    {
        const int c8 = (gt & 31) * 8;
        float w0[8], w1[8], w2[8], bs[8];
        ld8(p.conv_w + l * 768 + c8, w0); ld8(p.conv_w + l * 768 + 256 + c8, w1); ld8(p.conv_w + l * 768 + 512 + c8, w2); ld8(p.conv_b + l * 256 + c8, bs);
        for (int i = gt; i < nrows * 32; i += gsz) {
            const int row = i >> 5;
            int seq0, n;
            if (row < ROWS_L) { seq0 = (row >> 13) << 13; n = SEQ; } else { seq0 = ROWS_L + (((row - ROWS_L) >> 8) << 8); n = CTX; }
            const int pos = row - seq0;
            const bf16_t* pr = parts + (size_t)row * PW + c8;
            const bool hp = pos > 0, hn = pos + 1 < n;
            const bf16_t* pp = hp ? pr - PW : pr;
            const bf16_t* pn = hn ? pr + PW : pr;
            const uint4 r0 = *(const uint4*)(pr + PC_T), r2 = *(const uint4*)(pp + PC_T), r4 = *(const uint4*)(pn + PC_T), r6 = *(const uint4*)(pr + PC_GC);
            const float mp = hp ? 1.f : 0.f, mn = hn ? 1.f : 0.f;
            float tc[8], tp[8], tn[8], gg[8], o[8];
            unpack8(r0, tc); unpack8(r2, tp); unpack8(r4, tn); unpack8(r6, gg);
#pragma unroll
            for (int e = 0; e < 8; ++e) o[e] = gg[e] * (mp * tp[e] * w0[e] + tc[e] * w1[e] + mn * tn[e] * w2[e] + bs[e]);
            *(uint4*)(cat + (size_t)row * DM + 512 + c8) = pack8(o);
        }
    }
    for (int j = gt; j < nrows * 32; j += gsz) {
        const int g = j / (nrows * 8), rem = j - g * (nrows * 8), row = rem >> 3, c8 = g * 64 + (rem & 7) * 8;
        int seq0, n;
        if (row < ROWS_L) { seq0 = (row >> 13) << 13; n = SEQ; } else { seq0 = ROWS_L + (((row - ROWS_L) >> 8) << 8); n = CTX; }
        const bf16_t* pu = parts + (size_t)seq0 * PW + PC_UP + c8;
        bf16_t* dst = dbuf + (size_t)row * 256 + c8;
        const int pos = row - seq0;
        if (g == 0) pool_task<2>(pu, pos, n, dst);
        else if (g == 1) pool_task<4>(pu, pos, n, dst);
        else if (g == 2) pool_task<8>(pu, pos, n, dst);
        else pool_task<16>(pu, pos, n, dst);
    }
}

DI void phase_dft1(const Params& p, int l, bf16_t* smem) {
    const int tid = otid();
    float* st = (float*)smem;
    const bf16_t* parts = (const bf16_t*)(p.ws + OFF_PARTS);
    const bf16_t* F1 = (const bf16_t*)(p.ws + OFF_F1);
    const bf16_t* FC = (const bf16_t*)(p.ws + OFF_FC);
    const float* tw = (const float*)(p.ws + OFF_TW);
    bf16_t* G1 = (bf16_t*)(p.ws + OFF_G1);
    bf16_t* pcat = (bf16_t*)(p.ws + OFF_PCAT);
    const int nt1 = 2 * 64 * 4;
    const int ntot = nt1 + (l == 0 ? 16 : 0);
    for (int it = blockIdx.x; it < ntot; it += gridDim.x) {
        f32x4 acc[4][4];
        if (it < nt1) {
            const int b = it >> 8, t2 = (it >> 2) & 63, mt = (it >> 1) & 1, nt = it & 1;
            gemm_core<true>(F1 + (size_t)mt * 128 * 128, 128, parts + (size_t)(b * SEQ + t2) * PW + PC_UF + nt * 128, 64 * PW, 128, acc, smem);
            stage_acc(acc, st);
#pragma unroll 1
            for (int i = 0; i < 4; ++i) {
                const int q = tid + 256 * i, kk = q >> 4, c8 = (q & 15) * 8;
                const int rr = 32 * (kk >> 4) + (kk & 15);
                const int k1 = mt * 64 + kk;
                const float cs = tw[2 * (k1 * t2)], sn = tw[2 * (k1 * t2) + 1];
                float gr[8], gi[8], o[8];
                ld8(st + rr * ST_LD + c8, gr);
                ld8(st + (rr + 16) * ST_LD + c8, gi);
                bf16_t* dr = G1 + ((size_t)((b * 128 + k1) * 2 + 0) * 64 + t2) * 256 + nt * 128 + c8;
#pragma unroll
                for (int e = 0; e < 8; ++e) o[e] = gr[e] * cs + gi[e] * sn;
                *(uint4*)dr = pack8(o);
#pragma unroll
                for (int e = 0; e < 8; ++e) o[e] = gi[e] * cs - gr[e] * sn;
                *(uint4*)(dr + (size_t)64 * 256) = pack8(o);
            }
        } else {
            const int j0 = it - nt1, b = j0 >> 3, mt = (j0 >> 1) & 3, nt = j0 & 1;
            gemm_core<true>(FC + (size_t)mt * 128 * 256, 256, parts + (size_t)(ROWS_L + b * CTX) * PW + PC_UF + nt * 128, PW, 256, acc, smem);
            stage_acc(acc, st);
#pragma unroll 1
            for (int i = 0; i < 8; ++i) {
                const int q = tid + 256 * i, rl = q >> 4, c8 = (q & 15) * 8;
                const int m = mt * 128 + rl, c = m >> 8, k = m & 255;
                float v[8];
                ld8(st + rl * ST_LD + c8, v);
                *(uint4*)(pcat + (size_t)(ROWS_L + b * CTX + k) * 512 + c * 256 + nt * 128 + c8) = pack8(v);
            }
        }
    }
}

DI void phase_dft2_mixp(const Params& p, int l, bf16_t* smem, int item_lo, int item_hi, int blk0, int nblk) {
    const int tid = otid();
    float* st = (float*)smem;
    const bf16_t* F2 = (const bf16_t*)(p.ws + OFF_F2);
    const bf16_t* G1 = (const bf16_t*)(p.ws + OFF_G1);
    bf16_t* pcat = (bf16_t*)(p.ws + OFF_PCAT);
    const bf16_t* dbuf = (const bf16_t*)(p.ws + OFF_DBUF);
    const bf16_t* wp = (const bf16_t*)(p.ws + OFF_WPOOL) + (size_t)l * 65536;
    const bf16_t* parts = (const bf16_t*)(p.ws + OFF_PARTS);
    bf16_t* cat = (bf16_t*)(p.ws + OFF_H);
    const int nt2 = 2 * 128 * 2;
    const int nmt = (l == 0 ? ROWS : ROWS_L) / 128;
    (void)nmt;
    if ((int)blockIdx.x < blk0) return;
    for (int it = item_lo + ((int)blockIdx.x - blk0); it < item_hi; it += nblk) {
        f32x4 acc[4][4];
        if (it < nt2) {
            const int b = it >> 8, k1 = (it >> 1) & 127, nt = it & 1;
            gemm_core<true>(F2, 128, G1 + (size_t)(b * 128 + k1) * 128 * 256 + nt * 128, 256, 128, acc, smem);
            stage_acc(acc, st);
#pragma unroll 1
            for (int i = 0; i < 8; ++i) {
                const int q = tid + 256 * i, m = q >> 4, c8 = (q & 15) * 8;
                const int c = m >> 6, k2 = m & 63;
                float v[8];
                ld8(st + m * ST_LD + c8, v);
                *(uint4*)(pcat + (size_t)(b * SEQ + k1 + 128 * k2) * 512 + c * 256 + nt * 128 + c8) = pack8(v);
            }
        } else {
            const int j0 = it - nt2, tm = j0 >> 1, nt = j0 & 1;
            gemm_core_dma(dbuf + (size_t)tm * 128 * 256 + nt * 128, 256, wp + (size_t)(nt * 128) * 256 + nt * 128, 256, 128, acc, smem);
            stage_acc(acc, st);
            {
                const int c8 = (tid & 15) * 8, r0 = tid >> 4, n = nt * 128 + c8;
                float ps[8];
                ld8(p.pool_scale + l * 256 + n, ps);
                uint4 zr[8];
#pragma unroll
                for (int i = 0; i < 8; ++i) zr[i] = *(const uint4*)(parts + (size_t)(tm * 128 + r0 + 16 * i) * PW + PC_ZP + n);
#pragma unroll
                for (int i = 0; i < 8; ++i) {
                    float v[8], z[8];
                    ld8(st + (r0 + 16 * i) * ST_LD + c8, v);
                    unpack8(zr[i], z);
#pragma unroll
                    for (int e = 0; e < 8; ++e) v[e] = silu_f(z[e]) * ps[e] * v[e];
                    *(uint4*)(cat + (size_t)(tm * 128 + r0 + 16 * i) * DM + 768 + n) = pack8(v);
                }
            }
        }
    }
}

DI void phase_mixf(const Params& p, int l, bf16_t* smem) {
    const int tid = otid();
    float* st = (float*)smem;
    const bf16_t* pcat = (const bf16_t*)(p.ws + OFF_PCAT);
    const bf16_t* wc = (const bf16_t*)(p.ws + OFF_WCOMB) + (size_t)l * 131072;
    const bf16_t* parts = (const bf16_t*)(p.ws + OFF_PARTS);
    bf16_t* cat = (bf16_t*)(p.ws + OFF_H);
    const int nmt = (l == 0 ? ROWS : ROWS_L) / 128;
    for (int it = blockIdx.x; it < nmt * 2; it += gridDim.x) {
        const int tm = it >> 1, nt = it & 1;
        f32x4 acc[4][4];
        gemm_core_dma(pcat + (size_t)tm * 128 * 512, 512, wc + (size_t)(nt * 128) * 512, 512, 512, acc, smem);
        stage_acc(acc, st);
        const float sc = (tm < 128) ? 0.001381067932004976f : 0.0078125f;
        {
            const int c8 = (tid & 15) * 8, r0 = tid >> 4, n = nt * 128 + c8;
            uint4 zr[8];
#pragma unroll
            for (int i = 0; i < 8; ++i) zr[i] = *(const uint4*)(parts + (size_t)(tm * 128 + r0 + 16 * i) * PW + PC_ZF + n);
#pragma unroll
            for (int i = 0; i < 8; ++i) {
                float v[8], z[8];
                ld8(st + (r0 + 16 * i) * ST_LD + c8, v);
                unpack8(zr[i], z);
#pragma unroll
                for (int e = 0; e < 8; ++e) v[e] = silu_f(z[e]) * sc * v[e];
                *(uint4*)(cat + (size_t)(tm * 128 + r0 + 16 * i) * DM + n) = pack8(v);
            }
        }
    }
}

DI void phase_out(const Params& p, int l, const float* xl_in, const float* xc_in, float* xl_out, float* xc_out, bf16_t* smem) {
    const int tid = otid();
    float* st = (float*)smem;
    const bf16_t* cat = (const bf16_t*)(p.ws + OFF_H);
    const bf16_t* W = (const bf16_t*)(p.ws + OFF_WTOUT) + (size_t)l * DM * DM;
    const float* modv = (const float*)(p.ws + OFF_MODV) + (size_t)l * 3 * 3072;
    const int nmt = (l == 0 ? ROWS : ROWS_L) / 128;
    for (XIter t = xiter(nmt * 8); t.u < t.end; t.u += t.step) {
        int tm, tn;
        if (t.u < 1024) { const int ch = t.u >> 6, r = t.u & 63; tn = r >> 3; tm = ch * 8 + (r & 7); }
        else { const int j = t.u - 1024; tn = j >> 2; tm = 128 + (j & 3); }
        f32x4 acc[4][4];
        gemm_core_dma(cat + (size_t)tm * 128 * DM, DM, W + (size_t)tn * 128 * DM, DM, DM, acc, smem);
        stage_acc(acc, st);
        const int rb = tm * 128;
        const int v = (rb < ROWS_L) ? (rb >> 13) : 2;
        const float* gate = modv + v * 3072 + 2048;
        const float* xin = (rb < ROWS_L) ? xl_in : xc_in - (size_t)ROWS_L * DM;
        float* xout = (rb < ROWS_L) ? xl_out : xc_out - (size_t)ROWS_L * DM;
        {
            const int c8 = (tid & 15) * 8, r0 = tid >> 4;
            const size_t o0 = (size_t)(rb + r0) * DM + tn * 128 + c8;
            float gt[8];
            ld8(gate + tn * 128 + c8, gt);
            const bool lat = rb < ROWS_L;
            bf16_t* x1b = (bf16_t*)(p.ws + OFF_X1B);
            float4 x0[8], x1[8];
            if (lat && l == 1) {
#pragma unroll
                for (int i = 0; i < 8; ++i) { const uint4 u = *(const uint4*)(x1b + o0 + (size_t)i * 16 * DM);
                    x0[i] = make_float4(bflo(u.x), bfhi(u.x), bflo(u.y), bfhi(u.y)); x1[i] = make_float4(bflo(u.z), bfhi(u.z), bflo(u.w), bfhi(u.w)); }
            } else {
#pragma unroll
                for (int i = 0; i < 8; ++i) { x0[i] = *(const float4*)(xin + o0 + (size_t)i * 16 * DM); x1[i] = *(const float4*)(xin + o0 + (size_t)i * 16 * DM + 4); }
            }
#pragma unroll
            for (int i = 0; i < 8; ++i) {
                float a[8];
                ld8(st + (r0 + 16 * i) * ST_LD + c8, a);
                const float y0 = x0[i].x + gt[0] * a[0], y1 = x0[i].y + gt[1] * a[1], y2 = x0[i].z + gt[2] * a[2], y3 = x0[i].w + gt[3] * a[3];
                const float y4 = x1[i].x + gt[4] * a[4], y5 = x1[i].y + gt[5] * a[5], y6 = x1[i].z + gt[6] * a[6], y7 = x1[i].w + gt[7] * a[7];
                if (lat && l == 0) {
                    *(uint4*)(x1b + o0 + (size_t)i * 16 * DM) = make_uint4(pack2(y0, y1), pack2(y2, y3), pack2(y4, y5), pack2(y6, y7));
                } else {
                    float* d = xout + o0 + (size_t)i * 16 * DM;
                    *(float4*)(d) = make_float4(y0, y1, y2, y3);
                    *(float4*)(d + 4) = make_float4(y4, y5, y6, y7);
                }
            }
        }
    }
}

#ifndef PH_MASK
#define PH_MASK 0xFFFF
#endif
#ifndef PH_DUP
#define PH_DUP 0
#endif
__global__ void __launch_bounds__(256, 2) fwd_megakernel(Params p) {
    __shared__ __attribute__((aligned(16))) unsigned char smem_raw[SMEM_BYTES];
    bf16_t* smem = (bf16_t*)smem_raw;
    float* smf = (float*)smem_raw;
    volatile LAS unsigned* stw = (volatile LAS unsigned*)(smem_raw + SMEM_MAIN);
    if (threadIdx.x == 0) { stw[0] = 0u; stw[1] = 0u; stw[2] = 0u; stw[3] = 0u; }
    __syncthreads();
    if (p.never) cg::this_grid().sync();
    XcdBarrier bar = xcd_barrier_post((unsigned*)(p.ws + OFF_BAR), stw);

    if (PH_MASK & 1) phase0(p, smf);
    if (PH_DUP & 1) phase0(p, smf);
    xcd_barrier(bar);
    float* xc1 = (float*)(p.ws + OFF_XC1);
    for (int l = 0; l < 2; ++l) {
        const float* xl_in = (l == 0) ? p.x : p.out;
        const float* xc_in = (l == 0) ? p.ctx : xc1;
        if (PH_MASK & 2) phase_norm(p, l, xl_in, xc_in, (l == 1) ? (const bf16_t*)(p.ws + OFF_X1B) : nullptr);
        xcd_barrier(bar);
        if (PH_MASK & 4) phase_inproj(p, l, smem);
        if (PH_DUP & 4) phase_inproj(p, l, smem);
        xcd_barrier(bar);
        if (PH_MASK & 8) phase_attn(p, l, smem);
        if (PH_DUP & 8) phase_attn(p, l, smem);
        if (PH_MASK & 16) phase_convpool(p, l);
        if (PH_DUP & 16) phase_convpool(p, l);
        if (PH_MASK & 32) phase_dft1(p, l, smem);
        if (PH_DUP & 32) phase_dft1(p, l, smem);
        xcd_barrier(bar);
        if (PH_MASK & 64) phase_dft2_mixp(p, l, smem, 0, 512, 0, gridDim.x);
        xcd_barrier(bar);
        {
            const int nmix = (l == 0 ? ROWS : ROWS_L) / 64;
            const int b0 = ((int)gridDim.x > nmix) ? nmix : 0;
            if (PH_MASK & 128) phase_mixf(p, l, smem);
            if (PH_MASK & 64) phase_dft2_mixp(p, l, smem, 512, 512 + nmix, b0, (int)gridDim.x - b0);
        }
        xcd_barrier(bar);
        if (PH_MASK & 256) phase_out(p, l, xl_in, xc_in, p.out, xc1, smem);
        if (PH_DUP & 256) phase_out(p, l, xl_in, xc_in, (float*)(p.ws + OFF_G1), (float*)(p.ws + OFF_G1), smem);
        if (l == 0) xcd_barrier(bar);
    }
}

extern "C" void kernel_launch(void* const* d_in, const int* in_sizes, int n_in, void* d_out, int out_size, void* d_ws, size_t ws_size, hipStream_t stream) {
    static int grid_blocks = 0;
    if (!grid_blocks) {
        int dev = 0, cus = 0, per_cu = 0;
        hipGetDevice(&dev);
        hipDeviceGetAttribute(&cus, hipDeviceAttributeMultiprocessorCount, dev);
        hipOccupancyMaxActiveBlocksPerMultiprocessor(&per_cu, fwd_megakernel, 256, 0);
        if (per_cu > 2) per_cu = 2;
        if (per_cu < 1) per_cu = 1;
        grid_blocks = cus * per_cu;
        if (ws_size < WS_END) fprintf(stderr, "kernel_launch: workspace too small: %zu < %zu\n", ws_size, (size_t)WS_END);
    }
    hipMemsetAsync((char*)d_ws + OFF_BAR, 0, 16384, stream);
    Params p{};
    p.x = (const float*)d_in[0]; p.c = (const float*)d_in[1]; p.ctx = (const float*)d_in[2]; p.c_ctx = (const float*)d_in[3];
    p.w_mod = (const float*)d_in[4]; p.b_mod = (const float*)d_in[5]; p.norm_g = (const float*)d_in[6]; p.w_in = (const float*)d_in[7];
    p.q_gain = (const float*)d_in[8]; p.k_gain = (const float*)d_in[9]; p.w_fourier = (const float*)d_in[10]; p.conv_w = (const float*)d_in[11];
    p.conv_b = (const float*)d_in[12]; p.pool_w = (const float*)d_in[13]; p.pool_scale = (const float*)d_in[14]; p.w_out = (const float*)d_in[15];
    p.out = (float*)d_out; p.ws = (unsigned char*)d_ws; p.never = 0; p.pad = 0;
    void* args[] = {&p};
    hipError_t e = hipLaunchCooperativeKernel((void*)fwd_megakernel, dim3(grid_blocks), dim3(256), args, 0, stream);
    if (e != hipSuccess) fprintf(stderr, "cooperative launch failed: %s (grid %d)\n", hipGetErrorString(e), grid_blocks);
}
```

```cpp
#include <hip/hip_runtime.h>
#include <hip/hip_cooperative_groups.h>
#include <stdint.h>
#include <cstdio>
namespace cg = cooperative_groups;

typedef unsigned short bf16_t;
typedef __attribute__((ext_vector_type(8))) short bf16x8;
typedef __attribute__((ext_vector_type(4))) short bf16x4;
typedef __attribute__((ext_vector_type(4))) float f32x4;
typedef __attribute__((ext_vector_type(16))) float f32x16;
#define DI __device__ __forceinline__

#define SEQ 8192
#define CTX 256
#define DM 1024
#define DIN 2816
#define ROWS_L 16384
#define ROWS_C 512
#define ROWS 16896
#define NKEY 8448
#define PW 1792
#define PC_ZATT 0
#define PC_UF 256
#define PC_ZF 512
#define PC_T 768
#define PC_GC 1024
#define PC_UP 1280
#define PC_ZP 1536

constexpr size_t OFF_BAR = 0;
constexpr size_t OFF_MODV = 16384;
constexpr size_t OFF_ROPE = OFF_MODV + 2 * 3 * 3072 * 4;
constexpr size_t OFF_TW = OFF_ROPE + 6144 * 4;
constexpr size_t OFF_F1 = OFF_TW + 8192 * 2 * 4;
constexpr size_t OFF_F2 = OFF_F1 + 256 * 128 * 2;
constexpr size_t OFF_FC = OFF_F2 + 128 * 128 * 2;
constexpr size_t OFF_WCOMB = OFF_FC + 512 * 256 * 2;
constexpr size_t OFF_WPOOL = OFF_WCOMB + 2 * 256 * 512 * 2;
constexpr size_t OFF_WTIN = 2097152;
constexpr size_t OFF_WTOUT = OFF_WTIN + (size_t)2 * DIN * DM * 2;
constexpr size_t OFF_H = OFF_WTOUT + (size_t)2 * DM * DM * 2;
constexpr size_t OFF_PARTS = OFF_H + (size_t)ROWS * DM * 2;
constexpr size_t OFF_Q = OFF_PARTS + (size_t)ROWS * PW * 2;
constexpr size_t OFF_QC = OFF_Q + (size_t)2 * 4 * SEQ * 64 * 2;
constexpr size_t OFF_K = OFF_QC + (size_t)2 * 4 * CTX * 64 * 2;
constexpr size_t OFF_VT = OFF_K + (size_t)2 * 2 * NKEY * 64 * 2;
constexpr size_t OFF_DBUF = OFF_VT + (size_t)2 * 2 * NKEY * 64 * 2;
constexpr size_t OFF_G1 = OFF_DBUF + (size_t)ROWS * 256 * 2;
constexpr size_t OFF_PCAT = OFF_G1 + (size_t)2 * 128 * 2 * 64 * 256 * 2;
constexpr size_t OFF_XC1 = OFF_PCAT + (size_t)ROWS * 512 * 2;
constexpr size_t OFF_X1B = OFF_XC1 + (size_t)ROWS_C * DM * 4;
constexpr size_t OFF_XC1B = OFF_X1B + (size_t)ROWS_L * DM * 2;
constexpr size_t WS_END = OFF_XC1B + (size_t)ROWS_C * DM * 4;
static_assert(OFF_WPOOL + 2 * 256 * 256 * 2 <= OFF_WTIN, "ws map");

struct Params {
    const float *x, *c, *ctx, *c_ctx, *w_mod, *b_mod, *norm_g, *w_in, *q_gain, *k_gain, *w_fourier, *conv_w, *conv_b, *pool_w, *pool_scale, *w_out;
    float* out;
    unsigned char* ws;
    int never;
    int pad;
};

DI bf16_t f2bf(float x) { unsigned u = __float_as_uint(x); u += 0x7fffu + ((u >> 16) & 1u); return (bf16_t)(u >> 16); }
DI float bf2f(bf16_t h) { return __uint_as_float(((unsigned)h) << 16); }
typedef __attribute__((ext_vector_type(2))) float f32x2;
typedef __attribute__((ext_vector_type(2))) __bf16 bf16x2v;
DI unsigned pack2(float a, float b) { const f32x2 v = {a, b}; return __builtin_bit_cast(unsigned, __builtin_convertvector(v, bf16x2v)); }
struct XIter { int u, end, step; };
DI XIter xiter(int ntiles) {
    const int x = blockIdx.x & 7, j = blockIdx.x >> 3, nb = gridDim.x >> 3, per = (ntiles + 7) >> 3;
    XIter r; r.u = x * per + j; r.end = min((x + 1) * per, ntiles); r.step = nb; return r;
}
DI float silu_f(float z) { return z / (1.f + __expf(-z)); }
DI float bflo(unsigned w) { return __uint_as_float(w << 16); }
DI float bfhi(unsigned w) { return __uint_as_float(w & 0xffff0000u); }
DI int otid() { int t = threadIdx.x; asm volatile("" : "+v"(t)); return t; }

#define XB_TMO      128
#define XB_XCNT(j)  (256  + 64 * (j))
#define XB_XSUB(j)  (1280 + 64 * (j))
#define XB_XGEN(j)  (2304 + 64 * (j))
#define XB_TOP      3328
#define XB_TOPGEN   3392
#define XCD_BAR_WORDS 3456
#define XB_SPIN_CAP (1u << 20)
#define LAS __attribute__((address_space(3)))
DI unsigned xb_ld(unsigned* p) { return __hip_atomic_load(p, __ATOMIC_RELAXED, __HIP_MEMORY_SCOPE_AGENT); }
DI unsigned xb_add(unsigned* p, unsigned v) { return __hip_atomic_fetch_add(p, v, __ATOMIC_RELAXED, __HIP_MEMORY_SCOPE_AGENT); }
DI unsigned xb_xcc_id() { return (unsigned)__builtin_amdgcn_s_getreg((3 << 11) | 20) & 0xFu; }
#define XB_SPIN(cond, bar) do { unsigned _sp = 0; while (cond) { __builtin_amdgcn_s_sleep(1); \
    if ((++_sp & 255u) == 0u) { if (xb_ld(&(bar)[XB_TMO])) break; if (_sp > XB_SPIN_CAP) { atomicAdd(&(bar)[XB_TMO], 1u); break; } } } } while (0)
struct XcdBarrier { unsigned* bar; unsigned x; volatile LAS unsigned* st; };
DI XcdBarrier xcd_barrier_post(unsigned* bar, volatile LAS unsigned* st) {
    XcdBarrier b; b.bar = bar; b.x = xb_xcc_id(); b.st = st;
    if (threadIdx.x == 0) (void)xb_add(&bar[XB_XCNT(b.x)], 1u);
    return b;
}
DI void xcd_barrier_complete(unsigned* bar, unsigned x, unsigned& nloc, unsigned& nx) {
    const unsigned G = gridDim.x * gridDim.y * gridDim.z;
    unsigned sum, cnt, mine, sp = 0u;
    for (;;) {
        sum = 0u; cnt = 0u; mine = 0u;
#pragma unroll
        for (unsigned j = 0; j < 16; ++j) { const unsigned c = xb_ld(&bar[XB_XCNT(j)]); sum += c; cnt += (c > 0u) ? 1u : 0u; mine = (j == x) ? c : mine; }
        if (sum == G) break;
        __builtin_amdgcn_s_sleep(1);
        if ((++sp & 255u) == 0u) { if (xb_ld(&bar[XB_TMO])) break; if (sp > XB_SPIN_CAP) { atomicAdd(&bar[XB_TMO], 1u); break; } }
    }
    nloc = mine > 0u ? mine : 1u; nx = cnt > 0u ? cnt : 1u;
}
DI void xcd_barrier(const XcdBarrier& b) {
    asm volatile("s_waitcnt vmcnt(0)" ::: "memory");
    __syncthreads();
    if (threadIdx.x == 0) {
        unsigned* bar = b.bar;
        __builtin_amdgcn_s_waitcnt(0);
        unsigned nloc = b.st[0], nx = b.st[1];
        if (nloc == 0u) { xcd_barrier_complete(bar, b.x, nloc, nx); b.st[0] = nloc; b.st[1] = nx; }
        const unsigned old = xb_add(&bar[XB_XSUB(b.x)], 1u);
        const unsigned gen = old / nloc;
        if (old + 1u == (gen + 1u) * nloc) {
            __builtin_amdgcn_fence(__ATOMIC_RELEASE, "agent");
            asm volatile("s_waitcnt vmcnt(0)" ::: "memory");
            const unsigned og = xb_add(&bar[XB_TOP], 1u);
            const unsigned tg = og / nx;
            if (og + 1u == (tg + 1u) * nx) xb_add(&bar[XB_TOPGEN], 1u);
            else XB_SPIN(xb_ld(&bar[XB_TOPGEN]) == tg, bar);
            __builtin_amdgcn_fence(__ATOMIC_ACQUIRE, "agent");
            xb_add(&bar[XB_XGEN(b.x)], 1u);
            asm volatile("s_waitcnt vmcnt(0)" ::: "memory");
        } else {
            XB_SPIN(xb_ld(&bar[XB_TOPGEN]) == gen, bar);
            __builtin_amdgcn_fence(__ATOMIC_ACQUIRE, "agent");
            asm volatile("s_waitcnt vmcnt(0)" ::: "memory");
        }
    }
    __syncthreads();
}

#define LROW 72
#define TILE_E (128 * LROW)
#define SMEM_MAIN (4 * TILE_E * 2)
#define SMEM_BYTES (SMEM_MAIN + 16)

typedef __attribute__((ext_vector_type(4))) unsigned u32x4;
struct Stg { u32x4 a0, a1, a2, a3, b0, b1, b2, b3; };
template <bool BN>
DI u32x4 g_ld_b(const bf16_t* __restrict__ B, int ldb, int kt, int q) {
    if (!BN) return *(const u32x4*)(B + (size_t)(q >> 3) * ldb + kt * 64 + (q & 7) * 8);
    else     return *(const u32x4*)(B + (size_t)(kt * 64 + (q >> 4)) * ldb + (q & 15) * 8);
}
template <bool BN>
DI void g_load(Stg& r, const bf16_t* __restrict__ A, int lda, const bf16_t* __restrict__ B, int ldb, int kt, int tid) {
    const bf16_t* ap = A + (size_t)(tid >> 3) * lda + kt * 64 + (tid & 7) * 8;
    r.a0 = *(const u32x4*)(ap);
    r.a1 = *(const u32x4*)(ap + (size_t)32 * lda);
    r.a2 = *(const u32x4*)(ap + (size_t)64 * lda);
    r.a3 = *(const u32x4*)(ap + (size_t)96 * lda);
    r.b0 = g_ld_b<BN>(B, ldb, kt, tid);
    r.b1 = g_ld_b<BN>(B, ldb, kt, tid + 256);
    r.b2 = g_ld_b<BN>(B, ldb, kt, tid + 512);
    r.b3 = g_ld_b<BN>(B, ldb, kt, tid + 768);
}
template <bool BN>
DI void s_st_b(bf16_t* b, const u32x4 v, int q) {
    if (!BN) *(u32x4*)(b + (q >> 3) * LROW + (q & 7) * 8) = v;
    else {
        const int kr0 = q >> 4, n0 = (q & 15) * 8, kr = ((((kr0 >> 3) ^ (q & 7)) << 3) | (kr0 & 7));
        b[(n0 + 0) * LROW + kr] = (bf16_t)(v.x & 0xffffu); b[(n0 + 1) * LROW + kr] = (bf16_t)(v.x >> 16);
        b[(n0 + 2) * LROW + kr] = (bf16_t)(v.y & 0xffffu); b[(n0 + 3) * LROW + kr] = (bf16_t)(v.y >> 16);
        b[(n0 + 4) * LROW + kr] = (bf16_t)(v.z & 0xffffu); b[(n0 + 5) * LROW + kr] = (bf16_t)(v.z >> 16);
        b[(n0 + 6) * LROW + kr] = (bf16_t)(v.w & 0xffffu); b[(n0 + 7) * LROW + kr] = (bf16_t)(v.w >> 16);
    }
}
template <bool BN>
DI void s_store(const Stg& r, bf16_t* smem, int buf, int tid) {
    bf16_t* a = smem + buf * 2 * TILE_E;
    bf16_t* b = a + TILE_E;
    bf16_t* ap = a + (tid >> 3) * LROW + (tid & 7) * 8;
    *(u32x4*)(ap) = r.a0;
    *(u32x4*)(ap + 32 * LROW) = r.a1;
    *(u32x4*)(ap + 64 * LROW) = r.a2;
    *(u32x4*)(ap + 96 * LROW) = r.a3;
    s_st_b<BN>(b, r.b0, tid);
    s_st_b<BN>(b, r.b1, tid + 256);
    s_st_b<BN>(b, r.b2, tid + 512);
    s_st_b<BN>(b, r.b3, tid + 768);
}
DI void mma_tile(const bf16_t* smem, int buf, f32x4 (&acc)[4][4], int wm, int wn, int lane) {
    const bf16_t* a = smem + buf * 2 * TILE_E;
    const bf16_t* b = a + TILE_E;
#pragma unroll
    for (int kk = 0; kk < 2; ++kk) {
        bf16x8 af[4], bfr[4];
#pragma unroll
        for (int mi = 0; mi < 4; ++mi) af[mi] = *(const bf16x8*)(a + (wm * 64 + mi * 16 + (lane & 15)) * LROW + kk * 32 + (lane >> 4) * 8);
#pragma unroll
        for (int ni = 0; ni < 4; ++ni) bfr[ni] = *(const bf16x8*)(b + (wn * 64 + ni * 16 + (lane & 15)) * LROW + (((kk * 4 + (lane >> 4)) ^ ((ni * 2 + ((lane >> 3) & 1)) & 7)) << 3));
#pragma unroll
        for (int mi = 0; mi < 4; ++mi)
#pragma unroll
            for (int ni = 0; ni < 4; ++ni) acc[mi][ni] = __builtin_amdgcn_mfma_f32_16x16x32_bf16(af[mi], bfr[ni], acc[mi][ni], 0, 0, 0);
    }
}
template <bool BN>
DI void gemm_core(const bf16_t* __restrict__ A, int lda, const bf16_t* __restrict__ B, int ldb, int K, f32x4 (&acc)[4][4], bf16_t* smem) {
    const int tid = otid(), lane = tid & 63, wave = tid >> 6;
    const int wm = wave >> 1, wn = wave & 1;
#pragma unroll
    for (int mi = 0; mi < 4; ++mi)
#pragma unroll
        for (int ni = 0; ni < 4; ++ni) acc[mi][ni] = (f32x4){0.f, 0.f, 0.f, 0.f};
    const int nk = K >> 6;
    Stg r0, r1;
    __syncthreads();
    g_load<BN>(r0, A, lda, B, ldb, 0, tid);
    g_load<BN>(r1, A, lda, B, ldb, 1, tid);
    s_store<BN>(r0, smem, 0, tid);
    __syncthreads();
    for (int kt = 0; kt < nk; kt += 2) {
        if (kt + 2 < nk) g_load<BN>(r0, A, lda, B, ldb, kt + 2, tid);
        mma_tile(smem, 0, acc, wm, wn, lane);
        s_store<BN>(r1, smem, 1, tid);
        __syncthreads();
        if (kt + 3 < nk) g_load<BN>(r1, A, lda, B, ldb, kt + 3, tid);
        mma_tile(smem, 1, acc, wm, wn, lane);
        if (kt + 2 < nk) s_store<BN>(r0, smem, 0, tid);
        __syncthreads();
    }
}
#define GT_E (128 * 64)
DI void glds_tile(const bf16_t* __restrict__ G, int ld, int kt, bf16_t* lt, int tid) {
    const int c = (tid & 7) ^ ((tid >> 4) & 7);
    const bf16_t* g = G + (size_t)(tid >> 3) * ld + kt * 64 + c * 8;
    char* l = (char*)lt + tid * 16;
#pragma unroll
    for (int p = 0; p < 4; ++p)
        __builtin_amdgcn_global_load_lds((const unsigned*)(g + (size_t)(p * 32) * ld), (LAS unsigned*)(l + p * 4096), 16, 0, 0);
}
DI void mma_tile_sw(const bf16_t* smem, int buf, f32x4 (&acc)[4][4], int wm, int wn, int lane) {
    const char* a = (const char*)(smem + buf * 2 * GT_E);
    const char* b = a + GT_E * 2;
    const int sw = (lane & 15) >> 1;
#pragma unroll
    for (int kk = 0; kk < 2; ++kk) {
        bf16x8 af[4], bfr[4];
        const int co = ((kk * 4 + (lane >> 4)) ^ sw) << 4;
#pragma unroll
        for (int mi = 0; mi < 4; ++mi) af[mi] = *(const bf16x8*)(a + (wm * 64 + mi * 16 + (lane & 15)) * 128 + co);
#pragma unroll
        for (int ni = 0; ni < 4; ++ni) bfr[ni] = *(const bf16x8*)(b + (wn * 64 + ni * 16 + (lane & 15)) * 128 + co);
#pragma unroll
        for (int mi = 0; mi < 4; ++mi)
#pragma unroll
            for (int ni = 0; ni < 4; ++ni) acc[mi][ni] = __builtin_amdgcn_mfma_f32_16x16x32_bf16(af[mi], bfr[ni], acc[mi][ni], 0, 0, 0);
    }
}
DI void gemm_core_dma(const bf16_t* __restrict__ A, int lda, const bf16_t* __restrict__ B, int ldb, int K, f32x4 (&acc)[4][4], bf16_t* smem) {
    const int tid = otid(), lane = tid & 63, wave = tid >> 6;
    const int wm = wave >> 1, wn = wave & 1;
#pragma unroll
    for (int mi = 0; mi < 4; ++mi)
#pragma unroll
        for (int ni = 0; ni < 4; ++ni) acc[mi][ni] = (f32x4){0.f, 0.f, 0.f, 0.f};
    const int nk = K >> 6;
    __syncthreads();
    glds_tile(A, lda, 0, smem, tid);
    glds_tile(B, ldb, 0, smem + GT_E, tid);
    for (int kt = 0; kt < nk; ++kt) {
        asm volatile("s_waitcnt vmcnt(0)" ::: "memory");
        __syncthreads();
        if (kt + 1 < nk) {
            bf16_t* nb = smem + ((kt + 1) & 1) * 2 * GT_E;
            glds_tile(A, lda, kt + 1, nb, tid);
            glds_tile(B, ldb, kt + 1, nb + GT_E, tid);
        }
        mma_tile_sw(smem, kt & 1, acc, wm, wn, lane);
    }
    __syncthreads();
}
#define ST_LD 132
DI void stage_acc(f32x4 (&acc)[4][4], float* st) {
    const int lane = otid() & 63, wave = otid() >> 6, wm = wave >> 1, wn = wave & 1, fl = lane & 15, g4 = lane >> 4;
#pragma unroll
    for (int mi = 0; mi < 4; ++mi)
#pragma unroll
        for (int ni = 0; ni < 4; ++ni)
#pragma unroll
            for (int j = 0; j < 4; ++j) st[(wm * 64 + mi * 16 + g4 * 4 + j) * ST_LD + wn * 64 + ni * 16 + fl] = acc[mi][ni][j];
    __syncthreads();
}
DI void ld8(const float* q, float (&v)[8]) {
    const float4 a = *(const float4*)q, b = *(const float4*)(q + 4);
    v[0] = a.x; v[1] = a.y; v[2] = a.z; v[3] = a.w; v[4] = b.x; v[5] = b.y; v[6] = b.z; v[7] = b.w;
}
DI uint4 pack8(const float (&v)[8]) { return make_uint4(pack2(v[0], v[1]), pack2(v[2], v[3]), pack2(v[4], v[5]), pack2(v[6], v[7])); }
DI void unpack8(const uint4 u, float (&v)[8]) {
    v[0] = bflo(u.x); v[1] = bfhi(u.x); v[2] = bflo(u.y); v[3] = bfhi(u.y); v[4] = bflo(u.z); v[5] = bfhi(u.z); v[6] = bflo(u.w); v[7] = bfhi(u.w);
}

DI void phase0(const Params& p, float* smf) {
    const int tid = otid();
    unsigned char* ws = p.ws;
    float* modv = (float*)(ws + OFF_MODV);
    for (int it = blockIdx.x; it < 192; it += gridDim.x) {
        const int l = it / 96, n0 = (it % 96) * 32;
        __syncthreads();
        for (int i = tid; i < 3072; i += 256) {
            const int v = i >> 10, k = i & 1023;
            const float cv = (v == 0) ? p.c[k] : (v == 1) ? p.c[1024 + k] : p.c_ctx[k];
            smf[i] = silu_f(cv);
        }
        __syncthreads();
        const int col = tid & 31, kg = tid >> 5;
        float a0 = 0.f, a1 = 0.f, a2 = 0.f;
        const float* w = p.w_mod + (size_t)l * 1024 * 3072 + n0 + col;
#pragma unroll 16
        for (int kk = 0; kk < 128; ++kk) {
            const int k = kg * 128 + kk;
            const float wv = w[(size_t)k * 3072];
            a0 += smf[k] * wv; a1 += smf[1024 + k] * wv; a2 += smf[2048 + k] * wv;
        }
        __syncthreads();
        smf[3072 + (kg * 3 + 0) * 32 + col] = a0; smf[3072 + (kg * 3 + 1) * 32 + col] = a1; smf[3072 + (kg * 3 + 2) * 32 + col] = a2;
        __syncthreads();
        if (tid < 96) {
            const int v = tid >> 5, cc = tid & 31;
            float s = 0.f;
            for (int g = 0; g < 8; ++g) s += smf[3072 + (g * 3 + v) * 32 + cc];
            modv[(l * 3 + v) * 3072 + n0 + cc] = s + p.b_mod[l * 3072 + n0 + cc];
        }
    }
    {
        const int n_in = 2 * 16 * 44, n_out = 2 * 16 * 16;
        for (int it = blockIdx.x; it < n_in + n_out; it += gridDim.x) {
            const float* src; bf16_t* dst; int N, kt, nt;
            if (it < n_in) { const int l = it / 704, r = it % 704; kt = r / 44; nt = r % 44; N = DIN; src = p.w_in + (size_t)l * DM * DIN; dst = (bf16_t*)(ws + OFF_WTIN) + (size_t)l * DIN * DM; }
            else { const int j = it - n_in; const int l = j / 256, r = j % 256; kt = r / 16; nt = r % 16; N = DM; src = p.w_out + (size_t)l * DM * DM; dst = (bf16_t*)(ws + OFF_WTOUT) + (size_t)l * DM * DM; }
            __syncthreads();
#pragma unroll
            for (int ps = 0; ps < 4; ++ps) {
                const int kr = ps * 16 + (tid >> 4), c4 = (tid & 15) * 4;
                const float4 v = *(const float4*)(src + (size_t)(kt * 64 + kr) * N + nt * 64 + c4);
                smf[kr * 65 + c4 + 0] = v.x; smf[kr * 65 + c4 + 1] = v.y; smf[kr * 65 + c4 + 2] = v.z; smf[kr * 65 + c4 + 3] = v.w;
            }
            __syncthreads();
            const int n = tid >> 2, ks = (tid & 3) * 16;
            unsigned w[8];
#pragma unroll
            for (int e = 0; e < 8; ++e) w[e] = pack2(smf[(ks + 2 * e) * 65 + n], smf[(ks + 2 * e + 1) * 65 + n]);
            int ntd = nt;
            if (it < n_in && nt >= 20 && nt < 36) { const int grp = (nt - 20) >> 2, q4 = (nt - 20) & 3; ntd = (grp == 0) ? 28 + 2 * q4 : (grp == 1) ? 20 + 2 * q4 : (grp == 2) ? 21 + 2 * q4 : 29 + 2 * q4; }
            bf16_t* d = dst + (size_t)(ntd * 64 + n) * DM + kt * 64 + ks;
            *(uint4*)d = make_uint4(w[0], w[1], w[2], w[3]);
            *(uint4*)(d + 8) = make_uint4(w[4], w[5], w[6], w[7]);
        }
    }
    const int gtid = blockIdx.x * 256 + tid, gsz = gridDim.x * 256;
    {
        bf16_t* wc = (bf16_t*)(ws + OFF_WCOMB);
        __syncthreads();
        if (tid < 64) { smf[tid] = cospif((float)tid * (1.f / 32.f)); smf[64 + tid] = sinpif((float)tid * (1.f / 32.f)); }
        __syncthreads();
        for (int i = gtid; i < 2 * 512 * 256; i += gsz) {
            const int n = i & 255, kk = (i >> 8) & 511, l = i >> 17;
            const int c = kk >> 8, head = (kk >> 6) & 3, ch = kk & 63;
            const float* wf = p.w_fourier + (size_t)l * 65536 + (size_t)(head * 64) * 256 + n;
            float s = 0.f;
#pragma unroll 16
            for (int j = 0; j < 64; ++j) s += smf[c * 64 + ((j * ch) & 63)] * wf[j * 256];
            wc[(size_t)l * 131072 + n * 512 + kk] = f2bf(s);
        }
    }
    {
        bf16_t* wp = (bf16_t*)(ws + OFF_WPOOL);
        for (int i = gtid; i < 2 * 256 * 256; i += gsz) {
            const int k = i & 255, n = (i >> 8) & 255, l = i >> 16;
            float v = 0.f;
            if ((k >> 6) == (n >> 6)) v = p.pool_w[(size_t)l * 16384 + (n >> 6) * 4096 + (k & 63) * 64 + (n & 63)];
            wp[i] = f2bf(v);
        }
    }
    {
        float* tw = (float*)(ws + OFF_TW);
        for (int i = gtid; i < 8192; i += gsz) { const float a = (float)i * (1.f / 4096.f); tw[2 * i] = cospif(a); tw[2 * i + 1] = sinpif(a); }
        bf16_t* f1 = (bf16_t*)(ws + OFF_F1);
        for (int i = gtid; i < 256 * 128; i += gsz) {
            const int t1 = i & 127, m = i >> 7;
            const int k1 = (m >> 5) * 16 + (m & 15), c = (m >> 4) & 1;
            const float a = (float)((k1 * t1) & 127) * (1.f / 64.f);
            f1[i] = f2bf(c ? -sinpif(a) : cospif(a));
        }
        bf16_t* f2 = (bf16_t*)(ws + OFF_F2);
        for (int i = gtid; i < 128 * 128; i += gsz) {
            const int kx = i & 127, m = i >> 7;
            const int c = m >> 6, k2 = m & 63, cp = kx >> 6, t2 = kx & 63;
            const float a = (float)((k2 * t2) & 63) * (1.f / 32.f);
            float v;
            if (c == cp) v = cospif(a); else if (c == 0) v = sinpif(a); else v = -sinpif(a);
            f2[i] = f2bf(v);
        }
        bf16_t* fc = (bf16_t*)(ws + OFF_FC);
        for (int i = gtid; i < 512 * 256; i += gsz) {
            const int t = i & 255, m = i >> 8;
            const int c = m >> 8, k = m & 255;
            const float a = (float)((k * t) & 255) * (1.f / 128.f);
            fc[i] = f2bf(c ? -sinpif(a) : cospif(a));
        }
        float* rp = (float*)(ws + OFF_ROPE);
        for (int i = gtid; i < 3072; i += gsz) {
            const int f = i & 15;
            const int pos = (i < 2048) ? (i >> 4) : ((i - 2048) >> 4);
            const float inv = powf(10000.f, -(float)f * (1.f / 16.f));
            const float ang = (float)pos * inv;
            const double ad = (double)ang;
            const float cs = (float)cos(ad), sn = (float)sin(ad);
            if (i < 2048) { rp[i] = cs; rp[2048 + i] = sn; }
            else { rp[4096 + (i - 2048)] = cs; rp[5120 + (i - 2048)] = sn; }
        }
    }
}

DI void phase_norm(const Params& p, int l, const float* xl, const float* xc, const bf16_t* xlb) {
    const int lane = otid() & 63, wave = otid() >> 6;
    const float* modv = (const float*)(p.ws + OFF_MODV) + (size_t)l * 3 * 3072;
    const float* g = p.norm_g + l * 1024;
    bf16_t* H = (bf16_t*)(p.ws + OFF_H);
    for (int row = blockIdx.x * 4 + wave; row < ROWS; row += gridDim.x * 4) {
        const float* src = (row < ROWS_L) ? xl + (size_t)row * DM : xc + (size_t)(row - ROWS_L) * DM;
        const int v = (row < ROWS_L) ? (row >> 13) : 2;
        const float* mv = modv + v * 3072;
        float4 a[4];
        float ss = 0.f;
        if (xlb != nullptr && row < ROWS_L) {
            const bf16_t* sb = xlb + (size_t)row * DM;
#pragma unroll
            for (int i = 0; i < 4; ++i) { const uint2 u = *(const uint2*)(sb + i * 256 + lane * 4); a[i] = make_float4(bflo(u.x), bfhi(u.x), bflo(u.y), bfhi(u.y)); }
        } else {
#pragma unroll
            for (int i = 0; i < 4; ++i) a[i] = *(const float4*)(src + i * 256 + lane * 4);
            if (xlb != nullptr) {
                const float* p0 = (const float*)(p.ws + OFF_XC1) + (size_t)(row - ROWS_L) * DM;
                const float* p1 = (const float*)(p.ws + OFF_XC1B) + (size_t)(row - ROWS_L) * DM;
#pragma unroll
                for (int i = 0; i < 4; ++i) {
                    const float4 u = *(const float4*)(p0 + i * 256 + lane * 4), w = *(const float4*)(p1 + i * 256 + lane * 4);
                    a[i].x += u.x + w.x; a[i].y += u.y + w.y; a[i].z += u.z + w.z; a[i].w += u.w + w.w;
                }
            }
        }
#pragma unroll
        for (int i = 0; i < 4; ++i) ss += a[i].x * a[i].x + a[i].y * a[i].y + a[i].z * a[i].z + a[i].w * a[i].w;
#pragma unroll
        for (int o = 32; o >= 1; o >>= 1) ss += __shfl_xor(ss, o);
        const float rs = rsqrtf(ss * (1.f / 1024.f) + 1e-6f);
#pragma unroll
        for (int i = 0; i < 4; ++i) {
            const int c0 = i * 256 + lane * 4;
            const float4 gg = *(const float4*)(g + c0), sh = *(const float4*)(mv + c0), sc = *(const float4*)(mv + 1024 + c0);
            const float o0 = a[i].x * rs * gg.x * (1.f + sc.x) + sh.x, o1 = a[i].y * rs * gg.y * (1.f + sc.y) + sh.y;
            const float o2 = a[i].z * rs * gg.z * (1.f + sc.z) + sh.z, o3 = a[i].w * rs * gg.w * (1.f + sc.w) + sh.w;
            *(uint2*)(H + (size_t)row * DM + c0) = make_uint2(pack2(o0, o1), pack2(o2, o3));
        }
    }
}

DI void epi_inproj(const Params& p, int l, int tm, int tn, f32x4 (&acc)[4][4], float* st) {
    const int tid = otid();
    unsigned char* ws = p.ws;
    stage_acc(acc, st);
    const int rbase = tm * 128;
    const bool isctx = rbase >= ROWS_L;
    if (tn < 3) {
        const bool isq = tn < 2;
        const float* gain = (isq ? p.q_gain : p.k_gain) + l * 64;
        const float* rp = (const float*)(ws + OFF_ROPE);
#pragma unroll 1
        for (int i = 0; i < 8; ++i) {
            const int q = tid + 256 * i, rl = q >> 4, c8 = (q & 15) * 8;
            const int row = rbase + rl, hd = c8 >> 6, d0 = c8 & 63;
            float v[8], pv[8], g[8], pg[8];
            ld8(st + rl * ST_LD + c8, v);
            ld8(st + rl * ST_LD + (c8 ^ 16), pv);
            ld8(gain + d0, g);
            ld8(gain + (d0 ^ 16), pg);
            float ss = 0.f;
#pragma unroll
            for (int e = 0; e < 8; ++e) ss += v[e] * v[e];
            ss += __shfl_xor(ss, 1); ss += __shfl_xor(ss, 2); ss += __shfl_xor(ss, 4);
            const float rs = rsqrtf(ss * (1.f / 64.f) + 1e-6f);
#pragma unroll
            for (int e = 0; e < 8; ++e) { v[e] *= rs * g[e]; pv[e] *= rs * pg[e]; }
            bf16_t* dst;
            if (!isctx) {
                const int b = row >> 13, t = row & 8191;
                const int pos = (d0 >= 32) ? (t & 63) : (t >> 6);
                const float* ct = rp + ((d0 >= 32) ? 4096 : 0) + pos * 16 + (d0 & 8);
                float cs[8], sn[8];
                ld8(ct, cs);
                ld8(ct + ((d0 >= 32) ? 1024 : 2048), sn);
                const float sg = (d0 & 16) ? 1.f : -1.f;
#pragma unroll
                for (int e = 0; e < 8; ++e) v[e] = v[e] * cs[e] + sg * pv[e] * sn[e];
                if (isq) dst = (bf16_t*)(ws + OFF_Q) + ((size_t)(b * 4 + tn * 2 + hd) * SEQ + t) * 64 + d0;
                else     dst = (bf16_t*)(ws + OFF_K) + ((size_t)(b * 2 + hd) * NKEY + CTX + t) * 64 + d0;
            } else {
                const int rc = row - ROWS_L, b = rc >> 8, t = rc & 255;
                if (isq) dst = (bf16_t*)(ws + OFF_QC) + ((size_t)(b * 4 + tn * 2 + hd) * CTX + t) * 64 + d0;
                else     dst = (bf16_t*)(ws + OFF_K) + ((size_t)(b * 2 + hd) * NKEY + t) * 64 + d0;
            }
            if (isq) {
#pragma unroll
                for (int e = 0; e < 8; ++e) v[e] *= 0.18033688011112042f;
            }
            *(uint4*)dst = pack8(v);
        }
    } else if (tn == 3) {
        int b, key0;
        if (!isctx) { b = rbase >> 13; key0 = CTX + (rbase & 8191); } else { const int rc = rbase - ROWS_L; b = rc >> 8; key0 = rc & 255; }
#pragma unroll 1
        for (int i = 0; i < 8; ++i) {
            const int q = tid + 256 * i, col = q & 127, r8 = (q >> 7) * 8;
            float v[8];
#pragma unroll
            for (int e = 0; e < 8; ++e) v[e] = st[(r8 + e) * ST_LD + col];
            bf16_t* vt = (bf16_t*)(ws + OFF_VT) + ((size_t)(b * 2 + (col >> 6)) * 64 + (col & 63)) * NKEY + key0 + r8;
            *(uint4*)vt = pack8(v);
        }
    } else {
        bf16_t* parts = (bf16_t*)(ws + OFF_PARTS);
        if (tn >= 10 && tn < 18) {
            const bool isg = tn >= 14;
            const int dcol = (isg ? PC_GC + (tn - 14) * 64 : PC_T + (tn - 10) * 64);
#pragma unroll 1
            for (int i = 0; i < 4; ++i) {
                const int q = tid + 256 * i, rl = q >> 3, c8 = (q & 7) * 8;
                float v[8], w[8];
                ld8(st + rl * ST_LD + c8, v);
                ld8(st + rl * ST_LD + 64 + c8, w);
#pragma unroll
                for (int e = 0; e < 8; ++e) v[e] = isg ? silu_f(w[e]) * v[e] : v[e] * w[e];
                *(uint4*)(parts + (size_t)(rbase + rl) * PW + dcol + c8) = pack8(v);
            }
        } else {
            const int dbase = (tn < 10) ? tn * 128 - 512 : PC_UP + (tn - 18) * 128;
#pragma unroll 1
            for (int i = 0; i < 8; ++i) {
                const int q = tid + 256 * i, rl = q >> 4, c8 = (q & 15) * 8;
                float v[8];
                ld8(st + rl * ST_LD + c8, v);
                *(uint4*)(parts + (size_t)(rbase + rl) * PW + dbase + c8) = pack8(v);
            }
        }
    }
}

DI void phase_inproj(const Params& p, int l, bf16_t* smem) {
    const bf16_t* H = (const bf16_t*)(p.ws + OFF_H);
    const bf16_t* W = (const bf16_t*)(p.ws + OFF_WTIN) + (size_t)l * DIN * DM;
    const int nlat = 128 * 22;
    const int ntiles = nlat + (l == 0 ? 4 * 22 : 4 * 2);
    for (XIter t = xiter(ntiles); t.u < t.end; t.u += t.step) {
        const int u = t.u;
        int tm, tn;
        if (u < nlat) { const int ch = u / 176, r = u % 176; tn = r >> 3; tm = ch * 8 + (r & 7); }
        else { const int j = u - nlat; tm = 128 + (j & 3); tn = (l == 0 ? 0 : 2) + (j >> 2); }
        f32x4 acc[4][4];
        gemm_core_dma(H + (size_t)tm * 128 * DM, DM, W + (size_t)tn * 128 * DM, DM, DM, acc, smem);
        epi_inproj(p, l, tm, tn, acc, (float*)smem);
    }
}

#define KT_E (64 * LROW)
DI void attn_item(const Params& p, const bf16_t* Qb, const bf16_t* Kb, const bf16_t* VTb, int ntiles, int rowbase, int hq, bf16_t* smem) {
    const int tid = otid(), lane = tid & 63, wave = tid >> 6;
    const int r = lane & 31, h = lane >> 5;
    const float LOG2E = 1.4426950408889634f;
    bf16x8 qf[4];
    {
        const bf16_t* qrow = Qb + (size_t)(wave * 32 + r) * 64;
#pragma unroll
        for (int s = 0; s < 4; ++s) qf[s] = *(const bf16x8*)(qrow + s * 16 + h * 8);
    }
    f32x16 ot[2], zacc;
#pragma unroll
    for (int i = 0; i < 16; ++i) { ot[0][i] = 0.f; ot[1][i] = 0.f; zacc[i] = 0.f; }
    float m = 0.f, lsum = 0.f;
    bool stab = false;
    uint4 rk[2], rv[2];
    auto gload = [&](int kt) {
#pragma unroll
        for (int i = 0; i < 2; ++i) {
            const int q = tid + 256 * i;
            rk[i] = *(const uint4*)(Kb + (size_t)(kt * 64 + (q >> 3)) * 64 + (q & 7) * 8);
            rv[i] = *(const uint4*)(VTb + (size_t)(q >> 3) * NKEY + kt * 64 + (q & 7) * 8);
        }
    };
    auto sstore = [&](int buf) {
        bf16_t* sk = smem + buf * 2 * KT_E;
        bf16_t* sv = sk + KT_E;
#pragma unroll
        for (int i = 0; i < 2; ++i) {
            const int q = tid + 256 * i;
            *(uint4*)(sk + (q >> 3) * LROW + (q & 7) * 8) = rk[i];
            *(uint4*)(sv + (q >> 3) * LROW + (q & 7) * 8) = rv[i];
        }
    };
    __syncthreads();
    gload(0);
    sstore(0);
    __syncthreads();
    for (int kt = 0; kt < ntiles; ++kt) {
        if (kt + 1 < ntiles) gload(kt + 1);
        const bf16_t* sk = smem + (kt & 1) * 2 * KT_E;
        const bf16_t* sv = sk + KT_E;
        f32x16 st[2], pe[2];
#pragma unroll
        for (int blk = 0; blk < 2; ++blk) {
            st[blk] = __builtin_amdgcn_mfma_f32_32x32x16_bf16(*(const bf16x8*)(sk + (blk * 32 + r) * LROW + h * 8), qf[0], zacc, 0, 0, 0);
#pragma unroll
            for (int s = 1; s < 4; ++s)
                st[blk] = __builtin_amdgcn_mfma_f32_32x32x16_bf16(*(const bf16x8*)(sk + (blk * 32 + r) * LROW + s * 16 + h * 8), qf[s], st[blk], 0, 0, 0);
        }
        if (stab) {
#pragma unroll
            for (int i = 0; i < 16; ++i) { st[0][i] -= m; st[1][i] -= m; }
        }
        float ls = 0.f;
#pragma unroll
        for (int i = 0; i < 16; ++i) {
            pe[0][i] = __builtin_amdgcn_exp2f(st[0][i]); ls += pe[0][i];
            pe[1][i] = __builtin_amdgcn_exp2f(st[1][i]); ls += pe[1][i];
        }
        if (__any(!(ls <= 1.0e12f) || (ls < 1.0e-25f))) {
            float tmx = st[0][0];
#pragma unroll
            for (int i = 0; i < 16; ++i) { tmx = fmaxf(tmx, st[0][i]); tmx = fmaxf(tmx, st[1][i]); }
            tmx = fmaxf(tmx, __shfl_xor(tmx, 32));
            const float lrow = lsum + __shfl_xor(lsum, 32);
            const bool rebase = !(lrow >= 1.0e-20f);
            const float delta = rebase ? tmx : fmaxf(tmx, 0.f);
            const float alpha = rebase ? 0.f : __builtin_amdgcn_exp2f(-delta);
            m += delta;
            stab = true;
            lsum *= alpha;
            ls = 0.f;
#pragma unroll
            for (int i = 0; i < 16; ++i) {
                ot[0][i] *= alpha; ot[1][i] *= alpha;
                pe[0][i] = __builtin_amdgcn_exp2f(st[0][i] - delta); ls += pe[0][i];
                pe[1][i] = __builtin_amdgcn_exp2f(st[1][i] - delta); ls += pe[1][i];
            }
        }
        lsum += ls;
        bf16x8 pk[2][2];
#pragma unroll
        for (int blk = 0; blk < 2; ++blk)
#pragma unroll
            for (int s = 0; s < 2; ++s) {
                uint4 u;
                u.x = pack2(pe[blk][8 * s + 0], pe[blk][8 * s + 1]); u.y = pack2(pe[blk][8 * s + 2], pe[blk][8 * s + 3]);
                u.z = pack2(pe[blk][8 * s + 4], pe[blk][8 * s + 5]); u.w = pack2(pe[blk][8 * s + 6], pe[blk][8 * s + 7]);
                pk[blk][s] = __builtin_bit_cast(bf16x8, u);
            }
#pragma unroll
        for (int db = 0; db < 2; ++db)
#pragma unroll
            for (int blk = 0; blk < 2; ++blk)
#pragma unroll
                for (int s = 0; s < 2; ++s) {
                    const bf16_t* vp = sv + (db * 32 + r) * LROW + blk * 32 + s * 16 + h * 4;
                    const bf16x4 lo = *(const bf16x4*)vp;
                    const bf16x4 hi = *(const bf16x4*)(vp + 8);
                    const bf16x8 vf = __builtin_shufflevector(lo, hi, 0, 1, 2, 3, 4, 5, 6, 7);
                    ot[db] = __builtin_amdgcn_mfma_f32_32x32x16_bf16(vf, pk[blk][s], ot[db], 0, 0, 0);
                }
        if (kt + 1 < ntiles) sstore((kt + 1) & 1);
        __syncthreads();
    }
    lsum += __shfl_xor(lsum, 32);
    const float inv = 1.f / lsum;
    const int row = rowbase + wave * 32 + r;
    const bf16_t* zrow = (const bf16_t*)(p.ws + OFF_PARTS) + (size_t)row * PW + PC_ZATT + hq * 64;
    bf16_t* orow = (bf16_t*)(p.ws + OFF_H) + (size_t)row * DM + 256 + hq * 64;
#pragma unroll
    for (int db = 0; db < 2; ++db)
#pragma unroll
        for (int g = 0; g < 4; ++g) {
            const int d = db * 32 + g * 8 + h * 4;
            const uint2 z = *(const uint2*)(zrow + d);
            const float o0 = silu_f(bflo(z.x)) * ot[db][4 * g + 0] * inv, o1 = silu_f(bfhi(z.x)) * ot[db][4 * g + 1] * inv;
            const float o2 = silu_f(bflo(z.y)) * ot[db][4 * g + 2] * inv, o3 = silu_f(bfhi(z.y)) * ot[db][4 * g + 3] * inv;
            *(uint2*)(orow + d) = make_uint2(pack2(o0, o1), pack2(o2, o3));
        }
}

DI void phase_attn(const Params& p, int l, bf16_t* smem) {
    const bf16_t* Q = (const bf16_t*)(p.ws + OFF_Q);
    const bf16_t* QC = (const bf16_t*)(p.ws + OFF_QC);
    const bf16_t* Kk = (const bf16_t*)(p.ws + OFF_K);
    const bf16_t* VT = (const bf16_t*)(p.ws + OFF_VT);
    for (XIter t = xiter(512); t.u < t.end; t.u += t.step) {
        const int it = t.u;
        const int b = it >> 8, hq = (it >> 6) & 3, qt = it & 63;
        const size_t kv = (size_t)(b * 2 + (hq >> 1));
        attn_item(p, Q + ((size_t)(b * 4 + hq) * SEQ + qt * 128) * 64, Kk + kv * NKEY * 64, VT + kv * 64 * NKEY, NKEY / 64, b * SEQ + qt * 128, hq, smem);
    }
    if (l == 0) {
        for (int j = blockIdx.x; j < 16; j += gridDim.x) {
            const int b = j >> 3, hq = (j >> 1) & 3, qt = j & 1;
            const size_t kv = (size_t)(b * 2 + (hq >> 1));
            attn_item(p, QC + ((size_t)(b * 4 + hq) * CTX + qt * 128) * 64, Kk + kv * NKEY * 64, VT + kv * 64 * NKEY, CTX / 64, ROWS_L + b * CTX + qt * 128, hq, smem);
        }
    }
}

template <int W>
DI void pool_task(const bf16_t* __restrict__ pu, int pos, int n, bf16_t* __restrict__ dst) {
    constexpr int LEFT = W / 2;
    uint4 raw[W];
#pragma unroll
    for (int t = 0; t < W; ++t) { int q = pos - LEFT + t; q = q < 0 ? 0 : (q >= n ? n - 1 : q); raw[t] = *(const uint4*)(pu + (size_t)q * PW); }
    float sum[8], u[8];
#pragma unroll
    for (int e = 0; e < 8; ++e) sum[e] = 0.f;
#pragma unroll
    for (int t = 0; t < W; ++t) {
        const int q = pos - LEFT + t;
        const float mk = (q >= 0 && q < n) ? 1.f : 0.f;
        unpack8(raw[t], u);
#pragma unroll
        for (int e = 0; e < 8; ++e) sum[e] += mk * u[e];
    }
    const int lo = max(pos - LEFT, 0), hi = min(pos + W - LEFT, n);
    const float ic = 1.f / (float)(hi - lo);
    unpack8(raw[LEFT], u);
#pragma unroll
    for (int e = 0; e < 8; ++e) sum[e] = sum[e] * ic - u[e];
    *(uint4*)dst = pack8(sum);
}
DI void phase_convpool(const Params& p, int l) {
    const bf16_t* __restrict__ parts = (const bf16_t*)(p.ws + OFF_PARTS);
    bf16_t* __restrict__ cat = (bf16_t*)(p.ws + OFF_H);
    bf16_t* __restrict__ dbuf = (bf16_t*)(p.ws + OFF_DBUF);
    const int nrows = (l == 0 ? ROWS : ROWS_L);
    const int gsz = gridDim.x * 256, gt = blockIdx.x * 256 + otid();
    {
        const int c8 = (gt & 31) * 8;
        float w0[8], w1[8], w2[8], bs[8];
        ld8(p.conv_w + l * 768 + c8, w0); ld8(p.conv_w + l * 768 + 256 + c8, w1); ld8(p.conv_w + l * 768 + 512 + c8, w2); ld8(p.conv_b + l * 256 + c8, bs);
        for (int i = gt; i < nrows * 32; i += gsz) {
            const int row = i >> 5;
            int seq0, n;
            if (row < ROWS_L) { seq0 = (row >> 13) << 13; n = SEQ; } else { seq0 = ROWS_L + (((row - ROWS_L) >> 8) << 8); n = CTX; }
            const int pos = row - seq0;
            const bf16_t* pr = parts + (size_t)row * PW + c8;
            const bool hp = pos > 0, hn = pos + 1 < n;
            const bf16_t* pp = hp ? pr - PW : pr;
            const bf16_t* pn = hn ? pr + PW : pr;
            const uint4 r0 = *(const uint4*)(pr + PC_T), r2 = *(const uint4*)(pp + PC_T), r4 = *(const uint4*)(pn + PC_T), r6 = *(const uint4*)(pr + PC_GC);
            const float mp = hp ? 1.f : 0.f, mn = hn ? 1.f : 0.f;
            float tc[8], tp[8], tn[8], gg[8], o[8];
            unpack8(r0, tc); unpack8(r2, tp); unpack8(r4, tn); unpack8(r6, gg);
#pragma unroll
            for (int e = 0; e < 8; ++e) o[e] = gg[e] * (mp * tp[e] * w0[e] + tc[e] * w1[e] + mn * tn[e] * w2[e] + bs[e]);
            *(uint4*)(cat + (size_t)row * DM + 512 + c8) = pack8(o);
        }
    }
    for (int j = gt; j < nrows * 32; j += gsz) {
        const int g = j / (nrows * 8), rem = j - g * (nrows * 8), row = rem >> 3, c8 = g * 64 + (rem & 7) * 8;
        int seq0, n;
        if (row < ROWS_L) { seq0 = (row >> 13) << 13; n = SEQ; } else { seq0 = ROWS_L + (((row - ROWS_L) >> 8) << 8); n = CTX; }
        const bf16_t* pu = parts + (size_t)seq0 * PW + PC_UP + c8;
        bf16_t* dst = dbuf + (size_t)row * 256 + c8;
        const int pos = row - seq0;
        if (g == 0) pool_task<2>(pu, pos, n, dst);
        else if (g == 1) pool_task<4>(pu, pos, n, dst);
        else if (g == 2) pool_task<8>(pu, pos, n, dst);
        else pool_task<16>(pu, pos, n, dst);
    }
}

DI void phase_dft1(const Params& p, int l, bf16_t* smem) {
    const int tid = otid();
    float* st = (float*)smem;
    const bf16_t* parts = (const bf16_t*)(p.ws + OFF_PARTS);
    const bf16_t* F1 = (const bf16_t*)(p.ws + OFF_F1);
    const bf16_t* FC = (const bf16_t*)(p.ws + OFF_FC);
    const float* tw = (const float*)(p.ws + OFF_TW);
    bf16_t* G1 = (bf16_t*)(p.ws + OFF_G1);
    bf16_t* pcat = (bf16_t*)(p.ws + OFF_PCAT);
    const int nt1 = 2 * 64 * 4;
    const int ntot = nt1 + (l == 0 ? 16 : 0);
    for (int it = blockIdx.x; it < ntot; it += gridDim.x) {
        f32x4 acc[4][4];
        if (it < nt1) {
            const int b = it >> 8, t2 = (it >> 2) & 63, mt = (it >> 1) & 1, nt = it & 1;
            gemm_core<true>(F1 + (size_t)mt * 128 * 128, 128, parts + (size_t)(b * SEQ + t2) * PW + PC_UF + nt * 128, 64 * PW, 128, acc, smem);
            stage_acc(acc, st);
#pragma unroll 1
            for (int i = 0; i < 4; ++i) {
                const int q = tid + 256 * i, kk = q >> 4, c8 = (q & 15) * 8;
                const int rr = 32 * (kk >> 4) + (kk & 15);
                const int k1 = mt * 64 + kk;
                const float cs = tw[2 * (k1 * t2)], sn = tw[2 * (k1 * t2) + 1];
                float gr[8], gi[8], o[8];
                ld8(st + rr * ST_LD + c8, gr);
                ld8(st + (rr + 16) * ST_LD + c8, gi);
                bf16_t* dr = G1 + ((size_t)((b * 128 + k1) * 2 + 0) * 64 + t2) * 256 + nt * 128 + c8;
#pragma unroll
                for (int e = 0; e < 8; ++e) o[e] = gr[e] * cs + gi[e] * sn;
                *(uint4*)dr = pack8(o);
#pragma unroll
                for (int e = 0; e < 8; ++e) o[e] = gi[e] * cs - gr[e] * sn;
                *(uint4*)(dr + (size_t)64 * 256) = pack8(o);
            }
        } else {
            const int j0 = it - nt1, b = j0 >> 3, mt = (j0 >> 1) & 3, nt = j0 & 1;
            gemm_core<true>(FC + (size_t)mt * 128 * 256, 256, parts + (size_t)(ROWS_L + b * CTX) * PW + PC_UF + nt * 128, PW, 256, acc, smem);
            stage_acc(acc, st);
#pragma unroll 1
            for (int i = 0; i < 8; ++i) {
                const int q = tid + 256 * i, rl = q >> 4, c8 = (q & 15) * 8;
                const int m = mt * 128 + rl, c = m >> 8, k = m & 255;
                float v[8];
                ld8(st + rl * ST_LD + c8, v);
                *(uint4*)(pcat + (size_t)(ROWS_L + b * CTX + k) * 512 + c * 256 + nt * 128 + c8) = pack8(v);
            }
        }
    }
}

DI void phase_dft2_mixp(const Params& p, int l, bf16_t* smem, int item_lo, int item_hi, int blk0, int nblk) {
    const int tid = otid();
    float* st = (float*)smem;
    const bf16_t* F2 = (const bf16_t*)(p.ws + OFF_F2);
    const bf16_t* G1 = (const bf16_t*)(p.ws + OFF_G1);
    bf16_t* pcat = (bf16_t*)(p.ws + OFF_PCAT);
    const bf16_t* dbuf = (const bf16_t*)(p.ws + OFF_DBUF);
    const bf16_t* wp = (const bf16_t*)(p.ws + OFF_WPOOL) + (size_t)l * 65536;
    const bf16_t* parts = (const bf16_t*)(p.ws + OFF_PARTS);
    bf16_t* cat = (bf16_t*)(p.ws + OFF_H);
    const int nt2 = 2 * 128 * 2;
    const int nmt = (l == 0 ? ROWS : ROWS_L) / 128;
    (void)nmt;
    if ((int)blockIdx.x < blk0) return;
    for (int it = item_lo + ((int)blockIdx.x - blk0); it < item_hi; it += nblk) {
        f32x4 acc[4][4];
        if (it < nt2) {
            const int b = it >> 8, k1 = (it >> 1) & 127, nt = it & 1;
            gemm_core<true>(F2, 128, G1 + (size_t)(b * 128 + k1) * 128 * 256 + nt * 128, 256, 128, acc, smem);
            stage_acc(acc, st);
#pragma unroll 1
            for (int i = 0; i < 8; ++i) {
                const int q = tid + 256 * i, m = q >> 4, c8 = (q & 15) * 8;
                const int c = m >> 6, k2 = m & 63;
                float v[8];
                ld8(st + m * ST_LD + c8, v);
                *(uint4*)(pcat + (size_t)(b * SEQ + k1 + 128 * k2) * 512 + c * 256 + nt * 128 + c8) = pack8(v);
            }
        } else {
            const int j0 = it - nt2, tm = j0 >> 1, nt = j0 & 1;
            gemm_core_dma(dbuf + (size_t)tm * 128 * 256 + nt * 128, 256, wp + (size_t)(nt * 128) * 256 + nt * 128, 256, 128, acc, smem);
            stage_acc(acc, st);
            {
                const int c8 = (tid & 15) * 8, r0 = tid >> 4, n = nt * 128 + c8;
                float ps[8];
                ld8(p.pool_scale + l * 256 + n, ps);
                uint4 zr[8];
#pragma unroll
                for (int i = 0; i < 8; ++i) zr[i] = *(const uint4*)(parts + (size_t)(tm * 128 + r0 + 16 * i) * PW + PC_ZP + n);
#pragma unroll
                for (int i = 0; i < 8; ++i) {
                    float v[8], z[8];
                    ld8(st + (r0 + 16 * i) * ST_LD + c8, v);
                    unpack8(zr[i], z);
#pragma unroll
                    for (int e = 0; e < 8; ++e) v[e] = silu_f(z[e]) * ps[e] * v[e];
                    *(uint4*)(cat + (size_t)(tm * 128 + r0 + 16 * i) * DM + 768 + n) = pack8(v);
                }
            }
        }
    }
}

DI void phase_mixf(const Params& p, int l, bf16_t* smem) {
    const int tid = otid();
    float* st = (float*)smem;
    const bf16_t* pcat = (const bf16_t*)(p.ws + OFF_PCAT);
    const bf16_t* wc = (const bf16_t*)(p.ws + OFF_WCOMB) + (size_t)l * 131072;
    const bf16_t* parts = (const bf16_t*)(p.ws + OFF_PARTS);
    bf16_t* cat = (bf16_t*)(p.ws + OFF_H);
    const int nmt = (l == 0 ? ROWS : ROWS_L) / 128;
    for (int it = blockIdx.x; it < nmt * 2; it += gridDim.x) {
        const int tm = it >> 1, nt = it & 1;
        f32x4 acc[4][4];
        gemm_core_dma(pcat + (size_t)tm * 128 * 512, 512, wc + (size_t)(nt * 128) * 512, 512, 512, acc, smem);
        stage_acc(acc, st);
        const float sc = (tm < 128) ? 0.001381067932004976f : 0.0078125f;
        {
            const int c8 = (tid & 15) * 8, r0 = tid >> 4, n = nt * 128 + c8;
            uint4 zr[8];
#pragma unroll
            for (int i = 0; i < 8; ++i) zr[i] = *(const uint4*)(parts + (size_t)(tm * 128 + r0 + 16 * i) * PW + PC_ZF + n);
#pragma unroll
            for (int i = 0; i < 8; ++i) {
                float v[8], z[8];
                ld8(st + (r0 + 16 * i) * ST_LD + c8, v);
                unpack8(zr[i], z);
#pragma unroll
                for (int e = 0; e < 8; ++e) v[e] = silu_f(z[e]) * sc * v[e];
                *(uint4*)(cat + (size_t)(tm * 128 + r0 + 16 * i) * DM + n) = pack8(v);
            }
        }
    }
}

DI void phase_out(const Params& p, int l, const float* xl_in, const float* xc_in, float* xl_out, float* xc_out, bf16_t* smem) {
    const int tid = otid();
    float* st = (float*)smem;
    const bf16_t* cat = (const bf16_t*)(p.ws + OFF_H);
    const bf16_t* W = (const bf16_t*)(p.ws + OFF_WTOUT) + (size_t)l * DM * DM;
    const float* modv = (const float*)(p.ws + OFF_MODV) + (size_t)l * 3 * 3072;
    const int nmt = (l == 0 ? ROWS : ROWS_L) / 128;
    (void)nmt;
    for (XIter t = xiter(1024); t.u < t.end; t.u += t.step) {
        int tm, tn;
        { const int ch = t.u >> 6, r = t.u & 63; tn = r >> 3; tm = ch * 8 + (r & 7); }
        f32x4 acc[4][4];
        gemm_core_dma(cat + (size_t)tm * 128 * DM, DM, W + (size_t)tn * 128 * DM, DM, DM, acc, smem);
        stage_acc(acc, st);
        const int rb = tm * 128;
        const int v = (rb < ROWS_L) ? (rb >> 13) : 2;
        const float* gate = modv + v * 3072 + 2048;
        const float* xin = (rb < ROWS_L) ? xl_in : xc_in - (size_t)ROWS_L * DM;
        float* xout = (rb < ROWS_L) ? xl_out : xc_out - (size_t)ROWS_L * DM;
        {
            const int c8 = (tid & 15) * 8, r0 = tid >> 4;
            const size_t o0 = (size_t)(rb + r0) * DM + tn * 128 + c8;
            float gt[8];
            ld8(gate + tn * 128 + c8, gt);
            const bool lat = rb < ROWS_L;
            bf16_t* x1b = (bf16_t*)(p.ws + OFF_X1B);
            float4 x0[8], x1[8];
            if (lat && l == 1) {
#pragma unroll
                for (int i = 0; i < 8; ++i) { const uint4 u = *(const uint4*)(x1b + o0 + (size_t)i * 16 * DM);
                    x0[i] = make_float4(bflo(u.x), bfhi(u.x), bflo(u.y), bfhi(u.y)); x1[i] = make_float4(bflo(u.z), bfhi(u.z), bflo(u.w), bfhi(u.w)); }
            } else {
#pragma unroll
                for (int i = 0; i < 8; ++i) { x0[i] = *(const float4*)(xin + o0 + (size_t)i * 16 * DM); x1[i] = *(const float4*)(xin + o0 + (size_t)i * 16 * DM + 4); }
            }
#pragma unroll
            for (int i = 0; i < 8; ++i) {
                float a[8];
                ld8(st + (r0 + 16 * i) * ST_LD + c8, a);
                const float y0 = x0[i].x + gt[0] * a[0], y1 = x0[i].y + gt[1] * a[1], y2 = x0[i].z + gt[2] * a[2], y3 = x0[i].w + gt[3] * a[3];
                const float y4 = x1[i].x + gt[4] * a[4], y5 = x1[i].y + gt[5] * a[5], y6 = x1[i].z + gt[6] * a[6], y7 = x1[i].w + gt[7] * a[7];
                if (lat && l == 0) {
                    *(uint4*)(x1b + o0 + (size_t)i * 16 * DM) = make_uint4(pack2(y0, y1), pack2(y2, y3), pack2(y4, y5), pack2(y6, y7));
                } else {
                    float* d = xout + o0 + (size_t)i * 16 * DM;
                    *(float4*)(d) = make_float4(y0, y1, y2, y3);
                    *(float4*)(d + 4) = make_float4(y4, y5, y6, y7);
                }
            }
        }
    }
    if (l == 0) {
        for (int j = blockIdx.x; j < 64; j += gridDim.x) {
            const int kh = j & 1, tn = (j >> 1) & 7, tm = 128 + (j >> 4);
            f32x4 acc[4][4];
            gemm_core_dma(cat + (size_t)tm * 128 * DM + kh * 512, DM, W + (size_t)tn * 128 * DM + kh * 512, DM, 512, acc, smem);
            stage_acc(acc, st);
            float* part = (float*)(p.ws + (kh ? OFF_XC1B : OFF_XC1));
            const int c8 = (tid & 15) * 8, r0 = tid >> 4;
            float gt[8];
            ld8(modv + 2 * 3072 + 2048 + tn * 128 + c8, gt);
#pragma unroll
            for (int i = 0; i < 8; ++i) {
                float a[8];
                ld8(st + (r0 + 16 * i) * ST_LD + c8, a);
                float* d = part + (size_t)(tm * 128 - ROWS_L + r0 + 16 * i) * DM + tn * 128 + c8;
                *(float4*)(d) = make_float4(gt[0] * a[0], gt[1] * a[1], gt[2] * a[2], gt[3] * a[3]);
                *(float4*)(d + 4) = make_float4(gt[4] * a[4], gt[5] * a[5], gt[6] * a[6], gt[7] * a[7]);
            }
        }
    }
}

#ifndef PH_MASK
#define PH_MASK 0xFFFF
#endif
#ifndef PH_DUP
#define PH_DUP 0
#endif
__global__ void __launch_bounds__(256, 2) fwd_megakernel(Params p) {
    __shared__ __attribute__((aligned(16))) unsigned char smem_raw[SMEM_BYTES];
    bf16_t* smem = (bf16_t*)smem_raw;
    float* smf = (float*)smem_raw;
    volatile LAS unsigned* stw = (volatile LAS unsigned*)(smem_raw + SMEM_MAIN);
    if (threadIdx.x == 0) { stw[0] = 0u; stw[1] = 0u; stw[2] = 0u; stw[3] = 0u; }
    __syncthreads();
    if (p.never) cg::this_grid().sync();
    XcdBarrier bar = xcd_barrier_post((unsigned*)(p.ws + OFF_BAR), stw);

    if (PH_MASK & 1) phase0(p, smf);
    if (PH_DUP & 1) phase0(p, smf);
    xcd_barrier(bar);
    float* xc1 = (float*)(p.ws + OFF_XC1);
    for (int l = 0; l < 2; ++l) {
        const float* xl_in = (l == 0) ? p.x : p.out;
        const float* xc_in = p.ctx;
        if (PH_MASK & 2) phase_norm(p, l, xl_in, xc_in, (l == 1) ? (const bf16_t*)(p.ws + OFF_X1B) : nullptr);
        xcd_barrier(bar);
        if (PH_MASK & 4) phase_inproj(p, l, smem);
        if (PH_DUP & 4) phase_inproj(p, l, smem);
        xcd_barrier(bar);
        if (PH_MASK & 8) phase_attn(p, l, smem);
        if (PH_DUP & 8) phase_attn(p, l, smem);
        if (PH_MASK & 16) phase_convpool(p, l);
        if (PH_DUP & 16) phase_convpool(p, l);
        if (PH_MASK & 32) phase_dft1(p, l, smem);
        if (PH_DUP & 32) phase_dft1(p, l, smem);
        xcd_barrier(bar);
        if (PH_MASK & 64) phase_dft2_mixp(p, l, smem, 0, 512, 0, gridDim.x);
        xcd_barrier(bar);
        {
            const int nmix = (l == 0 ? ROWS : ROWS_L) / 64;
            const int b0 = ((int)gridDim.x > nmix) ? nmix : 0;
            if (PH_MASK & 128) phase_mixf(p, l, smem);
            if (PH_MASK & 64) phase_dft2_mixp(p, l, smem, 512, 512 + nmix, b0, (int)gridDim.x - b0);
        }
        xcd_barrier(bar);
        if (PH_MASK & 256) phase_out(p, l, xl_in, xc_in, p.out, xc1, smem);
        if (PH_DUP & 256) phase_out(p, l, xl_in, xc_in, (float*)(p.ws + OFF_G1), (float*)(p.ws + OFF_G1), smem);
        if (l == 0) xcd_barrier(bar);
    }
}

extern "C" void kernel_launch(void* const* d_in, const int* in_sizes, int n_in, void* d_out, int out_size, void* d_ws, size_t ws_size, hipStream_t stream) {
    static int grid_blocks = 0;
    if (!grid_blocks) {
        int dev = 0, cus = 0, per_cu = 0;
        hipGetDevice(&dev);
        hipDeviceGetAttribute(&cus, hipDeviceAttributeMultiprocessorCount, dev);
        hipOccupancyMaxActiveBlocksPerMultiprocessor(&per_cu, fwd_megakernel, 256, 0);
        if (per_cu > 2) per_cu = 2;
        if (per_cu < 1) per_cu = 1;
        grid_blocks = cus * per_cu;
        if (ws_size < WS_END) fprintf(stderr, "kernel_launch: workspace too small: %zu < %zu\n", ws_size, (size_t)WS_END);
    }
    hipMemsetAsync((char*)d_ws + OFF_BAR, 0, 16384, stream);
    Params p{};
    p.x = (const float*)d_in[0]; p.c = (const float*)d_in[1]; p.ctx = (const float*)d_in[2]; p.c_ctx = (const float*)d_in[3];
    p.w_mod = (const float*)d_in[4]; p.b_mod = (const float*)d_in[5]; p.norm_g = (const float*)d_in[6]; p.w_in = (const float*)d_in[7];
    p.q_gain = (const float*)d_in[8]; p.k_gain = (const float*)d_in[9]; p.w_fourier = (const float*)d_in[10]; p.conv_w = (const float*)d_in[11];
    p.conv_b = (const float*)d_in[12]; p.pool_w = (const float*)d_in[13]; p.pool_scale = (const float*)d_in[14]; p.w_out = (const float*)d_in[15];
    p.out = (float*)d_out; p.ws = (unsigned char*)d_ws; p.never = 0; p.pad = 0;
    void* args[] = {&p};
    hipError_t e = hipLaunchCooperativeKernel((void*)fwd_megakernel, dim3(grid_blocks), dim3(256), args, 0, stream);
    if (e != hipSuccess) fprintf(stderr, "cooperative launch failed: %s (grid %d)\n", hipGetErrorString(e), grid_blocks);
}
```

```cpp
#include <hip/hip_runtime.h>
#include <hip/hip_cooperative_groups.h>
#include <stdint.h>
#include <cstdio>
namespace cg = cooperative_groups;

typedef unsigned short bf16_t;
typedef __attribute__((ext_vector_type(8))) short bf16x8;
typedef __attribute__((ext_vector_type(4))) short bf16x4;
typedef __attribute__((ext_vector_type(4))) float f32x4;
typedef __attribute__((ext_vector_type(16))) float f32x16;
#define DI __device__ __forceinline__

#define SEQ 8192
#define CTX 256
#define DM 1024
#define DIN 2816
#define ROWS_L 16384
#define ROWS_C 512
#define ROWS 16896
#define NKEY 8448
#define PW 1792
#define PC_ZATT 0
#define PC_UF 256
#define PC_ZF 512
#define PC_T 768
#define PC_GC 1024
#define PC_UP 1280
#define PC_ZP 1536

constexpr size_t OFF_BAR = 0;
constexpr size_t OFF_MODV = 16384;
constexpr size_t OFF_ROPE = OFF_MODV + 2 * 3 * 3072 * 4;
constexpr size_t OFF_TW = OFF_ROPE + 6144 * 4;
constexpr size_t OFF_F1 = OFF_TW + 8192 * 2 * 4;
constexpr size_t OFF_F2 = OFF_F1 + 256 * 128 * 2;
constexpr size_t OFF_FC = OFF_F2 + 128 * 128 * 2;
constexpr size_t OFF_WCOMB = OFF_FC + 512 * 256 * 2;
constexpr size_t OFF_WPOOL = OFF_WCOMB + 2 * 256 * 512 * 2;
constexpr size_t OFF_WTIN = 2097152;
constexpr size_t OFF_WTOUT = OFF_WTIN + (size_t)2 * DIN * DM * 2;
constexpr size_t OFF_H = OFF_WTOUT + (size_t)2 * DM * DM * 2;
constexpr size_t OFF_PARTS = OFF_H + (size_t)ROWS * DM * 2;
constexpr size_t OFF_Q = OFF_PARTS + (size_t)ROWS * PW * 2;
constexpr size_t OFF_QC = OFF_Q + (size_t)2 * 4 * SEQ * 64 * 2;
constexpr size_t OFF_K = OFF_QC + (size_t)2 * 4 * CTX * 64 * 2;
constexpr size_t OFF_VT = OFF_K + (size_t)2 * 2 * NKEY * 64 * 2;
constexpr size_t OFF_DBUF = OFF_VT + (size_t)2 * 2 * NKEY * 64 * 2;
constexpr size_t OFF_G1 = OFF_DBUF + (size_t)ROWS * 256 * 2;
constexpr size_t OFF_PCAT = OFF_G1 + (size_t)2 * 128 * 2 * 64 * 256 * 2;
constexpr size_t OFF_XC1 = OFF_PCAT + (size_t)ROWS * 512 * 2;
constexpr size_t OFF_X1B = OFF_XC1 + (size_t)ROWS_C * DM * 4;
constexpr size_t OFF_XC1B = OFF_X1B + (size_t)ROWS_L * DM * 2;
constexpr size_t WS_END = OFF_XC1B + (size_t)ROWS_C * DM * 4;
static_assert(OFF_WPOOL + 2 * 256 * 256 * 2 <= OFF_WTIN, "ws map");

struct Params {
    const float *x, *c, *ctx, *c_ctx, *w_mod, *b_mod, *norm_g, *w_in, *q_gain, *k_gain, *w_fourier, *conv_w, *conv_b, *pool_w, *pool_scale, *w_out;
    float* out;
    unsigned char* ws;
    int never;
    int pad;
};

DI bf16_t f2bf(float x) { unsigned u = __float_as_uint(x); u += 0x7fffu + ((u >> 16) & 1u); return (bf16_t)(u >> 16); }
DI float bf2f(bf16_t h) { return __uint_as_float(((unsigned)h) << 16); }
typedef __attribute__((ext_vector_type(2))) float f32x2;
typedef __attribute__((ext_vector_type(2))) __bf16 bf16x2v;
DI unsigned pack2(float a, float b) { const f32x2 v = {a, b}; return __builtin_bit_cast(unsigned, __builtin_convertvector(v, bf16x2v)); }
struct XIter { int u, end, step; };
DI XIter xiter(int ntiles) {
    const int x = blockIdx.x & 7, j = blockIdx.x >> 3, nb = gridDim.x >> 3, per = (ntiles + 7) >> 3;
    XIter r; r.u = x * per + j; r.end = min((x + 1) * per, ntiles); r.step = nb; return r;
}
DI float silu_f(float z) { return z / (1.f + __expf(-z)); }
DI float bflo(unsigned w) { return __uint_as_float(w << 16); }
DI float bfhi(unsigned w) { return __uint_as_float(w & 0xffff0000u); }
DI int otid() { int t = threadIdx.x; asm volatile("" : "+v"(t)); return t; }

#define XB_TMO      128
#define XB_XCNT(j)  (256  + 64 * (j))
#define XB_XSUB(j)  (1280 + 64 * (j))
#define XB_XGEN(j)  (2304 + 64 * (j))
#define XB_TOP      3328
#define XB_TOPGEN   3392
#define XCD_BAR_WORDS 3456
#define XB_SPIN_CAP (1u << 20)
#define LAS __attribute__((address_space(3)))
DI unsigned xb_ld(unsigned* p) { return __hip_atomic_load(p, __ATOMIC_RELAXED, __HIP_MEMORY_SCOPE_AGENT); }
DI unsigned xb_add(unsigned* p, unsigned v) { return __hip_atomic_fetch_add(p, v, __ATOMIC_RELAXED, __HIP_MEMORY_SCOPE_AGENT); }
DI unsigned xb_xcc_id() { return (unsigned)__builtin_amdgcn_s_getreg((3 << 11) | 20) & 0xFu; }
#define XB_SPIN(cond, bar) do { unsigned _sp = 0; while (cond) { __builtin_amdgcn_s_sleep(1); \
    if ((++_sp & 255u) == 0u) { if (xb_ld(&(bar)[XB_TMO])) break; if (_sp > XB_SPIN_CAP) { atomicAdd(&(bar)[XB_TMO], 1u); break; } } } } while (0)
struct XcdBarrier { unsigned* bar; unsigned x; volatile LAS unsigned* st; };
DI XcdBarrier xcd_barrier_post(unsigned* bar, volatile LAS unsigned* st) {
    XcdBarrier b; b.bar = bar; b.x = xb_xcc_id(); b.st = st;
    if (threadIdx.x == 0) (void)xb_add(&bar[XB_XCNT(b.x)], 1u);
    return b;
}
DI void xcd_barrier_complete(unsigned* bar, unsigned x, unsigned& nloc, unsigned& nx) {
    const unsigned G = gridDim.x * gridDim.y * gridDim.z;
    unsigned sum, cnt, mine, sp = 0u;
    for (;;) {
        sum = 0u; cnt = 0u; mine = 0u;
#pragma unroll
        for (unsigned j = 0; j < 16; ++j) { const unsigned c = xb_ld(&bar[XB_XCNT(j)]); sum += c; cnt += (c > 0u) ? 1u : 0u; mine = (j == x) ? c : mine; }
        if (sum == G) break;
        __builtin_amdgcn_s_sleep(1);
        if ((++sp & 255u) == 0u) { if (xb_ld(&bar[XB_TMO])) break; if (sp > XB_SPIN_CAP) { atomicAdd(&bar[XB_TMO], 1u); break; } }
    }
    nloc = mine > 0u ? mine : 1u; nx = cnt > 0u ? cnt : 1u;
}
DI void xcd_barrier(const XcdBarrier& b) {
    asm volatile("s_waitcnt vmcnt(0)" ::: "memory");
    __syncthreads();
    if (threadIdx.x == 0) {
        unsigned* bar = b.bar;
        __builtin_amdgcn_s_waitcnt(0);
        unsigned nloc = b.st[0], nx = b.st[1];
        if (nloc == 0u) { xcd_barrier_complete(bar, b.x, nloc, nx); b.st[0] = nloc; b.st[1] = nx; }
        const unsigned old = xb_add(&bar[XB_XSUB(b.x)], 1u);
        const unsigned gen = old / nloc;
        if (old + 1u == (gen + 1u) * nloc) {
            __builtin_amdgcn_fence(__ATOMIC_RELEASE, "agent");
            asm volatile("s_waitcnt vmcnt(0)" ::: "memory");
            const unsigned og = xb_add(&bar[XB_TOP], 1u);
            const unsigned tg = og / nx;
            if (og + 1u == (tg + 1u) * nx) xb_add(&bar[XB_TOPGEN], 1u);
            else XB_SPIN(xb_ld(&bar[XB_TOPGEN]) == tg, bar);
            __builtin_amdgcn_fence(__ATOMIC_ACQUIRE, "agent");
            xb_add(&bar[XB_XGEN(b.x)], 1u);
            asm volatile("s_waitcnt vmcnt(0)" ::: "memory");
        } else {
            XB_SPIN(xb_ld(&bar[XB_TOPGEN]) == gen, bar);
            __builtin_amdgcn_fence(__ATOMIC_ACQUIRE, "agent");
            asm volatile("s_waitcnt vmcnt(0)" ::: "memory");
        }
    }
    __syncthreads();
}

#define LROW 72
#define TILE_E (128 * LROW)
#define SMEM_MAIN (4 * TILE_E * 2)
#define SMEM_BYTES (SMEM_MAIN + 16)

typedef __attribute__((ext_vector_type(4))) unsigned u32x4;
struct Stg { u32x4 a0, a1, a2, a3, b0, b1, b2, b3; };
template <bool BN>
DI u32x4 g_ld_b(const bf16_t* __restrict__ B, int ldb, int kt, int q) {
    if (!BN) return *(const u32x4*)(B + (size_t)(q >> 3) * ldb + kt * 64 + (q & 7) * 8);
    else     return *(const u32x4*)(B + (size_t)(kt * 64 + (q >> 4)) * ldb + (q & 15) * 8);
}
template <bool BN>
DI void g_load(Stg& r, const bf16_t* __restrict__ A, int lda, const bf16_t* __restrict__ B, int ldb, int kt, int tid) {
    const bf16_t* ap = A + (size_t)(tid >> 3) * lda + kt * 64 + (tid & 7) * 8;
    r.a0 = *(const u32x4*)(ap);
    r.a1 = *(const u32x4*)(ap + (size_t)32 * lda);
    r.a2 = *(const u32x4*)(ap + (size_t)64 * lda);
    r.a3 = *(const u32x4*)(ap + (size_t)96 * lda);
    r.b0 = g_ld_b<BN>(B, ldb, kt, tid);
    r.b1 = g_ld_b<BN>(B, ldb, kt, tid + 256);
    r.b2 = g_ld_b<BN>(B, ldb, kt, tid + 512);
    r.b3 = g_ld_b<BN>(B, ldb, kt, tid + 768);
}
template <bool BN>
DI void s_st_b(bf16_t* b, const u32x4 v, int q) {
    if (!BN) *(u32x4*)(b + (q >> 3) * LROW + (q & 7) * 8) = v;
    else {
        const int kr0 = q >> 4, n0 = (q & 15) * 8, kr = ((((kr0 >> 3) ^ (q & 7)) << 3) | (kr0 & 7));
        b[(n0 + 0) * LROW + kr] = (bf16_t)(v.x & 0xffffu); b[(n0 + 1) * LROW + kr] = (bf16_t)(v.x >> 16);
        b[(n0 + 2) * LROW + kr] = (bf16_t)(v.y & 0xffffu); b[(n0 + 3) * LROW + kr] = (bf16_t)(v.y >> 16);
        b[(n0 + 4) * LROW + kr] = (bf16_t)(v.z & 0xffffu); b[(n0 + 5) * LROW + kr] = (bf16_t)(v.z >> 16);
        b[(n0 + 6) * LROW + kr] = (bf16_t)(v.w & 0xffffu); b[(n0 + 7) * LROW + kr] = (bf16_t)(v.w >> 16);
    }
}
template <bool BN>
DI void s_store(const Stg& r, bf16_t* smem, int buf, int tid) {
    bf16_t* a = smem + buf * 2 * TILE_E;
    bf16_t* b = a + TILE_E;
    bf16_t* ap = a + (tid >> 3) * LROW + (tid & 7) * 8;
    *(u32x4*)(ap) = r.a0;
    *(u32x4*)(ap + 32 * LROW) = r.a1;
    *(u32x4*)(ap + 64 * LROW) = r.a2;
    *(u32x4*)(ap + 96 * LROW) = r.a3;
    s_st_b<BN>(b, r.b0, tid);
    s_st_b<BN>(b, r.b1, tid + 256);
    s_st_b<BN>(b, r.b2, tid + 512);
    s_st_b<BN>(b, r.b3, tid + 768);
}
DI void mma_tile(const bf16_t* smem, int buf, f32x4 (&acc)[4][4], int wm, int wn, int lane) {
    const bf16_t* a = smem + buf * 2 * TILE_E;
    const bf16_t* b = a + TILE_E;
#pragma unroll
    for (int kk = 0; kk < 2; ++kk) {
        bf16x8 af[4], bfr[4];
#pragma unroll
        for (int mi = 0; mi < 4; ++mi) af[mi] = *(const bf16x8*)(a + (wm * 64 + mi * 16 + (lane & 15)) * LROW + kk * 32 + (lane >> 4) * 8);
#pragma unroll
        for (int ni = 0; ni < 4; ++ni) bfr[ni] = *(const bf16x8*)(b + (wn * 64 + ni * 16 + (lane & 15)) * LROW + (((kk * 4 + (lane >> 4)) ^ ((ni * 2 + ((lane >> 3) & 1)) & 7)) << 3));
#pragma unroll
        for (int mi = 0; mi < 4; ++mi)
#pragma unroll
            for (int ni = 0; ni < 4; ++ni) acc[mi][ni] = __builtin_amdgcn_mfma_f32_16x16x32_bf16(af[mi], bfr[ni], acc[mi][ni], 0, 0, 0);
    }
}
template <bool BN>
DI void gemm_core(const bf16_t* __restrict__ A, int lda, const bf16_t* __restrict__ B, int ldb, int K, f32x4 (&acc)[4][4], bf16_t* smem) {
    const int tid = otid(), lane = tid & 63, wave = tid >> 6;
    const int wm = wave >> 1, wn = wave & 1;
#pragma unroll
    for (int mi = 0; mi < 4; ++mi)
#pragma unroll
        for (int ni = 0; ni < 4; ++ni) acc[mi][ni] = (f32x4){0.f, 0.f, 0.f, 0.f};
    const int nk = K >> 6;
    Stg r0, r1;
    __syncthreads();
    g_load<BN>(r0, A, lda, B, ldb, 0, tid);
    g_load<BN>(r1, A, lda, B, ldb, 1, tid);
    s_store<BN>(r0, smem, 0, tid);
    __syncthreads();
    for (int kt = 0; kt < nk; kt += 2) {
        if (kt + 2 < nk) g_load<BN>(r0, A, lda, B, ldb, kt + 2, tid);
        mma_tile(smem, 0, acc, wm, wn, lane);
        s_store<BN>(r1, smem, 1, tid);
        __syncthreads();
        if (kt + 3 < nk) g_load<BN>(r1, A, lda, B, ldb, kt + 3, tid);
        mma_tile(smem, 1, acc, wm, wn, lane);
        if (kt + 2 < nk) s_store<BN>(r0, smem, 0, tid);
        __syncthreads();
    }
}
#define GT_E (128 * 64)
DI void glds_tile(const bf16_t* __restrict__ G, int ld, int kt, bf16_t* lt, int tid) {
    const int c = (tid & 7) ^ ((tid >> 4) & 7);
    const bf16_t* g = G + (size_t)(tid >> 3) * ld + kt * 64 + c * 8;
    char* l = (char*)lt + tid * 16;
#pragma unroll
    for (int p = 0; p < 4; ++p)
        __builtin_amdgcn_global_load_lds((const unsigned*)(g + (size_t)(p * 32) * ld), (LAS unsigned*)(l + p * 4096), 16, 0, 0);
}
DI void mma_tile_sw(const bf16_t* smem, int buf, f32x4 (&acc)[4][4], int wm, int wn, int lane) {
    const char* a = (const char*)(smem + buf * 2 * GT_E);
    const char* b = a + GT_E * 2;
    const int sw = (lane & 15) >> 1;
#pragma unroll
    for (int kk = 0; kk < 2; ++kk) {
        bf16x8 af[4], bfr[4];
        const int co = ((kk * 4 + (lane >> 4)) ^ sw) << 4;
#pragma unroll
        for (int mi = 0; mi < 4; ++mi) af[mi] = *(const bf16x8*)(a + (wm * 64 + mi * 16 + (lane & 15)) * 128 + co);
#pragma unroll
        for (int ni = 0; ni < 4; ++ni) bfr[ni] = *(const bf16x8*)(b + (wn * 64 + ni * 16 + (lane & 15)) * 128 + co);
#pragma unroll
        for (int mi = 0; mi < 4; ++mi)
#pragma unroll
            for (int ni = 0; ni < 4; ++ni) acc[mi][ni] = __builtin_amdgcn_mfma_f32_16x16x32_bf16(af[mi], bfr[ni], acc[mi][ni], 0, 0, 0);
    }
}
DI void gemm_core_dma(const bf16_t* __restrict__ A, int lda, const bf16_t* __restrict__ B, int ldb, int K, f32x4 (&acc)[4][4], bf16_t* smem) {
    const int tid = otid(), lane = tid & 63, wave = tid >> 6;
    const int wm = wave >> 1, wn = wave & 1;
#pragma unroll
    for (int mi = 0; mi < 4; ++mi)
#pragma unroll
        for (int ni = 0; ni < 4; ++ni) acc[mi][ni] = (f32x4){0.f, 0.f, 0.f, 0.f};
    const int nk = K >> 6;
    __syncthreads();
    glds_tile(A, lda, 0, smem, tid);
    glds_tile(B, ldb, 0, smem + GT_E, tid);
    for (int kt = 0; kt < nk; ++kt) {
        asm volatile("s_waitcnt vmcnt(0)" ::: "memory");
        __syncthreads();
        if (kt + 1 < nk) {
            bf16_t* nb = smem + ((kt + 1) & 1) * 2 * GT_E;
            glds_tile(A, lda, kt + 1, nb, tid);
            glds_tile(B, ldb, kt + 1, nb + GT_E, tid);
        }
        mma_tile_sw(smem, kt & 1, acc, wm, wn, lane);
    }
    __syncthreads();
}
#define ST_LD 132
DI void stage_acc(f32x4 (&acc)[4][4], float* st) {
    const int lane = otid() & 63, wave = otid() >> 6, wm = wave >> 1, wn = wave & 1, fl = lane & 15, g4 = lane >> 4;
#pragma unroll
    for (int mi = 0; mi < 4; ++mi)
#pragma unroll
        for (int ni = 0; ni < 4; ++ni)
#pragma unroll
            for (int j = 0; j < 4; ++j) st[(wm * 64 + mi * 16 + g4 * 4 + j) * ST_LD + wn * 64 + ni * 16 + fl] = acc[mi][ni][j];
    __syncthreads();
}
DI void ld8(const float* q, float (&v)[8]) {
    const float4 a = *(const float4*)q, b = *(const float4*)(q + 4);
    v[0] = a.x; v[1] = a.y; v[2] = a.z; v[3] = a.w; v[4] = b.x; v[5] = b.y; v[6] = b.z; v[7] = b.w;
}
DI uint4 pack8(const float (&v)[8]) { return make_uint4(pack2(v[0], v[1]), pack2(v[2], v[3]), pack2(v[4], v[5]), pack2(v[6], v[7])); }
DI void unpack8(const uint4 u, float (&v)[8]) {
    v[0] = bflo(u.x); v[1] = bfhi(u.x); v[2] = bflo(u.y); v[3] = bfhi(u.y); v[4] = bflo(u.z); v[5] = bfhi(u.z); v[6] = bflo(u.w); v[7] = bfhi(u.w);
}

DI void phase0(const Params& p, float* smf) {
    const int tid = otid();
    unsigned char* ws = p.ws;
    float* modv = (float*)(ws + OFF_MODV);
    for (int it = blockIdx.x; it < 192; it += gridDim.x) {
        const int l = it / 96, n0 = (it % 96) * 32;
        __syncthreads();
        for (int i = tid; i < 3072; i += 256) {
            const int v = i >> 10, k = i & 1023;
            const float cv = (v == 0) ? p.c[k] : (v == 1) ? p.c[1024 + k] : p.c_ctx[k];
            smf[i] = silu_f(cv);
        }
        __syncthreads();
        const int col = tid & 31, kg = tid >> 5;
        float a0 = 0.f, a1 = 0.f, a2 = 0.f;
        const float* w = p.w_mod + (size_t)l * 1024 * 3072 + n0 + col;
#pragma unroll 16
        for (int kk = 0; kk < 128; ++kk) {
            const int k = kg * 128 + kk;
            const float wv = w[(size_t)k * 3072];
            a0 += smf[k] * wv; a1 += smf[1024 + k] * wv; a2 += smf[2048 + k] * wv;
        }
        __syncthreads();
        smf[3072 + (kg * 3 + 0) * 32 + col] = a0; smf[3072 + (kg * 3 + 1) * 32 + col] = a1; smf[3072 + (kg * 3 + 2) * 32 + col] = a2;
        __syncthreads();
        if (tid < 96) {
            const int v = tid >> 5, cc = tid & 31;
            float s = 0.f;
            for (int g = 0; g < 8; ++g) s += smf[3072 + (g * 3 + v) * 32 + cc];
            modv[(l * 3 + v) * 3072 + n0 + cc] = s + p.b_mod[l * 3072 + n0 + cc];
        }
    }
    {
        const int n_in = 2 * 16 * 44, n_out = 2 * 16 * 16;
        for (int it = blockIdx.x; it < n_in + n_out; it += gridDim.x) {
            const float* src; bf16_t* dst; int N, kt, nt;
            if (it < n_in) { const int l = it / 704, r = it % 704; kt = r / 44; nt = r % 44; N = DIN; src = p.w_in + (size_t)l * DM * DIN; dst = (bf16_t*)(ws + OFF_WTIN) + (size_t)l * DIN * DM; }
            else { const int j = it - n_in; const int l = j / 256, r = j % 256; kt = r / 16; nt = r % 16; N = DM; src = p.w_out + (size_t)l * DM * DM; dst = (bf16_t*)(ws + OFF_WTOUT) + (size_t)l * DM * DM; }
            __syncthreads();
#pragma unroll
            for (int ps = 0; ps < 4; ++ps) {
                const int kr = ps * 16 + (tid >> 4), c4 = (tid & 15) * 4;
                const float4 v = *(const float4*)(src + (size_t)(kt * 64 + kr) * N + nt * 64 + c4);
                smf[kr * 65 + c4 + 0] = v.x; smf[kr * 65 + c4 + 1] = v.y; smf[kr * 65 + c4 + 2] = v.z; smf[kr * 65 + c4 + 3] = v.w;
            }
            __syncthreads();
            const int n = tid >> 2, ks = (tid & 3) * 16;
            unsigned w[8];
#pragma unroll
            for (int e = 0; e < 8; ++e) w[e] = pack2(smf[(ks + 2 * e) * 65 + n], smf[(ks + 2 * e + 1) * 65 + n]);
            int ntd = nt;
            if (it < n_in && nt >= 20 && nt < 36) { const int grp = (nt - 20) >> 2, q4 = (nt - 20) & 3; ntd = (grp == 0) ? 28 + 2 * q4 : (grp == 1) ? 20 + 2 * q4 : (grp == 2) ? 21 + 2 * q4 : 29 + 2 * q4; }
            bf16_t* d = dst + (size_t)(ntd * 64 + n) * DM + kt * 64 + ks;
            *(uint4*)d = make_uint4(w[0], w[1], w[2], w[3]);
            *(uint4*)(d + 8) = make_uint4(w[4], w[5], w[6], w[7]);
        }
    }
    const int gtid = blockIdx.x * 256 + tid, gsz = gridDim.x * 256;
    {
        bf16_t* wc = (bf16_t*)(ws + OFF_WCOMB);
        __syncthreads();
        if (tid < 64) { smf[tid] = cospif((float)tid * (1.f / 32.f)); smf[64 + tid] = sinpif((float)tid * (1.f / 32.f)); }
        __syncthreads();
        for (int i = gtid; i < 2 * 512 * 256; i += gsz) {
            const int n = i & 255, kk = (i >> 8) & 511, l = i >> 17;
            const int c = kk >> 8, head = (kk >> 6) & 3, ch = kk & 63;
            const float* wf = p.w_fourier + (size_t)l * 65536 + (size_t)(head * 64) * 256 + n;
            float s = 0.f;
#pragma unroll 16
            for (int j = 0; j < 64; ++j) s += smf[c * 64 + ((j * ch) & 63)] * wf[j * 256];
            wc[(size_t)l * 131072 + n * 512 + kk] = f2bf(s);
        }
    }
    {
        bf16_t* wp = (bf16_t*)(ws + OFF_WPOOL);
        for (int i = gtid; i < 2 * 256 * 256; i += gsz) {
            const int k = i & 255, n = (i >> 8) & 255, l = i >> 16;
            float v = 0.f;
            if ((k >> 6) == (n >> 6)) v = p.pool_w[(size_t)l * 16384 + (n >> 6) * 4096 + (k & 63) * 64 + (n & 63)];
            wp[i] = f2bf(v);
        }
    }
    {
        float* tw = (float*)(ws + OFF_TW);
        for (int i = gtid; i < 8192; i += gsz) { const float a = (float)i * (1.f / 4096.f); tw[2 * i] = cospif(a); tw[2 * i + 1] = sinpif(a); }
        bf16_t* f1 = (bf16_t*)(ws + OFF_F1);
        for (int i = gtid; i < 256 * 128; i += gsz) {
            const int t1 = i & 127, m = i >> 7;
            const int k1 = (m >> 5) * 16 + (m & 15), c = (m >> 4) & 1;
            const float a = (float)((k1 * t1) & 127) * (1.f / 64.f);
            f1[i] = f2bf(c ? -sinpif(a) : cospif(a));
        }
        bf16_t* f2 = (bf16_t*)(ws + OFF_F2);
        for (int i = gtid; i < 128 * 128; i += gsz) {
            const int kx = i & 127, m = i >> 7;
            const int c = m >> 6, k2 = m & 63, cp = kx >> 6, t2 = kx & 63;
            const float a = (float)((k2 * t2) & 63) * (1.f / 32.f);
            float v;
            if (c == cp) v = cospif(a); else if (c == 0) v = sinpif(a); else v = -sinpif(a);
            f2[i] = f2bf(v);
        }
        bf16_t* fc = (bf16_t*)(ws + OFF_FC);
        for (int i = gtid; i < 512 * 256; i += gsz) {
            const int t = i & 255, m = i >> 8;
            const int c = m >> 8, k = m & 255;
            const float a = (float)((k * t) & 255) * (1.f / 128.f);
            fc[i] = f2bf(c ? -sinpif(a) : cospif(a));
        }
        float* rp = (float*)(ws + OFF_ROPE);
        for (int i = gtid; i < 3072; i += gsz) {
            const int f = i & 15;
            const int pos = (i < 2048) ? (i >> 4) : ((i - 2048) >> 4);
            const float inv = powf(10000.f, -(float)f * (1.f / 16.f));
            const float ang = (float)pos * inv;
            const double ad = (double)ang;
            const float cs = (float)cos(ad), sn = (float)sin(ad);
            if (i < 2048) { rp[i] = cs; rp[2048 + i] = sn; }
            else { rp[4096 + (i - 2048)] = cs; rp[5120 + (i - 2048)] = sn; }
        }
    }
}

DI void phase_norm(const Params& p, int l, const float* xl, const float* xc, const bf16_t* xlb) {
    const int lane = otid() & 63, wave = otid() >> 6;
    const float* modv = (const float*)(p.ws + OFF_MODV) + (size_t)l * 3 * 3072;
    const float* g = p.norm_g + l * 1024;
    bf16_t* H = (bf16_t*)(p.ws + OFF_H);
    for (int row = blockIdx.x * 4 + wave; row < ROWS; row += gridDim.x * 4) {
        const float* src = (row < ROWS_L) ? xl + (size_t)row * DM : xc + (size_t)(row - ROWS_L) * DM;
        const int v = (row < ROWS_L) ? (row >> 13) : 2;
        const float* mv = modv + v * 3072;
        float4 a[4];
        float ss = 0.f;
        if (xlb != nullptr && row < ROWS_L) {
            const bf16_t* sb = xlb + (size_t)row * DM;
#pragma unroll
            for (int i = 0; i < 4; ++i) { const uint2 u = *(const uint2*)(sb + i * 256 + lane * 4); a[i] = make_float4(bflo(u.x), bfhi(u.x), bflo(u.y), bfhi(u.y)); }
        } else {
#pragma unroll
            for (int i = 0; i < 4; ++i) { const f32x4 t_ = __builtin_nontemporal_load((const f32x4*)(src + i * 256 + lane * 4)); a[i] = make_float4(t_[0], t_[1], t_[2], t_[3]); }
            if (xlb != nullptr) {
                const float* p0 = (const float*)(p.ws + OFF_XC1) + (size_t)(row - ROWS_L) * DM;
                const float* p1 = (const float*)(p.ws + OFF_XC1B) + (size_t)(row - ROWS_L) * DM;
#pragma unroll
                for (int i = 0; i < 4; ++i) {
                    const float4 u = *(const float4*)(p0 + i * 256 + lane * 4), w = *(const float4*)(p1 + i * 256 + lane * 4);
                    a[i].x += u.x + w.x; a[i].y += u.y + w.y; a[i].z += u.z + w.z; a[i].w += u.w + w.w;
                }
            }
        }
#pragma unroll
        for (int i = 0; i < 4; ++i) ss += a[i].x * a[i].x + a[i].y * a[i].y + a[i].z * a[i].z + a[i].w * a[i].w;
#pragma unroll
        for (int o = 32; o >= 1; o >>= 1) ss += __shfl_xor(ss, o);
        const float rs = rsqrtf(ss * (1.f / 1024.f) + 1e-6f);
#pragma unroll
        for (int i = 0; i < 4; ++i) {
            const int c0 = i * 256 + lane * 4;
            const float4 gg = *(const float4*)(g + c0), sh = *(const float4*)(mv + c0), sc = *(const float4*)(mv + 1024 + c0);
            const float o0 = a[i].x * rs * gg.x * (1.f + sc.x) + sh.x, o1 = a[i].y * rs * gg.y * (1.f + sc.y) + sh.y;
            const float o2 = a[i].z * rs * gg.z * (1.f + sc.z) + sh.z, o3 = a[i].w * rs * gg.w * (1.f + sc.w) + sh.w;
            *(uint2*)(H + (size_t)row * DM + c0) = make_uint2(pack2(o0, o1), pack2(o2, o3));
        }
    }
}

DI void epi_inproj(const Params& p, int l, int tm, int tn, f32x4 (&acc)[4][4], float* st) {
    const int tid = otid();
    unsigned char* ws = p.ws;
    stage_acc(acc, st);
    const int rbase = tm * 128;
    const bool isctx = rbase >= ROWS_L;
    if (tn < 3) {
        const bool isq = tn < 2;
        const float* gain = (isq ? p.q_gain : p.k_gain) + l * 64;
        const float* rp = (const float*)(ws + OFF_ROPE);
#pragma unroll 1
        for (int i = 0; i < 8; ++i) {
            const int q = tid + 256 * i, rl = q >> 4, c8 = (q & 15) * 8;
            const int row = rbase + rl, hd = c8 >> 6, d0 = c8 & 63;
            float v[8], pv[8], g[8], pg[8];
            ld8(st + rl * ST_LD + c8, v);
            ld8(st + rl * ST_LD + (c8 ^ 16), pv);
            ld8(gain + d0, g);
            ld8(gain + (d0 ^ 16), pg);
            float ss = 0.f;
#pragma unroll
            for (int e = 0; e < 8; ++e) ss += v[e] * v[e];
            ss += __shfl_xor(ss, 1); ss += __shfl_xor(ss, 2); ss += __shfl_xor(ss, 4);
            const float rs = rsqrtf(ss * (1.f / 64.f) + 1e-6f);
#pragma unroll
            for (int e = 0; e < 8; ++e) { v[e] *= rs * g[e]; pv[e] *= rs * pg[e]; }
            bf16_t* dst;
            if (!isctx) {
                const int b = row >> 13, t = row & 8191;
                const int pos = (d0 >= 32) ? (t & 63) : (t >> 6);
                const float* ct = rp + ((d0 >= 32) ? 4096 : 0) + pos * 16 + (d0 & 8);
                float cs[8], sn[8];
                ld8(ct, cs);
                ld8(ct + ((d0 >= 32) ? 1024 : 2048), sn);
                const float sg = (d0 & 16) ? 1.f : -1.f;
#pragma unroll
                for (int e = 0; e < 8; ++e) v[e] = v[e] * cs[e] + sg * pv[e] * sn[e];
                if (isq) dst = (bf16_t*)(ws + OFF_Q) + ((size_t)(b * 4 + tn * 2 + hd) * SEQ + t) * 64 + d0;
                else     dst = (bf16_t*)(ws + OFF_K) + ((size_t)(b * 2 + hd) * NKEY + CTX + t) * 64 + d0;
            } else {
                const int rc = row - ROWS_L, b = rc >> 8, t = rc & 255;
                if (isq) dst = (bf16_t*)(ws + OFF_QC) + ((size_t)(b * 4 + tn * 2 + hd) * CTX + t) * 64 + d0;
                else     dst = (bf16_t*)(ws + OFF_K) + ((size_t)(b * 2 + hd) * NKEY + t) * 64 + d0;
            }
            if (isq) {
#pragma unroll
                for (int e = 0; e < 8; ++e) v[e] *= 0.18033688011112042f;
            }
            *(uint4*)dst = pack8(v);
        }
    } else if (tn == 3) {
        int b, key0;
        if (!isctx) { b = rbase >> 13; key0 = CTX + (rbase & 8191); } else { const int rc = rbase - ROWS_L; b = rc >> 8; key0 = rc & 255; }
#pragma unroll 1
        for (int i = 0; i < 8; ++i) {
            const int q = tid + 256 * i, col = q & 127, r8 = (q >> 7) * 8;
            float v[8];
#pragma unroll
            for (int e = 0; e < 8; ++e) v[e] = st[(r8 + e) * ST_LD + col];
            bf16_t* vt = (bf16_t*)(ws + OFF_VT) + ((size_t)(b * 2 + (col >> 6)) * 64 + (col & 63)) * NKEY + key0 + r8;
            *(uint4*)vt = pack8(v);
        }
    } else {
        bf16_t* parts = (bf16_t*)(ws + OFF_PARTS);
        if (tn >= 10 && tn < 18) {
            const bool isg = tn >= 14;
            const int dcol = (isg ? PC_GC + (tn - 14) * 64 : PC_T + (tn - 10) * 64);
#pragma unroll 1
            for (int i = 0; i < 4; ++i) {
                const int q = tid + 256 * i, rl = q >> 3, c8 = (q & 7) * 8;
                float v[8], w[8];
                ld8(st + rl * ST_LD + c8, v);
                ld8(st + rl * ST_LD + 64 + c8, w);
#pragma unroll
                for (int e = 0; e < 8; ++e) v[e] = isg ? silu_f(w[e]) * v[e] : v[e] * w[e];
                *(uint4*)(parts + (size_t)(rbase + rl) * PW + dcol + c8) = pack8(v);
            }
        } else {
            const int dbase = (tn < 10) ? tn * 128 - 512 : PC_UP + (tn - 18) * 128;
#pragma unroll 1
            for (int i = 0; i < 8; ++i) {
                const int q = tid + 256 * i, rl = q >> 4, c8 = (q & 15) * 8;
                float v[8];
                ld8(st + rl * ST_LD + c8, v);
                *(uint4*)(parts + (size_t)(rbase + rl) * PW + dbase + c8) = pack8(v);
            }
        }
    }
}

DI void phase_inproj(const Params& p, int l, bf16_t* smem) {
    const bf16_t* H = (const bf16_t*)(p.ws + OFF_H);
    const bf16_t* W = (const bf16_t*)(p.ws + OFF_WTIN) + (size_t)l * DIN * DM;
    const int nlat = 128 * 22;
    const int ntiles = nlat + (l == 0 ? 4 * 22 : 4 * 2);
    for (XIter t = xiter(ntiles); t.u < t.end; t.u += t.step) {
        const int u = t.u;
        int tm, tn;
        if (u < nlat) { const int ch = u / 176, r = u % 176; tn = r >> 3; tm = ch * 8 + (r & 7); }
        else { const int j = u - nlat; tm = 128 + (j & 3); tn = (l == 0 ? 0 : 2) + (j >> 2); }
        f32x4 acc[4][4];
        gemm_core_dma(H + (size_t)tm * 128 * DM, DM, W + (size_t)tn * 128 * DM, DM, DM, acc, smem);
        epi_inproj(p, l, tm, tn, acc, (float*)smem);
    }
}

#define KT_E (64 * LROW)
DI void attn_item(const Params& p, const bf16_t* Qb, const bf16_t* Kb, const bf16_t* VTb, int ntiles, int rowbase, int hq, bf16_t* smem) {
    const int tid = otid(), lane = tid & 63, wave = tid >> 6;
    const int r = lane & 31, h = lane >> 5;
    const float LOG2E = 1.4426950408889634f;
    bf16x8 qf[4];
    {
        const bf16_t* qrow = Qb + (size_t)(wave * 32 + r) * 64;
#pragma unroll
        for (int s = 0; s < 4; ++s) qf[s] = *(const bf16x8*)(qrow + s * 16 + h * 8);
    }
    f32x16 ot[2], zacc;
#pragma unroll
    for (int i = 0; i < 16; ++i) { ot[0][i] = 0.f; ot[1][i] = 0.f; zacc[i] = 0.f; }
    float m = 0.f, lsum = 0.f;
    bool stab = false;
    uint4 rk[2], rv[2];
    auto gload = [&](int kt) {
#pragma unroll
        for (int i = 0; i < 2; ++i) {
            const int q = tid + 256 * i;
            rk[i] = *(const uint4*)(Kb + (size_t)(kt * 64 + (q >> 3)) * 64 + (q & 7) * 8);
            rv[i] = *(const uint4*)(VTb + (size_t)(q >> 3) * NKEY + kt * 64 + (q & 7) * 8);
        }
    };
    auto sstore = [&](int buf) {
        bf16_t* sk = smem + buf * 2 * KT_E;
        bf16_t* sv = sk + KT_E;
#pragma unroll
        for (int i = 0; i < 2; ++i) {
            const int q = tid + 256 * i;
            *(uint4*)(sk + (q >> 3) * LROW + (q & 7) * 8) = rk[i];
            *(uint4*)(sv + (q >> 3) * LROW + (q & 7) * 8) = rv[i];
        }
    };
    __syncthreads();
    gload(0);
    sstore(0);
    __syncthreads();
    for (int kt = 0; kt < ntiles; ++kt) {
        if (kt + 1 < ntiles) gload(kt + 1);
        const bf16_t* sk = smem + (kt & 1) * 2 * KT_E;
        const bf16_t* sv = sk + KT_E;
        f32x16 st[2], pe[2];
#pragma unroll
        for (int blk = 0; blk < 2; ++blk) {
            st[blk] = __builtin_amdgcn_mfma_f32_32x32x16_bf16(*(const bf16x8*)(sk + (blk * 32 + r) * LROW + h * 8), qf[0], zacc, 0, 0, 0);
#pragma unroll
            for (int s = 1; s < 4; ++s)
                st[blk] = __builtin_amdgcn_mfma_f32_32x32x16_bf16(*(const bf16x8*)(sk + (blk * 32 + r) * LROW + s * 16 + h * 8), qf[s], st[blk], 0, 0, 0);
        }
        if (stab) {
#pragma unroll
            for (int i = 0; i < 16; ++i) { st[0][i] -= m; st[1][i] -= m; }
        }
        float ls = 0.f;
#pragma unroll
        for (int i = 0; i < 16; ++i) {
            pe[0][i] = __builtin_amdgcn_exp2f(st[0][i]); ls += pe[0][i];
            pe[1][i] = __builtin_amdgcn_exp2f(st[1][i]); ls += pe[1][i];
        }
        if (__any(!(ls <= 1.0e12f) || (ls < 1.0e-25f))) {
            float tmx = st[0][0];
#pragma unroll
            for (int i = 0; i < 16; ++i) { tmx = fmaxf(tmx, st[0][i]); tmx = fmaxf(tmx, st[1][i]); }
            tmx = fmaxf(tmx, __shfl_xor(tmx, 32));
            const float lrow = lsum + __shfl_xor(lsum, 32);
            const bool rebase = !(lrow >= 1.0e-20f);
            const float delta = rebase ? tmx : fmaxf(tmx, 0.f);
            const float alpha = rebase ? 0.f : __builtin_amdgcn_exp2f(-delta);
            m += delta;
            stab = true;
            lsum *= alpha;
            ls = 0.f;
#pragma unroll
            for (int i = 0; i < 16; ++i) {
                ot[0][i] *= alpha; ot[1][i] *= alpha;
                pe[0][i] = __builtin_amdgcn_exp2f(st[0][i] - delta); ls += pe[0][i];
                pe[1][i] = __builtin_amdgcn_exp2f(st[1][i] - delta); ls += pe[1][i];
            }
        }
        lsum += ls;
        bf16x8 pk[2][2];
#pragma unroll
        for (int blk = 0; blk < 2; ++blk)
#pragma unroll
            for (int s = 0; s < 2; ++s) {
                uint4 u;
                u.x = pack2(pe[blk][8 * s + 0], pe[blk][8 * s + 1]); u.y = pack2(pe[blk][8 * s + 2], pe[blk][8 * s + 3]);
                u.z = pack2(pe[blk][8 * s + 4], pe[blk][8 * s + 5]); u.w = pack2(pe[blk][8 * s + 6], pe[blk][8 * s + 7]);
                pk[blk][s] = __builtin_bit_cast(bf16x8, u);
            }
#pragma unroll
        for (int db = 0; db < 2; ++db)
#pragma unroll
            for (int blk = 0; blk < 2; ++blk)
#pragma unroll
                for (int s = 0; s < 2; ++s) {
                    const bf16_t* vp = sv + (db * 32 + r) * LROW + blk * 32 + s * 16 + h * 4;
                    const bf16x4 lo = *(const bf16x4*)vp;
                    const bf16x4 hi = *(const bf16x4*)(vp + 8);
                    const bf16x8 vf = __builtin_shufflevector(lo, hi, 0, 1, 2, 3, 4, 5, 6, 7);
                    ot[db] = __builtin_amdgcn_mfma_f32_32x32x16_bf16(vf, pk[blk][s], ot[db], 0, 0, 0);
                }
        if (kt + 1 < ntiles) sstore((kt + 1) & 1);
        __syncthreads();
    }
    lsum += __shfl_xor(lsum, 32);
    const float inv = 1.f / lsum;
    const int row = rowbase + wave * 32 + r;
    const bf16_t* zrow = (const bf16_t*)(p.ws + OFF_PARTS) + (size_t)row * PW + PC_ZATT + hq * 64;
    bf16_t* orow = (bf16_t*)(p.ws + OFF_H) + (size_t)row * DM + 256 + hq * 64;
#pragma unroll
    for (int db = 0; db < 2; ++db)
#pragma unroll
        for (int g = 0; g < 4; ++g) {
            const int d = db * 32 + g * 8 + h * 4;
            const uint2 z = *(const uint2*)(zrow + d);
            const float o0 = silu_f(bflo(z.x)) * ot[db][4 * g + 0] * inv, o1 = silu_f(bfhi(z.x)) * ot[db][4 * g + 1] * inv;
            const float o2 = silu_f(bflo(z.y)) * ot[db][4 * g + 2] * inv, o3 = silu_f(bfhi(z.y)) * ot[db][4 * g + 3] * inv;
            *(uint2*)(orow + d) = make_uint2(pack2(o0, o1), pack2(o2, o3));
        }
}

DI void phase_attn(const Params& p, int l, bf16_t* smem) {
    const bf16_t* Q = (const bf16_t*)(p.ws + OFF_Q);
    const bf16_t* QC = (const bf16_t*)(p.ws + OFF_QC);
    const bf16_t* Kk = (const bf16_t*)(p.ws + OFF_K);
    const bf16_t* VT = (const bf16_t*)(p.ws + OFF_VT);
    for (XIter t = xiter(512); t.u < t.end; t.u += t.step) {
        const int it = t.u;
        const int b = it >> 8, hq = (it >> 6) & 3, qt = it & 63;
        const size_t kv = (size_t)(b * 2 + (hq >> 1));
        attn_item(p, Q + ((size_t)(b * 4 + hq) * SEQ + qt * 128) * 64, Kk + kv * NKEY * 64, VT + kv * 64 * NKEY, NKEY / 64, b * SEQ + qt * 128, hq, smem);
    }
    if (l == 0) {
        for (int j = blockIdx.x; j < 16; j += gridDim.x) {
            const int b = j >> 3, hq = (j >> 1) & 3, qt = j & 1;
            const size_t kv = (size_t)(b * 2 + (hq >> 1));
            attn_item(p, QC + ((size_t)(b * 4 + hq) * CTX + qt * 128) * 64, Kk + kv * NKEY * 64, VT + kv * 64 * NKEY, CTX / 64, ROWS_L + b * CTX + qt * 128, hq, smem);
        }
    }
}

template <int W>
DI void pool_task(const bf16_t* __restrict__ pu, int pos, int n, bf16_t* __restrict__ dst) {
    constexpr int LEFT = W / 2;
    uint4 raw[W];
#pragma unroll
    for (int t = 0; t < W; ++t) { int q = pos - LEFT + t; q = q < 0 ? 0 : (q >= n ? n - 1 : q); raw[t] = *(const uint4*)(pu + (size_t)q * PW); }
    float sum[8], u[8];
#pragma unroll
    for (int e = 0; e < 8; ++e) sum[e] = 0.f;
#pragma unroll
    for (int t = 0; t < W; ++t) {
        const int q = pos - LEFT + t;
        const float mk = (q >= 0 && q < n) ? 1.f : 0.f;
        unpack8(raw[t], u);
#pragma unroll
        for (int e = 0; e < 8; ++e) sum[e] += mk * u[e];
    }
    const int lo = max(pos - LEFT, 0), hi = min(pos + W - LEFT, n);
    const float ic = 1.f / (float)(hi - lo);
    unpack8(raw[LEFT], u);
#pragma unroll
    for (int e = 0; e < 8; ++e) sum[e] = sum[e] * ic - u[e];
    *(uint4*)dst = pack8(sum);
}
DI void phase_convpool(const Params& p, int l) {
    const bf16_t* __restrict__ parts = (const bf16_t*)(p.ws + OFF_PARTS);
    bf16_t* __restrict__ cat = (bf16_t*)(p.ws + OFF_H);
    bf16_t* __restrict__ dbuf = (bf16_t*)(p.ws + OFF_DBUF);
    const int nrows = (l == 0 ? ROWS : ROWS_L);
    const int gsz = gridDim.x * 256, gt = blockIdx.x * 256 + otid();
    {
        const int c8 = (gt & 31) * 8;
        float w0[8], w1[8], w2[8], bs[8];
        ld8(p.conv_w + l * 768 + c8, w0); ld8(p.conv_w + l * 768 + 256 + c8, w1); ld8(p.conv_w + l * 768 + 512 + c8, w2); ld8(p.conv_b + l * 256 + c8, bs);
        for (int i = gt; i < nrows * 32; i += gsz) {
            const int row = i >> 5;
            int seq0, n;
            if (row < ROWS_L) { seq0 = (row >> 13) << 13; n = SEQ; } else { seq0 = ROWS_L + (((row - ROWS_L) >> 8) << 8); n = CTX; }
            const int pos = row - seq0;
            const bf16_t* pr = parts + (size_t)row * PW + c8;
            const bool hp = pos > 0, hn = pos + 1 < n;
            const bf16_t* pp = hp ? pr - PW : pr;
            const bf16_t* pn = hn ? pr + PW : pr;
            const uint4 r0 = *(const uint4*)(pr + PC_T), r2 = *(const uint4*)(pp + PC_T), r4 = *(const uint4*)(pn + PC_T), r6 = *(const uint4*)(pr + PC_GC);
            const float mp = hp ? 1.f : 0.f, mn = hn ? 1.f : 0.f;
            float tc[8], tp[8], tn[8], gg[8], o[8];
            unpack8(r0, tc); unpack8(r2, tp); unpack8(r4, tn); unpack8(r6, gg);
#pragma unroll
            for (int e = 0; e < 8; ++e) o[e] = gg[e] * (mp * tp[e] * w0[e] + tc[e] * w1[e] + mn * tn[e] * w2[e] + bs[e]);
            *(uint4*)(cat + (size_t)row * DM + 512 + c8) = pack8(o);
        }
    }
    for (int j = gt; j < nrows * 32; j += gsz) {
        const int g = j / (nrows * 8), rem = j - g * (nrows * 8), row = rem >> 3, c8 = g * 64 + (rem & 7) * 8;
        int seq0, n;
        if (row < ROWS_L) { seq0 = (row >> 13) << 13; n = SEQ; } else { seq0 = ROWS_L + (((row - ROWS_L) >> 8) << 8); n = CTX; }
        const bf16_t* pu = parts + (size_t)seq0 * PW + PC_UP + c8;
        bf16_t* dst = dbuf + (size_t)row * 256 + c8;
        const int pos = row - seq0;
        if (g == 0) pool_task<2>(pu, pos, n, dst);
        else if (g == 1) pool_task<4>(pu, pos, n, dst);
        else if (g == 2) pool_task<8>(pu, pos, n, dst);
        else pool_task<16>(pu, pos, n, dst);
    }
}

DI void phase_dft1(const Params& p, int l, bf16_t* smem) {
    const int tid = otid();
    float* st = (float*)smem;
    const bf16_t* parts = (const bf16_t*)(p.ws + OFF_PARTS);
    const bf16_t* F1 = (const bf16_t*)(p.ws + OFF_F1);
    const bf16_t* FC = (const bf16_t*)(p.ws + OFF_FC);
    const float* tw = (const float*)(p.ws + OFF_TW);
    bf16_t* G1 = (bf16_t*)(p.ws + OFF_G1);
    bf16_t* pcat = (bf16_t*)(p.ws + OFF_PCAT);
    const int nt1 = 2 * 64 * 4;
    const int ntot = nt1 + (l == 0 ? 16 : 0);
    for (int it = blockIdx.x; it < ntot; it += gridDim.x) {
        f32x4 acc[4][4];
        if (it < nt1) {
            const int b = it >> 8, t2 = (it >> 2) & 63, mt = (it >> 1) & 1, nt = it & 1;
            gemm_core<true>(F1 + (size_t)mt * 128 * 128, 128, parts + (size_t)(b * SEQ + t2) * PW + PC_UF + nt * 128, 64 * PW, 128, acc, smem);
            stage_acc(acc, st);
#pragma unroll 1
            for (int i = 0; i < 4; ++i) {
                const int q = tid + 256 * i, kk = q >> 4, c8 = (q & 15) * 8;
                const int rr = 32 * (kk >> 4) + (kk & 15);
                const int k1 = mt * 64 + kk;
                const float cs = tw[2 * (k1 * t2)], sn = tw[2 * (k1 * t2) + 1];
                float gr[8], gi[8], o[8];
                ld8(st + rr * ST_LD + c8, gr);
                ld8(st + (rr + 16) * ST_LD + c8, gi);
                bf16_t* dr = G1 + ((size_t)((b * 128 + k1) * 2 + 0) * 64 + t2) * 256 + nt * 128 + c8;
#pragma unroll
                for (int e = 0; e < 8; ++e) o[e] = gr[e] * cs + gi[e] * sn;
                *(uint4*)dr = pack8(o);
#pragma unroll
                for (int e = 0; e < 8; ++e) o[e] = gi[e] * cs - gr[e] * sn;
                *(uint4*)(dr + (size_t)64 * 256) = pack8(o);
            }
        } else {
            const int j0 = it - nt1, b = j0 >> 3, mt = (j0 >> 1) & 3, nt = j0 & 1;
            gemm_core<true>(FC + (size_t)mt * 128 * 256, 256, parts + (size_t)(ROWS_L + b * CTX) * PW + PC_UF + nt * 128, PW, 256, acc, smem);
            stage_acc(acc, st);
#pragma unroll 1
            for (int i = 0; i < 8; ++i) {
                const int q = tid + 256 * i, rl = q >> 4, c8 = (q & 15) * 8;
                const int m = mt * 128 + rl, c = m >> 8, k = m & 255;
                float v[8];
                ld8(st + rl * ST_LD + c8, v);
                *(uint4*)(pcat + (size_t)(ROWS_L + b * CTX + k) * 512 + c * 256 + nt * 128 + c8) = pack8(v);
            }
        }
    }
}

DI void phase_dft2_mixp(const Params& p, int l, bf16_t* smem, int item_lo, int item_hi, int blk0, int nblk) {
    const int tid = otid();
    float* st = (float*)smem;
    const bf16_t* F2 = (const bf16_t*)(p.ws + OFF_F2);
    const bf16_t* G1 = (const bf16_t*)(p.ws + OFF_G1);
    bf16_t* pcat = (bf16_t*)(p.ws + OFF_PCAT);
    const bf16_t* dbuf = (const bf16_t*)(p.ws + OFF_DBUF);
    const bf16_t* wp = (const bf16_t*)(p.ws + OFF_WPOOL) + (size_t)l * 65536;
    const bf16_t* parts = (const bf16_t*)(p.ws + OFF_PARTS);
    bf16_t* cat = (bf16_t*)(p.ws + OFF_H);
    const int nt2 = 2 * 128 * 2;
    const int nmt = (l == 0 ? ROWS : ROWS_L) / 128;
    (void)nmt;
    if ((int)blockIdx.x < blk0) return;
    for (int it = item_lo + ((int)blockIdx.x - blk0); it < item_hi; it += nblk) {
        f32x4 acc[4][4];
        if (it < nt2) {
            const int b = it >> 8, k1 = (it >> 1) & 127, nt = it & 1;
            gemm_core<true>(F2, 128, G1 + (size_t)(b * 128 + k1) * 128 * 256 + nt * 128, 256, 128, acc, smem);
            stage_acc(acc, st);
#pragma unroll 1
            for (int i = 0; i < 8; ++i) {
                const int q = tid + 256 * i, m = q >> 4, c8 = (q & 15) * 8;
                const int c = m >> 6, k2 = m & 63;
                float v[8];
                ld8(st + m * ST_LD + c8, v);
                *(uint4*)(pcat + (size_t)(b * SEQ + k1 + 128 * k2) * 512 + c * 256 + nt * 128 + c8) = pack8(v);
            }
        } else {
            const int j0 = it - nt2, tm = j0 >> 1, nt = j0 & 1;
            gemm_core_dma(dbuf + (size_t)tm * 128 * 256 + nt * 128, 256, wp + (size_t)(nt * 128) * 256 + nt * 128, 256, 128, acc, smem);
            stage_acc(acc, st);
            {
                const int c8 = (tid & 15) * 8, r0 = tid >> 4, n = nt * 128 + c8;
                float ps[8];
                ld8(p.pool_scale + l * 256 + n, ps);
                uint4 zr[8];
#pragma unroll
                for (int i = 0; i < 8; ++i) zr[i] = *(const uint4*)(parts + (size_t)(tm * 128 + r0 + 16 * i) * PW + PC_ZP + n);
#pragma unroll
                for (int i = 0; i < 8; ++i) {
                    float v[8], z[8];
                    ld8(st + (r0 + 16 * i) * ST_LD + c8, v);
                    unpack8(zr[i], z);
#pragma unroll
                    for (int e = 0; e < 8; ++e) v[e] = silu_f(z[e]) * ps[e] * v[e];
                    *(uint4*)(cat + (size_t)(tm * 128 + r0 + 16 * i) * DM + 768 + n) = pack8(v);
                }
            }
        }
    }
}

DI void phase_mixf(const Params& p, int l, bf16_t* smem) {
    const int tid = otid();
    float* st = (float*)smem;
    const bf16_t* pcat = (const bf16_t*)(p.ws + OFF_PCAT);
    const bf16_t* wc = (const bf16_t*)(p.ws + OFF_WCOMB) + (size_t)l * 131072;
    const bf16_t* parts = (const bf16_t*)(p.ws + OFF_PARTS);
    bf16_t* cat = (bf16_t*)(p.ws + OFF_H);
    const int nmt = (l == 0 ? ROWS : ROWS_L) / 128;
    for (int it = blockIdx.x; it < nmt * 2; it += gridDim.x) {
        const int tm = it >> 1, nt = it & 1;
        f32x4 acc[4][4];
        gemm_core_dma(pcat + (size_t)tm * 128 * 512, 512, wc + (size_t)(nt * 128) * 512, 512, 512, acc, smem);
        stage_acc(acc, st);
        const float sc = (tm < 128) ? 0.001381067932004976f : 0.0078125f;
        {
            const int c8 = (tid & 15) * 8, r0 = tid >> 4, n = nt * 128 + c8;
            uint4 zr[8];
#pragma unroll
            for (int i = 0; i < 8; ++i) zr[i] = *(const uint4*)(parts + (size_t)(tm * 128 + r0 + 16 * i) * PW + PC_ZF + n);
#pragma unroll
            for (int i = 0; i < 8; ++i) {
                float v[8], z[8];
                ld8(st + (r0 + 16 * i) * ST_LD + c8, v);
                unpack8(zr[i], z);
#pragma unroll
                for (int e = 0; e < 8; ++e) v[e] = silu_f(z[e]) * sc * v[e];
                *(uint4*)(cat + (size_t)(tm * 128 + r0 + 16 * i) * DM + n) = pack8(v);
            }
        }
    }
}

DI void phase_out(const Params& p, int l, const float* xl_in, const float* xc_in, float* xl_out, float* xc_out, bf16_t* smem) {
    const int tid = otid();
    float* st = (float*)smem;
    const bf16_t* cat = (const bf16_t*)(p.ws + OFF_H);
    const bf16_t* W = (const bf16_t*)(p.ws + OFF_WTOUT) + (size_t)l * DM * DM;
    const float* modv = (const float*)(p.ws + OFF_MODV) + (size_t)l * 3 * 3072;
    const int nmt = (l == 0 ? ROWS : ROWS_L) / 128;
    (void)nmt;
    for (XIter t = xiter(1024); t.u < t.end; t.u += t.step) {
        int tm, tn;
        { const int ch = t.u >> 6, r = t.u & 63; tn = r >> 3; tm = ch * 8 + (r & 7); }
        f32x4 acc[4][4];
        gemm_core_dma(cat + (size_t)tm * 128 * DM, DM, W + (size_t)tn * 128 * DM, DM, DM, acc, smem);
        stage_acc(acc, st);
        const int rb = tm * 128;
        const int v = (rb < ROWS_L) ? (rb >> 13) : 2;
        const float* gate = modv + v * 3072 + 2048;
        const float* xin = (rb < ROWS_L) ? xl_in : xc_in - (size_t)ROWS_L * DM;
        float* xout = (rb < ROWS_L) ? xl_out : xc_out - (size_t)ROWS_L * DM;
        {
            const int c8 = (tid & 15) * 8, r0 = tid >> 4;
            const size_t o0 = (size_t)(rb + r0) * DM + tn * 128 + c8;
            float gt[8];
            ld8(gate + tn * 128 + c8, gt);
            const bool lat = rb < ROWS_L;
            bf16_t* x1b = (bf16_t*)(p.ws + OFF_X1B);
            float4 x0[8], x1[8];
            if (lat && l == 1) {
#pragma unroll
                for (int i = 0; i < 8; ++i) { const uint4 u = *(const uint4*)(x1b + o0 + (size_t)i * 16 * DM);
                    x0[i] = make_float4(bflo(u.x), bfhi(u.x), bflo(u.y), bfhi(u.y)); x1[i] = make_float4(bflo(u.z), bfhi(u.z), bflo(u.w), bfhi(u.w)); }
            } else {
#pragma unroll
                for (int i = 0; i < 8; ++i) { x0[i] = *(const float4*)(xin + o0 + (size_t)i * 16 * DM); x1[i] = *(const float4*)(xin + o0 + (size_t)i * 16 * DM + 4); }
            }
#pragma unroll
            for (int i = 0; i < 8; ++i) {
                float a[8];
                ld8(st + (r0 + 16 * i) * ST_LD + c8, a);
                const float y0 = x0[i].x + gt[0] * a[0], y1 = x0[i].y + gt[1] * a[1], y2 = x0[i].z + gt[2] * a[2], y3 = x0[i].w + gt[3] * a[3];
                const float y4 = x1[i].x + gt[4] * a[4], y5 = x1[i].y + gt[5] * a[5], y6 = x1[i].z + gt[6] * a[6], y7 = x1[i].w + gt[7] * a[7];
                if (lat && l == 0) {
                    *(uint4*)(x1b + o0 + (size_t)i * 16 * DM) = make_uint4(pack2(y0, y1), pack2(y2, y3), pack2(y4, y5), pack2(y6, y7));
                } else {
                    float* d = xout + o0 + (size_t)i * 16 * DM;
                    *(float4*)(d) = make_float4(y0, y1, y2, y3);
                    *(float4*)(d + 4) = make_float4(y4, y5, y6, y7);
                }
            }
        }
    }
    if (l == 0) {
        for (int j = blockIdx.x; j < 64; j += gridDim.x) {
            const int kh = j & 1, tn = (j >> 1) & 7, tm = 128 + (j >> 4);
            f32x4 acc[4][4];
            gemm_core_dma(cat + (size_t)tm * 128 * DM + kh * 512, DM, W + (size_t)tn * 128 * DM + kh * 512, DM, 512, acc, smem);
            stage_acc(acc, st);
            float* part = (float*)(p.ws + (kh ? OFF_XC1B : OFF_XC1));
            const int c8 = (tid & 15) * 8, r0 = tid >> 4;
            float gt[8];
            ld8(modv + 2 * 3072 + 2048 + tn * 128 + c8, gt);
#pragma unroll
            for (int i = 0; i < 8; ++i) {
                float a[8];
                ld8(st + (r0 + 16 * i) * ST_LD + c8, a);
                float* d = part + (size_t)(tm * 128 - ROWS_L + r0 + 16 * i) * DM + tn * 128 + c8;
                *(float4*)(d) = make_float4(gt[0] * a[0], gt[1] * a[1], gt[2] * a[2], gt[3] * a[3]);
                *(float4*)(d + 4) = make_float4(gt[4] * a[4], gt[5] * a[5], gt[6] * a[6], gt[7] * a[7]);
            }
        }
    }
}

#ifndef PH_MASK
#define PH_MASK 0xFFFF
#endif
#ifndef PH_DUP
#define PH_DUP 0
#endif
__global__ void __launch_bounds__(256, 2) fwd_megakernel(Params p) {
    __shared__ __attribute__((aligned(16))) unsigned char smem_raw[SMEM_BYTES];
    bf16_t* smem = (bf16_t*)smem_raw;
    float* smf = (float*)smem_raw;
    volatile LAS unsigned* stw = (volatile LAS unsigned*)(smem_raw + SMEM_MAIN);
    if (threadIdx.x == 0) { stw[0] = 0u; stw[1] = 0u; stw[2] = 0u; stw[3] = 0u; }
    __syncthreads();
    if (p.never) cg::this_grid().sync();
    XcdBarrier bar = xcd_barrier_post((unsigned*)(p.ws + OFF_BAR), stw);

    if (PH_MASK & 1) phase0(p, smf);
    if (PH_DUP & 1) phase0(p, smf);
    xcd_barrier(bar);
    float* xc1 = (float*)(p.ws + OFF_XC1);
    for (int l = 0; l < 2; ++l) {
        const float* xl_in = (l == 0) ? p.x : p.out;
        const float* xc_in = p.ctx;
        if (PH_MASK & 2) phase_norm(p, l, xl_in, xc_in, (l == 1) ? (const bf16_t*)(p.ws + OFF_X1B) : nullptr);
        xcd_barrier(bar);
        if (PH_MASK & 4) phase_inproj(p, l, smem);
        if (PH_DUP & 4) phase_inproj(p, l, smem);
        xcd_barrier(bar);
        if (PH_MASK & 8) phase_attn(p, l, smem);
        if (PH_DUP & 8) phase_attn(p, l, smem);
        if (PH_MASK & 16) phase_convpool(p, l);
        if (PH_DUP & 16) phase_convpool(p, l);
        if (PH_MASK & 32) phase_dft1(p, l, smem);
        if (PH_DUP & 32) phase_dft1(p, l, smem);
        xcd_barrier(bar);
        if (PH_MASK & 64) phase_dft2_mixp(p, l, smem, 0, 512, 0, gridDim.x);
        xcd_barrier(bar);
        {
            const int nmix = (l == 0 ? ROWS : ROWS_L) / 64;
            const int b0 = ((int)gridDim.x > nmix) ? nmix : 0;
            if (PH_MASK & 128) phase_mixf(p, l, smem);
            if (PH_MASK & 64) phase_dft2_mixp(p, l, smem, 512, 512 + nmix, b0, (int)gridDim.x - b0);
        }
        xcd_barrier(bar);
        if (PH_MASK & 256) phase_out(p, l, xl_in, xc_in, p.out, xc1, smem);
        if (PH_DUP & 256) phase_out(p, l, xl_in, xc_in, (float*)(p.ws + OFF_G1), (float*)(p.ws + OFF_G1), smem);
        if (l == 0) xcd_barrier(bar);
    }
}

extern "C" void kernel_launch(void* const* d_in, const int* in_sizes, int n_in, void* d_out, int out_size, void* d_ws, size_t ws_size, hipStream_t stream) {
    static int grid_blocks = 0;
    if (!grid_blocks) {
        int dev = 0, cus = 0, per_cu = 0;
        hipGetDevice(&dev);
        hipDeviceGetAttribute(&cus, hipDeviceAttributeMultiprocessorCount, dev);
        hipOccupancyMaxActiveBlocksPerMultiprocessor(&per_cu, fwd_megakernel, 256, 0);
        if (per_cu > 2) per_cu = 2;
        if (per_cu < 1) per_cu = 1;
        grid_blocks = cus * per_cu;
        if (ws_size < WS_END) fprintf(stderr, "kernel_launch: workspace too small: %zu < %zu\n", ws_size, (size_t)WS_END);
    }
    hipMemsetAsync((char*)d_ws + OFF_BAR, 0, 16384, stream);
    Params p{};
    p.x = (const float*)d_in[0]; p.c = (const float*)d_in[1]; p.ctx = (const float*)d_in[2]; p.c_ctx = (const float*)d_in[3];
    p.w_mod = (const float*)d_in[4]; p.b_mod = (const float*)d_in[5]; p.norm_g = (const float*)d_in[6]; p.w_in = (const float*)d_in[7];
    p.q_gain = (const float*)d_in[8]; p.k_gain = (const float*)d_in[9]; p.w_fourier = (const float*)d_in[10]; p.conv_w = (const float*)d_in[11];
    p.conv_b = (const float*)d_in[12]; p.pool_w = (const float*)d_in[13]; p.pool_scale = (const float*)d_in[14]; p.w_out = (const float*)d_in[15];
    p.out = (float*)d_out; p.ws = (unsigned char*)d_ws; p.never = 0; p.pad = 0;
    void* args[] = {&p};
    hipError_t e = hipLaunchCooperativeKernel((void*)fwd_megakernel, dim3(grid_blocks), dim3(256), args, 0, stream);
    if (e != hipSuccess) fprintf(stderr, "cooperative launch failed: %s (grid %d)\n", hipGetErrorString(e), grid_blocks);
}
```

```cpp
#include <hip/hip_runtime.h>
#include <hip/hip_cooperative_groups.h>
#include <stdint.h>
#include <cstdio>
namespace cg = cooperative_groups;

typedef unsigned short bf16_t;
typedef __attribute__((ext_vector_type(8))) short bf16x8;
typedef __attribute__((ext_vector_type(4))) short bf16x4;
typedef __attribute__((ext_vector_type(4))) float f32x4;
typedef __attribute__((ext_vector_type(16))) float f32x16;
#define DI __device__ __forceinline__

#define SEQ 8192
#define CTX 256
#define DM 1024
#define DIN 2816
#define ROWS_L 16384
#define ROWS_C 512
#define ROWS 16896
#define NKEY 8448
#define PW 1792
#define PC_ZATT 0
#define PC_UF 256
#define PC_ZF 512
#define PC_T 768
#define PC_GC 1024
#define PC_UP 1280
#define PC_ZP 1536

constexpr size_t OFF_BAR = 0;
constexpr size_t OFF_MODV = 16384;
constexpr size_t OFF_ROPE = OFF_MODV + 2 * 3 * 3072 * 4;
constexpr size_t OFF_TW = OFF_ROPE + 6144 * 4;
constexpr size_t OFF_F1 = OFF_TW + 8192 * 2 * 4;
constexpr size_t OFF_F2 = OFF_F1 + 256 * 128 * 2;
constexpr size_t OFF_FC = OFF_F2 + 128 * 128 * 2;
constexpr size_t OFF_WCOMB = OFF_FC + 512 * 256 * 2;
constexpr size_t OFF_WPOOL = OFF_WCOMB + 2 * 256 * 512 * 2;
constexpr size_t OFF_WTIN = 2097152;
constexpr size_t OFF_WTOUT = OFF_WTIN + (size_t)2 * DIN * DM * 2;
constexpr size_t OFF_H = OFF_WTOUT + (size_t)2 * DM * DM * 2;
constexpr size_t OFF_PARTS = OFF_H + (size_t)ROWS * DM * 2;
constexpr size_t OFF_Q = OFF_PARTS + (size_t)ROWS * PW * 2;
constexpr size_t OFF_QC = OFF_Q + (size_t)2 * 4 * SEQ * 64 * 2;
constexpr size_t OFF_K = OFF_QC + (size_t)2 * 4 * CTX * 64 * 2;
constexpr size_t OFF_VT = OFF_K + (size_t)2 * 2 * NKEY * 64 * 2;
constexpr size_t OFF_DBUF = OFF_VT + (size_t)2 * 2 * NKEY * 64 * 2;
constexpr size_t OFF_G1 = OFF_DBUF + (size_t)ROWS * 256 * 2;
constexpr size_t OFF_PCAT = OFF_G1 + (size_t)2 * 128 * 2 * 64 * 256 * 2;
constexpr size_t OFF_XC1 = OFF_PCAT + (size_t)ROWS * 512 * 2;
constexpr size_t OFF_X1B = OFF_XC1 + (size_t)ROWS_C * DM * 4;
constexpr size_t OFF_XC1B = OFF_X1B + (size_t)ROWS_L * DM * 2;
constexpr size_t WS_END = OFF_XC1B + (size_t)ROWS_C * DM * 4;
static_assert(OFF_WPOOL + 2 * 256 * 256 * 2 <= OFF_WTIN, "ws map");

struct Params {
    const float *x, *c, *ctx, *c_ctx, *w_mod, *b_mod, *norm_g, *w_in, *q_gain, *k_gain, *w_fourier, *conv_w, *conv_b, *pool_w, *pool_scale, *w_out;
    float* out;
    unsigned char* ws;
    int never;
    int pad;
};

DI bf16_t f2bf(float x) { unsigned u = __float_as_uint(x); u += 0x7fffu + ((u >> 16) & 1u); return (bf16_t)(u >> 16); }
DI float bf2f(bf16_t h) { return __uint_as_float(((unsigned)h) << 16); }
typedef __attribute__((ext_vector_type(2))) float f32x2;
typedef __attribute__((ext_vector_type(2))) __bf16 bf16x2v;
DI unsigned pack2(float a, float b) { const f32x2 v = {a, b}; return __builtin_bit_cast(unsigned, __builtin_convertvector(v, bf16x2v)); }
DI float4 ldnt4(const float* q) { const f32x4 t_ = __builtin_nontemporal_load((const f32x4*)q); return make_float4(t_[0], t_[1], t_[2], t_[3]); }
struct XIter { int u, end, step; };
DI XIter xiter(int ntiles) {
    const int x = blockIdx.x & 7, j = blockIdx.x >> 3, nb = gridDim.x >> 3, per = (ntiles + 7) >> 3;
    XIter r; r.u = x * per + j; r.end = min((x + 1) * per, ntiles); r.step = nb; return r;
}
DI float silu_f(float z) { return z / (1.f + __expf(-z)); }
DI float bflo(unsigned w) { return __uint_as_float(w << 16); }
DI float bfhi(unsigned w) { return __uint_as_float(w & 0xffff0000u); }
DI int otid() { int t = threadIdx.x; asm volatile("" : "+v"(t)); return t; }

#define XB_TMO      128
#define XB_XCNT(j)  (256  + 64 * (j))
#define XB_XSUB(j)  (1280 + 64 * (j))
#define XB_XGEN(j)  (2304 + 64 * (j))
#define XB_TOP      3328
#define XB_TOPGEN   3392
#define XCD_BAR_WORDS 3456
#define XB_SPIN_CAP (1u << 20)
#define LAS __attribute__((address_space(3)))
DI unsigned xb_ld(unsigned* p) { return __hip_atomic_load(p, __ATOMIC_RELAXED, __HIP_MEMORY_SCOPE_AGENT); }
DI unsigned xb_add(unsigned* p, unsigned v) { return __hip_atomic_fetch_add(p, v, __ATOMIC_RELAXED, __HIP_MEMORY_SCOPE_AGENT); }
DI unsigned xb_xcc_id() { return (unsigned)__builtin_amdgcn_s_getreg((3 << 11) | 20) & 0xFu; }
#define XB_SPIN(cond, bar) do { unsigned _sp = 0; while (cond) { __builtin_amdgcn_s_sleep(1); \
    if ((++_sp & 255u) == 0u) { if (xb_ld(&(bar)[XB_TMO])) break; if (_sp > XB_SPIN_CAP) { atomicAdd(&(bar)[XB_TMO], 1u); break; } } } } while (0)
struct XcdBarrier { unsigned* bar; unsigned x; volatile LAS unsigned* st; };
DI XcdBarrier xcd_barrier_post(unsigned* bar, volatile LAS unsigned* st) {
    XcdBarrier b; b.bar = bar; b.x = xb_xcc_id(); b.st = st;
    if (threadIdx.x == 0) (void)xb_add(&bar[XB_XCNT(b.x)], 1u);
    return b;
}
DI void xcd_barrier_complete(unsigned* bar, unsigned x, unsigned& nloc, unsigned& nx) {
    const unsigned G = gridDim.x * gridDim.y * gridDim.z;
    unsigned sum, cnt, mine, sp = 0u;
    for (;;) {
        sum = 0u; cnt = 0u; mine = 0u;
#pragma unroll
        for (unsigned j = 0; j < 16; ++j) { const unsigned c = xb_ld(&bar[XB_XCNT(j)]); sum += c; cnt += (c > 0u) ? 1u : 0u; mine = (j == x) ? c : mine; }
        if (sum == G) break;
        __builtin_amdgcn_s_sleep(1);
        if ((++sp & 255u) == 0u) { if (xb_ld(&bar[XB_TMO])) break; if (sp > XB_SPIN_CAP) { atomicAdd(&bar[XB_TMO], 1u); break; } }
    }
    nloc = mine > 0u ? mine : 1u; nx = cnt > 0u ? cnt : 1u;
}
DI void xcd_barrier(const XcdBarrier& b) {
    asm volatile("s_waitcnt vmcnt(0)" ::: "memory");
    __syncthreads();
    if (threadIdx.x == 0) {
        unsigned* bar = b.bar;
        __builtin_amdgcn_s_waitcnt(0);
        unsigned nloc = b.st[0], nx = b.st[1];
        if (nloc == 0u) { xcd_barrier_complete(bar, b.x, nloc, nx); b.st[0] = nloc; b.st[1] = nx; }
        const unsigned old = xb_add(&bar[XB_XSUB(b.x)], 1u);
        const unsigned gen = old / nloc;
        if (old + 1u == (gen + 1u) * nloc) {
            __builtin_amdgcn_fence(__ATOMIC_RELEASE, "agent");
            asm volatile("s_waitcnt vmcnt(0)" ::: "memory");
            const unsigned og = xb_add(&bar[XB_TOP], 1u);
            const unsigned tg = og / nx;
            if (og + 1u == (tg + 1u) * nx) xb_add(&bar[XB_TOPGEN], 1u);
            else XB_SPIN(xb_ld(&bar[XB_TOPGEN]) == tg, bar);
            __builtin_amdgcn_fence(__ATOMIC_ACQUIRE, "agent");
            xb_add(&bar[XB_XGEN(b.x)], 1u);
            asm volatile("s_waitcnt vmcnt(0)" ::: "memory");
        } else {
            XB_SPIN(xb_ld(&bar[XB_TOPGEN]) == gen, bar);
            __builtin_amdgcn_fence(__ATOMIC_ACQUIRE, "agent");
            asm volatile("s_waitcnt vmcnt(0)" ::: "memory");
        }
    }
    __syncthreads();
}

#define LROW 72
#define TILE_E (128 * LROW)
#define SMEM_MAIN (4 * TILE_E * 2)
#define SMEM_BYTES (SMEM_MAIN + 16)

typedef __attribute__((ext_vector_type(4))) unsigned u32x4;
struct Stg { u32x4 a0, a1, a2, a3, b0, b1, b2, b3; };
template <bool BN>
DI u32x4 g_ld_b(const bf16_t* __restrict__ B, int ldb, int kt, int q) {
    if (!BN) return *(const u32x4*)(B + (size_t)(q >> 3) * ldb + kt * 64 + (q & 7) * 8);
    else     return *(const u32x4*)(B + (size_t)(kt * 64 + (q >> 4)) * ldb + (q & 15) * 8);
}
template <bool BN>
DI void g_load(Stg& r, const bf16_t* __restrict__ A, int lda, const bf16_t* __restrict__ B, int ldb, int kt, int tid) {
    const bf16_t* ap = A + (size_t)(tid >> 3) * lda + kt * 64 + (tid & 7) * 8;
    r.a0 = *(const u32x4*)(ap);
    r.a1 = *(const u32x4*)(ap + (size_t)32 * lda);
    r.a2 = *(const u32x4*)(ap + (size_t)64 * lda);
    r.a3 = *(const u32x4*)(ap + (size_t)96 * lda);
    r.b0 = g_ld_b<BN>(B, ldb, kt, tid);
    r.b1 = g_ld_b<BN>(B, ldb, kt, tid + 256);
    r.b2 = g_ld_b<BN>(B, ldb, kt, tid + 512);
    r.b3 = g_ld_b<BN>(B, ldb, kt, tid + 768);
}
template <bool BN>
DI void s_st_b(bf16_t* b, const u32x4 v, int q) {
    if (!BN) *(u32x4*)(b + (q >> 3) * LROW + (q & 7) * 8) = v;
    else {
        const int kr0 = q >> 4, n0 = (q & 15) * 8, kr = ((((kr0 >> 3) ^ (q & 7)) << 3) | (kr0 & 7));
        b[(n0 + 0) * LROW + kr] = (bf16_t)(v.x & 0xffffu); b[(n0 + 1) * LROW + kr] = (bf16_t)(v.x >> 16);
        b[(n0 + 2) * LROW + kr] = (bf16_t)(v.y & 0xffffu); b[(n0 + 3) * LROW + kr] = (bf16_t)(v.y >> 16);
        b[(n0 + 4) * LROW + kr] = (bf16_t)(v.z & 0xffffu); b[(n0 + 5) * LROW + kr] = (bf16_t)(v.z >> 16);
        b[(n0 + 6) * LROW + kr] = (bf16_t)(v.w & 0xffffu); b[(n0 + 7) * LROW + kr] = (bf16_t)(v.w >> 16);
    }
}
template <bool BN>
DI void s_store(const Stg& r, bf16_t* smem, int buf, int tid) {
    bf16_t* a = smem + buf * 2 * TILE_E;
    bf16_t* b = a + TILE_E;
    bf16_t* ap = a + (tid >> 3) * LROW + (tid & 7) * 8;
    *(u32x4*)(ap) = r.a0;
    *(u32x4*)(ap + 32 * LROW) = r.a1;
    *(u32x4*)(ap + 64 * LROW) = r.a2;
    *(u32x4*)(ap + 96 * LROW) = r.a3;
    s_st_b<BN>(b, r.b0, tid);
    s_st_b<BN>(b, r.b1, tid + 256);
    s_st_b<BN>(b, r.b2, tid + 512);
    s_st_b<BN>(b, r.b3, tid + 768);
}
DI void mma_tile(const bf16_t* smem, int buf, f32x4 (&acc)[4][4], int wm, int wn, int lane) {
    const bf16_t* a = smem + buf * 2 * TILE_E;
    const bf16_t* b = a + TILE_E;
#pragma unroll
    for (int kk = 0; kk < 2; ++kk) {
        bf16x8 af[4], bfr[4];
#pragma unroll
        for (int mi = 0; mi < 4; ++mi) af[mi] = *(const bf16x8*)(a + (wm * 64 + mi * 16 + (lane & 15)) * LROW + kk * 32 + (lane >> 4) * 8);
#pragma unroll
        for (int ni = 0; ni < 4; ++ni) bfr[ni] = *(const bf16x8*)(b + (wn * 64 + ni * 16 + (lane & 15)) * LROW + (((kk * 4 + (lane >> 4)) ^ ((ni * 2 + ((lane >> 3) & 1)) & 7)) << 3));
#pragma unroll
        for (int mi = 0; mi < 4; ++mi)
#pragma unroll
            for (int ni = 0; ni < 4; ++ni) acc[mi][ni] = __builtin_amdgcn_mfma_f32_16x16x32_bf16(af[mi], bfr[ni], acc[mi][ni], 0, 0, 0);
    }
}
template <bool BN>
DI void gemm_core(const bf16_t* __restrict__ A, int lda, const bf16_t* __restrict__ B, int ldb, int K, f32x4 (&acc)[4][4], bf16_t* smem) {
    const int tid = otid(), lane = tid & 63, wave = tid >> 6;
    const int wm = wave >> 1, wn = wave & 1;
#pragma unroll
    for (int mi = 0; mi < 4; ++mi)
#pragma unroll
        for (int ni = 0; ni < 4; ++ni) acc[mi][ni] = (f32x4){0.f, 0.f, 0.f, 0.f};
    const int nk = K >> 6;
    Stg r0, r1;
    __syncthreads();
    g_load<BN>(r0, A, lda, B, ldb, 0, tid);
    g_load<BN>(r1, A, lda, B, ldb, 1, tid);
    s_store<BN>(r0, smem, 0, tid);
    __syncthreads();
    for (int kt = 0; kt < nk; kt += 2) {
        if (kt + 2 < nk) g_load<BN>(r0, A, lda, B, ldb, kt + 2, tid);
        mma_tile(smem, 0, acc, wm, wn, lane);
        s_store<BN>(r1, smem, 1, tid);
        __syncthreads();
        if (kt + 3 < nk) g_load<BN>(r1, A, lda, B, ldb, kt + 3, tid);
        mma_tile(smem, 1, acc, wm, wn, lane);
        if (kt + 2 < nk) s_store<BN>(r0, smem, 0, tid);
        __syncthreads();
    }
}
#define GT_E (128 * 64)
DI void glds_tile(const bf16_t* __restrict__ G, int ld, int kt, bf16_t* lt, int tid) {
    const int c = (tid & 7) ^ ((tid >> 4) & 7);
    const bf16_t* g = G + (size_t)(tid >> 3) * ld + kt * 64 + c * 8;
    char* l = (char*)lt + tid * 16;
#pragma unroll
    for (int p = 0; p < 4; ++p)
        __builtin_amdgcn_global_load_lds((const unsigned*)(g + (size_t)(p * 32) * ld), (LAS unsigned*)(l + p * 4096), 16, 0, 0);
}
DI void mma_tile_sw(const bf16_t* smem, int buf, f32x4 (&acc)[4][4], int wm, int wn, int lane) {
    const char* a = (const char*)(smem + buf * 2 * GT_E);
    const char* b = a + GT_E * 2;
    const int sw = (lane & 15) >> 1;
#pragma unroll
    for (int kk = 0; kk < 2; ++kk) {
        bf16x8 af[4], bfr[4];
        const int co = ((kk * 4 + (lane >> 4)) ^ sw) << 4;
#pragma unroll
        for (int mi = 0; mi < 4; ++mi) af[mi] = *(const bf16x8*)(a + (wm * 64 + mi * 16 + (lane & 15)) * 128 + co);
#pragma unroll
        for (int ni = 0; ni < 4; ++ni) bfr[ni] = *(const bf16x8*)(b + (wn * 64 + ni * 16 + (lane & 15)) * 128 + co);
#pragma unroll
        for (int mi = 0; mi < 4; ++mi)
#pragma unroll
            for (int ni = 0; ni < 4; ++ni) acc[mi][ni] = __builtin_amdgcn_mfma_f32_16x16x32_bf16(af[mi], bfr[ni], acc[mi][ni], 0, 0, 0);
    }
}
DI void gemm_core_dma(const bf16_t* __restrict__ A, int lda, const bf16_t* __restrict__ B, int ldb, int K, f32x4 (&acc)[4][4], bf16_t* smem) {
    const int tid = otid(), lane = tid & 63, wave = tid >> 6;
    const int wm = wave >> 1, wn = wave & 1;
#pragma unroll
    for (int mi = 0; mi < 4; ++mi)
#pragma unroll
        for (int ni = 0; ni < 4; ++ni) acc[mi][ni] = (f32x4){0.f, 0.f, 0.f, 0.f};
    const int nk = K >> 6;
    __syncthreads();
    glds_tile(A, lda, 0, smem, tid);
    glds_tile(B, ldb, 0, smem + GT_E, tid);
    for (int kt = 0; kt < nk; ++kt) {
        asm volatile("s_waitcnt vmcnt(0)" ::: "memory");
        __syncthreads();
        if (kt + 1 < nk) {
            bf16_t* nb = smem + ((kt + 1) & 1) * 2 * GT_E;
            glds_tile(A, lda, kt + 1, nb, tid);
            glds_tile(B, ldb, kt + 1, nb + GT_E, tid);
        }
        mma_tile_sw(smem, kt & 1, acc, wm, wn, lane);
    }
    __syncthreads();
}
#define ST_LD 132
DI void stage_acc(f32x4 (&acc)[4][4], float* st) {
    const int lane = otid() & 63, wave = otid() >> 6, wm = wave >> 1, wn = wave & 1, fl = lane & 15, g4 = lane >> 4;
#pragma unroll
    for (int mi = 0; mi < 4; ++mi)
#pragma unroll
        for (int ni = 0; ni < 4; ++ni)
#pragma unroll
            for (int j = 0; j < 4; ++j) st[(wm * 64 + mi * 16 + g4 * 4 + j) * ST_LD + wn * 64 + ni * 16 + fl] = acc[mi][ni][j];
    __syncthreads();
}
DI void ld8(const float* q, float (&v)[8]) {
    const float4 a = *(const float4*)q, b = *(const float4*)(q + 4);
    v[0] = a.x; v[1] = a.y; v[2] = a.z; v[3] = a.w; v[4] = b.x; v[5] = b.y; v[6] = b.z; v[7] = b.w;
}
DI uint4 pack8(const float (&v)[8]) { return make_uint4(pack2(v[0], v[1]), pack2(v[2], v[3]), pack2(v[4], v[5]), pack2(v[6], v[7])); }
DI void unpack8(const uint4 u, float (&v)[8]) {
    v[0] = bflo(u.x); v[1] = bfhi(u.x); v[2] = bflo(u.y); v[3] = bfhi(u.y); v[4] = bflo(u.z); v[5] = bfhi(u.z); v[6] = bflo(u.w); v[7] = bfhi(u.w);
}

DI void phase0(const Params& p, float* smf) {
    const int tid = otid();
    unsigned char* ws = p.ws;
    float* modv = (float*)(ws + OFF_MODV);
    for (int it = blockIdx.x; it < 192; it += gridDim.x) {
        const int l = it / 96, n0 = (it % 96) * 32;
        __syncthreads();
        for (int i = tid; i < 3072; i += 256) {
            const int v = i >> 10, k = i & 1023;
            const float cv = (v == 0) ? p.c[k] : (v == 1) ? p.c[1024 + k] : p.c_ctx[k];
            smf[i] = silu_f(cv);
        }
        __syncthreads();
        const int col = tid & 31, kg = tid >> 5;
        float a0 = 0.f, a1 = 0.f, a2 = 0.f;
        const float* w = p.w_mod + (size_t)l * 1024 * 3072 + n0 + col;
#pragma unroll 16
        for (int kk = 0; kk < 128; ++kk) {
            const int k = kg * 128 + kk;
            const float wv = __builtin_nontemporal_load(w + (size_t)k * 3072);
            a0 += smf[k] * wv; a1 += smf[1024 + k] * wv; a2 += smf[2048 + k] * wv;
        }
        __syncthreads();
        smf[3072 + (kg * 3 + 0) * 32 + col] = a0; smf[3072 + (kg * 3 + 1) * 32 + col] = a1; smf[3072 + (kg * 3 + 2) * 32 + col] = a2;
        __syncthreads();
        if (tid < 96) {
            const int v = tid >> 5, cc = tid & 31;
            float s = 0.f;
            for (int g = 0; g < 8; ++g) s += smf[3072 + (g * 3 + v) * 32 + cc];
            modv[(l * 3 + v) * 3072 + n0 + cc] = s + p.b_mod[l * 3072 + n0 + cc];
        }
    }
    {
        const int n_in = 2 * 16 * 44, n_out = 2 * 16 * 16;
        for (int it = blockIdx.x; it < n_in + n_out; it += gridDim.x) {
            const float* src; bf16_t* dst; int N, kt, nt;
            if (it < n_in) { const int l = it / 704, r = it % 704; kt = r / 44; nt = r % 44; N = DIN; src = p.w_in + (size_t)l * DM * DIN; dst = (bf16_t*)(ws + OFF_WTIN) + (size_t)l * DIN * DM; }
            else { const int j = it - n_in; const int l = j / 256, r = j % 256; kt = r / 16; nt = r % 16; N = DM; src = p.w_out + (size_t)l * DM * DM; dst = (bf16_t*)(ws + OFF_WTOUT) + (size_t)l * DM * DM; }
            __syncthreads();
#pragma unroll
            for (int ps = 0; ps < 4; ++ps) {
                const int kr = ps * 16 + (tid >> 4), c4 = (tid & 15) * 4;
                const float4 v = ldnt4(src + (size_t)(kt * 64 + kr) * N + nt * 64 + c4);
                smf[kr * 65 + c4 + 0] = v.x; smf[kr * 65 + c4 + 1] = v.y; smf[kr * 65 + c4 + 2] = v.z; smf[kr * 65 + c4 + 3] = v.w;
            }
            __syncthreads();
            const int n = tid >> 2, ks = (tid & 3) * 16;
            unsigned w[8];
#pragma unroll
            for (int e = 0; e < 8; ++e) w[e] = pack2(smf[(ks + 2 * e) * 65 + n], smf[(ks + 2 * e + 1) * 65 + n]);
            int ntd = nt;
            if (it < n_in && nt >= 20 && nt < 36) { const int grp = (nt - 20) >> 2, q4 = (nt - 20) & 3; ntd = (grp == 0) ? 28 + 2 * q4 : (grp == 1) ? 20 + 2 * q4 : (grp == 2) ? 21 + 2 * q4 : 29 + 2 * q4; }
            bf16_t* d = dst + (size_t)(ntd * 64 + n) * DM + kt * 64 + ks;
            *(uint4*)d = make_uint4(w[0], w[1], w[2], w[3]);
            *(uint4*)(d + 8) = make_uint4(w[4], w[5], w[6], w[7]);
        }
    }
    const int gtid = blockIdx.x * 256 + tid, gsz = gridDim.x * 256;
    {
        bf16_t* wc = (bf16_t*)(ws + OFF_WCOMB);
        __syncthreads();
        if (tid < 64) { smf[tid] = cospif((float)tid * (1.f / 32.f)); smf[64 + tid] = sinpif((float)tid * (1.f / 32.f)); }
        __syncthreads();
        for (int i = gtid; i < 2 * 512 * 256; i += gsz) {
            const int n = i & 255, kk = (i >> 8) & 511, l = i >> 17;
            const int c = kk >> 8, head = (kk >> 6) & 3, ch = kk & 63;
            const float* wf = p.w_fourier + (size_t)l * 65536 + (size_t)(head * 64) * 256 + n;
            float s = 0.f;
#pragma unroll 16
            for (int j = 0; j < 64; ++j) s += smf[c * 64 + ((j * ch) & 63)] * wf[j * 256];
            wc[(size_t)l * 131072 + n * 512 + kk] = f2bf(s);
        }
    }
    {
        bf16_t* wp = (bf16_t*)(ws + OFF_WPOOL);
        for (int i = gtid; i < 2 * 256 * 256; i += gsz) {
            const int k = i & 255, n = (i >> 8) & 255, l = i >> 16;
            float v = 0.f;
            if ((k >> 6) == (n >> 6)) v = p.pool_w[(size_t)l * 16384 + (n >> 6) * 4096 + (k & 63) * 64 + (n & 63)];
            wp[i] = f2bf(v);
        }
    }
    {
        float* tw = (float*)(ws + OFF_TW);
        for (int i = gtid; i < 8192; i += gsz) { const float a = (float)i * (1.f / 4096.f); tw[2 * i] = cospif(a); tw[2 * i + 1] = sinpif(a); }
        bf16_t* f1 = (bf16_t*)(ws + OFF_F1);
        for (int i = gtid; i < 256 * 128; i += gsz) {
            const int t1 = i & 127, m = i >> 7;
            const int k1 = (m >> 5) * 16 + (m & 15), c = (m >> 4) & 1;
            const float a = (float)((k1 * t1) & 127) * (1.f / 64.f);
            f1[i] = f2bf(c ? -sinpif(a) : cospif(a));
        }
        bf16_t* f2 = (bf16_t*)(ws + OFF_F2);
        for (int i = gtid; i < 128 * 128; i += gsz) {
            const int kx = i & 127, m = i >> 7;
            const int c = m >> 6, k2 = m & 63, cp = kx >> 6, t2 = kx & 63;
            const float a = (float)((k2 * t2) & 63) * (1.f / 32.f);
            float v;
            if (c == cp) v = cospif(a); else if (c == 0) v = sinpif(a); else v = -sinpif(a);
            f2[i] = f2bf(v);
        }
        bf16_t* fc = (bf16_t*)(ws + OFF_FC);
        for (int i = gtid; i < 512 * 256; i += gsz) {
            const int t = i & 255, m = i >> 8;
            const int c = m >> 8, k = m & 255;
            const float a = (float)((k * t) & 255) * (1.f / 128.f);
            fc[i] = f2bf(c ? -sinpif(a) : cospif(a));
        }
        float* rp = (float*)(ws + OFF_ROPE);
        for (int i = gtid; i < 3072; i += gsz) {
            const int f = i & 15;
            const int pos = (i < 2048) ? (i >> 4) : ((i - 2048) >> 4);
            const float inv = powf(10000.f, -(float)f * (1.f / 16.f));
            const float ang = (float)pos * inv;
            const double ad = (double)ang;
            const float cs = (float)cos(ad), sn = (float)sin(ad);
            if (i < 2048) { rp[i] = cs; rp[2048 + i] = sn; }
            else { rp[4096 + (i - 2048)] = cs; rp[5120 + (i - 2048)] = sn; }
        }
    }
}

DI void phase_norm(const Params& p, int l, const float* xl, const float* xc, const bf16_t* xlb) {
    const int lane = otid() & 63, wave = otid() >> 6;
    const float* modv = (const float*)(p.ws + OFF_MODV) + (size_t)l * 3 * 3072;
    const float* g = p.norm_g + l * 1024;
    bf16_t* H = (bf16_t*)(p.ws + OFF_H);
    for (int row = blockIdx.x * 4 + wave; row < ROWS; row += gridDim.x * 4) {
        const float* src = (row < ROWS_L) ? xl + (size_t)row * DM : xc + (size_t)(row - ROWS_L) * DM;
        const int v = (row < ROWS_L) ? (row >> 13) : 2;
        const float* mv = modv + v * 3072;
        float4 a[4];
        float ss = 0.f;
        if (xlb != nullptr && row < ROWS_L) {
            const bf16_t* sb = xlb + (size_t)row * DM;
#pragma unroll
            for (int i = 0; i < 4; ++i) { const uint2 u = *(const uint2*)(sb + i * 256 + lane * 4); a[i] = make_float4(bflo(u.x), bfhi(u.x), bflo(u.y), bfhi(u.y)); }
        } else {
#pragma unroll
            for (int i = 0; i < 4; ++i) { const f32x4 t_ = __builtin_nontemporal_load((const f32x4*)(src + i * 256 + lane * 4)); a[i] = make_float4(t_[0], t_[1], t_[2], t_[3]); }
            if (xlb != nullptr) {
                const float* p0 = (const float*)(p.ws + OFF_XC1) + (size_t)(row - ROWS_L) * DM;
                const float* p1 = (const float*)(p.ws + OFF_XC1B) + (size_t)(row - ROWS_L) * DM;
#pragma unroll
                for (int i = 0; i < 4; ++i) {
                    const float4 u = *(const float4*)(p0 + i * 256 + lane * 4), w = *(const float4*)(p1 + i * 256 + lane * 4);
                    a[i].x += u.x + w.x; a[i].y += u.y + w.y; a[i].z += u.z + w.z; a[i].w += u.w + w.w;
                }
            }
        }
#pragma unroll
        for (int i = 0; i < 4; ++i) ss += a[i].x * a[i].x + a[i].y * a[i].y + a[i].z * a[i].z + a[i].w * a[i].w;
#pragma unroll
        for (int o = 32; o >= 1; o >>= 1) ss += __shfl_xor(ss, o);
        const float rs = rsqrtf(ss * (1.f / 1024.f) + 1e-6f);
#pragma unroll
        for (int i = 0; i < 4; ++i) {
            const int c0 = i * 256 + lane * 4;
            const float4 gg = *(const float4*)(g + c0), sh = *(const float4*)(mv + c0), sc = *(const float4*)(mv + 1024 + c0);
            const float o0 = a[i].x * rs * gg.x * (1.f + sc.x) + sh.x, o1 = a[i].y * rs * gg.y * (1.f + sc.y) + sh.y;
            const float o2 = a[i].z * rs * gg.z * (1.f + sc.z) + sh.z, o3 = a[i].w * rs * gg.w * (1.f + sc.w) + sh.w;
            *(uint2*)(H + (size_t)row * DM + c0) = make_uint2(pack2(o0, o1), pack2(o2, o3));
        }
    }
}

DI void epi_inproj(const Params& p, int l, int tm, int tn, f32x4 (&acc)[4][4], float* st) {
    const int tid = otid();
    unsigned char* ws = p.ws;
    stage_acc(acc, st);
    const int rbase = tm * 128;
    const bool isctx = rbase >= ROWS_L;
    if (tn < 3) {
        const bool isq = tn < 2;
        const float* gain = (isq ? p.q_gain : p.k_gain) + l * 64;
        const float* rp = (const float*)(ws + OFF_ROPE);
#pragma unroll 1
        for (int i = 0; i < 8; ++i) {
            const int q = tid + 256 * i, rl = q >> 4, c8 = (q & 15) * 8;
            const int row = rbase + rl, hd = c8 >> 6, d0 = c8 & 63;
            float v[8], pv[8], g[8], pg[8];
            ld8(st + rl * ST_LD + c8, v);
            ld8(st + rl * ST_LD + (c8 ^ 16), pv);
            ld8(gain + d0, g);
            ld8(gain + (d0 ^ 16), pg);
            float ss = 0.f;
#pragma unroll
            for (int e = 0; e < 8; ++e) ss += v[e] * v[e];
            ss += __shfl_xor(ss, 1); ss += __shfl_xor(ss, 2); ss += __shfl_xor(ss, 4);
            const float rs = rsqrtf(ss * (1.f / 64.f) + 1e-6f);
#pragma unroll
            for (int e = 0; e < 8; ++e) { v[e] *= rs * g[e]; pv[e] *= rs * pg[e]; }
            bf16_t* dst;
            if (!isctx) {
                const int b = row >> 13, t = row & 8191;
                const int pos = (d0 >= 32) ? (t & 63) : (t >> 6);
                const float* ct = rp + ((d0 >= 32) ? 4096 : 0) + pos * 16 + (d0 & 8);
                float cs[8], sn[8];
                ld8(ct, cs);
                ld8(ct + ((d0 >= 32) ? 1024 : 2048), sn);
                const float sg = (d0 & 16) ? 1.f : -1.f;
#pragma unroll
                for (int e = 0; e < 8; ++e) v[e] = v[e] * cs[e] + sg * pv[e] * sn[e];
                if (isq) dst = (bf16_t*)(ws + OFF_Q) + ((size_t)(b * 4 + tn * 2 + hd) * SEQ + t) * 64 + d0;
                else     dst = (bf16_t*)(ws + OFF_K) + ((size_t)(b * 2 + hd) * NKEY + CTX + t) * 64 + d0;
            } else {
                const int rc = row - ROWS_L, b = rc >> 8, t = rc & 255;
                if (isq) dst = (bf16_t*)(ws + OFF_QC) + ((size_t)(b * 4 + tn * 2 + hd) * CTX + t) * 64 + d0;
                else     dst = (bf16_t*)(ws + OFF_K) + ((size_t)(b * 2 + hd) * NKEY + t) * 64 + d0;
            }
            if (isq) {
#pragma unroll
                for (int e = 0; e < 8; ++e) v[e] *= 0.18033688011112042f;
            }
            *(uint4*)dst = pack8(v);
        }
    } else if (tn == 3) {
        int b, key0;
        if (!isctx) { b = rbase >> 13; key0 = CTX + (rbase & 8191); } else { const int rc = rbase - ROWS_L; b = rc >> 8; key0 = rc & 255; }
#pragma unroll 1
        for (int i = 0; i < 8; ++i) {
            const int q = tid + 256 * i, col = q & 127, r8 = (q >> 7) * 8;
            float v[8];
#pragma unroll
            for (int e = 0; e < 8; ++e) v[e] = st[(r8 + e) * ST_LD + col];
            bf16_t* vt = (bf16_t*)(ws + OFF_VT) + ((size_t)(b * 2 + (col >> 6)) * 64 + (col & 63)) * NKEY + key0 + r8;
            *(uint4*)vt = pack8(v);
        }
    } else {
        bf16_t* parts = (bf16_t*)(ws + OFF_PARTS);
        if (tn >= 10 && tn < 18) {
            const bool isg = tn >= 14;
            const int dcol = (isg ? PC_GC + (tn - 14) * 64 : PC_T + (tn - 10) * 64);
#pragma unroll 1
            for (int i = 0; i < 4; ++i) {
                const int q = tid + 256 * i, rl = q >> 3, c8 = (q & 7) * 8;
                float v[8], w[8];
                ld8(st + rl * ST_LD + c8, v);
                ld8(st + rl * ST_LD + 64 + c8, w);
#pragma unroll
                for (int e = 0; e < 8; ++e) v[e] = isg ? silu_f(w[e]) * v[e] : v[e] * w[e];
                *(uint4*)(parts + (size_t)(rbase + rl) * PW + dcol + c8) = pack8(v);
            }
        } else {
            const int dbase = (tn < 10) ? tn * 128 - 512 : PC_UP + (tn - 18) * 128;
#pragma unroll 1
            for (int i = 0; i < 8; ++i) {
                const int q = tid + 256 * i, rl = q >> 4, c8 = (q & 15) * 8;
                float v[8];
                ld8(st + rl * ST_LD + c8, v);
                *(uint4*)(parts + (size_t)(rbase + rl) * PW + dbase + c8) = pack8(v);
            }
        }
    }
}

DI void phase_inproj(const Params& p, int l, bf16_t* smem) {
    const bf16_t* H = (const bf16_t*)(p.ws + OFF_H);
    const bf16_t* W = (const bf16_t*)(p.ws + OFF_WTIN) + (size_t)l * DIN * DM;
    const int nlat = 128 * 22;
    const int ntiles = nlat + (l == 0 ? 4 * 22 : 4 * 2);
    for (XIter t = xiter(ntiles); t.u < t.end; t.u += t.step) {
        const int u = t.u;
        int tm, tn;
        if (u < nlat) { const int ch = u / 176, r = u % 176; tn = r >> 3; tm = ch * 8 + (r & 7); }
        else { const int j = u - nlat; tm = 128 + (j & 3); tn = (l == 0 ? 0 : 2) + (j >> 2); }
        f32x4 acc[4][4];
        gemm_core_dma(H + (size_t)tm * 128 * DM, DM, W + (size_t)tn * 128 * DM, DM, DM, acc, smem);
        epi_inproj(p, l, tm, tn, acc, (float*)smem);
    }
}

#define KT_E (64 * LROW)
DI void attn_item(const Params& p, const bf16_t* Qb, const bf16_t* Kb, const bf16_t* VTb, int ntiles, int rowbase, int hq, bf16_t* smem) {
    const int tid = otid(), lane = tid & 63, wave = tid >> 6;
    const int r = lane & 31, h = lane >> 5;
    const float LOG2E = 1.4426950408889634f;
    bf16x8 qf[4];
    {
        const bf16_t* qrow = Qb + (size_t)(wave * 32 + r) * 64;
#pragma unroll
        for (int s = 0; s < 4; ++s) qf[s] = *(const bf16x8*)(qrow + s * 16 + h * 8);
    }
    f32x16 ot[2], zacc;
#pragma unroll
    for (int i = 0; i < 16; ++i) { ot[0][i] = 0.f; ot[1][i] = 0.f; zacc[i] = 0.f; }
    float m = 0.f, lsum = 0.f;
    bool stab = false;
    uint4 rk[2], rv[2];
    auto gload = [&](int kt) {
#pragma unroll
        for (int i = 0; i < 2; ++i) {
            const int q = tid + 256 * i;
            rk[i] = *(const uint4*)(Kb + (size_t)(kt * 64 + (q >> 3)) * 64 + (q & 7) * 8);
            rv[i] = *(const uint4*)(VTb + (size_t)(q >> 3) * NKEY + kt * 64 + (q & 7) * 8);
        }
    };
    auto sstore = [&](int buf) {
        bf16_t* sk = smem + buf * 2 * KT_E;
        bf16_t* sv = sk + KT_E;
#pragma unroll
        for (int i = 0; i < 2; ++i) {
            const int q = tid + 256 * i;
            *(uint4*)(sk + (q >> 3) * LROW + (q & 7) * 8) = rk[i];
            *(uint4*)(sv + (q >> 3) * LROW + (q & 7) * 8) = rv[i];
        }
    };
    __syncthreads();
    gload(0);
    sstore(0);
    __syncthreads();
    for (int kt = 0; kt < ntiles; ++kt) {
        if (kt + 1 < ntiles) gload(kt + 1);
        const bf16_t* sk = smem + (kt & 1) * 2 * KT_E;
        const bf16_t* sv = sk + KT_E;
        f32x16 st[2], pe[2];
#pragma unroll
        for (int blk = 0; blk < 2; ++blk) {
            st[blk] = __builtin_amdgcn_mfma_f32_32x32x16_bf16(*(const bf16x8*)(sk + (blk * 32 + r) * LROW + h * 8), qf[0], zacc, 0, 0, 0);
#pragma unroll
            for (int s = 1; s < 4; ++s)
                st[blk] = __builtin_amdgcn_mfma_f32_32x32x16_bf16(*(const bf16x8*)(sk + (blk * 32 + r) * LROW + s * 16 + h * 8), qf[s], st[blk], 0, 0, 0);
        }
        if (stab) {
#pragma unroll
            for (int i = 0; i < 16; ++i) { st[0][i] -= m; st[1][i] -= m; }
        }
        float ls = 0.f;
#pragma unroll
        for (int i = 0; i < 16; ++i) {
            pe[0][i] = __builtin_amdgcn_exp2f(st[0][i]); ls += pe[0][i];
            pe[1][i] = __builtin_amdgcn_exp2f(st[1][i]); ls += pe[1][i];
        }
        if (__any(!(ls <= 1.0e12f) || (ls < 1.0e-25f))) {
            float tmx = st[0][0];
#pragma unroll
            for (int i = 0; i < 16; ++i) { tmx = fmaxf(tmx, st[0][i]); tmx = fmaxf(tmx, st[1][i]); }
            tmx = fmaxf(tmx, __shfl_xor(tmx, 32));
            const float lrow = lsum + __shfl_xor(lsum, 32);
            const bool rebase = !(lrow >= 1.0e-20f);
            const float delta = rebase ? tmx : fmaxf(tmx, 0.f);
            const float alpha = rebase ? 0.f : __builtin_amdgcn_exp2f(-delta);
            m += delta;
            stab = true;
            lsum *= alpha;
            ls = 0.f;
#pragma unroll
            for (int i = 0; i < 16; ++i) {
                ot[0][i] *= alpha; ot[1][i] *= alpha;
                pe[0][i] = __builtin_amdgcn_exp2f(st[0][i] - delta); ls += pe[0][i];
                pe[1][i] = __builtin_amdgcn_exp2f(st[1][i] - delta); ls += pe[1][i];
            }
        }
        lsum += ls;
        bf16x8 pk[2][2];
#pragma unroll
        for (int blk = 0; blk < 2; ++blk)
#pragma unroll
            for (int s = 0; s < 2; ++s) {
                uint4 u;
                u.x = pack2(pe[blk][8 * s + 0], pe[blk][8 * s + 1]); u.y = pack2(pe[blk][8 * s + 2], pe[blk][8 * s + 3]);
                u.z = pack2(pe[blk][8 * s + 4], pe[blk][8 * s + 5]); u.w = pack2(pe[blk][8 * s + 6], pe[blk][8 * s + 7]);
                pk[blk][s] = __builtin_bit_cast(bf16x8, u);
            }
#pragma unroll
        for (int db = 0; db < 2; ++db)
#pragma unroll
            for (int blk = 0; blk < 2; ++blk)
#pragma unroll
                for (int s = 0; s < 2; ++s) {
                    const bf16_t* vp = sv + (db * 32 + r) * LROW + blk * 32 + s * 16 + h * 4;
                    const bf16x4 lo = *(const bf16x4*)vp;
                    const bf16x4 hi = *(const bf16x4*)(vp + 8);
                    const bf16x8 vf = __builtin_shufflevector(lo, hi, 0, 1, 2, 3, 4, 5, 6, 7);
                    ot[db] = __builtin_amdgcn_mfma_f32_32x32x16_bf16(vf, pk[blk][s], ot[db], 0, 0, 0);
                }
        if (kt + 1 < ntiles) sstore((kt + 1) & 1);
        __syncthreads();
    }
    lsum += __shfl_xor(lsum, 32);
    const float inv = 1.f / lsum;
    const int row = rowbase + wave * 32 + r;
    const bf16_t* zrow = (const bf16_t*)(p.ws + OFF_PARTS) + (size_t)row * PW + PC_ZATT + hq * 64;
    bf16_t* orow = (bf16_t*)(p.ws + OFF_H) + (size_t)row * DM + 256 + hq * 64;
#pragma unroll
    for (int db = 0; db < 2; ++db)
#pragma unroll
        for (int g = 0; g < 4; ++g) {
            const int d = db * 32 + g * 8 + h * 4;
            const uint2 z = *(const uint2*)(zrow + d);
            const float o0 = silu_f(bflo(z.x)) * ot[db][4 * g + 0] * inv, o1 = silu_f(bfhi(z.x)) * ot[db][4 * g + 1] * inv;
            const float o2 = silu_f(bflo(z.y)) * ot[db][4 * g + 2] * inv, o3 = silu_f(bfhi(z.y)) * ot[db][4 * g + 3] * inv;
            *(uint2*)(orow + d) = make_uint2(pack2(o0, o1), pack2(o2, o3));
        }
}

DI void phase_attn(const Params& p, int l, bf16_t* smem) {
    const bf16_t* Q = (const bf16_t*)(p.ws + OFF_Q);
    const bf16_t* QC = (const bf16_t*)(p.ws + OFF_QC);
    const bf16_t* Kk = (const bf16_t*)(p.ws + OFF_K);
    const bf16_t* VT = (const bf16_t*)(p.ws + OFF_VT);
    for (XIter t = xiter(512); t.u < t.end; t.u += t.step) {
        const int it = t.u;
        const int b = it >> 8, hq = (it >> 6) & 3, qt = it & 63;
        const size_t kv = (size_t)(b * 2 + (hq >> 1));
        attn_item(p, Q + ((size_t)(b * 4 + hq) * SEQ + qt * 128) * 64, Kk + kv * NKEY * 64, VT + kv * 64 * NKEY, NKEY / 64, b * SEQ + qt * 128, hq, smem);
    }
    if (l == 0) {
        for (int j = blockIdx.x; j < 16; j += gridDim.x) {
            const int b = j >> 3, hq = (j >> 1) & 3, qt = j & 1;
            const size_t kv = (size_t)(b * 2 + (hq >> 1));
            attn_item(p, QC + ((size_t)(b * 4 + hq) * CTX + qt * 128) * 64, Kk + kv * NKEY * 64, VT + kv * 64 * NKEY, CTX / 64, ROWS_L + b * CTX + qt * 128, hq, smem);
        }
    }
}

template <int W>
DI void pool_task(const bf16_t* __restrict__ pu, int pos, int n, bf16_t* __restrict__ dst) {
    constexpr int LEFT = W / 2;
    uint4 raw[W];
#pragma unroll
    for (int t = 0; t < W; ++t) { int q = pos - LEFT + t; q = q < 0 ? 0 : (q >= n ? n - 1 : q); raw[t] = *(const uint4*)(pu + (size_t)q * PW); }
    float sum[8], u[8];
#pragma unroll
    for (int e = 0; e < 8; ++e) sum[e] = 0.f;
#pragma unroll
    for (int t = 0; t < W; ++t) {
        const int q = pos - LEFT + t;
        const float mk = (q >= 0 && q < n) ? 1.f : 0.f;
        unpack8(raw[t], u);
#pragma unroll
        for (int e = 0; e < 8; ++e) sum[e] += mk * u[e];
    }
    const int lo = max(pos - LEFT, 0), hi = min(pos + W - LEFT, n);
    const float ic = 1.f / (float)(hi - lo);
    unpack8(raw[LEFT], u);
#pragma unroll
    for (int e = 0; e < 8; ++e) sum[e] = sum[e] * ic - u[e];
    *(uint4*)dst = pack8(sum);
}
DI void phase_convpool(const Params& p, int l) {
    const bf16_t* __restrict__ parts = (const bf16_t*)(p.ws + OFF_PARTS);
    bf16_t* __restrict__ cat = (bf16_t*)(p.ws + OFF_H);
    bf16_t* __restrict__ dbuf = (bf16_t*)(p.ws + OFF_DBUF);
    const int nrows = (l == 0 ? ROWS : ROWS_L);
    const int gsz = gridDim.x * 256, gt = blockIdx.x * 256 + otid();
    {
        const int c8 = (gt & 31) * 8;
        float w0[8], w1[8], w2[8], bs[8];
        ld8(p.conv_w + l * 768 + c8, w0); ld8(p.conv_w + l * 768 + 256 + c8, w1); ld8(p.conv_w + l * 768 + 512 + c8, w2); ld8(p.conv_b + l * 256 + c8, bs);
        for (int i = gt; i < nrows * 32; i += gsz) {
            const int row = i >> 5;
            int seq0, n;
            if (row < ROWS_L) { seq0 = (row >> 13) << 13; n = SEQ; } else { seq0 = ROWS_L + (((row - ROWS_L) >> 8) << 8); n = CTX; }
            const int pos = row - seq0;
            const bf16_t* pr = parts + (size_t)row * PW + c8;
            const bool hp = pos > 0, hn = pos + 1 < n;
            const bf16_t* pp = hp ? pr - PW : pr;
            const bf16_t* pn = hn ? pr + PW : pr;
            const uint4 r0 = *(const uint4*)(pr + PC_T), r2 = *(const uint4*)(pp + PC_T), r4 = *(const uint4*)(pn + PC_T), r6 = *(const uint4*)(pr + PC_GC);
            const float mp = hp ? 1.f : 0.f, mn = hn ? 1.f : 0.f;
            float tc[8], tp[8], tn[8], gg[8], o[8];
            unpack8(r0, tc); unpack8(r2, tp); unpack8(r4, tn); unpack8(r6, gg);
#pragma unroll
            for (int e = 0; e < 8; ++e) o[e] = gg[e] * (mp * tp[e] * w0[e] + tc[e] * w1[e] + mn * tn[e] * w2[e] + bs[e]);
            *(uint4*)(cat + (size_t)row * DM + 512 + c8) = pack8(o);
        }
    }
    for (int j = gt; j < nrows * 32; j += gsz) {
        const int g = j / (nrows * 8), rem = j - g * (nrows * 8), row = rem >> 3, c8 = g * 64 + (rem & 7) * 8;
        int seq0, n;
        if (row < ROWS_L) { seq0 = (row >> 13) << 13; n = SEQ; } else { seq0 = ROWS_L + (((row - ROWS_L) >> 8) << 8); n = CTX; }
        const bf16_t* pu = parts + (size_t)seq0 * PW + PC_UP + c8;
        bf16_t* dst = dbuf + (size_t)row * 256 + c8;
        const int pos = row - seq0;
        if (g == 0) pool_task<2>(pu, pos, n, dst);
        else if (g == 1) pool_task<4>(pu, pos, n, dst);
        else if (g == 2) pool_task<8>(pu, pos, n, dst);
        else pool_task<16>(pu, pos, n, dst);
    }
}

DI void phase_dft1(const Params& p, int l, bf16_t* smem) {
    const int tid = otid();
    float* st = (float*)smem;
    const bf16_t* parts = (const bf16_t*)(p.ws + OFF_PARTS);
    const bf16_t* F1 = (const bf16_t*)(p.ws + OFF_F1);
    const bf16_t* FC = (const bf16_t*)(p.ws + OFF_FC);
    const float* tw = (const float*)(p.ws + OFF_TW);
    bf16_t* G1 = (bf16_t*)(p.ws + OFF_G1);
    bf16_t* pcat = (bf16_t*)(p.ws + OFF_PCAT);
    const int nt1 = 2 * 64 * 4;
    const int ntot = nt1 + (l == 0 ? 16 : 0);
    for (int it = blockIdx.x; it < ntot; it += gridDim.x) {
        f32x4 acc[4][4];
        if (it < nt1) {
            const int b = it >> 8, t2 = (it >> 2) & 63, mt = (it >> 1) & 1, nt = it & 1;
            gemm_core<true>(F1 + (size_t)mt * 128 * 128, 128, parts + (size_t)(b * SEQ + t2) * PW + PC_UF + nt * 128, 64 * PW, 128, acc, smem);
            stage_acc(acc, st);
#pragma unroll 1
            for (int i = 0; i < 4; ++i) {
                const int q = tid + 256 * i, kk = q >> 4, c8 = (q & 15) * 8;
                const int rr = 32 * (kk >> 4) + (kk & 15);
                const int k1 = mt * 64 + kk;
                const float cs = tw[2 * (k1 * t2)], sn = tw[2 * (k1 * t2) + 1];
                float gr[8], gi[8], o[8];
                ld8(st + rr * ST_LD + c8, gr);
                ld8(st + (rr + 16) * ST_LD + c8, gi);
                bf16_t* dr = G1 + ((size_t)((b * 128 + k1) * 2 + 0) * 64 + t2) * 256 + nt * 128 + c8;
#pragma unroll
                for (int e = 0; e < 8; ++e) o[e] = gr[e] * cs + gi[e] * sn;
                *(uint4*)dr = pack8(o);
#pragma unroll
                for (int e = 0; e < 8; ++e) o[e] = gi[e] * cs - gr[e] * sn;
                *(uint4*)(dr + (size_t)64 * 256) = pack8(o);
            }
        } else {
            const int j0 = it - nt1, b = j0 >> 3, mt = (j0 >> 1) & 3, nt = j0 & 1;
            gemm_core<true>(FC + (size_t)mt * 128 * 256, 256, parts + (size_t)(ROWS_L + b * CTX) * PW + PC_UF + nt * 128, PW, 256, acc, smem);
            stage_acc(acc, st);
#pragma unroll 1
            for (int i = 0; i < 8; ++i) {
                const int q = tid + 256 * i, rl = q >> 4, c8 = (q & 15) * 8;
                const int m = mt * 128 + rl, c = m >> 8, k = m & 255;
                float v[8];
                ld8(st + rl * ST_LD + c8, v);
                *(uint4*)(pcat + (size_t)(ROWS_L + b * CTX + k) * 512 + c * 256 + nt * 128 + c8) = pack8(v);
            }
        }
    }
}

DI void phase_dft2_mixp(const Params& p, int l, bf16_t* smem, int item_lo, int item_hi, int blk0, int nblk) {
    const int tid = otid();
    float* st = (float*)smem;
    const bf16_t* F2 = (const bf16_t*)(p.ws + OFF_F2);
    const bf16_t* G1 = (const bf16_t*)(p.ws + OFF_G1);
    bf16_t* pcat = (bf16_t*)(p.ws + OFF_PCAT);
    const bf16_t* dbuf = (const bf16_t*)(p.ws + OFF_DBUF);
    const bf16_t* wp = (const bf16_t*)(p.ws + OFF_WPOOL) + (size_t)l * 65536;
    const bf16_t* parts = (const bf16_t*)(p.ws + OFF_PARTS);
    bf16_t* cat = (bf16_t*)(p.ws + OFF_H);
    const int nt2 = 2 * 128 * 2;
    const int nmt = (l == 0 ? ROWS : ROWS_L) / 128;
    (void)nmt;
    if ((int)blockIdx.x < blk0) return;
    for (int it = item_lo + ((int)blockIdx.x - blk0); it < item_hi; it += nblk) {
        f32x4 acc[4][4];
        if (it < nt2) {
            const int b = it >> 8, k1 = (it >> 1) & 127, nt = it & 1;
            gemm_core<true>(F2, 128, G1 + (size_t)(b * 128 + k1) * 128 * 256 + nt * 128, 256, 128, acc, smem);
            stage_acc(acc, st);
#pragma unroll 1
            for (int i = 0; i < 8; ++i) {
                const int q = tid + 256 * i, m = q >> 4, c8 = (q & 15) * 8;
                const int c = m >> 6, k2 = m & 63;
                float v[8];
                ld8(st + m * ST_LD + c8, v);
                *(uint4*)(pcat + (size_t)(b * SEQ + k1 + 128 * k2) * 512 + c * 256 + nt * 128 + c8) = pack8(v);
            }
        } else {
            const int j0 = it - nt2, tm = j0 >> 1, nt = j0 & 1;
            gemm_core_dma(dbuf + (size_t)tm * 128 * 256 + nt * 128, 256, wp + (size_t)(nt * 128) * 256 + nt * 128, 256, 128, acc, smem);
            stage_acc(acc, st);
            {
                const int c8 = (tid & 15) * 8, r0 = tid >> 4, n = nt * 128 + c8;
                float ps[8];
                ld8(p.pool_scale + l * 256 + n, ps);
                uint4 zr[8];
#pragma unroll
                for (int i = 0; i < 8; ++i) zr[i] = *(const uint4*)(parts + (size_t)(tm * 128 + r0 + 16 * i) * PW + PC_ZP + n);
#pragma unroll
                for (int i = 0; i < 8; ++i) {
                    float v[8], z[8];
                    ld8(st + (r0 + 16 * i) * ST_LD + c8, v);
                    unpack8(zr[i], z);
#pragma unroll
                    for (int e = 0; e < 8; ++e) v[e] = silu_f(z[e]) * ps[e] * v[e];
                    *(uint4*)(cat + (size_t)(tm * 128 + r0 + 16 * i) * DM + 768 + n) = pack8(v);
                }
            }
        }
    }
}

DI void phase_mixf(const Params& p, int l, bf16_t* smem) {
    const int tid = otid();
    float* st = (float*)smem;
    const bf16_t* pcat = (const bf16_t*)(p.ws + OFF_PCAT);
    const bf16_t* wc = (const bf16_t*)(p.ws + OFF_WCOMB) + (size_t)l * 131072;
    const bf16_t* parts = (const bf16_t*)(p.ws + OFF_PARTS);
    bf16_t* cat = (bf16_t*)(p.ws + OFF_H);
    const int nmt = (l == 0 ? ROWS : ROWS_L) / 128;
    for (int it = blockIdx.x; it < nmt * 2; it += gridDim.x) {
        const int tm = it >> 1, nt = it & 1;
        f32x4 acc[4][4];
        gemm_core_dma(pcat + (size_t)tm * 128 * 512, 512, wc + (size_t)(nt * 128) * 512, 512, 512, acc, smem);
        stage_acc(acc, st);
        const float sc = (tm < 128) ? 0.001381067932004976f : 0.0078125f;
        {
            const int c8 = (tid & 15) * 8, r0 = tid >> 4, n = nt * 128 + c8;
            uint4 zr[8];
#pragma unroll
            for (int i = 0; i < 8; ++i) zr[i] = *(const uint4*)(parts + (size_t)(tm * 128 + r0 + 16 * i) * PW + PC_ZF + n);
#pragma unroll
            for (int i = 0; i < 8; ++i) {
                float v[8], z[8];
                ld8(st + (r0 + 16 * i) * ST_LD + c8, v);
                unpack8(zr[i], z);
#pragma unroll
                for (int e = 0; e < 8; ++e) v[e] = silu_f(z[e]) * sc * v[e];
                *(uint4*)(cat + (size_t)(tm * 128 + r0 + 16 * i) * DM + n) = pack8(v);
            }
        }
    }
}

DI void phase_out(const Params& p, int l, const float* xl_in, const float* xc_in, float* xl_out, float* xc_out, bf16_t* smem) {
    const int tid = otid();
    float* st = (float*)smem;
    const bf16_t* cat = (const bf16_t*)(p.ws + OFF_H);
    const bf16_t* W = (const bf16_t*)(p.ws + OFF_WTOUT) + (size_t)l * DM * DM;
    const float* modv = (const float*)(p.ws + OFF_MODV) + (size_t)l * 3 * 3072;
    const int nmt = (l == 0 ? ROWS : ROWS_L) / 128;
    (void)nmt;
    for (XIter t = xiter(1024); t.u < t.end; t.u += t.step) {
        int tm, tn;
        { const int ch = t.u >> 6, r = t.u & 63; tn = r >> 3; tm = ch * 8 + (r & 7); }
        f32x4 acc[4][4];
        gemm_core_dma(cat + (size_t)tm * 128 * DM, DM, W + (size_t)tn * 128 * DM, DM, DM, acc, smem);
        stage_acc(acc, st);
        const int rb = tm * 128;
        const int v = (rb < ROWS_L) ? (rb >> 13) : 2;
        const float* gate = modv + v * 3072 + 2048;
        const float* xin = (rb < ROWS_L) ? xl_in : xc_in - (size_t)ROWS_L * DM;
        float* xout = (rb < ROWS_L) ? xl_out : xc_out - (size_t)ROWS_L * DM;
        {
            const int c8 = (tid & 15) * 8, r0 = tid >> 4;
            const size_t o0 = (size_t)(rb + r0) * DM + tn * 128 + c8;
            float gt[8];
            ld8(gate + tn * 128 + c8, gt);
            const bool lat = rb < ROWS_L;
            bf16_t* x1b = (bf16_t*)(p.ws + OFF_X1B);
            float4 x0[8], x1[8];
            if (lat && l == 1) {
#pragma unroll
                for (int i = 0; i < 8; ++i) { const u32x4 u = __builtin_nontemporal_load((const u32x4*)(x1b + o0 + (size_t)i * 16 * DM));
                    x0[i] = make_float4(bflo(u.x), bfhi(u.x), bflo(u.y), bfhi(u.y)); x1[i] = make_float4(bflo(u.z), bfhi(u.z), bflo(u.w), bfhi(u.w)); }
            } else {
#pragma unroll
                for (int i = 0; i < 8; ++i) { x0[i] = ldnt4(xin + o0 + (size_t)i * 16 * DM); x1[i] = ldnt4(xin + o0 + (size_t)i * 16 * DM + 4); }
            }
#pragma unroll
            for (int i = 0; i < 8; ++i) {
                float a[8];
                ld8(st + (r0 + 16 * i) * ST_LD + c8, a);
                const float y0 = x0[i].x + gt[0] * a[0], y1 = x0[i].y + gt[1] * a[1], y2 = x0[i].z + gt[2] * a[2], y3 = x0[i].w + gt[3] * a[3];
                const float y4 = x1[i].x + gt[4] * a[4], y5 = x1[i].y + gt[5] * a[5], y6 = x1[i].z + gt[6] * a[6], y7 = x1[i].w + gt[7] * a[7];
                if (lat && l == 0) {
                    *(uint4*)(x1b + o0 + (size_t)i * 16 * DM) = make_uint4(pack2(y0, y1), pack2(y2, y3), pack2(y4, y5), pack2(y6, y7));
                } else {
                    float* d = xout + o0 + (size_t)i * 16 * DM;
                    __builtin_nontemporal_store((f32x4){y0, y1, y2, y3}, (f32x4*)d);
                    __builtin_nontemporal_store((f32x4){y4, y5, y6, y7}, (f32x4*)(d + 4));
                }
            }
        }
    }
    if (l == 0) {
        for (int j = blockIdx.x; j < 64; j += gridDim.x) {
            const int kh = j & 1, tn = (j >> 1) & 7, tm = 128 + (j >> 4);
            f32x4 acc[4][4];
            gemm_core_dma(cat + (size_t)tm * 128 * DM + kh * 512, DM, W + (size_t)tn * 128 * DM + kh * 512, DM, 512, acc, smem);
            stage_acc(acc, st);
            float* part = (float*)(p.ws + (kh ? OFF_XC1B : OFF_XC1));
            const int c8 = (tid & 15) * 8, r0 = tid >> 4;
            float gt[8];
            ld8(modv + 2 * 3072 + 2048 + tn * 128 + c8, gt);
#pragma unroll
            for (int i = 0; i < 8; ++i) {
                float a[8];
                ld8(st + (r0 + 16 * i) * ST_LD + c8, a);
                float* d = part + (size_t)(tm * 128 - ROWS_L + r0 + 16 * i) * DM + tn * 128 + c8;
                *(float4*)(d) = make_float4(gt[0] * a[0], gt[1] * a[1], gt[2] * a[2], gt[3] * a[3]);
                *(float4*)(d + 4) = make_float4(gt[4] * a[4], gt[5] * a[5], gt[6] * a[6], gt[7] * a[7]);
            }
        }
    }
}

#ifndef PH_MASK
#define PH_MASK 0xFFFF
#endif
#ifndef PH_DUP
#define PH_DUP 0
#endif
__global__ void __launch_bounds__(256, 2) fwd_megakernel(Params p) {
    __shared__ __attribute__((aligned(16))) unsigned char smem_raw[SMEM_BYTES];
    bf16_t* smem = (bf16_t*)smem_raw;
    float* smf = (float*)smem_raw;
    volatile LAS unsigned* stw = (volatile LAS unsigned*)(smem_raw + SMEM_MAIN);
    if (threadIdx.x == 0) { stw[0] = 0u; stw[1] = 0u; stw[2] = 0u; stw[3] = 0u; }
    __syncthreads();
    if (p.never) cg::this_grid().sync();
    XcdBarrier bar = xcd_barrier_post((unsigned*)(p.ws + OFF_BAR), stw);

    if (PH_MASK & 1) phase0(p, smf);
    if (PH_DUP & 1) phase0(p, smf);
    xcd_barrier(bar);
    float* xc1 = (float*)(p.ws + OFF_XC1);
    for (int l = 0; l < 2; ++l) {
        const float* xl_in = (l == 0) ? p.x : p.out;
        const float* xc_in = p.ctx;
        if (PH_MASK & 2) phase_norm(p, l, xl_in, xc_in, (l == 1) ? (const bf16_t*)(p.ws + OFF_X1B) : nullptr);
        xcd_barrier(bar);
        if (PH_MASK & 4) phase_inproj(p, l, smem);
        if (PH_DUP & 4) phase_inproj(p, l, smem);
        xcd_barrier(bar);
        if (PH_MASK & 8) phase_attn(p, l, smem);
        if (PH_DUP & 8) phase_attn(p, l, smem);
        if (PH_MASK & 16) phase_convpool(p, l);
        if (PH_DUP & 16) phase_convpool(p, l);
        if (PH_MASK & 32) phase_dft1(p, l, smem);
        if (PH_DUP & 32) phase_dft1(p, l, smem);
        xcd_barrier(bar);
        if (PH_MASK & 64) phase_dft2_mixp(p, l, smem, 0, 512, 0, gridDim.x);
        xcd_barrier(bar);
        {
            const int nmix = (l == 0 ? ROWS : ROWS_L) / 64;
            const int b0 = ((int)gridDim.x > nmix) ? nmix : 0;
            if (PH_MASK & 128) phase_mixf(p, l, smem);
            if (PH_MASK & 64) phase_dft2_mixp(p, l, smem, 512, 512 + nmix, b0, (int)gridDim.x - b0);
        }
        xcd_barrier(bar);
        if (PH_MASK & 256) phase_out(p, l, xl_in, xc_in, p.out, xc1, smem);
        if (PH_DUP & 256) phase_out(p, l, xl_in, xc_in, (float*)(p.ws + OFF_G1), (float*)(p.ws + OFF_G1), smem);
        if (l == 0) xcd_barrier(bar);
    }
}

extern "C" void kernel_launch(void* const* d_in, const int* in_sizes, int n_in, void* d_out, int out_size, void* d_ws, size_t ws_size, hipStream_t stream) {
    static int grid_blocks = 0;
    if (!grid_blocks) {
        int dev = 0, cus = 0, per_cu = 0;
        hipGetDevice(&dev);
        hipDeviceGetAttribute(&cus, hipDeviceAttributeMultiprocessorCount, dev);
        hipOccupancyMaxActiveBlocksPerMultiprocessor(&per_cu, fwd_megakernel, 256, 0);
        if (per_cu > 2) per_cu = 2;
        if (per_cu < 1) per_cu = 1;
        grid_blocks = cus * per_cu;
        if (ws_size < WS_END) fprintf(stderr, "kernel_launch: workspace too small: %zu < %zu\n", ws_size, (size_t)WS_END);
    }
    hipMemsetAsync((char*)d_ws + OFF_BAR, 0, 16384, stream);
    Params p{};
    p.x = (const float*)d_in[0]; p.c = (const float*)d_in[1]; p.ctx = (const float*)d_in[2]; p.c_ctx = (const float*)d_in[3];
    p.w_mod = (const float*)d_in[4]; p.b_mod = (const float*)d_in[5]; p.norm_g = (const float*)d_in[6]; p.w_in = (const float*)d_in[7];
    p.q_gain = (const float*)d_in[8]; p.k_gain = (const float*)d_in[9]; p.w_fourier = (const float*)d_in[10]; p.conv_w = (const float*)d_in[11];
    p.conv_b = (const float*)d_in[12]; p.pool_w = (const float*)d_in[13]; p.pool_scale = (const float*)d_in[14]; p.w_out = (const float*)d_in[15];
    p.out = (float*)d_out; p.ws = (unsigned char*)d_ws; p.never = 0; p.pad = 0;
    void* args[] = {&p};
    hipError_t e = hipLaunchCooperativeKernel((void*)fwd_megakernel, dim3(grid_blocks), dim3(256), args, 0, stream);
    if (e != hipSuccess) fprintf(stderr, "cooperative launch failed: %s (grid %d)\n", hipGetErrorString(e), grid_blocks);
}
```
